# Optimizing an MI355X kernel written in HIP

```python
import math
import jax, jax.numpy as jnp
from jax import lax
import numpy as np

D_MODEL = 1024
BATCH = 8
SEQ = 2048
DEPTH = 2

MEM_TOKENS = 256
HEAD_DIM = 64
MIX_WIDTH = D_MODEL
MEM_HEADS = 4
MEM_WIDTH = MEM_HEADS * HEAD_DIM
MAIN_WIDTH = MIX_WIDTH - MEM_WIDTH
S5_GROUP_DIM = 16
S5_GROUPS = MAIN_WIDTH // S5_GROUP_DIM
S5_STATE = 64
S5_DT_MIN = 0.001
S5_DT_MAX = 0.1
MOBA_HEADS = MAIN_WIDTH // HEAD_DIM
MOBA_KV_HEADS = 4
MOBA_GROUP = MOBA_HEADS // MOBA_KV_HEADS
KV_WIDTH = MOBA_KV_HEADS * HEAD_DIM
MOBA_BLOCK = 256
MOBA_TOP_BLOCKS = 3
MOBA_Q_CHUNK = 16
D_FF_DENSE = 256 * ((8 * D_MODEL // 3 + 255) // 256)
N_EXPERTS = 8
TOP_K = 2
D_FF_EXPERT = 7 * D_MODEL // 2
N_A_LAYERS = DEPTH // 2
RMS_EPS = 1e-6
NEG_INF = -1e30

kernel_name = "yoco_s5_moba_mem_moe_trunk"


def rms_norm(x, g):
    xf = x.astype(jnp.float32)
    y = xf * lax.rsqrt(jnp.mean(xf * xf, axis=-1, keepdims=True) + RMS_EPS)
    return (y * g.astype(jnp.float32)).astype(x.dtype)


def s5_mixer(u, lam_re, lam_im, log_dt, b_re, b_im, c_re, c_im, d_skip, w_glu, b_glu):
    f32 = jnp.float32
    bsz, s, _ = u.shape
    uf = u.astype(f32).reshape(bsz, s, S5_GROUPS, S5_GROUP_DIM)
    lam = lax.complex(lam_re.astype(f32), lam_im.astype(f32))
    dt = jnp.exp(log_dt.astype(f32))[:, None]
    lam_bar = jnp.exp(lam * dt)
    b = lax.complex(b_re.astype(f32), b_im.astype(f32))
    b_bar = ((lam_bar - 1.0) / lam)[..., None] * b
    bu = jnp.einsum('gpn,bsgn->bsgp', b_bar, uf)
    a = jnp.broadcast_to(lam_bar, bu.shape)

    def combine(left, right):
        a_l, b_l = left
        a_r, b_r = right
        return a_r * a_l, a_r * b_l + b_r

    _, states = lax.associative_scan(combine, (a, bu), axis=1)
    c = lax.complex(c_re.astype(f32), c_im.astype(f32))
    y = jnp.einsum('gnp,bsgp->bsgn', c, states).real \
        + d_skip.astype(f32).reshape(S5_GROUPS, S5_GROUP_DIM) * uf
    y = y.reshape(bsz, s, MAIN_WIDTH)
    g = jax.nn.gelu(y)
    out = g * jax.nn.sigmoid(g @ w_glu.astype(f32) + b_glu.astype(f32))
    return out.astype(u.dtype)


def memory_attention(q, mem, mem_norm, w_mem_k, w_mem_v, q_gain, k_gain):
    bsz, s, _ = q.shape
    mem_n = rms_norm(mem, mem_norm)
    qh = rms_norm(q.reshape(bsz, s, MEM_HEADS, HEAD_DIM), q_gain)
    kh = rms_norm((mem_n @ w_mem_k).reshape(bsz, MEM_TOKENS, MEM_HEADS, HEAD_DIM), k_gain)
    vh = (mem_n @ w_mem_v).reshape(bsz, MEM_TOKENS, MEM_HEADS, HEAD_DIM)
    logits = jnp.einsum('bshd,bmhd->bhsm', qh, kh).astype(jnp.float32) * (HEAD_DIM ** -0.5)
    p = jax.nn.softmax(logits, axis=-1).astype(vh.dtype)
    o = jnp.einsum('bhsm,bmhd->bshd', p, vh)
    return o.reshape(bsz, s, MEM_WIDTH)


def shared_kv(h, kv_norm, w_k, w_v, k_gain):
    bsz, s, _ = h.shape
    hn = rms_norm(h, kv_norm)
    k = rms_norm((hn @ w_k).reshape(bsz, s, MOBA_KV_HEADS, HEAD_DIM), k_gain)
    v = (hn @ w_v).reshape(bsz, s, MOBA_KV_HEADS, HEAD_DIM)
    nb = -(-s // MOBA_BLOCK)
    pad = nb * MOBA_BLOCK - s
    k = jnp.pad(k, ((0, 0), (0, pad), (0, 0), (0, 0)))
    v = jnp.pad(v, ((0, 0), (0, pad), (0, 0), (0, 0)))
    k_blocks = k.reshape(bsz, nb, MOBA_BLOCK, MOBA_KV_HEADS, HEAD_DIM).transpose(0, 3, 1, 2, 4)
    v_blocks = v.reshape(bsz, nb, MOBA_BLOCK, MOBA_KV_HEADS, HEAD_DIM).transpose(0, 3, 1, 2, 4)
    k_means = jnp.mean(k_blocks.astype(jnp.float32), axis=3).astype(k.dtype)
    return k_blocks, v_blocks, k_means


def moba_attention(q, k_blocks, v_blocks, k_means, q_gain):
    bsz, s, _ = q.shape
    nb = k_blocks.shape[2]
    k_sel = min(MOBA_TOP_BLOCKS, nb)
    n_chunks = s // MOBA_Q_CHUNK
    scale = HEAD_DIM ** -0.5
    qh = rms_norm(q.reshape(bsz, s, MOBA_HEADS, HEAD_DIM), q_gain)
    qh = qh.reshape(bsz, s, MOBA_KV_HEADS, MOBA_GROUP, HEAD_DIM)
    b_idx = jnp.arange(bsz)[:, None, None, None, None]
    h_idx = jnp.arange(MOBA_KV_HEADS)[None, :, None, None, None]
    blk_ids = jnp.arange(nb)
    slot_ids = jnp.arange(k_sel)

    def chunk(ci):
        start = ci * MOBA_Q_CHUNK
        qc = lax.dynamic_slice_in_dim(qh, start, MOBA_Q_CHUNK, axis=1)
        blk = start // MOBA_BLOCK
        gate = jnp.einsum('bqkgd,bknd->bkgqn', qc, k_means).astype(jnp.float32)
        gate = jnp.where(blk_ids < blk, gate, NEG_INF)
        _, top_i = lax.top_k(gate, k_sel)
        valid = slot_ids < blk
        ks = k_blocks[b_idx, h_idx, top_i]
        vs = v_blocks[b_idx, h_idx, top_i]
        s_sel = jnp.einsum('bqkgd,bkgqnjd->bkgqnj', qc, ks).astype(jnp.float32) * scale
        s_sel = jnp.where(valid[:, None], s_sel, NEG_INF)
        k_own = lax.dynamic_index_in_dim(k_blocks, blk, axis=2, keepdims=False)
        v_own = lax.dynamic_index_in_dim(v_blocks, blk, axis=2, keepdims=False)
        s_own = jnp.einsum('bqkgd,bkjd->bkgqj', qc, k_own).astype(jnp.float32) * scale
        q_pos = start + jnp.arange(MOBA_Q_CHUNK)
        k_pos = blk * MOBA_BLOCK + jnp.arange(MOBA_BLOCK)
        s_own = jnp.where(k_pos[None, :] <= q_pos[:, None], s_own, NEG_INF)
        logits = jnp.concatenate(
            [s_sel.reshape(bsz, MOBA_KV_HEADS, MOBA_GROUP, MOBA_Q_CHUNK, k_sel * MOBA_BLOCK), s_own],
            axis=-1)
        p = jax.nn.softmax(logits, axis=-1).astype(vs.dtype)
        p_sel = p[..., :k_sel * MOBA_BLOCK].reshape(
            bsz, MOBA_KV_HEADS, MOBA_GROUP, MOBA_Q_CHUNK, k_sel, MOBA_BLOCK)
        p_own = p[..., k_sel * MOBA_BLOCK:]
        o = jnp.einsum('bkgqnj,bkgqnjd->bqkgd', p_sel, vs) \
            + jnp.einsum('bkgqj,bkjd->bqkgd', p_own, v_own)
        return o

    outs = lax.map(chunk, jnp.arange(n_chunks))
    return outs.transpose(1, 0, 2, 3, 4, 5).reshape(bsz, s, MAIN_WIDTH)


def swiglu(h, w_gate, w_up, w_down):
    return (jax.nn.silu(h @ w_gate) * (h @ w_up)) @ w_down


def moe_swiglu(h, w_router, w_gate, w_up, w_down):
    bsz, s, d = h.shape
    t = bsz * s
    ht = h.reshape(t, d)
    logits = (ht @ w_router).astype(jnp.float32)
    top_vals, top_idx = lax.top_k(logits, TOP_K)
    gates = jax.nn.softmax(top_vals, axis=-1)
    flat_e = top_idx.reshape(-1)
    order = jnp.argsort(flat_e)
    tok = order // TOP_K
    xs = ht[tok]
    group_sizes = jnp.bincount(flat_e, length=N_EXPERTS).astype(jnp.int32)
    g = lax.ragged_dot(xs, w_gate, group_sizes)
    u = lax.ragged_dot(xs, w_up, group_sizes)
    y = lax.ragged_dot(jax.nn.silu(g) * u, w_down, group_sizes)
    y = y * gates.reshape(-1)[order][:, None].astype(y.dtype)
    out = jax.ops.segment_sum(y, tok, num_segments=t)
    return out.reshape(bsz, s, d)


def setup_inputs(seed: int = 0) -> dict:
    key = jax.random.key(seed)
    keys = iter(jax.random.split(key, 64))
    f32 = jnp.float32

    def normal(shape, scale):
        return scale * jax.random.normal(next(keys), shape, f32)

    def gain(n):
        return 1.0 + normal((n,), 0.02)

    n_idx = jnp.arange(S5_STATE, dtype=f32)[None, :]
    inp = {}
    inp["x"] = normal((BATCH, SEQ, D_MODEL), 1.0)
    inp["mem"] = normal((BATCH, MEM_TOKENS, D_MODEL), 1.0)
    inp["l0_mix_norm"] = gain(D_MODEL)
    inp["l0_w_in"] = normal((D_MODEL, MIX_WIDTH), D_MODEL ** -0.5)
    inp["l0_s5_lam_re"] = -0.5 + normal((S5_GROUPS, S5_STATE), 0.01)
    inp["l0_s5_lam_im"] = math.pi * n_idx + normal((S5_GROUPS, S5_STATE), 0.01)
    inp["l0_s5_log_dt"] = jax.random.uniform(next(keys), (S5_GROUPS,), f32,
                                             math.log(S5_DT_MIN), math.log(S5_DT_MAX))
    inp["l0_s5_b_re"] = normal((S5_GROUPS, S5_STATE, S5_GROUP_DIM), (2 * S5_GROUP_DIM) ** -0.5)
    inp["l0_s5_b_im"] = normal((S5_GROUPS, S5_STATE, S5_GROUP_DIM), (2 * S5_GROUP_DIM) ** -0.5)
    inp["l0_s5_c_re"] = normal((S5_GROUPS, S5_GROUP_DIM, S5_STATE), S5_STATE ** -0.5)
    inp["l0_s5_c_im"] = normal((S5_GROUPS, S5_GROUP_DIM, S5_STATE), S5_STATE ** -0.5)
    inp["l0_s5_d"] = normal((MAIN_WIDTH,), 1.0)
    inp["l0_s5_w_glu"] = normal((MAIN_WIDTH, MAIN_WIDTH), MAIN_WIDTH ** -0.5)
    inp["l0_s5_b_glu"] = normal((MAIN_WIDTH,), 0.01)
    inp["l0_mem_norm"] = gain(D_MODEL)
    inp["l0_w_mem_k"] = normal((D_MODEL, MEM_WIDTH), D_MODEL ** -0.5)
    inp["l0_w_mem_v"] = normal((D_MODEL, MEM_WIDTH), D_MODEL ** -0.5)
    inp["l0_mem_q_gain"] = gain(HEAD_DIM)
    inp["l0_mem_k_gain"] = gain(HEAD_DIM)
    inp["l0_w_out"] = normal((MIX_WIDTH, D_MODEL), MIX_WIDTH ** -0.5)
    inp["l0_ffn_norm"] = gain(D_MODEL)
    inp["l0_ffn_w_gate"] = normal((D_MODEL, D_FF_DENSE), D_MODEL ** -0.5)
    inp["l0_ffn_w_up"] = normal((D_MODEL, D_FF_DENSE), D_MODEL ** -0.5)
    inp["l0_ffn_w_down"] = normal((D_FF_DENSE, D_MODEL), D_FF_DENSE ** -0.5)
    inp["kv_norm"] = gain(D_MODEL)
    inp["kv_w_k"] = normal((D_MODEL, KV_WIDTH), D_MODEL ** -0.5)
    inp["kv_w_v"] = normal((D_MODEL, KV_WIDTH), D_MODEL ** -0.5)
    inp["kv_k_gain"] = gain(HEAD_DIM)
    inp["l1_mix_norm"] = gain(D_MODEL)
    inp["l1_w_in"] = normal((D_MODEL, MIX_WIDTH), D_MODEL ** -0.5)
    inp["l1_moba_q_gain"] = gain(HEAD_DIM)
    inp["l1_mem_norm"] = gain(D_MODEL)
    inp["l1_w_mem_k"] = normal((D_MODEL, MEM_WIDTH), D_MODEL ** -0.5)
    inp["l1_w_mem_v"] = normal((D_MODEL, MEM_WIDTH), D_MODEL ** -0.5)
    inp["l1_mem_q_gain"] = gain(HEAD_DIM)
    inp["l1_mem_k_gain"] = gain(HEAD_DIM)
    inp["l1_w_out"] = normal((MIX_WIDTH, D_MODEL), MIX_WIDTH ** -0.5)
    inp["l1_ffn_norm"] = gain(D_MODEL)
    inp["l1_moe_router"] = normal((D_MODEL, N_EXPERTS), D_MODEL ** -0.5)
    inp["l1_moe_w_gate"] = normal((N_EXPERTS, D_MODEL, D_FF_EXPERT), D_MODEL ** -0.5)
    inp["l1_moe_w_up"] = normal((N_EXPERTS, D_MODEL, D_FF_EXPERT), D_MODEL ** -0.5)
    inp["l1_moe_w_down"] = normal((N_EXPERTS, D_FF_EXPERT, D_MODEL), D_FF_EXPERT ** -0.5)
    return inp


def reference(x, mem,
              l0_mix_norm, l0_w_in, l0_s5_lam_re, l0_s5_lam_im, l0_s5_log_dt,
              l0_s5_b_re, l0_s5_b_im, l0_s5_c_re, l0_s5_c_im, l0_s5_d, l0_s5_w_glu, l0_s5_b_glu,
              l0_mem_norm, l0_w_mem_k, l0_w_mem_v, l0_mem_q_gain, l0_mem_k_gain,
              l0_w_out, l0_ffn_norm, l0_ffn_w_gate, l0_ffn_w_up, l0_ffn_w_down,
              kv_norm, kv_w_k, kv_w_v, kv_k_gain,
              l1_mix_norm, l1_w_in, l1_moba_q_gain,
              l1_mem_norm, l1_w_mem_k, l1_w_mem_v, l1_mem_q_gain, l1_mem_k_gain,
              l1_w_out, l1_ffn_norm, l1_moe_router, l1_moe_w_gate, l1_moe_w_up, l1_moe_w_down):
    layers = [
        dict(mix_norm=l0_mix_norm, w_in=l0_w_in,
             main=(l0_s5_lam_re, l0_s5_lam_im, l0_s5_log_dt, l0_s5_b_re, l0_s5_b_im,
                   l0_s5_c_re, l0_s5_c_im, l0_s5_d, l0_s5_w_glu, l0_s5_b_glu),
             mem=(l0_mem_norm, l0_w_mem_k, l0_w_mem_v, l0_mem_q_gain, l0_mem_k_gain),
             w_out=l0_w_out, ffn_norm=l0_ffn_norm,
             ffn=(l0_ffn_w_gate, l0_ffn_w_up, l0_ffn_w_down)),
        dict(mix_norm=l1_mix_norm, w_in=l1_w_in,
             main=(l1_moba_q_gain,),
             mem=(l1_mem_norm, l1_w_mem_k, l1_w_mem_v, l1_mem_q_gain, l1_mem_k_gain),
             w_out=l1_w_out, ffn_norm=l1_ffn_norm,
             ffn=(l1_moe_router, l1_moe_w_gate, l1_moe_w_up, l1_moe_w_down)),
    ]
    kv = None
    for i in range(DEPTH):
        p = layers[i]
        h = rms_norm(x, p["mix_norm"])
        proj = h @ p["w_in"]
        main_in = proj[..., :MAIN_WIDTH]
        q_mem = proj[..., MAIN_WIDTH:]
        if i < N_A_LAYERS:
            main = s5_mixer(main_in, *p["main"])
        else:
            if kv is None:
                kv = shared_kv(x, kv_norm, kv_w_k, kv_w_v, kv_k_gain)
            main = moba_attention(main_in, *kv, *p["main"])
        mem_out = memory_attention(q_mem, mem, *p["mem"])
        x = x + jnp.concatenate([main, mem_out], axis=-1) @ p["w_out"]
        h = rms_norm(x, p["ffn_norm"])
        if i % 2 == 0:
            x = x + swiglu(h, *p["ffn"])
        else:
            x = x + moe_swiglu(h, *p["ffn"])
    return x
```

```cpp
#include <hip/hip_runtime.h>
#include <cstdio>
#include <cstdint>

namespace pg8 {
#define PG8_LAS __attribute__((address_space(3)))
typedef unsigned short bf16_t;
typedef short bf16x8 __attribute__((ext_vector_type(8)));
typedef float f32x4 __attribute__((ext_vector_type(4)));
typedef unsigned u32x4 __attribute__((ext_vector_type(4)));
constexpr int BM = 256, BK = 64, HALF = 128, HTB = HALF * BK * 2  , STAGE_BYTES = 8 * HTB, NXCD = 8, WGM = 4;

__host__ __device__ __forceinline__ int lds_byte(int r, int c) { const int st = (r >> 4) * 2 + (c >> 5), rr = r & 15, cc = c & 31, ob = rr * 64 + cc * 2; return st * 1024 + (ob ^ (((ob >> 9) & 1) << 5)); }
__host__ __device__ __forceinline__ void stage_rc(int b, int& R, int& C) { const int st = b / 1024, sb = b % 1024, swz = sb ^ (((sb >> 9) & 1) << 5); R = (st >> 1) * 16 + swz / 64; C = (st & 1) * 32 + (swz % 64) / 2; }
__host__ __device__ __forceinline__ int perm32(int rho) { const int n = rho >> 4, i = rho & 15; return 8 * (i >> 2) + 4 * n + (i & 3); }

struct Unit { int pm, pn; int k0, nk, part; };
struct Gemm { const bf16_t* A; const bf16_t* Bt; int lda, ldb, K; int amode = 0; };

struct StaticOrder {
    static constexpr bool STREAMK = false;
    int nM, nN, nwg, G, c;
    __host__ __device__ __forceinline__ void init(int nM_, int nN_, int G_, int c_) { nM = nM_; nN = nN_; nwg = nM * nN; G = G_; c = c_; }
    __host__ __device__ __forceinline__ bool next(int i, Unit& u) const {
        const long L = (long)i * G + c; if (L >= nwg || c >= G) return false;
        u.k0 = 0; u.nk = 0; u.part = 0; map((int)L, u); return true;
    }
    __host__ __device__ __forceinline__ void map(int L, Unit& u) const {
        int wgid = L; { const int q = nwg / NXCD, r = nwg % NXCD, xcd = wgid % NXCD, off = wgid / NXCD; wgid = (xcd < r ? xcd * (q + 1) : r * (q + 1) + (xcd - r) * q) + off; }
        const int nig = WGM * nN, gid = wgid / nig, fm = gid * WGM, gsz = (nM - fm) < WGM ? (nM - fm) : WGM;
        u.pm = fm + ((wgid % nig) % gsz); u.pn = (wgid % nig) / gsz;
    }
};
struct RangeOrder {
    static constexpr bool STREAMK = false;
    StaticOrder S; int i0, i1;
    __host__ __device__ __forceinline__ bool next(int i, Unit& u) const { return (i0 + i < i1) && S.next(i0 + i, u); }
};
struct BatchOrder {
    static constexpr bool STREAMK = false;
    int nunits, tm, tn, G, c;
    __host__ __device__ __forceinline__ void init(int nb, int tm_, int tn_, int G_, int c_) { tm = tm_; tn = tn_; nunits = nb * tm * tn; G = G_; c = c_; }
    __host__ __device__ __forceinline__ bool next(int i, Unit& u) const {
        const int L = i * G + c; if (L >= nunits || c >= G) return false;
        const int b = L / (tm * tn), r = L % (tm * tn); u.pm = b * tm + r / tn; u.pn = b * tn + r % tn; u.k0 = 0; u.nk = 0; u.part = 0; return true;
    }
};
struct GroupOrder {
    static constexpr bool STREAMK = false;
    StaticOrder S; int npe; int pe[8];
    __host__ __device__ __forceinline__ bool next(int i, Unit& u) const {
        if (!S.next(i, u)) return false;
        int e = 0;
#pragma unroll
        for (int k = 0; k < 7; ++k) e += (u.pm >= pe[k]) ? 1 : 0;
        u.pn += e * npe; return true;
    }
};

typedef float f32x2_t __attribute__((ext_vector_type(2))); typedef __bf16 bf16x2_t __attribute__((ext_vector_type(2)));
struct GroupStream {
    static constexpr bool STREAMK = true;
    const PG8_LAS unsigned* tab;
    __device__ __forceinline__ int c() const { return (int)tab[11]; }
    __device__ __forceinline__ int split() const { return (int)tab[9]; }
    __device__ __forceinline__ unsigned target() const { return tab[12]; }
    __device__ __forceinline__ unsigned long long* slots() const { return (unsigned long long*)(((unsigned long long)tab[17] << 32) | tab[16]); }
    __device__ __forceinline__ unsigned* flags() const { return (unsigned*)(((unsigned long long)tab[19] << 32) | tab[18]); }
    __device__ __forceinline__ bool next(int i, Unit& u) const {
        const int nunits = (int)tab[8], sp = (int)tab[9], npe = (int)tab[13], ntk = (int)tab[14], G = (int)tab[15], c_ = (int)tab[11];
        int L, k0 = 0, nk = ntk, part = 0;
        if (i == 0) { L = c_; if (L >= nunits) return false; }
        else if (i == 1) { const int j = c_ / sp, p = c_ % sp; L = G + j; if (L >= nunits) return false; const int base = (ntk / sp) & ~1, xh = (ntk - sp * base) >> 1; nk = base + (p < xh ? 2 : 0); k0 = p * base + 2 * (p < xh ? p : xh); part = (sp == 1) ? 0 : (p == 0 ? 1 : 2); }
        else return false;
        StaticOrder S; S.init((int)tab[10], npe, 1, 0); S.map(L, u); int e = 0;
#pragma unroll
        for (int k = 0; k < 7; ++k) e += (u.pm >= (int)tab[k]) ? 1 : 0;
        u.pn += e * npe; u.k0 = k0; u.nk = nk; u.part = part; return true;
    }
};
constexpr int SK_SLOT_WORDS = 32 * 512;

__device__ __forceinline__ unsigned cvt_pk_bf16(float lo, float hi) { f32x2_t v = {lo, hi}; bf16x2_t b = __builtin_convertvector(v, bf16x2_t); return __builtin_bit_cast(unsigned, b); }
__device__ __forceinline__ float bf_lo(unsigned w) { return __builtin_bit_cast(float, w << 16); }
__device__ __forceinline__ float bf_hi(unsigned w) { return __builtin_bit_cast(float, w & 0xffff0000u); }
__device__ __forceinline__ float fsigmoid(float x) { return __builtin_amdgcn_rcpf(1.f + __builtin_amdgcn_exp2f(-1.4426950408889634f * x)); }
__device__ __forceinline__ float gelu_tanh(float y) { const float z = 0.7978845608028654f * (y + 0.044715f * y * y * y); return y * fsigmoid(2.f * z); }

#define EPI_LOOP_ROWS for (int ai = 0; ai < 2; ++ai) _Pragma("unroll") for (int m = 0; m < 4; ++m)
__device__ __forceinline__ u32x4 pack8(const f32x4& v0, const f32x4& v1) { u32x4 w; w.x = cvt_pk_bf16(v0[0], v0[1]); w.y = cvt_pk_bf16(v0[2], v0[3]); w.z = cvt_pk_bf16(v1[0], v1[1]); w.w = cvt_pk_bf16(v1[2], v1[3]); return w; }

__device__ __forceinline__ float rs_row(const float* SS, int row) {
    const f32x4 a = *(const f32x4*)(SS + (size_t)row * 16), b = *(const f32x4*)(SS + (size_t)row * 16 + 4), c = *(const f32x4*)(SS + (size_t)row * 16 + 8), d = *(const f32x4*)(SS + (size_t)row * 16 + 12);
    const float s = ((a[0] + a[1]) + (a[2] + a[3])) + ((b[0] + b[1]) + (b[2] + b[3])) + ((c[0] + c[1]) + (c[2] + c[3])) + ((d[0] + d[1]) + (d[2] + d[3]));
    return 1.f / __builtin_sqrtf(s * (1.f / 1024.f) + 1e-6f);
}
template <int SCALE  > struct EpiPlainS {
    static constexpr bool PERM = true, AFTER_DRAIN = false;
    bf16_t* O; int ldc; int pm0, pn0; const float* SS; float inv;
    __device__ __forceinline__ void operator()(const f32x4 (&acc)[2][2][4][2], const Unit& u, int wr, int wc, int fr, int fq) const {
        const int row0 = (u.pm - pm0) * BM + wr * 64 + fr, col0 = (u.pn - pn0) * BM + wc * 32 + 8 * fq;
        float cs[2][8];
        if (SCALE == 2) {
#pragma unroll
            for (int bj = 0; bj < 2; ++bj)
#pragma unroll
                for (int e = 0; e < 8; ++e) cs[bj][e] = rs_row(SS, u.pn * BM + bj * HALF + wc * 32 + 8 * fq + e) * inv; }
#pragma unroll
        EPI_LOOP_ROWS { bf16_t* rowp = O + (size_t)(row0 + ai * HALF + m * 16) * ldc + col0; float rs = 1.f; if (SCALE == 1) rs = rs_row(SS, u.pm * BM + wr * 64 + fr + ai * HALF + m * 16) * inv;
#pragma unroll
            for (int bj = 0; bj < 2; ++bj) { f32x4 v0 = acc[ai][bj][m][0], v1 = acc[ai][bj][m][1];
                if (SCALE == 1) { v0 = v0 * rs; v1 = v1 * rs; }
                if (SCALE == 2) { v0 = v0 * (f32x4){cs[bj][0], cs[bj][1], cs[bj][2], cs[bj][3]}; v1 = v1 * (f32x4){cs[bj][4], cs[bj][5], cs[bj][6], cs[bj][7]}; }
                *(u32x4*)(rowp + bj * HALF) = pack8(v0, v1); } }
    }
};
struct EpiPlain {
    static constexpr bool PERM = true, AFTER_DRAIN = false;
    bf16_t* O; int ldc; int pm0, pn0;
    __device__ __forceinline__ void operator()(const f32x4 (&acc)[2][2][4][2], const Unit& u, int wr, int wc, int fr, int fq) const {
        const int row0 = (u.pm - pm0) * BM + wr * 64 + fr, col0 = (u.pn - pn0) * BM + wc * 32 + 8 * fq;
#pragma unroll
        EPI_LOOP_ROWS { bf16_t* rowp = O + (size_t)(row0 + ai * HALF + m * 16) * ldc + col0;
#pragma unroll
            for (int bj = 0; bj < 2; ++bj) *(u32x4*)(rowp + bj * HALF) = pack8(acc[ai][bj][m][0], acc[ai][bj][m][1]); }
    }
};
struct EpiProj0 {
    static constexpr bool PERM = true, AFTER_DRAIN = false;
    bf16_t* UG; bf16_t* QM;
    __device__ __forceinline__ void operator()(const f32x4 (&acc)[2][2][4][2], const Unit& u, int wr, int wc, int fr, int fq) const {
        const int row0 = u.pm * BM + wr * 64 + fr;
#pragma unroll
        EPI_LOOP_ROWS { const int t = row0 + ai * HALF + m * 16;
#pragma unroll
            for (int bj = 0; bj < 2; ++bj) { const int c = u.pn * BM + bj * HALF + wc * 32 + 8 * fq; bf16_t* p;
                if (u.pn < 3) p = UG + ((size_t)((c >> 4) * 512 + (t >> 5))) * 640 + (t & 31) * 16 + (c & 15); else p = QM + (size_t)t * 256 + (c - 768);
                *(u32x4*)p = pack8(acc[ai][bj][m][0], acc[ai][bj][m][1]); } }
    }
};
struct EpiS5a {
    static constexpr bool PERM = true, AFTER_DRAIN = false;
    float* XC;
    __device__ __forceinline__ void operator()(const f32x4 (&acc)[2][2][4][2], const Unit& u, int wr, int wc, int fr, int fq) const {
        const int row0 = u.pm * BM + wr * 64 + fr, col0 = wc * 32 + 8 * fq;
#pragma unroll
        EPI_LOOP_ROWS { float* rowp = XC + (size_t)(row0 + ai * HALF + m * 16) * 128 + col0; *(f32x4*)rowp = acc[ai][0][m][0]; *(f32x4*)(rowp + 4) = acc[ai][0][m][1]; }
    }
};
struct EpiS5c {
    static constexpr bool PERM = true, AFTER_DRAIN = false;
    const bf16_t* UG; const float* dskip; bf16_t* GACT;
    __device__ __forceinline__ void operator()(const f32x4 (&acc)[2][2][4][2], const Unit& u, int wr, int wc, int fr, int fq) const {
        const int row0 = u.pm * BM + wr * 64 + fr, g = u.pm >> 1;
#pragma unroll
        for (int bj = 0; bj < 2; ++bj) { const int col8 = (u.pn & 1) * BM + bj * HALF + wc * 32 + 8 * fq, j = col8 >> 4, nb = col8 & 15;
            const f32x4 d0 = *(const f32x4*)(dskip + g * 16 + nb), d1 = *(const f32x4*)(dskip + g * 16 + nb + 4);
#pragma unroll
            EPI_LOOP_ROWS { const int R = row0 + ai * HALF + m * 16, chunk = R & 511, t = chunk * 32 + j;
                const u32x4 uu = *(const u32x4*)(UG + (size_t)R * 640 + j * 16 + nb);
                f32x4 v0 = acc[ai][bj][m][0], v1 = acc[ai][bj][m][1];
                v0[0] = gelu_tanh(v0[0] + d0[0] * bf_lo(uu.x)); v0[1] = gelu_tanh(v0[1] + d0[1] * bf_hi(uu.x)); v0[2] = gelu_tanh(v0[2] + d0[2] * bf_lo(uu.y)); v0[3] = gelu_tanh(v0[3] + d0[3] * bf_hi(uu.y));
                v1[0] = gelu_tanh(v1[0] + d1[0] * bf_lo(uu.z)); v1[1] = gelu_tanh(v1[1] + d1[1] * bf_hi(uu.z)); v1[2] = gelu_tanh(v1[2] + d1[2] * bf_lo(uu.w)); v1[3] = gelu_tanh(v1[3] + d1[3] * bf_hi(uu.w));
                *(u32x4*)(GACT + ((size_t)g * 16384 + t) * 16 + nb) = pack8(v0, v1); } }
    }
};
struct EpiGlu {
    static constexpr bool PERM = true, AFTER_DRAIN = false;
    const bf16_t* GACT; const float* bias; bf16_t* CAT;
    __device__ __forceinline__ void operator()(const f32x4 (&acc)[2][2][4][2], const Unit& u, int wr, int wc, int fr, int fq) const {
        const int row0 = u.pm * BM + wr * 64 + fr;
#pragma unroll
        for (int bj = 0; bj < 2; ++bj) { const int c = u.pn * BM + bj * HALF + wc * 32 + 8 * fq;
            const f32x4 b0 = *(const f32x4*)(bias + c), b1 = *(const f32x4*)(bias + c + 4);
#pragma unroll
            EPI_LOOP_ROWS { const int t = row0 + ai * HALF + m * 16;
                const u32x4 gg = *(const u32x4*)(GACT + ((size_t)(c >> 4) * 16384 + t) * 16 + (c & 15));
                f32x4 v0 = acc[ai][bj][m][0] + b0, v1 = acc[ai][bj][m][1] + b1;
                v0[0] = bf_lo(gg.x) * fsigmoid(v0[0]); v0[1] = bf_hi(gg.x) * fsigmoid(v0[1]); v0[2] = bf_lo(gg.y) * fsigmoid(v0[2]); v0[3] = bf_hi(gg.y) * fsigmoid(v0[3]);
                v1[0] = bf_lo(gg.z) * fsigmoid(v1[0]); v1[1] = bf_hi(gg.z) * fsigmoid(v1[1]); v1[2] = bf_lo(gg.w) * fsigmoid(v1[2]); v1[3] = bf_hi(gg.w) * fsigmoid(v1[3]);
                *(u32x4*)(CAT + (size_t)t * 1024 + c) = pack8(v0, v1); } }
    }
};
typedef unsigned u32x2_ __attribute__((ext_vector_type(2)));
__device__ __forceinline__ unsigned pk4_fp8(float a, float b, float c, float d) { int w = 0; w = __builtin_amdgcn_cvt_pk_fp8_f32(a, b, w, false); w = __builtin_amdgcn_cvt_pk_fp8_f32(c, d, w, true); return (unsigned)w; }
__device__ __forceinline__ float swiglu_fast(float ag, float au, float c1, float K) { const float e = __builtin_amdgcn_exp2f(ag * c1); return (ag * au) * __builtin_amdgcn_rcpf(__builtin_fmaf(e, K, K)); }
template <int SCALE  , bool OUT8 = false  > struct EpiSwiglu {
    static constexpr bool PERM = true, AFTER_DRAIN = false;
    bf16_t* O; int ldc; int npe; int pm0; const float* RS; float osc;
    __device__ __forceinline__ void operator()(const f32x4 (&acc)[2][2][4][2], const Unit& u, int wr, int wc, int fr, int fq) const {
        const int row0 = (u.pm - pm0) * BM + wr * 64 + fr, col0 = (u.pn % npe) * HALF + wc * 32 + 8 * fq;
#pragma unroll
        EPI_LOOP_ROWS { f32x4 v0, v1; const int r = row0 + ai * HALF + m * 16; const float rs = (SCALE == 1) ? rs_row(RS, r) : RS[r]; const float c1 = -1.4426950408889634f * rs, K = __builtin_amdgcn_rcpf(rs * rs * (OUT8 ? osc : 1.f));
#pragma unroll
            for (int e = 0; e < 4; ++e) { v0[e] = swiglu_fast(acc[ai][0][m][0][e], acc[ai][1][m][0][e], c1, K); v1[e] = swiglu_fast(acc[ai][0][m][1][e], acc[ai][1][m][1][e], c1, K); }
            if constexpr (OUT8) {
#pragma unroll
                for (int e = 0; e < 4; ++e) { v0[e] = __builtin_amdgcn_fmed3f(v0[e], -440.f, 440.f); v1[e] = __builtin_amdgcn_fmed3f(v1[e], -440.f, 440.f); }
                *(u32x2_*)((unsigned char*)O + (size_t)r * ldc + col0) = (u32x2_){pk4_fp8(v0[0], v0[1], v0[2], v0[3]), pk4_fp8(v1[0], v1[1], v1[2], v1[3])}; }
            else *(u32x4*)(O + (size_t)r * ldc + col0) = pack8(v0, v1); }
    }
};
struct EpiSwigluF8 {
    static constexpr bool PERM = true, AFTER_DRAIN = false;
    unsigned char* O; int ldc; int npe; int pm0; float inv, sc;
    __device__ __forceinline__ void operator()(const f32x4 (&acc)[2][2][4][2], const Unit& u, int wr, int wc, int fr, int fq) const {
        const int row0 = (u.pm - pm0) * BM + wr * 64 + fr, col0 = (u.pn % npe) * HALF + wc * 32 + 8 * fq;
        const float c1 = -1.4426950408889634f * inv, K = 1.f / (inv * inv * sc);
#pragma unroll
        EPI_LOOP_ROWS { f32x4 v0, v1; const int r = row0 + ai * HALF + m * 16;
#pragma unroll
            for (int e = 0; e < 4; ++e) { v0[e] = __builtin_amdgcn_fmed3f(swiglu_fast(acc[ai][0][m][0][e], acc[ai][1][m][0][e], c1, K), -440.f, 440.f); v1[e] = __builtin_amdgcn_fmed3f(swiglu_fast(acc[ai][0][m][1][e], acc[ai][1][m][1][e], c1, K), -440.f, 440.f); }
            *(u32x2_*)(O + (size_t)r * ldc + col0) = (u32x2_){pk4_fp8(v0[0], v0[1], v0[2], v0[3]), pk4_fp8(v1[0], v1[1], v1[2], v1[3])}; }
    }
};
template <bool F32BASE  , bool W8 = false  > struct EpiResidB {
    static constexpr bool PERM = true, AFTER_DRAIN = false;
    const float* R; bf16_t* XR; float* SS; float inv; unsigned char* X8;
    __device__ __forceinline__ void operator()(const f32x4 (&acc)[2][2][4][2], const Unit& u, int wr, int wc, int fr, int fq) const {
        const int row0 = u.pm * BM + wr * 64 + fr, col0 = u.pn * BM + wc * 32 + 8 * fq;
#pragma unroll
        EPI_LOOP_ROWS { const int row = row0 + ai * HALF + m * 16; const size_t o = (size_t)row * 1024 + col0; float ss = 0.f;
#pragma unroll
            for (int bj = 0; bj < 2; ++bj) { f32x4 r0, r1;
                if (F32BASE) { r0 = *(const f32x4*)(R + o + bj * HALF); r1 = *(const f32x4*)(R + o + bj * HALF + 4); }
                else { const u32x4 w = *(const u32x4*)(XR + o + bj * HALF); r0 = (f32x4){bf_lo(w.x), bf_hi(w.x), bf_lo(w.y), bf_hi(w.y)}; r1 = (f32x4){bf_lo(w.z), bf_hi(w.z), bf_lo(w.w), bf_hi(w.w)}; }
                r0 = r0 + acc[ai][bj][m][0] * inv; r1 = r1 + acc[ai][bj][m][1] * inv;
                ss += (r0[0] * r0[0] + r0[1] * r0[1]) + (r0[2] * r0[2] + r0[3] * r0[3]) + (r1[0] * r1[0] + r1[1] * r1[1]) + (r1[2] * r1[2] + r1[3] * r1[3]);
                *(u32x4*)(XR + o + bj * HALF) = pack8(r0, r1);
                if constexpr (W8) { f32x4 q0, q1;
#pragma unroll
                    for (int e = 0; e < 4; ++e) { q0[e] = __builtin_amdgcn_fmed3f(r0[e] * 8.f, -440.f, 440.f); q1[e] = __builtin_amdgcn_fmed3f(r1[e] * 8.f, -440.f, 440.f); }
                    *(u32x2_*)(X8 + o + bj * HALF) = (u32x2_){pk4_fp8(q0[0], q0[1], q0[2], q0[3]), pk4_fp8(q1[0], q1[1], q1[2], q1[3])}; } }
            ss += __shfl_xor(ss, 16); ss += __shfl_xor(ss, 32);
            if (fq == 0) SS[(size_t)row * 16 + u.pn * 4 + wc] = ss; }
    }
};
template <bool FIRST  > struct EpiMoeDown {
    static constexpr bool PERM = true, AFTER_DRAIN = false;
    float* OUT; const int* rowtok; const float* rowgate; int pm0; const bf16_t* XR; float sc;
    __device__ __forceinline__ void operator()(const f32x4 (&acc)[2][2][4][2], const Unit& u, int wr, int wc, int fr, int fq) const {
        const int row0 = (u.pm - pm0) * BM + wr * 64 + fr, col0 = (u.pn & 3) * BM + wc * 32 + 8 * fq;
#pragma unroll
        EPI_LOOP_ROWS { const int r = row0 + ai * HALF + m * 16; const int t = rowtok[r]; const float gt = rowgate[r] * sc;
            if (t >= 0) { float* o = OUT + (size_t)t * 1024 + col0;
#pragma unroll
                for (int bj = 0; bj < 2; ++bj) { f32x4 r0, r1;
                    if (FIRST) { const u32x4 w = *(const u32x4*)(XR + (size_t)t * 1024 + col0 + bj * HALF); r0 = (f32x4){bf_lo(w.x), bf_hi(w.x), bf_lo(w.y), bf_hi(w.y)}; r1 = (f32x4){bf_lo(w.z), bf_hi(w.z), bf_lo(w.w), bf_hi(w.w)}; }
                    else { r0 = *(const f32x4*)(o + bj * HALF); r1 = *(const f32x4*)(o + bj * HALF + 4); }
                    *(f32x4*)(o + bj * HALF) = r0 + acc[ai][bj][m][0] * gt; *(f32x4*)(o + bj * HALF + 4) = r1 + acc[ai][bj][m][1] * gt; } } }
    }
};

__device__ __forceinline__ void sk_store_partial(const f32x4 (&acc)[2][2][4][2], unsigned long long* slot, int tid) {
#pragma unroll
    for (int ai = 0; ai < 2; ++ai)
#pragma unroll
        for (int bj = 0; bj < 2; ++bj)
#pragma unroll
            for (int m = 0; m < 4; ++m)
#pragma unroll
                for (int n = 0; n < 2; ++n) { const f32x4 v = acc[ai][bj][m][n]; const unsigned long long w = (unsigned long long)cvt_pk_bf16(v[0], v[1]) | ((unsigned long long)cvt_pk_bf16(v[2], v[3]) << 32);
                    __hip_atomic_store(slot + (((ai * 2 + bj) * 4 + m) * 2 + n) * 512 + tid, w, __ATOMIC_RELAXED, __HIP_MEMORY_SCOPE_AGENT); }
}
__device__ __forceinline__ void sk_add_partial(f32x4 (&acc)[2][2][4][2], unsigned long long* slot, int tid) {
#pragma unroll
    for (int ai = 0; ai < 2; ++ai)
#pragma unroll
        for (int bj = 0; bj < 2; ++bj)
#pragma unroll
            for (int m = 0; m < 4; ++m)
#pragma unroll
                for (int n = 0; n < 2; ++n) { const unsigned long long w = __hip_atomic_load(slot + (((ai * 2 + bj) * 4 + m) * 2 + n) * 512 + tid, __ATOMIC_RELAXED, __HIP_MEMORY_SCOPE_AGENT);
                    const unsigned lo = (unsigned)w, hi = (unsigned)(w >> 32); acc[ai][bj][m][n] = acc[ai][bj][m][n] + (f32x4){bf_lo(lo), bf_hi(lo), bf_lo(hi), bf_hi(hi)};
                    if (n == 1 && (m & 1)) asm volatile("" ::: "memory"); }
}
typedef int i32x4_ __attribute__((ext_vector_type(4)));
typedef int i32x8_ __attribute__((ext_vector_type(8)));
template <class Epi, class Sched, bool ALIGN_EPI = false, bool SP2 = false, bool FP8 = false>
__device__ __forceinline__ void gemm_phase(PG8_LAS unsigned char* lds, const Gemm g, const Sched& S, const Epi& E) {
    const int tid = threadIdx.x, wid = __builtin_amdgcn_readfirstlane(tid >> 6), lane = tid & 63, wr = wid >> 2, wc = wid & 3, fr = lane & 15, fq = lane >> 4;
    const int K = g.K; int nt = K / BK;
    unsigned voffA[2], voffB[2];
#pragma unroll
    for (int i = 0; i < 2; ++i) { int R, C; stage_rc(tid * 16 + i * 8192, R, C); const int Rb = Epi::PERM ? ((R & ~31) + perm32(R & 31)) : R;
        voffA[i] = g.amode ? (unsigned)(((C >> 4) * g.lda + R) * 16 + (C & 15)) * 2u : (unsigned)(R * g.lda + C) * 2u; voffB[i] = (unsigned)(Rb * g.ldb + C) * 2u; }
    const size_t kstep = (size_t)(BK * 2);
    const size_t hstepA = g.amode ? (size_t)HALF * 32 : (size_t)HALF * g.lda * 2, hstepB = (size_t)HALF * g.ldb * 2;
    const size_t kstepA = g.amode ? (size_t)4 * g.lda * 32 : kstep;
    const size_t tstepA = 2 * hstepA, tstepB = 2 * hstepB;
    const unsigned ldsw = (unsigned)wid * 1024u;
    const int aoff = lds_byte(wr * 64 + fr, fq * 8), boff = lds_byte(wc * 32 + fr, fq * 8);
#define PG8_SA(b, h) (((b) * 2 + (h)) * HTB)
#define PG8_SB(b, h) ((4 + (b) * 2 + (h)) * HTB)
#define PG8_STAGE(bufoff, gbase, voff) do { _Pragma("unroll") for (int _i = 0; _i < 2; ++_i) \
        __builtin_amdgcn_global_load_lds((const unsigned*)((const char*)(gbase) + (voff)[_i]), (PG8_LAS unsigned*)(lds + (bufoff) + ldsw + _i * 8192), 16, 0, 0); } while (0)
#define PG8_LDA(dst, b, h) do { if constexpr (FP8) { _Pragma("unroll") for (int m = 0; m < 4; ++m) { const i32x4_ l_ = *(const PG8_LAS i32x4_*)(lds + PG8_SA(b, h) + aoff + m * 2048), h_ = *(const PG8_LAS i32x4_*)(lds + PG8_SA(b, h) + aoff + m * 2048 + 1024); dst##8[m] = __builtin_shufflevector(l_, h_, 0, 1, 2, 3, 4, 5, 6, 7); } } \
        else { _Pragma("unroll") for (int m = 0; m < 4; ++m) _Pragma("unroll") for (int k = 0; k < 2; ++k) dst[m][k] = *(const PG8_LAS bf16x8*)(lds + PG8_SA(b, h) + aoff + m * 2048 + k * 1024); } } while (0)
#define PG8_LDB(dst, b, h) do { if constexpr (FP8) { _Pragma("unroll") for (int n = 0; n < 2; ++n) { const i32x4_ l_ = *(const PG8_LAS i32x4_*)(lds + PG8_SB(b, h) + boff + n * 2048), h_ = *(const PG8_LAS i32x4_*)(lds + PG8_SB(b, h) + boff + n * 2048 + 1024); dst##8[n] = __builtin_shufflevector(l_, h_, 0, 1, 2, 3, 4, 5, 6, 7); } } \
        else { _Pragma("unroll") for (int n = 0; n < 2; ++n) _Pragma("unroll") for (int k = 0; k < 2; ++k) dst[n][k] = *(const PG8_LAS bf16x8*)(lds + PG8_SB(b, h) + boff + n * 2048 + k * 1024); } } while (0)
#define PG8_MMA(ai, bj, At, Bt) do { __builtin_amdgcn_s_setprio(1); \
        if constexpr (FP8) { _Pragma("unroll") for (int m = 0; m < 4; ++m) _Pragma("unroll") for (int n = 0; n < 2; ++n) \
            acc[ai][bj][m][n] = __builtin_amdgcn_mfma_scale_f32_16x16x128_f8f6f4(Bt##8[n], At##8[m], acc[ai][bj][m][n], 0, 0, 0, 0x7f7f7f7f, 0, 0x7f7f7f7f); \
            _Pragma("unroll") for (int m = 0; m < 4; ++m) _Pragma("unroll") for (int n = 0; n < 2; ++n) asm volatile("" : "+v"(acc[ai][bj][m][n])); } \
        else { _Pragma("unroll") for (int m = 0; m < 4; ++m) _Pragma("unroll") for (int n = 0; n < 2; ++n) _Pragma("unroll") for (int k = 0; k < 2; ++k) \
            acc[ai][bj][m][n] = __builtin_amdgcn_mfma_f32_16x16x32_bf16(Bt[n][k], At[m][k], acc[ai][bj][m][n], 0, 0, 0); } \
        __builtin_amdgcn_s_setprio(0); } while (0)
#define PG8_WAIT_V(n) asm volatile("s_waitcnt vmcnt(" #n ")" ::: "memory")
#define PG8_WAIT_L(n) asm volatile("s_waitcnt lgkmcnt(" #n ")" ::: "memory")
#define PG8_BAR __builtin_amdgcn_s_barrier()
#define PG8_SCHED __builtin_amdgcn_sched_barrier(0)
    Unit cur, nxt; int ui = 0;
    if (!S.next(0, cur)) return;
    f32x4 acc[2][2][4][2];
#pragma unroll
    for (int a = 0; a < 2; ++a)
#pragma unroll
        for (int b = 0; b < 2; ++b)
#pragma unroll
            for (int m = 0; m < 4; ++m)
#pragma unroll
                for (int n = 0; n < 2; ++n) acc[a][b][m][n] = (f32x4){0.f, 0.f, 0.f, 0.f};
    bf16x8 At[4][2], B0[2][2], B1[2][2];
    i32x8_ At8[4], B08[2], B18[2];
    const char* cA = (const char*)g.A + (size_t)cur.pm * tstepA; const char* cB = (const char*)g.Bt + (size_t)cur.pn * tstepB;
    if constexpr (Sched::STREAMK) { nt = cur.nk; cA += (size_t)cur.k0 * kstep; cB += (size_t)cur.k0 * kstep; }

    if constexpr (SP2) {
        PG8_STAGE(PG8_SB(0, 0), cB, voffB); PG8_STAGE(PG8_SB(0, 1), cB + hstepB, voffB); PG8_STAGE(PG8_SA(0, 0), cA, voffA); PG8_STAGE(PG8_SA(0, 1), cA + hstepA, voffA);
        if (wr == 1) PG8_BAR;
        PG8_WAIT_V(2); PG8_BAR;
        PG8_STAGE(PG8_SB(1, 0), cB + kstep, voffB); PG8_STAGE(PG8_SA(1, 0), cA + kstepA, voffA); PG8_STAGE(PG8_SB(1, 1), cB + hstepB + kstep, voffB);
        PG8_WAIT_V(6); PG8_BAR;
    } else {
        PG8_STAGE(PG8_SB(0, 0), cB, voffB); PG8_STAGE(PG8_SA(0, 0), cA, voffA); PG8_STAGE(PG8_SB(0, 1), cB + hstepB, voffB); PG8_STAGE(PG8_SA(0, 1), cA + hstepA, voffA);
        if (wr == 1) PG8_BAR;
        PG8_WAIT_V(4); PG8_BAR;
        PG8_STAGE(PG8_SB(1, 0), cB + kstep, voffB); PG8_STAGE(PG8_SA(1, 0), cA + kstepA, voffA); PG8_STAGE(PG8_SB(1, 1), cB + hstepB + kstep, voffB);
        PG8_WAIT_V(6); PG8_BAR;
    }
    for (;;) {
        const bool has_next = S.next(ui + 1, nxt);
        const char* nA = has_next ? (const char*)g.A + (size_t)nxt.pm * tstepA : cA; const char* nB = has_next ? (const char*)g.Bt + (size_t)nxt.pn * tstepB : cB;
        if constexpr (Sched::STREAMK) { if (has_next) { nA += (size_t)nxt.k0 * kstep; nB += (size_t)nxt.k0 * kstep; } }
        for (int t = 0; t < nt; t += 2) {
            const bool last = (t == nt - 2);
            const char* a1 = cA + (size_t)(t + 1) * kstepA;
            const char* a2 = last ? nA : cA + (size_t)(t + 2) * kstepA; const char* b2 = last ? nB : cB + (size_t)(t + 2) * kstep;
            const char* a3 = a2 + kstepA; const char* b3 = b2 + kstep;

            if constexpr (SP2) {
            PG8_LDB(B0, 0, 0); PG8_LDB(B1, 0, 1); PG8_SCHED; PG8_LDA(At, 0, 0); PG8_STAGE(PG8_SA(1, 1), a1 + hstepA, voffA);
            PG8_WAIT_V(8); PG8_WAIT_L(0); PG8_BAR; PG8_MMA(0, 0, At, B0); PG8_MMA(0, 1, At, B1); PG8_BAR; PG8_SCHED;
            PG8_LDA(At, 0, 1); PG8_STAGE(PG8_SB(0, 0), b2, voffB); PG8_STAGE(PG8_SB(0, 1), b2 + hstepB, voffB); PG8_STAGE(PG8_SA(0, 0), a2, voffA);
            PG8_WAIT_V(8); PG8_WAIT_L(0); PG8_BAR; PG8_MMA(1, 0, At, B0); PG8_MMA(1, 1, At, B1); PG8_BAR; PG8_SCHED;
            PG8_LDB(B0, 1, 0); PG8_LDB(B1, 1, 1); PG8_SCHED; PG8_LDA(At, 1, 0); PG8_STAGE(PG8_SA(0, 1), a2 + hstepA, voffA);
            PG8_WAIT_V(8); PG8_WAIT_L(0); PG8_BAR; PG8_MMA(0, 0, At, B0); PG8_MMA(0, 1, At, B1); PG8_BAR; PG8_SCHED;
            PG8_LDA(At, 1, 1); PG8_STAGE(PG8_SB(1, 0), b3, voffB); PG8_STAGE(PG8_SB(1, 1), b3 + hstepB, voffB); PG8_STAGE(PG8_SA(1, 0), a3, voffA);
            PG8_WAIT_V(8); PG8_WAIT_L(0); PG8_BAR; PG8_MMA(1, 0, At, B0); PG8_MMA(1, 1, At, B1); PG8_BAR; PG8_SCHED;
            } else {
            PG8_LDB(B0, 0, 0); PG8_SCHED; PG8_LDA(At, 0, 0); PG8_STAGE(PG8_SA(1, 1), a1 + hstepA, voffA);
            PG8_WAIT_L(8); PG8_BAR; PG8_WAIT_L(0); PG8_MMA(0, 0, At, B0); PG8_BAR; PG8_SCHED;
            PG8_LDB(B1, 0, 1); PG8_STAGE(PG8_SB(0, 0), b2, voffB);
            PG8_BAR; PG8_WAIT_L(0); PG8_MMA(0, 1, At, B1); PG8_BAR;
            PG8_LDA(At, 0, 1); PG8_STAGE(PG8_SA(0, 0), a2, voffA);
            PG8_BAR; PG8_WAIT_L(0); PG8_MMA(1, 0, At, B0); PG8_BAR; PG8_SCHED;
            PG8_STAGE(PG8_SB(0, 1), b2 + hstepB, voffB);
            PG8_WAIT_V(6); PG8_BAR; PG8_MMA(1, 1, At, B1); PG8_BAR;
            PG8_LDB(B0, 1, 0); PG8_SCHED; PG8_LDA(At, 1, 0); PG8_STAGE(PG8_SA(0, 1), a2 + hstepA, voffA);
            PG8_WAIT_L(8); PG8_BAR; PG8_WAIT_L(0); PG8_MMA(0, 0, At, B0); PG8_BAR; PG8_SCHED;
            PG8_LDB(B1, 1, 1); PG8_STAGE(PG8_SB(1, 0), b3, voffB);
            PG8_BAR; PG8_WAIT_L(0); PG8_MMA(0, 1, At, B1); PG8_BAR;
            PG8_LDA(At, 1, 1); PG8_STAGE(PG8_SA(1, 0), a3, voffA);
            PG8_BAR; PG8_WAIT_L(0); PG8_MMA(1, 0, At, B0); PG8_BAR; PG8_SCHED;
            PG8_STAGE(PG8_SB(1, 1), b3 + hstepB, voffB);
            PG8_WAIT_V(6); PG8_BAR; PG8_MMA(1, 1, At, B1); PG8_BAR;
            }
        }
        if constexpr (ALIGN_EPI) { if (wr == 0) PG8_BAR; }
        if constexpr (Sched::STREAMK) {
            if (cur.part == 2) { sk_store_partial(acc, S.slots() + (size_t)S.c() * SK_SLOT_WORDS, tid); PG8_WAIT_V(0);
                if (lane == 0) __hip_atomic_fetch_add(S.flags() + S.c() * 64, 1u, __ATOMIC_RELAXED, __HIP_MEMORY_SCOPE_AGENT); }
            else if (cur.part == 0) E(acc, cur, wr, wc, fr, fq);
        } else
        if constexpr (!Epi::AFTER_DRAIN) { E(acc, cur, wr, wc, fr, fq); }
        if (!has_next) break;
#pragma unroll
        for (int a = 0; a < 2; ++a)
#pragma unroll
            for (int b = 0; b < 2; ++b)
#pragma unroll
                for (int m = 0; m < 4; ++m)
#pragma unroll
                    for (int n = 0; n < 2; ++n) acc[a][b][m][n] = (f32x4){0.f, 0.f, 0.f, 0.f};
        cur = nxt; cA = nA; cB = nB; ++ui;
        if constexpr (Sched::STREAMK) nt = cur.nk;
        if constexpr (ALIGN_EPI) { if (wr == 1) PG8_BAR; }
    }
    PG8_WAIT_V(0);
    if constexpr (!ALIGN_EPI) { if (wr == 0) PG8_BAR; }
    PG8_BAR;
    if constexpr (Epi::AFTER_DRAIN) { E.fused(acc, cur, wr, wc, fr, fq, lds, wid, lane); }
    if constexpr (Sched::STREAMK) { if (cur.part == 1) {
        const int np = S.split();
        if (tid == 0) { for (int q = 1; q < np; ++q) { unsigned sp = 0; while (__hip_atomic_load(S.flags() + (S.c() + q) * 64, __ATOMIC_RELAXED, __HIP_MEMORY_SCOPE_AGENT) < S.target()) { __builtin_amdgcn_s_sleep(2); if (++sp > (1u << 22)) break; } } }
        __syncthreads();
        for (int q = 1; q < np; ++q) sk_add_partial(acc, S.slots() + (size_t)(S.c() + q) * SK_SLOT_WORDS, tid);
        E(acc, cur, wr, wc, fr, fq); } }
#undef PG8_SA
#undef PG8_SB
#undef PG8_STAGE
#undef PG8_LDA
#undef PG8_LDB
#undef PG8_MMA
#undef PG8_WAIT_V
#undef PG8_WAIT_L
#undef PG8_BAR
#undef PG8_SCHED
}
}


constexpr int NWAVES = 8, NTHREADS = 512;
constexpr int T = 16384, D = 1024, SEQ = 2048, NB = 8;
constexpr int DFF = 2816, DFE = 3584, NEXP = 8;
constexpr int RROWS = 18432;
constexpr float RMS_EPS = 1e-6f;
constexpr float MOE_WSCALE = 64.f, MOE_ASCALE = 8.f;

constexpr size_t MiB = 1u << 20;
constexpr size_t WS_CTL = 0, CTL_ZERO_BYTES = 256 * 1024;
constexpr size_t WS_SMALL = 1 * MiB;
constexpr size_t SM_KMEANS = WS_SMALL, SM_LAM32 = WS_SMALL + 64 * 1024, SM_WGCNT = WS_SMALL + 128 * 1024, SM_PANEND = WS_SMALL + 160 * 1024,
                 SM_TOKE = WS_SMALL + 192 * 1024, SM_TOKLP = WS_SMALL + 320 * 1024, SM_TOKG = WS_SMALL + 448 * 1024, SM_ROWTOK = WS_SMALL + 576 * 1024, SM_ROWGATE = WS_SMALL + 720 * 1024;
static_assert(SM_ROWGATE + 2 * RROWS * 4 <= 2 * MiB, "small tables");
constexpr size_t WS_WMEMK = 2 * MiB, WS_WMEMV = 3 * MiB, WS_WKQ = 4 * MiB, WS_WV = WS_WKQ + 2560 * 1024, WS_WOUT1 = 7 * MiB, WS_WMGU = 9 * MiB, WS_WMD = 121 * MiB;
constexpr size_t WS_XB = 177 * MiB, WS_CAT = 209 * MiB, WS_MEMN = 241 * MiB, WS_MEMK = 245 * MiB, WS_MEMVT = 247 * MiB;
constexpr size_t WS_ARENA = 249 * MiB, WS_END = 447 * MiB;
constexpr size_t AR_XS = WS_ARENA, AR_ACTM = WS_ARENA + 72 * MiB;
constexpr size_t AR_WIN0 = WS_ARENA, AR_WGLU = WS_ARENA + 2 * MiB, AR_WOUT0 = WS_ARENA + 4 * MiB, AR_WFGU = WS_ARENA + 6 * MiB, AR_WFD = WS_ARENA + 17 * MiB;
constexpr size_t AR_TZ = WS_ARENA + 23 * MiB, AR_W1T = WS_ARENA + 53 * MiB, AR_UG = WS_ARENA + 65 * MiB, AR_QM0 = WS_ARENA + 95 * MiB, AR_XC = WS_ARENA + 103 * MiB, AR_GACT = WS_ARENA + 115 * MiB;
constexpr size_t AR_X8 = WS_ARENA + 140 * MiB;
constexpr size_t AR_S5SM = WS_ARENA + 156 * MiB;
constexpr size_t AR_ACT0 = WS_ARENA + 23 * MiB;
constexpr size_t AR_KQ = WS_ARENA, AR_VT = WS_ARENA + 40 * MiB;
static_assert(AR_ACTM + (size_t)RROWS * DFE * 2 <= WS_END && AR_ACT0 + (size_t)T * DFF * 2 <= AR_GACT, "arena");
constexpr int CW_BAR = 4096, CW_QUEUE = 8192, CW_SKFLAG = 16384;
static_assert((CW_SKFLAG + 2 * 256 * 64 + 64) * 4 <= (int)CTL_ZERO_BYTES, "control words inside the per-call memset");

constexpr int RING_BYTES = 131072, MISC_OFF = RING_BYTES + 320, LDS_BYTES = 147456;

#define GAS __attribute__((address_space(1)))
#define LAS __attribute__((address_space(3)))
typedef unsigned short bf16;
typedef unsigned v4u __attribute__((ext_vector_type(4)));
typedef unsigned v2u __attribute__((ext_vector_type(2)));
typedef float f32x4 __attribute__((ext_vector_type(4)));
typedef float f32x16 __attribute__((ext_vector_type(16)));
typedef short bf16x8 __attribute__((ext_vector_type(8)));
typedef short s16x4 __attribute__((ext_vector_type(4)));
typedef GAS unsigned gu32;
#define LDS_WAIT() asm volatile("s_waitcnt lgkmcnt(0)" ::: "memory")
using pg8::cvt_pk_bf16; using pg8::bf_lo; using pg8::bf_hi;
__device__ __forceinline__ unsigned f2bf(float f) { unsigned u = __builtin_bit_cast(unsigned, f); return (u + 0x7fffu + ((u >> 16) & 1u)) >> 16; }
__device__ __forceinline__ unsigned pk2(float lo, float hi) { return f2bf(lo) | (f2bf(hi) << 16); }
__device__ __forceinline__ float wave_sum(float v) {
#pragma unroll
    for (int o = 1; o < 64; o <<= 1) v += __shfl_xor(v, o);
    return v;
}

#define XB_TMO      128
#define XB_XCNT(j)  (256  + 64 * (j))
#define XB_XSUB(j)  (1280 + 64 * (j))
#define XB_XGEN(j)  (2304 + 64 * (j))
#define XB_TOP      3328
#define XB_TOPGEN   3392
#define XCD_BAR_WORDS 3456
#define XB_SPIN_CAP (1u << 18)

__device__ __forceinline__ unsigned xb_ld(unsigned* p)              { return __hip_atomic_load(p, __ATOMIC_RELAXED, __HIP_MEMORY_SCOPE_AGENT); }
__device__ __forceinline__ unsigned xb_add(unsigned* p, unsigned v) { return __hip_atomic_fetch_add(p, v, __ATOMIC_RELAXED, __HIP_MEMORY_SCOPE_AGENT); }
__device__ __forceinline__ unsigned xb_xcc_id() { return (unsigned)__builtin_amdgcn_s_getreg((3 << 11) | 20) & 0xFu; }
#define XB_SPIN(cond, bar) do { unsigned _sp = 0; while (cond) { __builtin_amdgcn_s_sleep(1); \
    if ((++_sp & 255u) == 0u) { if (xb_ld(&(bar)[XB_TMO])) break; if (_sp > XB_SPIN_CAP) { atomicAdd(&(bar)[XB_TMO], 1u); break; } } } } while (0)

struct XcdBarrier {
    unsigned* bar; unsigned x;
    volatile LAS unsigned* st;
};

__device__ __forceinline__ XcdBarrier xcd_barrier_post(unsigned* bar, volatile LAS unsigned* st) {
    XcdBarrier b; b.bar = bar; b.x = xb_xcc_id(); b.st = st;
    if (threadIdx.x == 0) (void)xb_add(&bar[XB_XCNT(b.x)], 1u);
    return b;
}
__device__ __forceinline__ void xcd_barrier_complete(unsigned* bar, unsigned x, unsigned& nloc, unsigned& nx) {
    const unsigned G = gridDim.x * gridDim.y * gridDim.z;
    unsigned sum, cnt, mine, sp = 0u;
    for (;;) {
        sum = 0u; cnt = 0u; mine = 0u;
#pragma unroll
        for (unsigned j = 0; j < 16; ++j) { const unsigned c = xb_ld(&bar[XB_XCNT(j)]); sum += c; cnt += (c > 0u) ? 1u : 0u; mine = (j == x) ? c : mine; }
        if (sum == G) break;
        __builtin_amdgcn_s_sleep(1);
        if ((++sp & 255u) == 0u) { if (xb_ld(&bar[XB_TMO])) break; if (sp > XB_SPIN_CAP) { atomicAdd(&bar[XB_TMO], 1u); break; } }
    }
    nloc = mine > 0u ? mine : 1u; nx = cnt > 0u ? cnt : 1u;
}

__device__ __forceinline__ void xcd_barrier(const XcdBarrier& b) {
    asm volatile("s_waitcnt vmcnt(0)" ::: "memory");
    __syncthreads();
    if (threadIdx.x == 0) {
        unsigned* bar = b.bar;
        __builtin_amdgcn_s_waitcnt(0);
        unsigned nloc = b.st[0], nx = b.st[1];
        if (nloc == 0u) { xcd_barrier_complete(bar, b.x, nloc, nx); b.st[0] = nloc; b.st[1] = nx; }
        const unsigned old = xb_add(&bar[XB_XSUB(b.x)], 1u);
        const unsigned gen = old / nloc;
        if (old + 1u == (gen + 1u) * nloc) {
            __builtin_amdgcn_fence(__ATOMIC_RELEASE, "agent");
            asm volatile("s_waitcnt vmcnt(0)" ::: "memory");
            const unsigned og = xb_add(&bar[XB_TOP], 1u);
            const unsigned tg = og / nx;
            if (og + 1u == (tg + 1u) * nx) xb_add(&bar[XB_TOPGEN], 1u);
            else XB_SPIN(xb_ld(&bar[XB_TOPGEN]) == tg, bar);
            __builtin_amdgcn_fence(__ATOMIC_ACQUIRE, "agent");
            xb_add(&bar[XB_XGEN(b.x)], 1u);
            asm volatile("s_waitcnt vmcnt(0)" ::: "memory");
        } else {
            XB_SPIN(xb_ld(&bar[XB_XGEN(b.x)]) == gen, bar);
            __builtin_amdgcn_fence(__ATOMIC_ACQUIRE, "agent");
            asm volatile("s_waitcnt vmcnt(0)" ::: "memory");
        }
    }
    __syncthreads();
}


__device__ __forceinline__ void cvt_item(const float* W, int ldw, int k0, int n0, const float* gain, bf16* WT, int ldo, int orow0, LAS unsigned* scr, int lane) {
    const int nq = lane & 15, kr = lane >> 4;
    f32x4 a[8], b[8];
    const float* src = W + (size_t)(k0 + 2 * kr) * ldw + n0 + 4 * nq;
#pragma unroll
    for (int i = 0; i < 8; ++i) { a[i] = *(const GAS f32x4*)(src + (size_t)(8 * i) * ldw); b[i] = *(const GAS f32x4*)(src + (size_t)(8 * i + 1) * ldw); }
    if (gain) {
#pragma unroll
        for (int i = 0; i < 8; ++i) { const float ga = gain[k0 + 8 * i + 2 * kr], gb = gain[k0 + 8 * i + 2 * kr + 1]; a[i] = a[i] * ga; b[i] = b[i] * gb; } }
#pragma unroll
    for (int i = 0; i < 8; ++i) {
#pragma unroll
        for (int e = 0; e < 4; ++e) scr[(4 * nq + e) * 33 + 4 * i + kr] = cvt_pk_bf16(a[i][e], b[i][e]); }
    LDS_WAIT(); asm volatile("" ::: "memory");
#pragma unroll
    for (int j = 0; j < 8; ++j) { const int q = lane + 64 * j, n = q >> 3, c = q & 7; const LAS unsigned* sp = scr + n * 33 + 4 * c;
        v4u o; o.x = sp[0]; o.y = sp[1]; o.z = sp[2]; o.w = sp[3];
        *(GAS v4u*)(WT + (size_t)(orow0 + n) * ldo + k0 + 8 * c) = o; }
    LDS_WAIT(); asm volatile("" ::: "memory");
}
struct CvtDesc { const float* src; const float* gain; bf16* dst; int ldw, ldo, k0; };
__device__ __forceinline__ void cvt_load(const CvtDesc& d, f32x4 (&a)[8], f32x4 (&b)[8], float (&ga)[8], float (&gb)[8], int lane) {
    const int nq = lane & 15, kr = lane >> 4; const float* src = d.src + (size_t)(2 * kr) * d.ldw + 4 * nq;
    if (d.gain) {
#pragma unroll
        for (int i = 0; i < 8; ++i) { ga[i] = d.gain[d.k0 + 8 * i + 2 * kr]; gb[i] = d.gain[d.k0 + 8 * i + 2 * kr + 1]; } }
    else {
#pragma unroll
        for (int i = 0; i < 8; ++i) { ga[i] = 1.f; gb[i] = 1.f; } }
#pragma unroll
    for (int i = 0; i < 8; ++i) { a[i] = *(const GAS f32x4*)(src + (size_t)(8 * i) * d.ldw); b[i] = *(const GAS f32x4*)(src + (size_t)(8 * i + 1) * d.ldw); }
}
__device__ __forceinline__ void cvt_emit(const CvtDesc& d, f32x4 (&a)[8], f32x4 (&b)[8], const float (&ga)[8], const float (&gb)[8], LAS unsigned* scr, int lane) {
    const int nq = lane & 15, kr = lane >> 4;
#pragma unroll
    for (int i = 0; i < 8; ++i) {
#pragma unroll
        for (int e = 0; e < 4; ++e) scr[(4 * nq + e) * 33 + 4 * i + kr] = cvt_pk_bf16(a[i][e] * ga[i], b[i][e] * gb[i]); }
    LDS_WAIT(); asm volatile("" ::: "memory");
#pragma unroll
    for (int j = 0; j < 8; ++j) { const int q = lane + 64 * j, n = q >> 3, c = q & 7; const LAS unsigned* sp = scr + n * 33 + 4 * c;
        v4u o; o.x = sp[0]; o.y = sp[1]; o.z = sp[2]; o.w = sp[3];
        *(GAS v4u*)(d.dst + (size_t)n * d.ldo + 8 * c) = o; }
    LDS_WAIT(); asm volatile("" ::: "memory");
}
struct CvtDesc8 { const float* src; const float* gain; unsigned char* dst; int ldw, ldo, k0; };
__device__ __forceinline__ void cvt_load8(const CvtDesc8& d, f32x4 (&a)[4][4], float (&g)[4][4], float scale, int lane) {
    const int nq = lane & 15, kr = lane >> 4; const float* src = d.src + (size_t)(4 * kr) * d.ldw + 4 * nq;
#pragma unroll
    for (int i = 0; i < 4; ++i)
#pragma unroll
        for (int r = 0; r < 4; ++r) g[i][r] = d.gain ? d.gain[d.k0 + 16 * i + 4 * kr + r] * scale : scale;
#pragma unroll
    for (int i = 0; i < 4; ++i)
#pragma unroll
        for (int r = 0; r < 4; ++r) a[i][r] = __builtin_nontemporal_load((const GAS f32x4*)(src + (size_t)(16 * i + r) * d.ldw));
}
__device__ __forceinline__ void cvt_load8_dma(const CvtDesc8& d, f32x4 (&a)[4][4], float (&g)[4][4], float scale, LAS unsigned char* buf, int lane) {
    const int nq = lane & 15, kr = lane >> 4;
#pragma unroll
    for (int i = 0; i < 4; ++i)
#pragma unroll
        for (int r = 0; r < 4; ++r) g[i][r] = d.gain ? d.gain[d.k0 + 16 * i + 4 * kr + r] * scale : scale;
    const float* src = d.src + (size_t)kr * d.ldw + 4 * nq;
#pragma unroll
    for (int j = 0; j < 16; ++j) __builtin_amdgcn_global_load_lds((const unsigned*)(src + (size_t)(4 * j) * d.ldw), (LAS unsigned*)(buf + j * 1024), 16, 0, 2);
    asm volatile("s_waitcnt vmcnt(0)" ::: "memory");
#pragma unroll
    for (int i = 0; i < 4; ++i)
#pragma unroll
        for (int r = 0; r < 4; ++r) a[i][r] = *(const LAS f32x4*)(buf + (16 * i + 4 * kr + r) * 256 + nq * 16);
    LDS_WAIT(); asm volatile("" ::: "memory");
}
__device__ __forceinline__ void cvt_emit8(const CvtDesc8& d, f32x4 (&a)[4][4], const float (&g)[4][4], LAS unsigned* scr, int lane) {
    const int nq = lane & 15, kr = lane >> 4;
#pragma unroll
    for (int i = 0; i < 4; ++i)
#pragma unroll
        for (int e = 0; e < 4; ++e) scr[(4 * nq + e) * 17 + 4 * i + kr] = pg8::pk4_fp8(a[i][0][e] * g[i][0], a[i][1][e] * g[i][1], a[i][2][e] * g[i][2], a[i][3][e] * g[i][3]);
    LDS_WAIT(); asm volatile("" ::: "memory");
#pragma unroll
    for (int j = 0; j < 4; ++j) { const int q = lane + 64 * j, n = q >> 2, c = q & 3; const LAS unsigned* sp = scr + n * 17 + 4 * c;
        v4u o; o.x = sp[0]; o.y = sp[1]; o.z = sp[2]; o.w = sp[3];
        __builtin_nontemporal_store(o, (GAS v4u*)(d.dst + (size_t)n * d.ldo + 16 * c)); }
    LDS_WAIT(); asm volatile("" ::: "memory");
}
__device__ __forceinline__ void rms_row_to_bf16(const float* xrow, bf16* orow, int lane) {
    const GAS f32x4* xr = (const GAS f32x4*)xrow + lane;
    f32x4 v[4]; float s = 0.f;
#pragma unroll
    for (int j = 0; j < 4; ++j) { v[j] = xr[64 * j]; s += (v[j].x * v[j].x + v[j].y * v[j].y) + (v[j].z * v[j].z + v[j].w * v[j].w); }
    const float r = 1.f / sqrtf(wave_sum(s) * (1.f / 1024.f) + RMS_EPS);
    GAS unsigned long long* o8 = (GAS unsigned long long*)orow + lane;
#pragma unroll
    for (int j = 0; j < 4; ++j) o8[64 * j] = (unsigned long long)pk2(v[j].x * r, v[j].y * r) | ((unsigned long long)pk2(v[j].z * r, v[j].w * r) << 32);
}
__device__ __forceinline__ void dsincos(double a, double& s, double& c) {
    const double k = rint(a * 0.63661977236758134308);
    double r = fma(-k, 1.57079632679489655800e+00, a); r = fma(-k, 6.12323399573676603587e-17, r);
    const double z = r * r;
    double ps = 1.0 / 355687428096000.0;
    ps = fma(ps, z, -1.0 / 1307674368000.0); ps = fma(ps, z, 1.0 / 6227020800.0); ps = fma(ps, z, -1.0 / 39916800.0); ps = fma(ps, z, 1.0 / 362880.0);
    ps = fma(ps, z, -1.0 / 5040.0); ps = fma(ps, z, 1.0 / 120.0); ps = fma(ps, z, -1.0 / 6.0); ps = fma(ps * z, r, r);
    double pc = -1.0 / 6402373705728000.0;
    pc = fma(pc, z, 1.0 / 20922789888000.0); pc = fma(pc, z, -1.0 / 87178291200.0); pc = fma(pc, z, 1.0 / 479001600.0); pc = fma(pc, z, -1.0 / 3628800.0);
    pc = fma(pc, z, 1.0 / 40320.0); pc = fma(pc, z, -1.0 / 720.0); pc = fma(pc, z, 1.0 / 24.0); pc = fma(pc, z, -0.5); pc = fma(pc, z, 1.0);
    const long q = (long)k & 3;
    s = (q == 0) ? ps : (q == 1) ? pc : (q == 2) ? -ps : -pc;
    c = (q == 0) ? pc : (q == 1) ? -ps : (q == 2) ? -pc : ps;
}
__device__ __forceinline__ double dexp(double x) {
    const double k = rint(x * 1.44269504088896338700);
    double r = fma(-k, 6.93147180369123816490e-01, x); r = fma(-k, 1.90821492927058770002e-10, r);
    double p = 1.0 / 6227020800.0;
    p = fma(p, r, 1.0 / 479001600.0); p = fma(p, r, 1.0 / 39916800.0); p = fma(p, r, 1.0 / 3628800.0); p = fma(p, r, 1.0 / 362880.0); p = fma(p, r, 1.0 / 40320.0);
    p = fma(p, r, 1.0 / 5040.0); p = fma(p, r, 1.0 / 720.0); p = fma(p, r, 1.0 / 120.0); p = fma(p, r, 1.0 / 24.0); p = fma(p, r, 1.0 / 6.0); p = fma(p, r, 0.5); p = fma(p, r, 1.0); p = fma(p, r, 1.0);
    const long ki = (long)k;
    return p * __builtin_bit_cast(double, (unsigned long long)(1023 + ki) << 52);
}
constexpr int S5SM_PW = 64 * 33, S5SM_HEAD = 2 * S5SM_PW + 2048, S5SM_FLOATS = S5SM_HEAD + 8192;
struct S5Lds { LAS float* pwr; LAS float* pwi; LAS float* bbr; LAS float* bbi; LAS float* ccr; LAS float* cci; LAS float* km; };
__device__ __forceinline__ S5Lds s5_lds(LAS unsigned char* lds) { S5Lds L; L.pwr = (LAS float*)lds; L.pwi = L.pwr + S5SM_PW; L.bbr = L.pwi + S5SM_PW; L.bbi = L.bbr + 1024; L.ccr = L.bbi + 1024; L.cci = L.ccr + 1024; L.km = L.cci + 1024; return L; }
__device__ __forceinline__ void s5_tables_small(int g, LAS unsigned char* lds, const float* lam_re, const float* lam_im, const float* log_dt, const float* b_re, const float* b_im,
                                                const float* c_re, const float* c_im, float* S5SM, float* LAM32, int tid) {
    const S5Lds L = s5_lds(lds); LAS float* pwr = L.pwr; LAS float* pwi = L.pwi; LAS float* bbr = L.bbr; LAS float* bbi = L.bbi; LAS float* ccr = L.ccr; LAS float* cci = L.cci; LAS float* km = L.km;
    const double dt = dexp((double)log_dt[g]);
    for (int idx = tid; idx < 64 * 33; idx += NTHREADS) { const int p = idx / 33, tau = idx % 33;
        const double lr = lam_re[g * 64 + p], li = lam_im[g * 64 + p]; const double mag = dexp(lr * dt * tau); double s, c; dsincos(li * dt * tau, s, c);
        pwr[idx] = (float)(mag * c); pwi[idx] = (float)(mag * s); }
    for (int idx = tid; idx < 1024; idx += NTHREADS) { const int p = idx >> 4, m = idx & 15;
        const double lr = lam_re[g * 64 + p], li = lam_im[g * 64 + p]; const double mag = dexp(lr * dt); double s, c; dsincos(li * dt, s, c);
        const double ar = mag * c - 1.0, ai = mag * s, den = lr * lr + li * li, fr_ = (ar * lr + ai * li) / den, fi_ = (ai * lr - ar * li) / den;
        const double br = b_re[(g * 64 + p) * 16 + m], bi = b_im[(g * 64 + p) * 16 + m];
        bbr[idx] = (float)(fr_ * br - fi_ * bi); bbi[idx] = (float)(fr_ * bi + fi_ * br);
        ccr[idx] = c_re[g * 1024 + idx]; cci[idx] = c_im[g * 1024 + idx]; }
    __syncthreads();
    { const int half = tid >> 8, n = (tid >> 4) & 15, m = tid & 15; float acc[16];
#pragma unroll
      for (int t = 0; t < 16; ++t) acc[t] = 0.f;
      for (int p = 0; p < 64; ++p) { const float cr = ccr[n * 64 + p], ci = cci[n * 64 + p], br = bbr[p * 16 + m], bi = bbi[p * 16 + m]; const float zr = cr * br - ci * bi, zi = cr * bi + ci * br;
#pragma unroll
          for (int t = 0; t < 16; ++t) acc[t] += zr * pwr[p * 33 + 16 * half + t] - zi * pwi[p * 33 + 16 * half + t]; }
#pragma unroll
      for (int t = 0; t < 16; ++t) km[((16 * half + t) * 16 + n) * 16 + m] = acc[t]; }
    __syncthreads();
    float* S = S5SM + (size_t)g * S5SM_FLOATS;
    for (int i = tid; i < S5SM_HEAD; i += NTHREADS) S[i] = pwr[i];
    for (int i = tid; i < 8192; i += NTHREADS) S[S5SM_HEAD + i] = km[i];
    if (tid < 64) { LAM32[(g * 64 + tid) * 2] = pwr[tid * 33 + 32]; LAM32[(g * 64 + tid) * 2 + 1] = pwi[tid * 33 + 32]; }
    __syncthreads();
}
__device__ __forceinline__ void s5_load(int g, LAS unsigned char* lds, const float* S5SM, const float* c_re, const float* c_im, bool with_km, int tid) {
    const S5Lds L = s5_lds(lds); const float* S = S5SM + (size_t)g * S5SM_FLOATS;
    for (int i = tid; i < S5SM_HEAD / 4; i += NTHREADS) *(LAS f32x4*)(L.pwr + 4 * i) = *(const GAS f32x4*)(S + 4 * i);
    for (int i = tid; i < 256; i += NTHREADS) { *(LAS f32x4*)(L.ccr + 4 * i) = *(const GAS f32x4*)(c_re + g * 1024 + 4 * i); *(LAS f32x4*)(L.cci + 4 * i) = *(const GAS f32x4*)(c_im + g * 1024 + 4 * i); }
    if (with_km) for (int i = tid; i < 2048; i += NTHREADS) *(LAS f32x4*)(L.km + 4 * i) = *(const GAS f32x4*)(S + S5SM_HEAD + 4 * i);
    __syncthreads();
}
__device__ __forceinline__ void s5_expand_tz(int g, LAS unsigned char* lds, bf16* TZ, int row_lo, int row_hi, int tid) {
    const S5Lds L = s5_lds(lds); LAS float* pwr = L.pwr; LAS float* pwi = L.pwi; LAS float* ccr = L.ccr; LAS float* cci = L.cci; LAS float* km = L.km;
    bf16* tz = TZ + (size_t)g * 512 * 640;
    for (int pc = row_lo * 80 + tid; pc < row_hi * 80; pc += NTHREADS) { const int row = pc / 80, c8 = pc % 80, j = row >> 4, n = row & 15; float v[8];
        if (c8 < 64) { const int i = c8 >> 1, m0 = (c8 & 1) * 8;
#pragma unroll
            for (int e = 0; e < 8; ++e) v[e] = (i <= j) ? km[((j - i) * 16 + n) * 16 + m0 + e] : 0.f; }
        else { const int p0 = (c8 - 64) * 4;
#pragma unroll
            for (int q = 0; q < 4; ++q) { const int p = p0 + q; const float cr = ccr[n * 64 + p], ci = cci[n * 64 + p], pr = pwr[p * 33 + j + 1], pi = pwi[p * 33 + j + 1];
                v[2 * q] = cr * pr - ci * pi; v[2 * q + 1] = -(cr * pi + ci * pr); } }
        v4u o; o.x = pk2(v[0], v[1]); o.y = pk2(v[2], v[3]); o.z = pk2(v[4], v[5]); o.w = pk2(v[6], v[7]);
        *(GAS v4u*)(tz + (size_t)row * 640 + c8 * 8) = o; }
}
__device__ __forceinline__ void s5_expand_w1t(int g, LAS unsigned char* lds, bf16* W1T, int row_lo, int row_hi, int tid) {
    const S5Lds L = s5_lds(lds); LAS float* pwr = L.pwr; LAS float* pwi = L.pwi; LAS float* bbr = L.bbr; LAS float* bbi = L.bbi;
    bf16* w1 = W1T + (size_t)g * 256 * 512;
    for (int pc = row_lo * 64 + tid; pc < row_hi * 64; pc += NTHREADS) { const int row = pc >> 6, c8 = pc & 63, p = row >> 1, ri = row & 1, i = c8 >> 1, m0 = (c8 & 1) * 8; float v[8];
        const float ar = pwr[p * 33 + 31 - i], ai = pwi[p * 33 + 31 - i];
#pragma unroll
        for (int e = 0; e < 8; ++e) { const float br = bbr[p * 16 + m0 + e], bi = bbi[p * 16 + m0 + e]; v[e] = ri ? (ar * bi + ai * br) : (ar * br - ai * bi); }
        v4u o; o.x = pk2(v[0], v[1]); o.y = pk2(v[2], v[3]); o.z = pk2(v[4], v[5]); o.w = pk2(v[6], v[7]);
        *(GAS v4u*)(w1 + (size_t)row * 512 + c8 * 8) = o; }
}

constexpr int KS_PITCH = 144, VS_PITCH = 520, ATT_KS = 0, ATT_VS = 256 * KS_PITCH;
static_assert(ATT_VS + 64 * VS_PITCH <= RING_BYTES, "attention LDS");
#define MFMA32(a, b, c) __builtin_amdgcn_mfma_f32_32x32x16_bf16(a, b, c, 0, 0, 0)
struct KVRegs { v4u k[4]; v4u v[4]; };
__device__ __forceinline__ void att_load(KVRegs& R, const bf16* Kg, int kpitch, const bf16* Vg, int vpitch, int tid) {
#pragma unroll
    for (int i = 0; i < 4; ++i) { const int p = tid + NTHREADS * i, row = p >> 3, c = p & 7; R.k[i] = *(const GAS v4u*)(Kg + (size_t)row * kpitch + c * 8); }
#pragma unroll
    for (int i = 0; i < 4; ++i) { const int p = tid + NTHREADS * i, row = p >> 5, c = p & 31; R.v[i] = *(const GAS v4u*)(Vg + (size_t)row * vpitch + c * 8); }
}
__device__ __forceinline__ void att_store(LAS unsigned char* lds, const KVRegs& R, int tid) {
#pragma unroll
    for (int i = 0; i < 4; ++i) { const int p = tid + NTHREADS * i, row = p >> 3, c = p & 7; *(LAS v4u*)(lds + ATT_KS + row * KS_PITCH + c * 16) = R.k[i]; }
#pragma unroll
    for (int i = 0; i < 4; ++i) { const int p = tid + NTHREADS * i, row = p >> 5, c = p & 31;
        LAS v2u* d = (LAS v2u*)(lds + ATT_VS + row * VS_PITCH + c * 16); d[0] = (v2u){R.v[i].x, R.v[i].y}; d[1] = (v2u){R.v[i].z, R.v[i].w}; }
}
__device__ __forceinline__ void att_stage(LAS unsigned char* lds, const bf16* Kg, int kpitch, const bf16* Vg, int vpitch, int tid) { KVRegs R; att_load(R, Kg, kpitch, Vg, vpitch, tid); att_store(lds, R, tid); }
__device__ __forceinline__ void att_qk(const LAS unsigned char* lds, const bf16x8 (&qf)[4], int kt, f32x16& p0, f32x16& p1, int lane) {
    const int r32 = lane & 31, hi = lane >> 5;
#pragma unroll
    for (int r = 0; r < 16; ++r) { p0[r] = 0.f; p1[r] = 0.f; }
    const LAS unsigned char* kb = lds + ATT_KS + (kt * 64 + r32) * KS_PITCH + hi * 16;
#pragma unroll
    for (int d0 = 0; d0 < 4; ++d0) { const bf16x8 k0 = *(const LAS bf16x8*)(kb + d0 * 32), k1 = *(const LAS bf16x8*)(kb + 32 * KS_PITCH + d0 * 32);
        p0 = MFMA32(k0, qf[d0], p0); p1 = MFMA32(k1, qf[d0], p1); }
}
template <int MODE> __device__ __forceinline__ void att_finish(const LAS unsigned char* lds, int kt, f32x16& p0, f32x16& p1, f32x16& o0, f32x16& o1, float& l, int qloc, bool rowoff, int lane) {
    const int r32 = lane & 31, hi = lane >> 5; const float NEG = -__builtin_inff();
    if (MODE == 1) { const int kv0 = kt * 64 + 4 * hi;
#pragma unroll
        for (int r = 0; r < 16; ++r) { const int kv = kv0 + (r & 3) + 8 * (r >> 2); if (kv > qloc) p0[r] = NEG; if (kv + 32 > qloc) p1[r] = NEG; } }
    float rs = 0.f;
#pragma unroll
    for (int r = 0; r < 16; ++r) { p0[r] = __builtin_amdgcn_exp2f(p0[r]); p1[r] = __builtin_amdgcn_exp2f(p1[r]); rs += p0[r] + p1[r]; }
    if (MODE == 2) rs = rowoff ? 0.f : rs;
    l += rs;
    bf16x8 pb[4];
#pragma unroll
    for (int s = 0; s < 2; ++s) { v4u w0, w1;
        w0.x = cvt_pk_bf16(p0[8 * s + 0], p0[8 * s + 1]); w0.y = cvt_pk_bf16(p0[8 * s + 2], p0[8 * s + 3]); w0.z = cvt_pk_bf16(p0[8 * s + 4], p0[8 * s + 5]); w0.w = cvt_pk_bf16(p0[8 * s + 6], p0[8 * s + 7]);
        w1.x = cvt_pk_bf16(p1[8 * s + 0], p1[8 * s + 1]); w1.y = cvt_pk_bf16(p1[8 * s + 2], p1[8 * s + 3]); w1.z = cvt_pk_bf16(p1[8 * s + 4], p1[8 * s + 5]); w1.w = cvt_pk_bf16(p1[8 * s + 6], p1[8 * s + 7]);
        if (MODE == 2) { if (rowoff) { w0 = (v4u){0u, 0u, 0u, 0u}; w1 = (v4u){0u, 0u, 0u, 0u}; } }
        pb[s] = __builtin_bit_cast(bf16x8, w0); pb[2 + s] = __builtin_bit_cast(bf16x8, w1); }
    const LAS unsigned char* vb = lds + ATT_VS + r32 * VS_PITCH + (kt * 64 + 4 * hi) * 2;
#pragma unroll
    for (int s = 0; s < 4; ++s) { const int ko = (32 * (s >> 1) + 16 * (s & 1)) * 2;
        const s16x4 a0 = *(const LAS s16x4*)(vb + ko), a1 = *(const LAS s16x4*)(vb + ko + 16);
        const s16x4 b0 = *(const LAS s16x4*)(vb + 32 * VS_PITCH + ko), b1 = *(const LAS s16x4*)(vb + 32 * VS_PITCH + ko + 16);
        const bf16x8 va = (bf16x8){a0[0], a0[1], a0[2], a0[3], a1[0], a1[1], a1[2], a1[3]}, vc = (bf16x8){b0[0], b0[1], b0[2], b0[3], b1[0], b1[1], b1[2], b1[3]};
        o0 = MFMA32(va, pb[s], o0); o1 = MFMA32(vc, pb[s], o1); }
}
template <int MODE> __device__ __forceinline__ void att_block(const LAS unsigned char* lds, const bf16x8 (&qf)[4], f32x16& o0, f32x16& o1, float& l, int nkt, int qloc, bool rowoff, int lane) {
    f32x16 pa0, pa1, pb0, pb1;
    att_qk(lds, qf, 0, pa0, pa1, lane);
    int kt = 0;
    for (; kt + 1 < nkt; kt += 2) {
        att_qk(lds, qf, kt + 1, pb0, pb1, lane);
        att_finish<MODE>(lds, kt, pa0, pa1, o0, o1, l, qloc, rowoff, lane);
        if (kt + 2 < nkt) att_qk(lds, qf, kt + 2, pa0, pa1, lane);
        att_finish<MODE>(lds, kt + 1, pb0, pb1, o0, o1, l, qloc, rowoff, lane);
    }
    if (kt < nkt) att_finish<MODE>(lds, kt, pa0, pa1, o0, o1, l, qloc, rowoff, lane);
}
__device__ __forceinline__ void att_load_q(const bf16* qrow  , float (&qv)[4][8], bf16x8 (&qf)[4]) {
    float ss = 0.f;
#pragma unroll
    for (int d0 = 0; d0 < 4; ++d0) { const v4u w = *(const GAS v4u*)(qrow + d0 * 16);
        qv[d0][0] = bf_lo(w.x); qv[d0][1] = bf_hi(w.x); qv[d0][2] = bf_lo(w.y); qv[d0][3] = bf_hi(w.y); qv[d0][4] = bf_lo(w.z); qv[d0][5] = bf_hi(w.z); qv[d0][6] = bf_lo(w.w); qv[d0][7] = bf_hi(w.w);
#pragma unroll
        for (int e = 0; e < 8; ++e) ss += qv[d0][e] * qv[d0][e]; }
    ss += __shfl_xor(ss, 32);
    const float sc = (1.f / sqrtf(ss * (1.f / 64.f) + RMS_EPS)) * (0.125f * 1.4426950408889634f);
#pragma unroll
    for (int d0 = 0; d0 < 4; ++d0) { v4u w; w.x = cvt_pk_bf16(qv[d0][0] * sc, qv[d0][1] * sc); w.y = cvt_pk_bf16(qv[d0][2] * sc, qv[d0][3] * sc); w.z = cvt_pk_bf16(qv[d0][4] * sc, qv[d0][5] * sc); w.w = cvt_pk_bf16(qv[d0][6] * sc, qv[d0][7] * sc);
        qf[d0] = __builtin_bit_cast(bf16x8, w); }
}
constexpr int ATT_OST = 73728, OST_PITCH = 144;
static_assert(ATT_OST >= ATT_VS + 64 * VS_PITCH && ATT_OST + 8 * 32 * OST_PITCH <= RING_BYTES, "attention output stage");
template <bool OUT8 = false  >
__device__ __forceinline__ void att_store_o(LAS unsigned char* lds, bf16* obase  , int opitch, const f32x16& o0, const f32x16& o1, float l, int lane, int wid) {
    const int r32 = lane & 31, hi = lane >> 5;
    l += __shfl_xor(l, 32); const float inv = 1.f / l;
    LAS unsigned char* st = lds + ATT_OST + wid * (32 * OST_PITCH);
    if constexpr (OUT8) {
        const float i8 = inv * 8.f;
#pragma unroll
        for (int a = 0; a < 4; ++a) {
            *(LAS unsigned*)(st + r32 * OST_PITCH + (8 * a + 4 * hi)) = pg8::pk4_fp8(__builtin_amdgcn_fmed3f(o0[4 * a] * i8, -440.f, 440.f), __builtin_amdgcn_fmed3f(o0[4 * a + 1] * i8, -440.f, 440.f), __builtin_amdgcn_fmed3f(o0[4 * a + 2] * i8, -440.f, 440.f), __builtin_amdgcn_fmed3f(o0[4 * a + 3] * i8, -440.f, 440.f));
            *(LAS unsigned*)(st + r32 * OST_PITCH + (32 + 8 * a + 4 * hi)) = pg8::pk4_fp8(__builtin_amdgcn_fmed3f(o1[4 * a] * i8, -440.f, 440.f), __builtin_amdgcn_fmed3f(o1[4 * a + 1] * i8, -440.f, 440.f), __builtin_amdgcn_fmed3f(o1[4 * a + 2] * i8, -440.f, 440.f), __builtin_amdgcn_fmed3f(o1[4 * a + 3] * i8, -440.f, 440.f)); }
        LDS_WAIT(); asm volatile("" ::: "memory");
#pragma unroll
        for (int i = 0; i < 2; ++i) { const int idx = lane + 64 * i, row = idx >> 2, c = idx & 3;
            const v4u v = *(const LAS v4u*)(st + row * OST_PITCH + c * 16);
            *(GAS v4u*)((unsigned char*)obase + (size_t)row * opitch + c * 16) = v; }
        LDS_WAIT(); asm volatile("" ::: "memory");
        return; }
#pragma unroll
    for (int a = 0; a < 4; ++a) {
        *(LAS v2u*)(st + r32 * OST_PITCH + (8 * a + 4 * hi) * 2) = (v2u){cvt_pk_bf16(o0[4 * a] * inv, o0[4 * a + 1] * inv), cvt_pk_bf16(o0[4 * a + 2] * inv, o0[4 * a + 3] * inv)};
        *(LAS v2u*)(st + r32 * OST_PITCH + (32 + 8 * a + 4 * hi) * 2) = (v2u){cvt_pk_bf16(o1[4 * a] * inv, o1[4 * a + 1] * inv), cvt_pk_bf16(o1[4 * a + 2] * inv, o1[4 * a + 3] * inv)}; }
    LDS_WAIT(); asm volatile("" ::: "memory");
#pragma unroll
    for (int i = 0; i < 4; ++i) { const int idx = lane + 64 * i, row = idx >> 3, c = idx & 7;
        const v4u v = *(const LAS v4u*)(st + row * OST_PITCH + c * 16);
        *(GAS v4u*)(obase + (size_t)row * opitch + c * 8) = v; }
    LDS_WAIT(); asm volatile("" ::: "memory");
}
template <bool OUT8 = false  >
__device__ __forceinline__ void mem_unit(LAS unsigned char* lds, const bf16* Q, int qpitch, const bf16* Kg, const bf16* Vg, bf16* O, int tid) {
    const int lane = tid & 63, wid = __builtin_amdgcn_readfirstlane(tid >> 6), r32 = lane & 31, hi = lane >> 5;
    att_stage(lds, Kg, 512, Vg, 2048, tid);
    float qv[4][8]; bf16x8 qf[4];
    att_load_q(Q + (size_t)(wid * 32 + r32) * qpitch + hi * 8, qv, qf);
    __syncthreads();
    f32x16 o0, o1; float l = 0.f;
#pragma unroll
    for (int r = 0; r < 16; ++r) { o0[r] = 0.f; o1[r] = 0.f; }
    att_block<0>(lds, qf, o0, o1, l, 4, 0, false, lane);
    if constexpr (OUT8) att_store_o<true>(lds, (bf16*)((unsigned char*)O + (size_t)(wid * 32) * 1024), 1024, o0, o1, l, lane, wid);
    else att_store_o(lds, O + (size_t)(wid * 32) * 1024, 1024, o0, o1, l, lane, wid);
    __syncthreads();
}
__device__ __forceinline__ void moba_unit(LAS unsigned char* lds, int b, int qh, int qblk, const bf16* KQ, const bf16* VT, const float* KMEANS, bf16* CAT, int tid) {
    const int lane = tid & 63, wid = __builtin_amdgcn_readfirstlane(tid >> 6), r32 = lane & 31, hi = lane >> 5, kvh = qh / 3;
    const size_t tok0 = (size_t)b * SEQ + (size_t)qblk * 256;
    att_stage(lds, KQ + tok0 * 1280 + kvh * 64, 1280, VT + (size_t)(kvh * 64) * T + tok0, T, tid);
    float qv[4][8]; bf16x8 qf[4];
    att_load_q(KQ + (tok0 + wid * 32 + r32) * 1280 + 256 + qh * 64 + hi * 8, qv, qf);
    unsigned sel = 0u;
    if (qblk > 0) {
        float gt[7];
#pragma unroll
        for (int j = 0; j < 7; ++j) { gt[j] = -3e38f;
            if (j < qblk) { const float* km = KMEANS + (size_t)((b * 4 + kvh) * 8 + j) * 64 + hi * 8; float a = 0.f;
#pragma unroll
                for (int d0 = 0; d0 < 4; ++d0) { const f32x4 k0 = *(const GAS f32x4*)(km + d0 * 16), k1 = *(const GAS f32x4*)(km + d0 * 16 + 4);
                    a += qv[d0][0] * k0[0] + qv[d0][1] * k0[1] + qv[d0][2] * k0[2] + qv[d0][3] * k0[3] + qv[d0][4] * k1[0] + qv[d0][5] * k1[1] + qv[d0][6] * k1[2] + qv[d0][7] * k1[3]; }
                a += __shfl_xor(a, 32); gt[j] = a; } }
#pragma unroll
        for (int j = 0; j < 7; ++j) { int rank = 0;
#pragma unroll
            for (int j2 = 0; j2 < 7; ++j2) if (j2 != j) rank += (gt[j2] > gt[j] || (gt[j2] == gt[j] && j2 < j)) ? 1 : 0;
            if (j < qblk && rank < 3) sel |= 1u << j; }
    }
    __syncthreads();
    f32x16 o0, o1; float l = 0.f;
#pragma unroll
    for (int r = 0; r < 16; ++r) { o0[r] = 0.f; o1[r] = 0.f; }
    att_block<1>(lds, qf, o0, o1, l, (wid >> 1) + 1, wid * 32 + r32, false, lane);
    for (int j = 0; j < qblk; ++j) {
        __syncthreads();
        { const size_t tk = (size_t)b * SEQ + (size_t)j * 256; att_stage(lds, KQ + tk * 1280 + kvh * 64, 1280, VT + (size_t)(kvh * 64) * T + tk, T, tid); }
        __syncthreads();
        const bool off = !((sel >> j) & 1u);
        if (!__all(off)) att_block<2>(lds, qf, o0, o1, l, 4, 0, off, lane);
    }
    att_store_o<true>(lds, (bf16*)((unsigned char*)CAT + (size_t)(tok0 + wid * 32) * 1024 + qh * 64), 1024, o0, o1, l, lane, wid);
    __syncthreads();
}

struct Args { const float* in[42]; float* out; unsigned char* ws; int ph_lo, ph_hi; };
constexpr int NPHASE = 21;
__global__ void __launch_bounds__(NTHREADS, 2) fwd_kernel(Args args) {
    extern __shared__ __attribute__((aligned(16))) unsigned char lds_raw[];
    LAS unsigned char* lds = (LAS unsigned char*)lds_raw;
    volatile LAS unsigned* MISC = (volatile LAS unsigned*)(lds + MISC_OFF);
    const int tid = threadIdx.x, lane = tid & 63, wave = __builtin_amdgcn_readfirstlane(tid >> 6);
    const int G = gridDim.x, bx = blockIdx.x;
    const int gw = bx * NWAVES + wave, NGW = G * NWAVES;
    unsigned char* ws = args.ws;
    gu32* ctl = (gu32*)(ws + WS_CTL);
    for (int u = tid; u < (LDS_BYTES - RING_BYTES) / 4; u += NTHREADS) ((LAS unsigned*)(lds + RING_BYTES))[u] = 0u;
    __syncthreads();
    const int lo = args.ph_lo, hi_ph = args.ph_hi;
    XcdBarrier bar; bar.bar = (unsigned*)(ctl + CW_BAR); bar.x = 0; bar.st = nullptr;
    if (hi_ph - lo > 1) bar = xcd_barrier_post((unsigned*)(ctl + CW_BAR), MISC + 8);
#define IN(k) (lo <= (k) && (k) < hi_ph)
#define SEAM(k) do { if (IN(k) && IN((k) + 1)) xcd_barrier(bar); } while (0)
    const float* const* in = args.in;
    float* OUT = args.out;
    bf16* W_MEMK = (bf16*)(ws + WS_WMEMK); bf16* W_MEMV = (bf16*)(ws + WS_WMEMV); bf16* W_KQ = (bf16*)(ws + WS_WKQ); bf16* W_V = (bf16*)(ws + WS_WV); bf16* W_OUT1 = (bf16*)(ws + WS_WOUT1);
    bf16* W_MGU = (bf16*)(ws + WS_WMGU); bf16* W_MD = (bf16*)(ws + WS_WMD);
    bf16* XB = (bf16*)(ws + WS_XB); bf16* CAT = (bf16*)(ws + WS_CAT); bf16* MEMN = (bf16*)(ws + WS_MEMN); bf16* MEMK = (bf16*)(ws + WS_MEMK); bf16* MEMVT = (bf16*)(ws + WS_MEMVT);
    bf16* XS = (bf16*)(ws + AR_XS); bf16* ACTM = (bf16*)(ws + AR_ACTM);
    bf16* W_IN0 = (bf16*)(ws + AR_WIN0); bf16* W_GLU = (bf16*)(ws + AR_WGLU); bf16* W_OUT0 = (bf16*)(ws + AR_WOUT0); bf16* W_FGU = (bf16*)(ws + AR_WFGU); bf16* W_FD = (bf16*)(ws + AR_WFD);
    bf16* TZ = (bf16*)(ws + AR_TZ); bf16* W1T = (bf16*)(ws + AR_W1T); bf16* UG = (bf16*)(ws + AR_UG); bf16* QM0 = (bf16*)(ws + AR_QM0); float* XC = (float*)(ws + AR_XC); bf16* GACT = (bf16*)(ws + AR_GACT);
    unsigned char* X8 = ws + AR_X8;
    float* S5SM = (float*)(ws + AR_S5SM);
    bf16* ACT0 = (bf16*)(ws + AR_ACT0); bf16* KQ = (bf16*)(ws + AR_KQ); bf16* VT = (bf16*)(ws + AR_VT);
    float* KMEANS = (float*)(ws + SM_KMEANS); float* LAM32 = (float*)(ws + SM_LAM32); int* PANEND = (int*)(ws + SM_PANEND);
    int* WGCNT = (int*)(ws + WS_MEMN + 3 * MiB);
    float* SS = (float*)(ws + WS_MEMN); float* ROWRS = (float*)(ws + WS_MEMN + MiB); float* TOKRS = (float*)(ws + WS_MEMN + 2 * MiB);
    int* TOKE = (int*)(ws + SM_TOKE); int* TOKLP = (int*)(ws + SM_TOKLP); float* TOKG = (float*)(ws + SM_TOKG); int* ROWTOK = (int*)(ws + SM_ROWTOK); float* ROWGATE = (float*)(ws + SM_ROWGATE);

    if (IN(0)) {
        if (bx < 48) s5_tables_small(bx, lds, in[4], in[5], in[6], in[7], in[8], in[9], in[10], S5SM, LAM32, tid);
        LAS unsigned* scr = (LAS unsigned*)(lds + wave * 16384);
        constexpr int I_E = (1024 / 64) * (DFE / 64), I_ED = (DFE / 64) * (1024 / 64);
        constexpr int I_MOE = NEXP * (2 * I_E + I_ED);
        constexpr int I_SQ = 16 * 16, I_GLU = 12 * 12, I_M = 16 * 4, I_F = 16 * 44, I_FD = 44 * 16;
        constexpr int NITEMS = 4 * I_SQ + I_GLU + 6 * I_M + 2 * I_F + I_FD;
        for (;;) {
            int it0 = 0; if (lane == 0) it0 = (int)__hip_atomic_fetch_add((unsigned*)(ctl + CW_QUEUE + 64), 2u, __ATOMIC_RELAXED, __HIP_MEMORY_SCOPE_AGENT);
            it0 = __builtin_amdgcn_readfirstlane(it0);
            if (it0 >= NITEMS) break;
            for (int it = it0; it < it0 + 2 && it < NITEMS; ++it) {
            int r = it;
#define CV_F8(NI, SRC, LDW, NPB, GAIN, DST, LDO, ROW0) if (r < (NI)) { const int kb = r / (NPB), n0 = (r % (NPB)) * 64; CvtDesc8 d; d.src = (SRC) + (size_t)(kb * 64) * (LDW) + n0; d.gain = (GAIN); d.dst = (unsigned char*)(DST) + (size_t)((ROW0) + n0) * (LDO) + kb * 64; d.ldw = (LDW); d.ldo = (LDO); d.k0 = kb * 64; \
                f32x4 a[4][4]; float gq[4][4]; cvt_load8(d, a, gq, MOE_WSCALE, lane); cvt_emit8(d, a, gq, scr, lane); continue; } r -= (NI);
#define CV_PLAIN(NI, SRC, LDW, NPB, GAIN, DST, LDO, ROW0) if (r < (NI)) { const int kb = r / (NPB), n0 = (r % (NPB)) * 64; cvt_item(SRC, LDW, kb * 64, n0, GAIN, DST, LDO, (ROW0) + n0, scr, lane); continue; } r -= (NI);
            CV_PLAIN(I_SQ, in[3], 1024, 16, in[2], W_IN0, 1024, 0)
            CV_PLAIN(I_SQ, in[19], 1024, 16, nullptr, W_OUT0, 1024, 0)
            CV_F8(I_SQ, in[29], 1024, 16, in[28], W_KQ, 1024, 256)
            if (r < I_SQ) { const int kb = r / 16, n0 = (r % 16) * 64; CvtDesc8 d; d.src = in[36] + (size_t)(kb * 64) * 1024 + n0; d.gain = nullptr; d.dst = (unsigned char*)W_OUT1 + (size_t)n0 * 1024 + kb * 64; d.ldw = 1024; d.ldo = 1024; d.k0 = kb * 64;
                f32x4 a[4][4]; float gq[4][4]; cvt_load8(d, a, gq, MOE_WSCALE, lane); cvt_emit8(d, a, gq, scr, lane); continue; }
            r -= I_SQ;
            CV_PLAIN(I_GLU, in[12], 768, 12, nullptr, W_GLU, 768, 0)
            CV_PLAIN(I_M, in[15], 256, 4, in[14], W_MEMK, 1024, 0)
            CV_PLAIN(I_M, in[32], 256, 4, in[31], W_MEMK, 1024, 256)
            CV_PLAIN(I_M, in[16], 256, 4, in[14], W_MEMV, 1024, 0)
            CV_PLAIN(I_M, in[33], 256, 4, in[31], W_MEMV, 1024, 256)
            CV_F8(I_M, in[25], 256, 4, in[24], W_KQ, 1024, 0)
            CV_F8(I_M, in[26], 256, 4, in[24], W_V, 1024, 0)
            if (r < 2 * I_F) { const int up = r / I_F; r -= up * I_F; const int kb = r / 44, n0 = (r % 44) * 64;
                cvt_item(in[21 + up], DFF, kb * 64, n0, in[20], W_FGU, 1024, (n0 >> 7) * 256 + (n0 & 127) + up * 128, scr, lane); continue; }
            r -= 2 * I_F;
            { const int kb = r / 16, n0 = (r % 16) * 64; CvtDesc8 d; d.src = in[23] + (size_t)(kb * 64) * 1024 + n0; d.gain = nullptr; d.dst = (unsigned char*)W_FD + (size_t)n0 * DFF + kb * 64; d.ldw = 1024; d.ldo = DFF; d.k0 = kb * 64;
              f32x4 a[4][4]; float gq[4][4]; cvt_load8(d, a, gq, MOE_WSCALE, lane); cvt_emit8(d, a, gq, scr, lane); }
            }
        }
        for (;;) {
            int r0 = 0; if (lane == 0) r0 = (int)__hip_atomic_fetch_add((unsigned*)(ctl + CW_QUEUE + 192), 16u, __ATOMIC_RELAXED, __HIP_MEMORY_SCOPE_AGENT);
            r0 = __builtin_amdgcn_readfirstlane(r0);
            if (r0 >= T + NB * 256) break;
            for (int mrow = r0; mrow < r0 + 16; ++mrow) { if (mrow < T) rms_row_to_bf16(in[0] + (size_t)mrow * D, XB + (size_t)mrow * D, lane); else rms_row_to_bf16(in[1] + (size_t)(mrow - T) * D, MEMN + (size_t)(mrow - T) * D, lane); } }
        for (int i = bx * NTHREADS + tid; i < 2 * RROWS; i += G * NTHREADS) ROWTOK[i] = -1;
    }
    SEAM(0);
    if (IN(1)) { pg8::Gemm g{XB, W_IN0, 1024, 1024, 1024}; pg8::StaticOrder S; S.init(T / 256, 4, G, bx); pg8::EpiProj0 E{UG, QM0};
        pg8::gemm_phase<pg8::EpiProj0, pg8::StaticOrder, true, true>(lds, g, S, E);
        if (bx < 192) { const int sg = bx >> 2, sq = bx & 3; s5_load(sg, lds, S5SM, in[9], in[10], false, tid); s5_expand_w1t(sg, lds, W1T, sq * 32, sq * 32 + 32, tid); __syncthreads(); } }
    SEAM(1);
    if (IN(2)) {
        if (bx < 96) { pg8::Gemm g{UG, W1T, 640, 512, 512}; pg8::BatchOrder S; S.init(48, 2, 1, 96, bx); pg8::EpiS5a E{XC};
          pg8::gemm_phase<pg8::EpiS5a, pg8::BatchOrder, true, true>(lds, g, S, E);
          if (tid < 256) { const int g = bx >> 1, mt = bx & 1, bl = tid >> 6, p = tid & 63;
            const float lr = LAM32[(g * 64 + p) * 2], li = LAM32[(g * 64 + p) * 2 + 1]; float hr = 0.f, hi_ = 0.f;
            const size_t row0 = (size_t)g * 512 + mt * 256 + bl * 64;
            for (int c = 0; c < 64; ++c) { const float xr = XC[(row0 + c) * 128 + 2 * p], xi = XC[(row0 + c) * 128 + 2 * p + 1];
                *(GAS unsigned*)(UG + (row0 + c) * 640 + 512 + 2 * p) = cvt_pk_bf16(hr, hi_);
                const float nr = lr * hr - li * hi_ + xr, ni = lr * hi_ + li * hr + xi; hr = nr; hi_ = ni; } } }
        else if (bx < 112) { pg8::Gemm g{MEMN, W_MEMK, 1024, 1024, 1024}; pg8::StaticOrder S; S.init(8, 2, 16, bx - 96); pg8::EpiPlain E{MEMK, 512, 0, 0};
          pg8::gemm_phase<pg8::EpiPlain, pg8::StaticOrder, true, true>(lds, g, S, E);
          pg8::Unit u; S.next(0, u); const int layer = u.pn; const float* kg = layer ? in[35] : in[18]; const float* qg = layer ? in[34] : in[17];
          const int c0 = lane * 4, d = c0 & 63; float gk[4];
#pragma unroll
          for (int e = 0; e < 4; ++e) gk[e] = kg[d + e] * qg[d + e];
          for (int rr = 0; rr < 32; ++rr) { bf16* p = MEMK + (size_t)(u.pm * 256 + wave * 32 + rr) * 512 + layer * 256 + c0; const v2u w = *(const GAS v2u*)p;
              float v[4] = {bf_lo(w.x), bf_hi(w.x), bf_lo(w.y), bf_hi(w.y)}; float ss = v[0] * v[0] + v[1] * v[1] + v[2] * v[2] + v[3] * v[3];
              ss += __shfl_xor(ss, 1); ss += __shfl_xor(ss, 2); ss += __shfl_xor(ss, 4); ss += __shfl_xor(ss, 8);
              const float r = 1.f / sqrtf(ss * (1.f / 64.f) + RMS_EPS);
              *(GAS v2u*)p = (v2u){cvt_pk_bf16(v[0] * r * gk[0], v[1] * r * gk[1]), cvt_pk_bf16(v[2] * r * gk[2], v[3] * r * gk[3])}; } }
        else if (bx < 128) { pg8::Gemm g{W_MEMV, MEMN, 1024, 1024, 1024}; pg8::StaticOrder S; S.init(2, 8, 16, bx - 112); pg8::EpiPlain E{MEMVT, 2048, 0, 0};
          pg8::gemm_phase<pg8::EpiPlain, pg8::StaticOrder, true, true>(lds, g, S, E); }
        else { int cur = -1;
          for (int it = (bx - 128) * 3; it < (bx - 128) * 3 + 3; ++it) { const int sg = it >> 3, part = it & 7;
              if (sg != cur) { __syncthreads(); s5_load(sg, lds, S5SM, in[9], in[10], true, tid); cur = sg; }
              s5_expand_tz(sg, lds, TZ, part * 64, part * 64 + 64, tid); }
          __syncthreads(); }
    }
    SEAM(2);
    if (IN(4)) {
        if (bx < 192) { pg8::Gemm g{UG, TZ, 640, 640, 640}; pg8::BatchOrder S; S.init(48, 2, 2, 192, bx); pg8::EpiS5c E{UG, in[11], GACT};
            pg8::gemm_phase<pg8::EpiS5c, pg8::BatchOrder, true, true>(lds, g, S, E); }
        for (;;) {
            if (tid == 0) MISC[0] = __hip_atomic_fetch_add((unsigned*)(ctl + CW_QUEUE + 128), 1u, __ATOMIC_RELAXED, __HIP_MEMORY_SCOPE_AGENT);
            __syncthreads();
            const int u = (int)MISC[0];
            __syncthreads();
            if (u >= 256) break;
            const int b = u >> 5, h = (u >> 3) & 3, qt = u & 7; const size_t t0 = (size_t)b * SEQ + qt * 256;
            mem_unit(lds, QM0 + t0 * 256 + h * 64, 256, MEMK + (size_t)(b * 256) * 512 + h * 64, MEMVT + (size_t)(h * 64) * 2048 + b * 256, CAT + t0 * 1024 + 768 + h * 64, tid); }
    }
    SEAM(4);
    if (IN(5)) { pg8::Gemm g{GACT, W_GLU, T, 768, 768, 1}; pg8::StaticOrder S; S.init(T / 256, 3, G, bx); pg8::EpiGlu E{GACT, in[13], CAT};
        pg8::gemm_phase<pg8::EpiGlu, pg8::StaticOrder, true, true>(lds, g, S, E); }
    SEAM(5);
    if (IN(6)) { pg8::Gemm g{CAT, W_OUT0, 1024, 1024, 1024}; pg8::StaticOrder S; S.init(T / 256, 4, G, bx); pg8::EpiResidB<true> E{in[0], XB, SS, 1.f, nullptr};
        pg8::gemm_phase<pg8::EpiResidB<true>, pg8::StaticOrder, true, true>(lds, g, S, E); }
    SEAM(6);
    if (IN(8)) {
        pg8::Gemm g{XB, W_FGU, 1024, 1024, 1024}; pg8::EpiSwiglu<1, true> E{ACT0, DFF, 22, 0, SS, MOE_ASCALE};
        const int slot = (bx >> 3) & 3, n1 = (slot == 0) ? 0 : (slot == 1) ? 1 : (slot == 2) ? 3 : 4;
        { pg8::RangeOrder S; S.S.init(T / 256, 22, G, bx); S.i0 = 0; S.i1 = n1; pg8::gemm_phase<pg8::EpiSwiglu<1, true>, pg8::RangeOrder, true, true>(lds, g, S, E); }
        { LAS unsigned* scr = (LAS unsigned*)(lds + wave * 16384);
          constexpr int I_E = (1024 / 64) * (DFE / 64), I_ED = (DFE / 64) * (1024 / 64), I_MOE = NEXP * (2 * I_E + I_ED), SHARE = (I_MOE + 255) / 256;
#define MOE_DESC(D_, IT_) do { int r = (IT_); const int e = r / (2 * I_E + I_ED); r -= e * (2 * I_E + I_ED); \
              if (r < 2 * I_E) { const int up = r / I_E; r -= up * I_E; const int kb = r / (DFE / 64), n0 = (r % (DFE / 64)) * 64; \
                  (D_).src = in[39 + up] + (size_t)e * 1024 * DFE + (size_t)(kb * 64) * DFE + n0; (D_).ldw = DFE; (D_).gain = in[37]; (D_).k0 = kb * 64; (D_).ldo = 1024; \
                  (D_).dst = (unsigned char*)W_MGU + (size_t)(e * 7168 + (n0 >> 7) * 256 + (n0 & 127) + up * 128) * 1024 + kb * 64; } \
              else { r -= 2 * I_E; const int kb = r / 16, n0 = (r % 16) * 64; \
                  (D_).src = in[41] + (size_t)e * DFE * 1024 + (size_t)(kb * 64) * 1024 + n0; (D_).ldw = 1024; (D_).gain = nullptr; (D_).k0 = kb * 64; (D_).ldo = DFE; \
                  (D_).dst = (unsigned char*)W_MD + (size_t)(e * 1024 + n0) * DFE + kb * 64; } } while (0)
          static_assert(SHARE == 84 && I_MOE == 256 * 84, "share sizes");
          const int it_beg = (bx < 128) ? bx * 72 : 128 * 72 + (bx - 128) * 96, it_end = it_beg + ((bx < 128) ? 72 : 96);
          for (int it = it_beg + wave; it < it_end; it += NWAVES) { CvtDesc8 d0; f32x4 a0[4][4]; float g0[4][4]; MOE_DESC(d0, it); cvt_load8_dma(d0, a0, g0, MOE_WSCALE, (LAS unsigned char*)scr, lane); cvt_emit8(d0, a0, g0, scr, lane); }
#undef MOE_DESC
          __syncthreads(); }
        { pg8::RangeOrder S; S.S.init(T / 256, 22, G, bx); S.i0 = n1; S.i1 = 1 << 20; pg8::gemm_phase<pg8::EpiSwiglu<1, true>, pg8::RangeOrder, true, true>(lds, g, S, E); }
    }
    SEAM(8);
    if (IN(9)) { pg8::Gemm g{ACT0, W_FD, DFF / 2, DFF / 2, DFF / 2}; pg8::StaticOrder S; S.init(T / 256, 4, G, bx); pg8::EpiResidB<false, true> E{nullptr, XB, SS, 1.f / (MOE_WSCALE * MOE_ASCALE), X8};
        pg8::gemm_phase<pg8::EpiResidB<false, true>, pg8::StaticOrder, true, true, true>(lds, g, S, E); }
    SEAM(9);
    if (IN(11)) {
        { pg8::Gemm g{(bf16*)X8, W_KQ, 512, 512, 512}; pg8::StaticOrder S; S.init(T / 256, 5, G, bx); pg8::EpiPlainS<1> E{KQ, 1280, 0, 0, SS, 1.f / (MOE_WSCALE * 8.f)};
          pg8::gemm_phase<pg8::EpiPlainS<1>, pg8::StaticOrder, true, true, true>(lds, g, S, E);
          pg8::Unit u;
          for (int i = 0; S.next(i, u); ++i) if (u.pn == 0) {
            const int b = u.pm >> 3, blk = u.pm & 7; const size_t t0 = (size_t)u.pm * 256;
            const int c0 = lane * 4, d = c0 & 63; float gk[4], cs[4] = {0.f, 0.f, 0.f, 0.f};
#pragma unroll
            for (int e = 0; e < 4; ++e) gk[e] = in[27][d + e] * in[30][d + e];
            for (int rr = 0; rr < 32; ++rr) { bf16* p = KQ + (t0 + wave * 32 + rr) * 1280 + c0; const v2u w = *(const GAS v2u*)p;
                float v[4] = {bf_lo(w.x), bf_hi(w.x), bf_lo(w.y), bf_hi(w.y)}; float ss = v[0] * v[0] + v[1] * v[1] + v[2] * v[2] + v[3] * v[3];
                ss += __shfl_xor(ss, 1); ss += __shfl_xor(ss, 2); ss += __shfl_xor(ss, 4); ss += __shfl_xor(ss, 8);
                const float r = 1.f / sqrtf(ss * (1.f / 64.f) + RMS_EPS);
#pragma unroll
                for (int e = 0; e < 4; ++e) { v[e] *= r * gk[e]; cs[e] += v[e]; }
                *(GAS v2u*)p = (v2u){cvt_pk_bf16(v[0], v[1]), cvt_pk_bf16(v[2], v[3])}; }
            LAS float* red = (LAS float*)lds;
#pragma unroll
            for (int e = 0; e < 4; ++e) red[wave * 256 + c0 + e] = cs[e];
            __syncthreads();
            if (tid < 256) { float sm = 0.f;
#pragma unroll
                for (int w = 0; w < 8; ++w) sm += red[w * 256 + tid];
                KMEANS[(size_t)((b * 4 + (tid >> 6)) * 8 + blk) * 64 + (tid & 63)] = sm * (1.f / 256.f); }
            __syncthreads(); } }
        { pg8::Gemm g{W_V, (bf16*)X8, 512, 512, 512}; pg8::StaticOrder S; S.init(1, T / 256, 64, bx - 64); pg8::EpiPlainS<2> E{VT, T, 0, 0, SS, 1.f / (MOE_WSCALE * 8.f)};
          if (bx >= 64) pg8::gemm_phase<pg8::EpiPlainS<2>, pg8::StaticOrder, true, true, true>(lds, g, S, E); }
    }
    SEAM(11);

    if (IN(13)) {
        for (;;) {
            if (tid == 0) MISC[0] = __hip_atomic_fetch_add((unsigned*)(ctl + CW_QUEUE), 1u, __ATOMIC_RELAXED, __HIP_MEMORY_SCOPE_AGENT);
            __syncthreads();
            const int it = (int)MISC[0];
            __syncthreads();
            if (it >= 1024) break;
            if (it < 768) { const int qblk = 7 - it / 96, r = it % 96; moba_unit(lds, r / 12, r % 12, qblk, KQ, VT, KMEANS, CAT, tid); }
            else { const int u = it - 768, b = u >> 5, h = (u >> 3) & 3, qt = u & 7; const size_t t0 = (size_t)b * SEQ + qt * 256;
                mem_unit<true>(lds, KQ + t0 * 1280 + 1024 + h * 64, 1280, MEMK + (size_t)(b * 256) * 512 + 256 + h * 64, MEMVT + (size_t)(256 + h * 64) * 2048 + b * 256, (bf16*)((unsigned char*)CAT + t0 * 1024 + 768 + h * 64), tid); }
        }
    }
    SEAM(13);
    if (IN(14)) { pg8::Gemm g{CAT, W_OUT1, 512, 512, 512}; pg8::StaticOrder S; S.init(T / 256, 4, G, bx); pg8::EpiResidB<false> E{nullptr, XB, SS, 1.f / (MOE_WSCALE * 8.f), nullptr};
        pg8::gemm_phase<pg8::EpiResidB<false>, pg8::StaticOrder, true, true, true>(lds, g, S, E); }
    SEAM(14);
    if (IN(15)) {
        LAS float* wrt = (LAS float*)lds;
        LAS int* el = (LAS int*)(lds + 32768);
        for (int i = tid; i < 8192; i += NTHREADS) { const int k = i >> 3, e = i & 7; wrt[e * 1024 + k] = in[37][k] * in[38][i]; }
        __syncthreads();
        const int tpw = T / G;
        for (int tl = wave; tl < tpw; tl += NWAVES) { const int t = bx * tpw + tl;
            const GAS v2u* xr = (const GAS v2u*)(XB + (size_t)t * D) + lane; f32x4 v[4]; float s = 0.f;
#pragma unroll
            for (int j = 0; j < 4; ++j) { const v2u w = xr[64 * j]; v[j] = (f32x4){bf_lo(w.x), bf_hi(w.x), bf_lo(w.y), bf_hi(w.y)}; s += (v[j].x * v[j].x + v[j].y * v[j].y) + (v[j].z * v[j].z + v[j].w * v[j].w); }
            const float r = 1.f / sqrtf(wave_sum(s) * (1.f / 1024.f) + RMS_EPS);
#pragma unroll
            for (int j = 0; j < 4; ++j) v[j] = v[j] * r;
            float lg[8];
#pragma unroll
            for (int e = 0; e < 8; ++e) { float a = 0.f;
#pragma unroll
                for (int j = 0; j < 4; ++j) { const f32x4 w = *(const LAS f32x4*)(wrt + e * 1024 + 256 * j + 4 * lane); a += v[j].x * w.x + v[j].y * w.y + v[j].z * w.z + v[j].w * w.w; }
                lg[e] = wave_sum(a); }
            int i0 = 0; float v0 = lg[0];
#pragma unroll
            for (int e = 1; e < 8; ++e) if (lg[e] > v0) { v0 = lg[e]; i0 = e; }
            int i1 = -1; float v1 = -3e38f;
#pragma unroll
            for (int e = 0; e < 8; ++e) if (e != i0 && lg[e] > v1) { v1 = lg[e]; i1 = e; }
            const float e1 = __expf(v1 - v0), g0 = 1.f / (1.f + e1), g1 = e1 * g0;
            if (lane == 0) { el[tl] = i0 * 8 + i1; TOKE[2 * t] = i0; TOKE[2 * t + 1] = i1; TOKG[2 * t] = g0; TOKG[2 * t + 1] = g1; TOKRS[t] = r; } }
        __syncthreads();
        if (tid < tpw) { const int pd = el[tid]; int lp = 0; for (int j = 0; j < tid; ++j) lp += (el[j] == pd) ? 1 : 0; TOKLP[(size_t)bx * tpw + tid] = lp; }
        if (tid >= 64 && tid < 128) { const int pd = tid - 64; int n = 0; for (int j = 0; j < tpw; ++j) n += (el[j] == pd) ? 1 : 0; WGCNT[bx * 64 + pd] = n; }
        __syncthreads();
    }
    SEAM(15);
    if (IN(16)) {
        LAS int* tab = (LAS int*)lds; LAS int* Cp = tab + 16384; LAS int* PRE = Cp + 64; LAS int* Fp = PRE + 64; LAS int* bAu = Fp + 64; LAS int* bAf = bAu + 64; LAS int* bBu = bAf + 64; LAS int* bBf = bBu + 64;
        LAS int* offA = bBf + 64; LAS int* offB = offA + 8; LAS int* UA = offB + 8; LAS int* VB = UA + 8;
        for (int i = tid; i < G * 64; i += NTHREADS) tab[i] = WGCNT[i];
        __syncthreads();
        if (tid < 64) { int tot = 0, pre = 0; for (int w = 0; w < G; ++w) { const int v = tab[w * 64 + tid]; if (w < bx) pre += v; tot += v; } Cp[tid] = tot; PRE[tid] = pre; Fp[tid] = 0; }
        __syncthreads();
        if (tid == 0) {
            int n0[8], rr[8], sup[8], dem[8]; int srem = 0;
            for (int e = 0; e < 8; ++e) { int n = 0; for (int b2 = 0; b2 < 8; ++b2) n += Cp[e * 8 + b2]; n0[e] = n; rr[e] = n & 255; srem += rr[e]; sup[e] = rr[e]; dem[e] = 0; }
            const int mup = srem >> 8;
            for (int it = 0; it < mup; ++it) { int be = -1, bv = -1; for (int e = 0; e < 8; ++e) if (dem[e] == 0 && sup[e] > bv) { bv = sup[e]; be = e; }
                if (be >= 0) { dem[be] = 256 - rr[be]; sup[be] = 0; } }
            for (int a = 0; a < 8; ++a) for (int b2 = 0; b2 < 8; ++b2) if (a != b2 && sup[a] > 0 && dem[b2] > 0) { int f = sup[a] < dem[b2] ? sup[a] : dem[b2]; if (Cp[a * 8 + b2] < f) f = Cp[a * 8 + b2];
                Fp[a * 8 + b2] = f; sup[a] -= f; dem[b2] -= f; }
            int oa = 0, ob = 0;
            for (int e = 0; e < 8; ++e) { int ua = 0, vb = 0, fin = 0, fout = 0;
                for (int x = 0; x < 8; ++x) { ua += Cp[e * 8 + x] - Fp[e * 8 + x]; vb += Cp[x * 8 + e] - Fp[x * 8 + e]; fin += Fp[x * 8 + e]; fout += Fp[e * 8 + x]; }
                UA[e] = ua; VB[e] = vb; offA[e] = oa * 256; offB[e] = ob * 256; oa += (ua + fin + 255) >> 8; ob += (vb + fout + 255) >> 8;
                if (bx == 0) { PANEND[e] = oa; PANEND[8 + e] = ob; } }
        }
        __syncthreads();
        if (tid < 64) { const int a = tid >> 3, b2 = tid & 7; int s1 = 0, s2 = 0, s3 = 0, s4 = 0;
            for (int x = 0; x < b2; ++x) { s1 += Cp[a * 8 + x] - Fp[a * 8 + x]; s4 += Fp[a * 8 + x]; }
            for (int x = 0; x < a; ++x) { s2 += Fp[x * 8 + b2]; s3 += Cp[x * 8 + b2] - Fp[x * 8 + b2]; }
            bAu[tid] = offA[a] + s1 - Fp[tid]; bAf[tid] = offA[b2] + UA[b2] + s2; bBu[tid] = offB[b2] + s3 - Fp[tid]; bBf[tid] = offB[a] + VB[a] + s4; }
        __syncthreads();
        const int tpw = T / G;
        for (int tl = wave; tl < tpw; tl += NWAVES) { const int t = bx * tpw + tl;
            const int pd = TOKE[2 * t] * 8 + TOKE[2 * t + 1], q = PRE[pd] + TOKLP[(size_t)bx * tpw + tl]; const bool fl = q < Fp[pd];
            const int rowA = q + (fl ? bAf[pd] : bAu[pd]), rowB = q + (fl ? bBf[pd] : bBu[pd]);
            const float rs_ = TOKRS[t];
            if (lane == 0) { ROWTOK[rowA] = t; ROWGATE[rowA] = TOKG[2 * t + (fl ? 1 : 0)]; ROWRS[rowA] = rs_;
                             ROWTOK[RROWS + rowB] = t; ROWGATE[RROWS + rowB] = TOKG[2 * t + (fl ? 0 : 1)]; ROWRS[RROWS + rowB] = rs_; }
            const GAS v4u* src = (const GAS v4u*)(XB + (size_t)t * D);
            GAS v2u* dA = (GAS v2u*)((unsigned char*)XS + (size_t)rowA * D); GAS v2u* dB = (GAS v2u*)((unsigned char*)XS + ((size_t)RROWS + rowB) * D);
#pragma unroll
            for (int h = 0; h < 2; ++h) { const v4u w = src[64 * h + lane];
                const v2u o = (v2u){pg8::pk4_fp8(bf_lo(w.x) * rs_, bf_hi(w.x) * rs_, bf_lo(w.y) * rs_, bf_hi(w.y) * rs_), pg8::pk4_fp8(bf_lo(w.z) * rs_, bf_hi(w.z) * rs_, bf_lo(w.w) * rs_, bf_hi(w.w) * rs_)};
                dA[64 * h + lane] = o; dB[64 * h + lane] = o; } }
        __syncthreads();
    }
    SEAM(16);
#define MOE_ROUND(PH, KK, FIRST_) \
    if (IN(PH)) { pg8::GroupOrder S; for (int e = 0; e < 8; ++e) S.pe[e] = PANEND[(KK) * 8 + e]; S.npe = 28; S.S.init(S.pe[7], 28, G, bx); \
        pg8::Gemm g{XS + (size_t)(KK) * RROWS * (D / 2), W_MGU, 512, 512, 512}; pg8::EpiSwigluF8 E{(unsigned char*)ACTM + (size_t)(KK) * RROWS * DFE, DFE, 28, 0, 1.f / MOE_WSCALE, MOE_ASCALE}; \
        pg8::gemm_phase<pg8::EpiSwigluF8, pg8::GroupOrder, true, true, true>(lds, g, S, E); } \
    SEAM(PH); \
    if (IN((PH) + 1)) { volatile LAS unsigned* tb = MISC + 16; \
        if (tid < 8) tb[tid] = (unsigned)PANEND[(KK) * 8 + tid]; \
        if (tid == 8) { const int npan = PANEND[(KK) * 8 + 7]; const int nun = npan * 4, tl = nun - G; \
            tb[8] = (unsigned)nun; tb[9] = (tl <= G / 4) ? 4u : (tl <= G / 2) ? 2u : 1u; tb[10] = (unsigned)npan; tb[11] = (unsigned)bx; tb[12] = 8u; tb[13] = 4u; tb[14] = (unsigned)(DFE / 128); tb[15] = (unsigned)G; \
            const unsigned long long sl = (unsigned long long)((KK) == 0 ? (unsigned char*)CAT : (unsigned char*)XS + 36 * MiB), fl = (unsigned long long)(unsigned*)(ctl + CW_SKFLAG + (KK) * 256 * 64); \
            tb[16] = (unsigned)sl; tb[17] = (unsigned)(sl >> 32); tb[18] = (unsigned)fl; tb[19] = (unsigned)(fl >> 32); } \
        __syncthreads(); \
        pg8::GroupStream S; S.tab = (const LAS unsigned*)(lds + MISC_OFF + 64); \
        pg8::Gemm g{ACTM + (size_t)(KK) * RROWS * (DFE / 2), W_MD, DFE / 2, DFE / 2, DFE / 2}; pg8::EpiMoeDown<FIRST_> E{OUT, ROWTOK + (KK) * RROWS, ROWGATE + (KK) * RROWS, 0, XB, 1.f / (MOE_WSCALE * MOE_ASCALE)}; \
        pg8::gemm_phase<pg8::EpiMoeDown<FIRST_>, pg8::GroupStream, true, true, true>(lds, g, S, E); }
    MOE_ROUND(17, 1, true)
    MOE_ROUND(19, 0, false)

#undef IN
#undef SEAM
}

extern "C" void kernel_launch(void* const* d_in, const int* in_sizes, int n_in, void* d_out, int out_size, void* d_ws, size_t ws_size, hipStream_t stream) {
    static int grid = 0;
    if (grid == 0) {
        if (n_in != 42 || in_sizes[0] != T * D || out_size != T * D || ws_size < WS_END) { fprintf(stderr, "kernel_launch: unexpected shapes (n_in %d, in0 %d, out %d, ws %zu < %zu); nothing launched\n", n_in, n_in > 0 ? in_sizes[0] : -1, out_size, ws_size, (size_t)WS_END); grid = -1; return; }
        int dev = 0, cus = 0, per_cu = 0;
        if (hipGetDevice(&dev) != hipSuccess || hipDeviceGetAttribute(&cus, hipDeviceAttributeMultiprocessorCount, dev) != hipSuccess) { grid = -1; return; }
        if (hipFuncSetAttribute((const void*)fwd_kernel, hipFuncAttributeMaxDynamicSharedMemorySize, LDS_BYTES) != hipSuccess) { fprintf(stderr, "kernel_launch: hipFuncSetAttribute failed\n"); grid = -1; return; }
        if (hipOccupancyMaxActiveBlocksPerMultiprocessor(&per_cu, (const void*)fwd_kernel, NTHREADS, LDS_BYTES) != hipSuccess || per_cu < 1) { fprintf(stderr, "kernel_launch: occupancy query reports %d\n", per_cu); }
        (void)hipGetLastError();
        grid = 256;
        if (cus < 256) { fprintf(stderr, "kernel_launch: device has %d CUs, need 256\n", cus); grid = -1; return; }
    }
    if (grid < 0) return;
    if (hipMemsetAsync((char*)d_ws + WS_CTL, 0, CTL_ZERO_BYTES, stream) != hipSuccess) return;
    Args a{};
    for (int i = 0; i < 42; ++i) a.in[i] = (const float*)d_in[i];
    a.out = (float*)d_out; a.ws = (unsigned char*)d_ws;
#ifdef MK_SPLIT
    for (int p = 0; p < NPHASE; ++p) { a.ph_lo = p; a.ph_hi = p + 1; hipLaunchKernelGGL(fwd_kernel, dim3(grid), dim3(NTHREADS), LDS_BYTES, stream, a); }
#else
#ifndef STOP_AFTER
#define STOP_AFTER (NPHASE - 1)
#endif
    a.ph_lo = 0; a.ph_hi = STOP_AFTER + 1;
    hipLaunchKernelGGL(fwd_kernel, dim3(grid), dim3(NTHREADS), LDS_BYTES, stream, a);
#endif
}
```

```cpp
#include <hip/hip_runtime.h>
#include <cstdio>
#include <cstdint>

namespace pg8 {
#define PG8_LAS __attribute__((address_space(3)))
typedef unsigned short bf16_t;
typedef short bf16x8 __attribute__((ext_vector_type(8)));
typedef float f32x4 __attribute__((ext_vector_type(4)));
typedef unsigned u32x4 __attribute__((ext_vector_type(4)));
constexpr int BM = 256, BK = 64, HALF = 128, HTB = HALF * BK * 2  , STAGE_BYTES = 8 * HTB, NXCD = 8, WGM = 4;

__host__ __device__ __forceinline__ int lds_byte(int r, int c) { const int st = (r >> 4) * 2 + (c >> 5), rr = r & 15, cc = c & 31, ob = rr * 64 + cc * 2; return st * 1024 + (ob ^ (((ob >> 9) & 1) << 5)); }
__host__ __device__ __forceinline__ void stage_rc(int b, int& R, int& C) { const int st = b / 1024, sb = b % 1024, swz = sb ^ (((sb >> 9) & 1) << 5); R = (st >> 1) * 16 + swz / 64; C = (st & 1) * 32 + (swz % 64) / 2; }
__host__ __device__ __forceinline__ int perm32(int rho) { const int n = rho >> 4, i = rho & 15; return 8 * (i >> 2) + 4 * n + (i & 3); }

struct Unit { int pm, pn; int k0, nk, part; };
struct Gemm { const bf16_t* A; const bf16_t* Bt; int lda, ldb, K; int amode = 0; };

struct StaticOrder {
    static constexpr bool STREAMK = false;
    int nM, nN, nwg, G, c;
    __host__ __device__ __forceinline__ void init(int nM_, int nN_, int G_, int c_) { nM = nM_; nN = nN_; nwg = nM * nN; G = G_; c = c_; }
    __host__ __device__ __forceinline__ bool next(int i, Unit& u) const {
        const long L = (long)i * G + c; if (L >= nwg || c >= G) return false;
        u.k0 = 0; u.nk = 0; u.part = 0; map((int)L, u); return true;
    }
    __host__ __device__ __forceinline__ void map(int L, Unit& u) const {
        int wgid = L; { const int q = nwg / NXCD, r = nwg % NXCD, xcd = wgid % NXCD, off = wgid / NXCD; wgid = (xcd < r ? xcd * (q + 1) : r * (q + 1) + (xcd - r) * q) + off; }
        const int nig = WGM * nN, gid = wgid / nig, fm = gid * WGM, gsz = (nM - fm) < WGM ? (nM - fm) : WGM;
        u.pm = fm + ((wgid % nig) % gsz); u.pn = (wgid % nig) / gsz;
    }
};
struct RangeOrder {
    static constexpr bool STREAMK = false;
    StaticOrder S; int i0, i1;
    __host__ __device__ __forceinline__ bool next(int i, Unit& u) const { return (i0 + i < i1) && S.next(i0 + i, u); }
};
struct BatchOrder {
    static constexpr bool STREAMK = false;
    int nunits, tm, tn, G, c;
    __host__ __device__ __forceinline__ void init(int nb, int tm_, int tn_, int G_, int c_) { tm = tm_; tn = tn_; nunits = nb * tm * tn; G = G_; c = c_; }
    __host__ __device__ __forceinline__ bool next(int i, Unit& u) const {
        const int L = i * G + c; if (L >= nunits || c >= G) return false;
        const int b = L / (tm * tn), r = L % (tm * tn); u.pm = b * tm + r / tn; u.pn = b * tn + r % tn; u.k0 = 0; u.nk = 0; u.part = 0; return true;
    }
};
struct GroupOrder {
    static constexpr bool STREAMK = false;
    StaticOrder S; int npe; int pe[8];
    __host__ __device__ __forceinline__ bool next(int i, Unit& u) const {
        if (!S.next(i, u)) return false;
        int e = 0;
#pragma unroll
        for (int k = 0; k < 7; ++k) e += (u.pm >= pe[k]) ? 1 : 0;
        u.pn += e * npe; return true;
    }
};

typedef float f32x2_t __attribute__((ext_vector_type(2))); typedef __bf16 bf16x2_t __attribute__((ext_vector_type(2)));
struct GroupStream {
    static constexpr bool STREAMK = true;
    const PG8_LAS unsigned* tab;
    __device__ __forceinline__ int c() const { return (int)tab[11]; }
    __device__ __forceinline__ int split() const { return (int)tab[9]; }
    __device__ __forceinline__ unsigned target() const { return tab[12]; }
    __device__ __forceinline__ unsigned long long* slots() const { return (unsigned long long*)(((unsigned long long)tab[17] << 32) | tab[16]); }
    __device__ __forceinline__ unsigned* flags() const { return (unsigned*)(((unsigned long long)tab[19] << 32) | tab[18]); }
    __device__ __forceinline__ bool next(int i, Unit& u) const {
        const int nunits = (int)tab[8], sp = (int)tab[9], npe = (int)tab[13], ntk = (int)tab[14], G = (int)tab[15], c_ = (int)tab[11];
        int L, k0 = 0, nk = ntk, part = 0;
        if (i == 0) { L = c_; if (L >= nunits) return false; }
        else if (i == 1) { const int j = c_ / sp, p = c_ % sp; L = G + j; if (L >= nunits) return false; const int base = (ntk / sp) & ~1, xh = (ntk - sp * base) >> 1; nk = base + (p < xh ? 2 : 0); k0 = p * base + 2 * (p < xh ? p : xh); part = (sp == 1) ? 0 : (p == 0 ? 1 : 2); }
        else return false;
        StaticOrder S; S.init((int)tab[10], npe, 1, 0); S.map(L, u); int e = 0;
#pragma unroll
        for (int k = 0; k < 7; ++k) e += (u.pm >= (int)tab[k]) ? 1 : 0;
        u.pn += e * npe; u.k0 = k0; u.nk = nk; u.part = part; return true;
    }
};
constexpr int SK_SLOT_WORDS = 32 * 512;

__device__ __forceinline__ unsigned cvt_pk_bf16(float lo, float hi) { f32x2_t v = {lo, hi}; bf16x2_t b = __builtin_convertvector(v, bf16x2_t); return __builtin_bit_cast(unsigned, b); }
__device__ __forceinline__ float bf_lo(unsigned w) { return __builtin_bit_cast(float, w << 16); }
__device__ __forceinline__ float bf_hi(unsigned w) { return __builtin_bit_cast(float, w & 0xffff0000u); }
__device__ __forceinline__ float fsigmoid(float x) { return __builtin_amdgcn_rcpf(1.f + __builtin_amdgcn_exp2f(-1.4426950408889634f * x)); }
__device__ __forceinline__ float gelu_tanh(float y) { const float z = 0.7978845608028654f * (y + 0.044715f * y * y * y); return y * fsigmoid(2.f * z); }

#define EPI_LOOP_ROWS for (int ai = 0; ai < 2; ++ai) _Pragma("unroll") for (int m = 0; m < 4; ++m)
__device__ __forceinline__ u32x4 pack8(const f32x4& v0, const f32x4& v1) { u32x4 w; w.x = cvt_pk_bf16(v0[0], v0[1]); w.y = cvt_pk_bf16(v0[2], v0[3]); w.z = cvt_pk_bf16(v1[0], v1[1]); w.w = cvt_pk_bf16(v1[2], v1[3]); return w; }

__device__ __forceinline__ float rs_row(const float* SS, int row) {
    const f32x4 a = *(const f32x4*)(SS + (size_t)row * 16), b = *(const f32x4*)(SS + (size_t)row * 16 + 4), c = *(const f32x4*)(SS + (size_t)row * 16 + 8), d = *(const f32x4*)(SS + (size_t)row * 16 + 12);
    const float s = ((a[0] + a[1]) + (a[2] + a[3])) + ((b[0] + b[1]) + (b[2] + b[3])) + ((c[0] + c[1]) + (c[2] + c[3])) + ((d[0] + d[1]) + (d[2] + d[3]));
    return 1.f / __builtin_sqrtf(s * (1.f / 1024.f) + 1e-6f);
}
template <int SCALE  > struct EpiPlainS {
    static constexpr bool PERM = true, AFTER_DRAIN = false;
    bf16_t* O; int ldc; int pm0, pn0; const float* SS; float inv;
    __device__ __forceinline__ void operator()(const f32x4 (&acc)[2][2][4][2], const Unit& u, int wr, int wc, int fr, int fq) const {
        const int row0 = (u.pm - pm0) * BM + wr * 64 + fr, col0 = (u.pn - pn0) * BM + wc * 32 + 8 * fq;
        float cs[2][8];
        if (SCALE == 2) {
#pragma unroll
            for (int bj = 0; bj < 2; ++bj)
#pragma unroll
                for (int e = 0; e < 8; ++e) cs[bj][e] = rs_row(SS, u.pn * BM + bj * HALF + wc * 32 + 8 * fq + e) * inv; }
#pragma unroll
        EPI_LOOP_ROWS { bf16_t* rowp = O + (size_t)(row0 + ai * HALF + m * 16) * ldc + col0; float rs = 1.f; if (SCALE == 1) rs = rs_row(SS, u.pm * BM + wr * 64 + fr + ai * HALF + m * 16) * inv;
#pragma unroll
            for (int bj = 0; bj < 2; ++bj) { f32x4 v0 = acc[ai][bj][m][0], v1 = acc[ai][bj][m][1];
                if (SCALE == 1) { v0 = v0 * rs; v1 = v1 * rs; }
                if (SCALE == 2) { v0 = v0 * (f32x4){cs[bj][0], cs[bj][1], cs[bj][2], cs[bj][3]}; v1 = v1 * (f32x4){cs[bj][4], cs[bj][5], cs[bj][6], cs[bj][7]}; }
                *(u32x4*)(rowp + bj * HALF) = pack8(v0, v1); } }
    }
};
struct EpiPlain {
    static constexpr bool PERM = true, AFTER_DRAIN = false;
    bf16_t* O; int ldc; int pm0, pn0;
    __device__ __forceinline__ void operator()(const f32x4 (&acc)[2][2][4][2], const Unit& u, int wr, int wc, int fr, int fq) const {
        const int row0 = (u.pm - pm0) * BM + wr * 64 + fr, col0 = (u.pn - pn0) * BM + wc * 32 + 8 * fq;
#pragma unroll
        EPI_LOOP_ROWS { bf16_t* rowp = O + (size_t)(row0 + ai * HALF + m * 16) * ldc + col0;
#pragma unroll
            for (int bj = 0; bj < 2; ++bj) *(u32x4*)(rowp + bj * HALF) = pack8(acc[ai][bj][m][0], acc[ai][bj][m][1]); }
    }
};
struct EpiProj0 {
    static constexpr bool PERM = true, AFTER_DRAIN = false;
    bf16_t* UG; bf16_t* QM;
    __device__ __forceinline__ void operator()(const f32x4 (&acc)[2][2][4][2], const Unit& u, int wr, int wc, int fr, int fq) const {
        const int row0 = u.pm * BM + wr * 64 + fr;
#pragma unroll
        EPI_LOOP_ROWS { const int t = row0 + ai * HALF + m * 16;
#pragma unroll
            for (int bj = 0; bj < 2; ++bj) { const int c = u.pn * BM + bj * HALF + wc * 32 + 8 * fq; bf16_t* p;
                if (u.pn < 3) p = UG + ((size_t)((c >> 4) * 512 + (t >> 5))) * 640 + (t & 31) * 16 + (c & 15); else p = QM + (size_t)t * 256 + (c - 768);
                *(u32x4*)p = pack8(acc[ai][bj][m][0], acc[ai][bj][m][1]); } }
    }
};
struct EpiS5a {
    static constexpr bool PERM = true, AFTER_DRAIN = false;
    float* XC;
    __device__ __forceinline__ void operator()(const f32x4 (&acc)[2][2][4][2], const Unit& u, int wr, int wc, int fr, int fq) const {
        const int row0 = u.pm * BM + wr * 64 + fr, col0 = wc * 32 + 8 * fq;
#pragma unroll
        EPI_LOOP_ROWS { float* rowp = XC + (size_t)(row0 + ai * HALF + m * 16) * 128 + col0; *(f32x4*)rowp = acc[ai][0][m][0]; *(f32x4*)(rowp + 4) = acc[ai][0][m][1]; }
    }
};
struct EpiS5c {
    static constexpr bool PERM = true, AFTER_DRAIN = false;
    const bf16_t* UG; const float* dskip; bf16_t* GACT;
    __device__ __forceinline__ void operator()(const f32x4 (&acc)[2][2][4][2], const Unit& u, int wr, int wc, int fr, int fq) const {
        const int row0 = u.pm * BM + wr * 64 + fr, g = u.pm >> 1;
#pragma unroll
        for (int bj = 0; bj < 2; ++bj) { const int col8 = (u.pn & 1) * BM + bj * HALF + wc * 32 + 8 * fq, j = col8 >> 4, nb = col8 & 15;
            const f32x4 d0 = *(const f32x4*)(dskip + g * 16 + nb), d1 = *(const f32x4*)(dskip + g * 16 + nb + 4);
#pragma unroll
            EPI_LOOP_ROWS { const int R = row0 + ai * HALF + m * 16, chunk = R & 511, t = chunk * 32 + j;
                const u32x4 uu = *(const u32x4*)(UG + (size_t)R * 640 + j * 16 + nb);
                f32x4 v0 = acc[ai][bj][m][0], v1 = acc[ai][bj][m][1];
                v0[0] = gelu_tanh(v0[0] + d0[0] * bf_lo(uu.x)); v0[1] = gelu_tanh(v0[1] + d0[1] * bf_hi(uu.x)); v0[2] = gelu_tanh(v0[2] + d0[2] * bf_lo(uu.y)); v0[3] = gelu_tanh(v0[3] + d0[3] * bf_hi(uu.y));
                v1[0] = gelu_tanh(v1[0] + d1[0] * bf_lo(uu.z)); v1[1] = gelu_tanh(v1[1] + d1[1] * bf_hi(uu.z)); v1[2] = gelu_tanh(v1[2] + d1[2] * bf_lo(uu.w)); v1[3] = gelu_tanh(v1[3] + d1[3] * bf_hi(uu.w));
                *(u32x4*)(GACT + ((size_t)g * 16384 + t) * 16 + nb) = pack8(v0, v1); } }
    }
};
struct EpiGlu {
    static constexpr bool PERM = true, AFTER_DRAIN = false;
    const bf16_t* GACT; const float* bias; bf16_t* CAT;
    __device__ __forceinline__ void operator()(const f32x4 (&acc)[2][2][4][2], const Unit& u, int wr, int wc, int fr, int fq) const {
        const int row0 = u.pm * BM + wr * 64 + fr;
#pragma unroll
        for (int bj = 0; bj < 2; ++bj) { const int c = u.pn * BM + bj * HALF + wc * 32 + 8 * fq;
            const f32x4 b0 = *(const f32x4*)(bias + c), b1 = *(const f32x4*)(bias + c + 4);
#pragma unroll
            EPI_LOOP_ROWS { const int t = row0 + ai * HALF + m * 16;
                const u32x4 gg = *(const u32x4*)(GACT + ((size_t)(c >> 4) * 16384 + t) * 16 + (c & 15));
                f32x4 v0 = acc[ai][bj][m][0] + b0, v1 = acc[ai][bj][m][1] + b1;
                v0[0] = bf_lo(gg.x) * fsigmoid(v0[0]); v0[1] = bf_hi(gg.x) * fsigmoid(v0[1]); v0[2] = bf_lo(gg.y) * fsigmoid(v0[2]); v0[3] = bf_hi(gg.y) * fsigmoid(v0[3]);
                v1[0] = bf_lo(gg.z) * fsigmoid(v1[0]); v1[1] = bf_hi(gg.z) * fsigmoid(v1[1]); v1[2] = bf_lo(gg.w) * fsigmoid(v1[2]); v1[3] = bf_hi(gg.w) * fsigmoid(v1[3]);
                *(u32x4*)(CAT + (size_t)t * 1024 + c) = pack8(v0, v1); } }
    }
};
typedef unsigned u32x2_ __attribute__((ext_vector_type(2)));
__device__ __forceinline__ unsigned pk4_fp8(float a, float b, float c, float d) { int w = 0; w = __builtin_amdgcn_cvt_pk_fp8_f32(a, b, w, false); w = __builtin_amdgcn_cvt_pk_fp8_f32(c, d, w, true); return (unsigned)w; }
__device__ __forceinline__ float swiglu_fast(float ag, float au, float c1, float K) { const float e = __builtin_amdgcn_exp2f(ag * c1); return (ag * au) * __builtin_amdgcn_rcpf(__builtin_fmaf(e, K, K)); }
template <int SCALE  , bool OUT8 = false  > struct EpiSwiglu {
    static constexpr bool PERM = true, AFTER_DRAIN = false;
    bf16_t* O; int ldc; int npe; int pm0; const float* RS; float osc;
    __device__ __forceinline__ void operator()(const f32x4 (&acc)[2][2][4][2], const Unit& u, int wr, int wc, int fr, int fq) const {
        const int row0 = (u.pm - pm0) * BM + wr * 64 + fr, col0 = (u.pn % npe) * HALF + wc * 32 + 8 * fq;
#pragma unroll
        EPI_LOOP_ROWS { f32x4 v0, v1; const int r = row0 + ai * HALF + m * 16; const float rs = (SCALE == 1) ? rs_row(RS, r) : RS[r]; const float c1 = -1.4426950408889634f * rs, K = __builtin_amdgcn_rcpf(rs * rs * (OUT8 ? osc : 1.f));
#pragma unroll
            for (int e = 0; e < 4; ++e) { v0[e] = swiglu_fast(acc[ai][0][m][0][e], acc[ai][1][m][0][e], c1, K); v1[e] = swiglu_fast(acc[ai][0][m][1][e], acc[ai][1][m][1][e], c1, K); }
            if constexpr (OUT8) {
#pragma unroll
                for (int e = 0; e < 4; ++e) { v0[e] = __builtin_amdgcn_fmed3f(v0[e], -440.f, 440.f); v1[e] = __builtin_amdgcn_fmed3f(v1[e], -440.f, 440.f); }
                *(u32x2_*)((unsigned char*)O + (size_t)r * ldc + col0) = (u32x2_){pk4_fp8(v0[0], v0[1], v0[2], v0[3]), pk4_fp8(v1[0], v1[1], v1[2], v1[3])}; }
            else *(u32x4*)(O + (size_t)r * ldc + col0) = pack8(v0, v1); }
    }
};
struct EpiSwigluF8 {
    static constexpr bool PERM = true, AFTER_DRAIN = false;
    unsigned char* O; int ldc; int npe; int pm0; float inv, sc;
    __device__ __forceinline__ void operator()(const f32x4 (&acc)[2][2][4][2], const Unit& u, int wr, int wc, int fr, int fq) const {
        const int row0 = (u.pm - pm0) * BM + wr * 64 + fr, col0 = (u.pn % npe) * HALF + wc * 32 + 8 * fq;
        const float c1 = -1.4426950408889634f * inv, K = 1.f / (inv * inv * sc);
#pragma unroll
        EPI_LOOP_ROWS { f32x4 v0, v1; const int r = row0 + ai * HALF + m * 16;
#pragma unroll
            for (int e = 0; e < 4; ++e) { v0[e] = __builtin_amdgcn_fmed3f(swiglu_fast(acc[ai][0][m][0][e], acc[ai][1][m][0][e], c1, K), -440.f, 440.f); v1[e] = __builtin_amdgcn_fmed3f(swiglu_fast(acc[ai][0][m][1][e], acc[ai][1][m][1][e], c1, K), -440.f, 440.f); }
            *(u32x2_*)(O + (size_t)r * ldc + col0) = (u32x2_){pk4_fp8(v0[0], v0[1], v0[2], v0[3]), pk4_fp8(v1[0], v1[1], v1[2], v1[3])}; }
    }
};
template <bool F32BASE  , bool W8 = false  > struct EpiResidB {
    static constexpr bool PERM = true, AFTER_DRAIN = false;
    const float* R; bf16_t* XR; float* SS; float inv; unsigned char* X8;
    __device__ __forceinline__ void operator()(const f32x4 (&acc)[2][2][4][2], const Unit& u, int wr, int wc, int fr, int fq) const {
        const int row0 = u.pm * BM + wr * 64 + fr, col0 = u.pn * BM + wc * 32 + 8 * fq;
#pragma unroll
        EPI_LOOP_ROWS { const int row = row0 + ai * HALF + m * 16; const size_t o = (size_t)row * 1024 + col0; float ss = 0.f;
#pragma unroll
            for (int bj = 0; bj < 2; ++bj) { f32x4 r0, r1;
                if (F32BASE) { r0 = *(const f32x4*)(R + o + bj * HALF); r1 = *(const f32x4*)(R + o + bj * HALF + 4); }
                else { const u32x4 w = *(const u32x4*)(XR + o + bj * HALF); r0 = (f32x4){bf_lo(w.x), bf_hi(w.x), bf_lo(w.y), bf_hi(w.y)}; r1 = (f32x4){bf_lo(w.z), bf_hi(w.z), bf_lo(w.w), bf_hi(w.w)}; }
                r0 = r0 + acc[ai][bj][m][0] * inv; r1 = r1 + acc[ai][bj][m][1] * inv;
                ss += (r0[0] * r0[0] + r0[1] * r0[1]) + (r0[2] * r0[2] + r0[3] * r0[3]) + (r1[0] * r1[0] + r1[1] * r1[1]) + (r1[2] * r1[2] + r1[3] * r1[3]);
                *(u32x4*)(XR + o + bj * HALF) = pack8(r0, r1);
                if constexpr (W8) { f32x4 q0, q1;
#pragma unroll
                    for (int e = 0; e < 4; ++e) { q0[e] = __builtin_amdgcn_fmed3f(r0[e] * 8.f, -440.f, 440.f); q1[e] = __builtin_amdgcn_fmed3f(r1[e] * 8.f, -440.f, 440.f); }
                    *(u32x2_*)(X8 + o + bj * HALF) = (u32x2_){pk4_fp8(q0[0], q0[1], q0[2], q0[3]), pk4_fp8(q1[0], q1[1], q1[2], q1[3])}; } }
            ss += __shfl_xor(ss, 16); ss += __shfl_xor(ss, 32);
            if (fq == 0) SS[(size_t)row * 16 + u.pn * 4 + wc] = ss; }
    }
};
template <bool FIRST  > struct EpiMoeDown {
    static constexpr bool PERM = true, AFTER_DRAIN = false;
    float* OUT; const int* rowtok; const float* rowgate; int pm0; const bf16_t* XR; float sc;
    __device__ __forceinline__ void operator()(const f32x4 (&acc)[2][2][4][2], const Unit& u, int wr, int wc, int fr, int fq) const {
        const int row0 = (u.pm - pm0) * BM + wr * 64 + fr, col0 = (u.pn & 3) * BM + wc * 32 + 8 * fq;
#pragma unroll
        EPI_LOOP_ROWS { const int r = row0 + ai * HALF + m * 16; const int t = rowtok[r]; const float gt = rowgate[r] * sc;
            if (t >= 0) { float* o = OUT + (size_t)t * 1024 + col0;
#pragma unroll
                for (int bj = 0; bj < 2; ++bj) { f32x4 r0, r1;
                    if (FIRST) { const u32x4 w = *(const u32x4*)(XR + (size_t)t * 1024 + col0 + bj * HALF); r0 = (f32x4){bf_lo(w.x), bf_hi(w.x), bf_lo(w.y), bf_hi(w.y)}; r1 = (f32x4){bf_lo(w.z), bf_hi(w.z), bf_lo(w.w), bf_hi(w.w)}; }
                    else { r0 = *(const f32x4*)(o + bj * HALF); r1 = *(const f32x4*)(o + bj * HALF + 4); }
                    *(f32x4*)(o + bj * HALF) = r0 + acc[ai][bj][m][0] * gt; *(f32x4*)(o + bj * HALF + 4) = r1 + acc[ai][bj][m][1] * gt; } } }
    }
};

__device__ __forceinline__ void sk_store_partial(const f32x4 (&acc)[2][2][4][2], unsigned long long* slot, int tid) {
#pragma unroll
    for (int ai = 0; ai < 2; ++ai)
#pragma unroll
        for (int bj = 0; bj < 2; ++bj)
#pragma unroll
            for (int m = 0; m < 4; ++m)
#pragma unroll
                for (int n = 0; n < 2; ++n) { const f32x4 v = acc[ai][bj][m][n]; const unsigned long long w = (unsigned long long)cvt_pk_bf16(v[0], v[1]) | ((unsigned long long)cvt_pk_bf16(v[2], v[3]) << 32);
                    __hip_atomic_store(slot + (((ai * 2 + bj) * 4 + m) * 2 + n) * 512 + tid, w, __ATOMIC_RELAXED, __HIP_MEMORY_SCOPE_AGENT); }
}
__device__ __forceinline__ void sk_add_partial(f32x4 (&acc)[2][2][4][2], unsigned long long* slot, int tid) {
#pragma unroll
    for (int ai = 0; ai < 2; ++ai)
#pragma unroll
        for (int bj = 0; bj < 2; ++bj)
#pragma unroll
            for (int m = 0; m < 4; ++m)
#pragma unroll
                for (int n = 0; n < 2; ++n) { const unsigned long long w = __hip_atomic_load(slot + (((ai * 2 + bj) * 4 + m) * 2 + n) * 512 + tid, __ATOMIC_RELAXED, __HIP_MEMORY_SCOPE_AGENT);
                    const unsigned lo = (unsigned)w, hi = (unsigned)(w >> 32); acc[ai][bj][m][n] = acc[ai][bj][m][n] + (f32x4){bf_lo(lo), bf_hi(lo), bf_lo(hi), bf_hi(hi)};
                    if (n == 1 && (m & 1)) asm volatile("" ::: "memory"); }
}
typedef int i32x4_ __attribute__((ext_vector_type(4)));
typedef int i32x8_ __attribute__((ext_vector_type(8)));
template <class Epi, class Sched, bool ALIGN_EPI = false, bool SP2 = false, bool FP8 = false>
__device__ __forceinline__ void gemm_phase(PG8_LAS unsigned char* lds, const Gemm g, const Sched& S, const Epi& E) {
    const int tid = threadIdx.x, wid = __builtin_amdgcn_readfirstlane(tid >> 6), lane = tid & 63, wr = wid >> 2, wc = wid & 3, fr = lane & 15, fq = lane >> 4;
    const int K = g.K; int nt = K / BK;
    unsigned voffA[2], voffB[2];
#pragma unroll
    for (int i = 0; i < 2; ++i) { int R, C; stage_rc(tid * 16 + i * 8192, R, C); const int Rb = Epi::PERM ? ((R & ~31) + perm32(R & 31)) : R;
        voffA[i] = g.amode ? (unsigned)(((C >> 4) * g.lda + R) * 16 + (C & 15)) * 2u : (unsigned)(R * g.lda + C) * 2u; voffB[i] = (unsigned)(Rb * g.ldb + C) * 2u; }
    const size_t kstep = (size_t)(BK * 2);
    const size_t hstepA = g.amode ? (size_t)HALF * 32 : (size_t)HALF * g.lda * 2, hstepB = (size_t)HALF * g.ldb * 2;
    const size_t kstepA = g.amode ? (size_t)4 * g.lda * 32 : kstep;
    const size_t tstepA = 2 * hstepA, tstepB = 2 * hstepB;
    const unsigned ldsw = (unsigned)wid * 1024u;
    const int aoff = lds_byte(wr * 64 + fr, fq * 8), boff = lds_byte(wc * 32 + fr, fq * 8);
#define PG8_SA(b, h) (((b) * 2 + (h)) * HTB)
#define PG8_SB(b, h) ((4 + (b) * 2 + (h)) * HTB)
#define PG8_STAGE(bufoff, gbase, voff) do { _Pragma("unroll") for (int _i = 0; _i < 2; ++_i) \
        __builtin_amdgcn_global_load_lds((const unsigned*)((const char*)(gbase) + (voff)[_i]), (PG8_LAS unsigned*)(lds + (bufoff) + ldsw + _i * 8192), 16, 0, 0); } while (0)
#define PG8_LDA(dst, b, h) do { if constexpr (FP8) { _Pragma("unroll") for (int m = 0; m < 4; ++m) { const i32x4_ l_ = *(const PG8_LAS i32x4_*)(lds + PG8_SA(b, h) + aoff + m * 2048), h_ = *(const PG8_LAS i32x4_*)(lds + PG8_SA(b, h) + aoff + m * 2048 + 1024); dst##8[m] = __builtin_shufflevector(l_, h_, 0, 1, 2, 3, 4, 5, 6, 7); } } \
        else { _Pragma("unroll") for (int m = 0; m < 4; ++m) _Pragma("unroll") for (int k = 0; k < 2; ++k) dst[m][k] = *(const PG8_LAS bf16x8*)(lds + PG8_SA(b, h) + aoff + m * 2048 + k * 1024); } } while (0)
#define PG8_LDB(dst, b, h) do { if constexpr (FP8) { _Pragma("unroll") for (int n = 0; n < 2; ++n) { const i32x4_ l_ = *(const PG8_LAS i32x4_*)(lds + PG8_SB(b, h) + boff + n * 2048), h_ = *(const PG8_LAS i32x4_*)(lds + PG8_SB(b, h) + boff + n * 2048 + 1024); dst##8[n] = __builtin_shufflevector(l_, h_, 0, 1, 2, 3, 4, 5, 6, 7); } } \
        else { _Pragma("unroll") for (int n = 0; n < 2; ++n) _Pragma("unroll") for (int k = 0; k < 2; ++k) dst[n][k] = *(const PG8_LAS bf16x8*)(lds + PG8_SB(b, h) + boff + n * 2048 + k * 1024); } } while (0)
#define PG8_MMA(ai, bj, At, Bt) do { __builtin_amdgcn_s_setprio(1); \
        if constexpr (FP8) { _Pragma("unroll") for (int m = 0; m < 4; ++m) _Pragma("unroll") for (int n = 0; n < 2; ++n) \
            acc[ai][bj][m][n] = __builtin_amdgcn_mfma_scale_f32_16x16x128_f8f6f4(Bt##8[n], At##8[m], acc[ai][bj][m][n], 0, 0, 0, 0x7f7f7f7f, 0, 0x7f7f7f7f); \
            _Pragma("unroll") for (int m = 0; m < 4; ++m) _Pragma("unroll") for (int n = 0; n < 2; ++n) asm volatile("" : "+v"(acc[ai][bj][m][n])); } \
        else { _Pragma("unroll") for (int m = 0; m < 4; ++m) _Pragma("unroll") for (int n = 0; n < 2; ++n) _Pragma("unroll") for (int k = 0; k < 2; ++k) \
            acc[ai][bj][m][n] = __builtin_amdgcn_mfma_f32_16x16x32_bf16(Bt[n][k], At[m][k], acc[ai][bj][m][n], 0, 0, 0); } \
        __builtin_amdgcn_s_setprio(0); } while (0)
#define PG8_WAIT_V(n) asm volatile("s_waitcnt vmcnt(" #n ")" ::: "memory")
#define PG8_WAIT_L(n) asm volatile("s_waitcnt lgkmcnt(" #n ")" ::: "memory")
#define PG8_BAR __builtin_amdgcn_s_barrier()
#define PG8_SCHED __builtin_amdgcn_sched_barrier(0)
    Unit cur, nxt; int ui = 0;
    if (!S.next(0, cur)) return;
    f32x4 acc[2][2][4][2];
#pragma unroll
    for (int a = 0; a < 2; ++a)
#pragma unroll
        for (int b = 0; b < 2; ++b)
#pragma unroll
            for (int m = 0; m < 4; ++m)
#pragma unroll
                for (int n = 0; n < 2; ++n) acc[a][b][m][n] = (f32x4){0.f, 0.f, 0.f, 0.f};
    bf16x8 At[4][2], B0[2][2], B1[2][2];
    i32x8_ At8[4], B08[2], B18[2];
    const char* cA = (const char*)g.A + (size_t)cur.pm * tstepA; const char* cB = (const char*)g.Bt + (size_t)cur.pn * tstepB;
    if constexpr (Sched::STREAMK) { nt = cur.nk; cA += (size_t)cur.k0 * kstep; cB += (size_t)cur.k0 * kstep; }

    if constexpr (SP2) {
        PG8_STAGE(PG8_SB(0, 0), cB, voffB); PG8_STAGE(PG8_SB(0, 1), cB + hstepB, voffB); PG8_STAGE(PG8_SA(0, 0), cA, voffA); PG8_STAGE(PG8_SA(0, 1), cA + hstepA, voffA);
        if (wr == 1) PG8_BAR;
        PG8_WAIT_V(2); PG8_BAR;
        PG8_STAGE(PG8_SB(1, 0), cB + kstep, voffB); PG8_STAGE(PG8_SA(1, 0), cA + kstepA, voffA); PG8_STAGE(PG8_SB(1, 1), cB + hstepB + kstep, voffB);
        PG8_WAIT_V(6); PG8_BAR;
    } else {
        PG8_STAGE(PG8_SB(0, 0), cB, voffB); PG8_STAGE(PG8_SA(0, 0), cA, voffA); PG8_STAGE(PG8_SB(0, 1), cB + hstepB, voffB); PG8_STAGE(PG8_SA(0, 1), cA + hstepA, voffA);
        if (wr == 1) PG8_BAR;
        PG8_WAIT_V(4); PG8_BAR;
        PG8_STAGE(PG8_SB(1, 0), cB + kstep, voffB); PG8_STAGE(PG8_SA(1, 0), cA + kstepA, voffA); PG8_STAGE(PG8_SB(1, 1), cB + hstepB + kstep, voffB);
        PG8_WAIT_V(6); PG8_BAR;
    }
    for (;;) {
        const bool has_next = S.next(ui + 1, nxt);
        const char* nA = has_next ? (const char*)g.A + (size_t)nxt.pm * tstepA : cA; const char* nB = has_next ? (const char*)g.Bt + (size_t)nxt.pn * tstepB : cB;
        if constexpr (Sched::STREAMK) { if (has_next) { nA += (size_t)nxt.k0 * kstep; nB += (size_t)nxt.k0 * kstep; } }
        for (int t = 0; t < nt; t += 2) {
            const bool last = (t == nt - 2);
            const char* a1 = cA + (size_t)(t + 1) * kstepA;
            const char* a2 = last ? nA : cA + (size_t)(t + 2) * kstepA; const char* b2 = last ? nB : cB + (size_t)(t + 2) * kstep;
            const char* a3 = a2 + kstepA; const char* b3 = b2 + kstep;

            if constexpr (SP2) {
            PG8_LDB(B0, 0, 0); PG8_LDB(B1, 0, 1); PG8_SCHED; PG8_LDA(At, 0, 0); PG8_STAGE(PG8_SA(1, 1), a1 + hstepA, voffA);
            PG8_WAIT_V(8); PG8_WAIT_L(0); PG8_BAR; PG8_MMA(0, 0, At, B0); PG8_MMA(0, 1, At, B1); PG8_BAR; PG8_SCHED;
            PG8_LDA(At, 0, 1); PG8_STAGE(PG8_SB(0, 0), b2, voffB); PG8_STAGE(PG8_SB(0, 1), b2 + hstepB, voffB); PG8_STAGE(PG8_SA(0, 0), a2, voffA);
            PG8_WAIT_V(8); PG8_WAIT_L(0); PG8_BAR; PG8_MMA(1, 0, At, B0); PG8_MMA(1, 1, At, B1); PG8_BAR; PG8_SCHED;
            PG8_LDB(B0, 1, 0); PG8_LDB(B1, 1, 1); PG8_SCHED; PG8_LDA(At, 1, 0); PG8_STAGE(PG8_SA(0, 1), a2 + hstepA, voffA);
            PG8_WAIT_V(8); PG8_WAIT_L(0); PG8_BAR; PG8_MMA(0, 0, At, B0); PG8_MMA(0, 1, At, B1); PG8_BAR; PG8_SCHED;
            PG8_LDA(At, 1, 1); PG8_STAGE(PG8_SB(1, 0), b3, voffB); PG8_STAGE(PG8_SB(1, 1), b3 + hstepB, voffB); PG8_STAGE(PG8_SA(1, 0), a3, voffA);
            PG8_WAIT_V(8); PG8_WAIT_L(0); PG8_BAR; PG8_MMA(1, 0, At, B0); PG8_MMA(1, 1, At, B1); PG8_BAR; PG8_SCHED;
            } else {
            PG8_LDB(B0, 0, 0); PG8_SCHED; PG8_LDA(At, 0, 0); PG8_STAGE(PG8_SA(1, 1), a1 + hstepA, voffA);
            PG8_WAIT_L(8); PG8_BAR; PG8_WAIT_L(0); PG8_MMA(0, 0, At, B0); PG8_BAR; PG8_SCHED;
            PG8_LDB(B1, 0, 1); PG8_STAGE(PG8_SB(0, 0), b2, voffB);
            PG8_BAR; PG8_WAIT_L(0); PG8_MMA(0, 1, At, B1); PG8_BAR;
            PG8_LDA(At, 0, 1); PG8_STAGE(PG8_SA(0, 0), a2, voffA);
            PG8_BAR; PG8_WAIT_L(0); PG8_MMA(1, 0, At, B0); PG8_BAR; PG8_SCHED;
            PG8_STAGE(PG8_SB(0, 1), b2 + hstepB, voffB);
            PG8_WAIT_V(6); PG8_BAR; PG8_MMA(1, 1, At, B1); PG8_BAR;
            PG8_LDB(B0, 1, 0); PG8_SCHED; PG8_LDA(At, 1, 0); PG8_STAGE(PG8_SA(0, 1), a2 + hstepA, voffA);
            PG8_WAIT_L(8); PG8_BAR; PG8_WAIT_L(0); PG8_MMA(0, 0, At, B0); PG8_BAR; PG8_SCHED;
            PG8_LDB(B1, 1, 1); PG8_STAGE(PG8_SB(1, 0), b3, voffB);
            PG8_BAR; PG8_WAIT_L(0); PG8_MMA(0, 1, At, B1); PG8_BAR;
            PG8_LDA(At, 1, 1); PG8_STAGE(PG8_SA(1, 0), a3, voffA);
            PG8_BAR; PG8_WAIT_L(0); PG8_MMA(1, 0, At, B0); PG8_BAR; PG8_SCHED;
            PG8_STAGE(PG8_SB(1, 1), b3 + hstepB, voffB);
            PG8_WAIT_V(6); PG8_BAR; PG8_MMA(1, 1, At, B1); PG8_BAR;
            }
        }
        if constexpr (ALIGN_EPI) { if (wr == 0) PG8_BAR; }
        if constexpr (Sched::STREAMK) {
            if (cur.part == 2) { sk_store_partial(acc, S.slots() + (size_t)S.c() * SK_SLOT_WORDS, tid); PG8_WAIT_V(0);
                if (lane == 0) __hip_atomic_fetch_add(S.flags() + S.c() * 64, 1u, __ATOMIC_RELAXED, __HIP_MEMORY_SCOPE_AGENT); }
            else if (cur.part == 0) E(acc, cur, wr, wc, fr, fq);
        } else
        if constexpr (!Epi::AFTER_DRAIN) { E(acc, cur, wr, wc, fr, fq); }
        if (!has_next) break;
#pragma unroll
        for (int a = 0; a < 2; ++a)
#pragma unroll
            for (int b = 0; b < 2; ++b)
#pragma unroll
                for (int m = 0; m < 4; ++m)
#pragma unroll
                    for (int n = 0; n < 2; ++n) acc[a][b][m][n] = (f32x4){0.f, 0.f, 0.f, 0.f};
        cur = nxt; cA = nA; cB = nB; ++ui;
        if constexpr (Sched::STREAMK) nt = cur.nk;
        if constexpr (ALIGN_EPI) { if (wr == 1) PG8_BAR; }
    }
    PG8_WAIT_V(0);
    if constexpr (!ALIGN_EPI) { if (wr == 0) PG8_BAR; }
    PG8_BAR;
    if constexpr (Epi::AFTER_DRAIN) { E.fused(acc, cur, wr, wc, fr, fq, lds, wid, lane); }
    if constexpr (Sched::STREAMK) { if (cur.part == 1) {
        const int np = S.split();
        if (tid == 0) { for (int q = 1; q < np; ++q) { unsigned sp = 0; while (__hip_atomic_load(S.flags() + (S.c() + q) * 64, __ATOMIC_RELAXED, __HIP_MEMORY_SCOPE_AGENT) < S.target()) { __builtin_amdgcn_s_sleep(2); if (++sp > (1u << 22)) break; } } }
        __syncthreads();
        for (int q = 1; q < np; ++q) sk_add_partial(acc, S.slots() + (size_t)(S.c() + q) * SK_SLOT_WORDS, tid);
        E(acc, cur, wr, wc, fr, fq); } }
#undef PG8_SA
#undef PG8_SB
#undef PG8_STAGE
#undef PG8_LDA
#undef PG8_LDB
#undef PG8_MMA
#undef PG8_WAIT_V
#undef PG8_WAIT_L
#undef PG8_BAR
#undef PG8_SCHED
}
}


constexpr int NWAVES = 8, NTHREADS = 512;
constexpr int T = 16384, D = 1024, SEQ = 2048, NB = 8;
constexpr int DFF = 2816, DFE = 3584, NEXP = 8;
constexpr int RROWS = 18432;
constexpr float RMS_EPS = 1e-6f;
constexpr float MOE_WSCALE = 64.f, MOE_ASCALE = 8.f;

constexpr size_t MiB = 1u << 20;
constexpr size_t WS_CTL = 0, CTL_ZERO_BYTES = 256 * 1024;
constexpr size_t WS_SMALL = 1 * MiB;
constexpr size_t SM_KMEANS = WS_SMALL, SM_LAM32 = WS_SMALL + 64 * 1024, SM_WGCNT = WS_SMALL + 128 * 1024, SM_PANEND = WS_SMALL + 160 * 1024,
                 SM_TOKE = WS_SMALL + 192 * 1024, SM_TOKLP = WS_SMALL + 320 * 1024, SM_TOKG = WS_SMALL + 448 * 1024, SM_ROWTOK = WS_SMALL + 576 * 1024, SM_ROWGATE = WS_SMALL + 720 * 1024;
static_assert(SM_ROWGATE + 2 * RROWS * 4 <= 2 * MiB, "small tables");
constexpr size_t WS_WMEMK = 2 * MiB, WS_WMEMV = 3 * MiB, WS_WKQ = 4 * MiB, WS_WV = WS_WKQ + 2560 * 1024, WS_WOUT1 = 7 * MiB, WS_WMGU = 9 * MiB, WS_WMD = 121 * MiB;
constexpr size_t WS_XB = 177 * MiB, WS_CAT = 209 * MiB, WS_MEMN = 241 * MiB, WS_MEMK = 245 * MiB, WS_MEMVT = 247 * MiB;
constexpr size_t WS_ARENA = 249 * MiB, WS_END = 447 * MiB;
constexpr size_t AR_XS = WS_ARENA, AR_ACTM = WS_ARENA + 72 * MiB;
constexpr size_t AR_WIN0 = WS_ARENA, AR_WGLU = WS_ARENA + 2 * MiB, AR_WOUT0 = WS_ARENA + 4 * MiB, AR_WFGU = WS_ARENA + 6 * MiB, AR_WFD = WS_ARENA + 17 * MiB;
constexpr size_t AR_TZ = WS_ARENA + 23 * MiB, AR_W1T = WS_ARENA + 53 * MiB, AR_UG = WS_ARENA + 65 * MiB, AR_QM0 = WS_ARENA + 95 * MiB, AR_XC = WS_ARENA + 103 * MiB, AR_GACT = WS_ARENA + 115 * MiB;
constexpr size_t AR_X8 = WS_ARENA + 140 * MiB;
constexpr size_t AR_S5SM = WS_ARENA + 156 * MiB;
constexpr size_t AR_ACT0 = WS_ARENA + 23 * MiB;
constexpr size_t AR_KQ = WS_ARENA, AR_VT = WS_ARENA + 40 * MiB;
static_assert(AR_ACTM + (size_t)RROWS * DFE * 2 <= WS_END && AR_ACT0 + (size_t)T * DFF * 2 <= AR_GACT, "arena");
constexpr int CW_BAR = 4096, CW_QUEUE = 8192, CW_SKFLAG = 16384;
static_assert((CW_SKFLAG + 2 * 256 * 64 + 64) * 4 <= (int)CTL_ZERO_BYTES, "control words inside the per-call memset");

constexpr int RING_BYTES = 131072, MISC_OFF = RING_BYTES + 320, LDS_BYTES = 147456;

#define GAS __attribute__((address_space(1)))
#define LAS __attribute__((address_space(3)))
typedef unsigned short bf16;
typedef unsigned v4u __attribute__((ext_vector_type(4)));
typedef unsigned v2u __attribute__((ext_vector_type(2)));
typedef float f32x4 __attribute__((ext_vector_type(4)));
typedef float f32x16 __attribute__((ext_vector_type(16)));
typedef short bf16x8 __attribute__((ext_vector_type(8)));
typedef short s16x4 __attribute__((ext_vector_type(4)));
typedef GAS unsigned gu32;
#define LDS_WAIT() asm volatile("s_waitcnt lgkmcnt(0)" ::: "memory")
using pg8::cvt_pk_bf16; using pg8::bf_lo; using pg8::bf_hi;
__device__ __forceinline__ unsigned f2bf(float f) { unsigned u = __builtin_bit_cast(unsigned, f); return (u + 0x7fffu + ((u >> 16) & 1u)) >> 16; }
__device__ __forceinline__ unsigned pk2(float lo, float hi) { return f2bf(lo) | (f2bf(hi) << 16); }
__device__ __forceinline__ float wave_sum(float v) {
#pragma unroll
    for (int o = 1; o < 64; o <<= 1) v += __shfl_xor(v, o);
    return v;
}

#define XB_TMO      128
#define XB_XCNT(j)  (256  + 64 * (j))
#define XB_XSUB(j)  (1280 + 64 * (j))
#define XB_XGEN(j)  (2304 + 64 * (j))
#define XB_TOP      3328
#define XB_TOPGEN   3392
#define XCD_BAR_WORDS 3456
#define XB_SPIN_CAP (1u << 18)

__device__ __forceinline__ unsigned xb_ld(unsigned* p)              { return __hip_atomic_load(p, __ATOMIC_RELAXED, __HIP_MEMORY_SCOPE_AGENT); }
__device__ __forceinline__ unsigned xb_add(unsigned* p, unsigned v) { return __hip_atomic_fetch_add(p, v, __ATOMIC_RELAXED, __HIP_MEMORY_SCOPE_AGENT); }
__device__ __forceinline__ unsigned xb_xcc_id() { return (unsigned)__builtin_amdgcn_s_getreg((3 << 11) | 20) & 0xFu; }
#define XB_SPIN(cond, bar) do { unsigned _sp = 0; while (cond) { __builtin_amdgcn_s_sleep(1); \
    if ((++_sp & 255u) == 0u) { if (xb_ld(&(bar)[XB_TMO])) break; if (_sp > XB_SPIN_CAP) { atomicAdd(&(bar)[XB_TMO], 1u); break; } } } } while (0)

struct XcdBarrier {
    unsigned* bar; unsigned x;
    volatile LAS unsigned* st;
};

__device__ __forceinline__ XcdBarrier xcd_barrier_post(unsigned* bar, volatile LAS unsigned* st) {
    XcdBarrier b; b.bar = bar; b.x = xb_xcc_id(); b.st = st;
    if (threadIdx.x == 0) (void)xb_add(&bar[XB_XCNT(b.x)], 1u);
    return b;
}
__device__ __forceinline__ void xcd_barrier_complete(unsigned* bar, unsigned x, unsigned& nloc, unsigned& nx) {
    const unsigned G = gridDim.x * gridDim.y * gridDim.z;
    unsigned sum, cnt, mine, sp = 0u;
    for (;;) {
        sum = 0u; cnt = 0u; mine = 0u;
#pragma unroll
        for (unsigned j = 0; j < 16; ++j) { const unsigned c = xb_ld(&bar[XB_XCNT(j)]); sum += c; cnt += (c > 0u) ? 1u : 0u; mine = (j == x) ? c : mine; }
        if (sum == G) break;
        __builtin_amdgcn_s_sleep(1);
        if ((++sp & 255u) == 0u) { if (xb_ld(&bar[XB_TMO])) break; if (sp > XB_SPIN_CAP) { atomicAdd(&bar[XB_TMO], 1u); break; } }
    }
    nloc = mine > 0u ? mine : 1u; nx = cnt > 0u ? cnt : 1u;
}

__device__ __forceinline__ void xcd_barrier(const XcdBarrier& b) {
    asm volatile("s_waitcnt vmcnt(0)" ::: "memory");
    __syncthreads();
    if (threadIdx.x == 0) {
        unsigned* bar = b.bar;
        __builtin_amdgcn_s_waitcnt(0);
        unsigned nloc = b.st[0], nx = b.st[1];
        if (nloc == 0u) { xcd_barrier_complete(bar, b.x, nloc, nx); b.st[0] = nloc; b.st[1] = nx; }
        const unsigned old = xb_add(&bar[XB_XSUB(b.x)], 1u);
        const unsigned gen = old / nloc;
        if (old + 1u == (gen + 1u) * nloc) {
            __builtin_amdgcn_fence(__ATOMIC_RELEASE, "agent");
            asm volatile("s_waitcnt vmcnt(0)" ::: "memory");
            const unsigned og = xb_add(&bar[XB_TOP], 1u);
            const unsigned tg = og / nx;
            if (og + 1u == (tg + 1u) * nx) xb_add(&bar[XB_TOPGEN], 1u);
            else XB_SPIN(xb_ld(&bar[XB_TOPGEN]) == tg, bar);
            __builtin_amdgcn_fence(__ATOMIC_ACQUIRE, "agent");
            xb_add(&bar[XB_XGEN(b.x)], 1u);
            asm volatile("s_waitcnt vmcnt(0)" ::: "memory");
        } else {
            XB_SPIN(xb_ld(&bar[XB_XGEN(b.x)]) == gen, bar);
            __builtin_amdgcn_fence(__ATOMIC_ACQUIRE, "agent");
            asm volatile("s_waitcnt vmcnt(0)" ::: "memory");
        }
    }
    __syncthreads();
}


__device__ __forceinline__ void cvt_item(const float* W, int ldw, int k0, int n0, const float* gain, bf16* WT, int ldo, int orow0, LAS unsigned* scr, int lane) {
    const int nq = lane & 15, kr = lane >> 4;
    f32x4 a[8], b[8];
    const float* src = W + (size_t)(k0 + 2 * kr) * ldw + n0 + 4 * nq;
#pragma unroll
    for (int i = 0; i < 8; ++i) { a[i] = *(const GAS f32x4*)(src + (size_t)(8 * i) * ldw); b[i] = *(const GAS f32x4*)(src + (size_t)(8 * i + 1) * ldw); }
    if (gain) {
#pragma unroll
        for (int i = 0; i < 8; ++i) { const float ga = gain[k0 + 8 * i + 2 * kr], gb = gain[k0 + 8 * i + 2 * kr + 1]; a[i] = a[i] * ga; b[i] = b[i] * gb; } }
#pragma unroll
    for (int i = 0; i < 8; ++i) {
#pragma unroll
        for (int e = 0; e < 4; ++e) scr[(4 * nq + e) * 33 + 4 * i + kr] = cvt_pk_bf16(a[i][e], b[i][e]); }
    LDS_WAIT(); asm volatile("" ::: "memory");
#pragma unroll
    for (int j = 0; j < 8; ++j) { const int q = lane + 64 * j, n = q >> 3, c = q & 7; const LAS unsigned* sp = scr + n * 33 + 4 * c;
        v4u o; o.x = sp[0]; o.y = sp[1]; o.z = sp[2]; o.w = sp[3];
        *(GAS v4u*)(WT + (size_t)(orow0 + n) * ldo + k0 + 8 * c) = o; }
    LDS_WAIT(); asm volatile("" ::: "memory");
}
struct CvtDesc { const float* src; const float* gain; bf16* dst; int ldw, ldo, k0; };
__device__ __forceinline__ void cvt_load(const CvtDesc& d, f32x4 (&a)[8], f32x4 (&b)[8], float (&ga)[8], float (&gb)[8], int lane) {
    const int nq = lane & 15, kr = lane >> 4; const float* src = d.src + (size_t)(2 * kr) * d.ldw + 4 * nq;
    if (d.gain) {
#pragma unroll
        for (int i = 0; i < 8; ++i) { ga[i] = d.gain[d.k0 + 8 * i + 2 * kr]; gb[i] = d.gain[d.k0 + 8 * i + 2 * kr + 1]; } }
    else {
#pragma unroll
        for (int i = 0; i < 8; ++i) { ga[i] = 1.f; gb[i] = 1.f; } }
#pragma unroll
    for (int i = 0; i < 8; ++i) { a[i] = *(const GAS f32x4*)(src + (size_t)(8 * i) * d.ldw); b[i] = *(const GAS f32x4*)(src + (size_t)(8 * i + 1) * d.ldw); }
}
__device__ __forceinline__ void cvt_emit(const CvtDesc& d, f32x4 (&a)[8], f32x4 (&b)[8], const float (&ga)[8], const float (&gb)[8], LAS unsigned* scr, int lane) {
    const int nq = lane & 15, kr = lane >> 4;
#pragma unroll
    for (int i = 0; i < 8; ++i) {
#pragma unroll
        for (int e = 0; e < 4; ++e) scr[(4 * nq + e) * 33 + 4 * i + kr] = cvt_pk_bf16(a[i][e] * ga[i], b[i][e] * gb[i]); }
    LDS_WAIT(); asm volatile("" ::: "memory");
#pragma unroll
    for (int j = 0; j < 8; ++j) { const int q = lane + 64 * j, n = q >> 3, c = q & 7; const LAS unsigned* sp = scr + n * 33 + 4 * c;
        v4u o; o.x = sp[0]; o.y = sp[1]; o.z = sp[2]; o.w = sp[3];
        *(GAS v4u*)(d.dst + (size_t)n * d.ldo + 8 * c) = o; }
    LDS_WAIT(); asm volatile("" ::: "memory");
}
struct CvtDesc8 { const float* src; const float* gain; unsigned char* dst; int ldw, ldo, k0; };
__device__ __forceinline__ void cvt_load8(const CvtDesc8& d, f32x4 (&a)[4][4], float (&g)[4][4], float scale, int lane) {
    const int nq = lane & 15, kr = lane >> 4; const float* src = d.src + (size_t)(4 * kr) * d.ldw + 4 * nq;
#pragma unroll
    for (int i = 0; i < 4; ++i)
#pragma unroll
        for (int r = 0; r < 4; ++r) g[i][r] = d.gain ? d.gain[d.k0 + 16 * i + 4 * kr + r] * scale : scale;
#pragma unroll
    for (int i = 0; i < 4; ++i)
#pragma unroll
        for (int r = 0; r < 4; ++r) a[i][r] = __builtin_nontemporal_load((const GAS f32x4*)(src + (size_t)(16 * i + r) * d.ldw));
}
__device__ __forceinline__ void cvt_load8_dma(const CvtDesc8& d, f32x4 (&a)[4][4], float (&g)[4][4], float scale, LAS unsigned char* buf, int lane) {
    const int nq = lane & 15, kr = lane >> 4;
#pragma unroll
    for (int i = 0; i < 4; ++i)
#pragma unroll
        for (int r = 0; r < 4; ++r) g[i][r] = d.gain ? d.gain[d.k0 + 16 * i + 4 * kr + r] * scale : scale;
    const float* src = d.src + (size_t)kr * d.ldw + 4 * nq;
#pragma unroll
    for (int j = 0; j < 16; ++j) __builtin_amdgcn_global_load_lds((const unsigned*)(src + (size_t)(4 * j) * d.ldw), (LAS unsigned*)(buf + j * 1024), 16, 0, 2);
    asm volatile("s_waitcnt vmcnt(0)" ::: "memory");
#pragma unroll
    for (int i = 0; i < 4; ++i)
#pragma unroll
        for (int r = 0; r < 4; ++r) a[i][r] = *(const LAS f32x4*)(buf + (16 * i + 4 * kr + r) * 256 + nq * 16);
    LDS_WAIT(); asm volatile("" ::: "memory");
}
__device__ __forceinline__ void cvt_emit8(const CvtDesc8& d, f32x4 (&a)[4][4], const float (&g)[4][4], LAS unsigned* scr, int lane) {
    const int nq = lane & 15, kr = lane >> 4;
#pragma unroll
    for (int i = 0; i < 4; ++i)
#pragma unroll
        for (int e = 0; e < 4; ++e) scr[(4 * nq + e) * 17 + 4 * i + kr] = pg8::pk4_fp8(a[i][0][e] * g[i][0], a[i][1][e] * g[i][1], a[i][2][e] * g[i][2], a[i][3][e] * g[i][3]);
    LDS_WAIT(); asm volatile("" ::: "memory");
#pragma unroll
    for (int j = 0; j < 4; ++j) { const int q = lane + 64 * j, n = q >> 2, c = q & 3; const LAS unsigned* sp = scr + n * 17 + 4 * c;
        v4u o; o.x = sp[0]; o.y = sp[1]; o.z = sp[2]; o.w = sp[3];
        __builtin_nontemporal_store(o, (GAS v4u*)(d.dst + (size_t)n * d.ldo + 16 * c)); }
    LDS_WAIT(); asm volatile("" ::: "memory");
}
__device__ __forceinline__ void rms_row_to_bf16(const float* xrow, bf16* orow, int lane) {
    const GAS f32x4* xr = (const GAS f32x4*)xrow + lane;
    f32x4 v[4]; float s = 0.f;
#pragma unroll
    for (int j = 0; j < 4; ++j) { v[j] = xr[64 * j]; s += (v[j].x * v[j].x + v[j].y * v[j].y) + (v[j].z * v[j].z + v[j].w * v[j].w); }
    const float r = 1.f / sqrtf(wave_sum(s) * (1.f / 1024.f) + RMS_EPS);
    GAS unsigned long long* o8 = (GAS unsigned long long*)orow + lane;
#pragma unroll
    for (int j = 0; j < 4; ++j) o8[64 * j] = (unsigned long long)pk2(v[j].x * r, v[j].y * r) | ((unsigned long long)pk2(v[j].z * r, v[j].w * r) << 32);
}
__device__ __forceinline__ void dsincos(double a, double& s, double& c) {
    const double k = rint(a * 0.63661977236758134308);
    double r = fma(-k, 1.57079632679489655800e+00, a); r = fma(-k, 6.12323399573676603587e-17, r);
    const double z = r * r;
    double ps = 1.0 / 355687428096000.0;
    ps = fma(ps, z, -1.0 / 1307674368000.0); ps = fma(ps, z, 1.0 / 6227020800.0); ps = fma(ps, z, -1.0 / 39916800.0); ps = fma(ps, z, 1.0 / 362880.0);
    ps = fma(ps, z, -1.0 / 5040.0); ps = fma(ps, z, 1.0 / 120.0); ps = fma(ps, z, -1.0 / 6.0); ps = fma(ps * z, r, r);
    double pc = -1.0 / 6402373705728000.0;
    pc = fma(pc, z, 1.0 / 20922789888000.0); pc = fma(pc, z, -1.0 / 87178291200.0); pc = fma(pc, z, 1.0 / 479001600.0); pc = fma(pc, z, -1.0 / 3628800.0);
    pc = fma(pc, z, 1.0 / 40320.0); pc = fma(pc, z, -1.0 / 720.0); pc = fma(pc, z, 1.0 / 24.0); pc = fma(pc, z, -0.5); pc = fma(pc, z, 1.0);
    const long q = (long)k & 3;
    s = (q == 0) ? ps : (q == 1) ? pc : (q == 2) ? -ps : -pc;
    c = (q == 0) ? pc : (q == 1) ? -ps : (q == 2) ? -pc : ps;
}
__device__ __forceinline__ double dexp(double x) {
    const double k = rint(x * 1.44269504088896338700);
    double r = fma(-k, 6.93147180369123816490e-01, x); r = fma(-k, 1.90821492927058770002e-10, r);
    double p = 1.0 / 6227020800.0;
    p = fma(p, r, 1.0 / 479001600.0); p = fma(p, r, 1.0 / 39916800.0); p = fma(p, r, 1.0 / 3628800.0); p = fma(p, r, 1.0 / 362880.0); p = fma(p, r, 1.0 / 40320.0);
    p = fma(p, r, 1.0 / 5040.0); p = fma(p, r, 1.0 / 720.0); p = fma(p, r, 1.0 / 120.0); p = fma(p, r, 1.0 / 24.0); p = fma(p, r, 1.0 / 6.0); p = fma(p, r, 0.5); p = fma(p, r, 1.0); p = fma(p, r, 1.0);
    const long ki = (long)k;
    return p * __builtin_bit_cast(double, (unsigned long long)(1023 + ki) << 52);
}
constexpr int S5SM_PW = 64 * 33, S5SM_HEAD = 2 * S5SM_PW + 2048, S5SM_FLOATS = S5SM_HEAD + 8192;
struct S5Lds { LAS float* pwr; LAS float* pwi; LAS float* bbr; LAS float* bbi; LAS float* ccr; LAS float* cci; LAS float* km; };
__device__ __forceinline__ S5Lds s5_lds(LAS unsigned char* lds) { S5Lds L; L.pwr = (LAS float*)lds; L.pwi = L.pwr + S5SM_PW; L.bbr = L.pwi + S5SM_PW; L.bbi = L.bbr + 1024; L.ccr = L.bbi + 1024; L.cci = L.ccr + 1024; L.km = L.cci + 1024; return L; }
__device__ __forceinline__ void s5_tables_small(int g, LAS unsigned char* lds, const float* lam_re, const float* lam_im, const float* log_dt, const float* b_re, const float* b_im,
                                                const float* c_re, const float* c_im, float* S5SM, float* LAM32, int tid) {
    const S5Lds L = s5_lds(lds); LAS float* pwr = L.pwr; LAS float* pwi = L.pwi; LAS float* bbr = L.bbr; LAS float* bbi = L.bbi; LAS float* ccr = L.ccr; LAS float* cci = L.cci; LAS float* km = L.km;
    const double dt = dexp((double)log_dt[g]);
    for (int idx = tid; idx < 64 * 33; idx += NTHREADS) { const int p = idx / 33, tau = idx % 33;
        const double lr = lam_re[g * 64 + p], li = lam_im[g * 64 + p]; const double mag = dexp(lr * dt * tau); double s, c; dsincos(li * dt * tau, s, c);
        pwr[idx] = (float)(mag * c); pwi[idx] = (float)(mag * s); }
    for (int idx = tid; idx < 1024; idx += NTHREADS) { const int p = idx >> 4, m = idx & 15;
        const double lr = lam_re[g * 64 + p], li = lam_im[g * 64 + p]; const double mag = dexp(lr * dt); double s, c; dsincos(li * dt, s, c);
        const double ar = mag * c - 1.0, ai = mag * s, den = lr * lr + li * li, fr_ = (ar * lr + ai * li) / den, fi_ = (ai * lr - ar * li) / den;
        const double br = b_re[(g * 64 + p) * 16 + m], bi = b_im[(g * 64 + p) * 16 + m];
        bbr[idx] = (float)(fr_ * br - fi_ * bi); bbi[idx] = (float)(fr_ * bi + fi_ * br);
        ccr[idx] = c_re[g * 1024 + idx]; cci[idx] = c_im[g * 1024 + idx]; }
    __syncthreads();
    { const int half = tid >> 8, n = (tid >> 4) & 15, m = tid & 15; float acc[16];
#pragma unroll
      for (int t = 0; t < 16; ++t) acc[t] = 0.f;
      for (int p = 0; p < 64; ++p) { const float cr = ccr[n * 64 + p], ci = cci[n * 64 + p], br = bbr[p * 16 + m], bi = bbi[p * 16 + m]; const float zr = cr * br - ci * bi, zi = cr * bi + ci * br;
#pragma unroll
          for (int t = 0; t < 16; ++t) acc[t] += zr * pwr[p * 33 + 16 * half + t] - zi * pwi[p * 33 + 16 * half + t]; }
#pragma unroll
      for (int t = 0; t < 16; ++t) km[((16 * half + t) * 16 + n) * 16 + m] = acc[t]; }
    __syncthreads();
    float* S = S5SM + (size_t)g * S5SM_FLOATS;
    for (int i = tid; i < S5SM_HEAD; i += NTHREADS) S[i] = pwr[i];
    for (int i = tid; i < 8192; i += NTHREADS) S[S5SM_HEAD + i] = km[i];
    if (tid < 64) { LAM32[(g * 64 + tid) * 2] = pwr[tid * 33 + 32]; LAM32[(g * 64 + tid) * 2 + 1] = pwi[tid * 33 + 32]; }
    __syncthreads();
}
__device__ __forceinline__ void s5_load(int g, LAS unsigned char* lds, const float* S5SM, const float* c_re, const float* c_im, bool with_km, int tid) {
    const S5Lds L = s5_lds(lds); const float* S = S5SM + (size_t)g * S5SM_FLOATS;
    for (int i = tid; i < S5SM_HEAD / 4; i += NTHREADS) *(LAS f32x4*)(L.pwr + 4 * i) = *(const GAS f32x4*)(S + 4 * i);
    for (int i = tid; i < 256; i += NTHREADS) { *(LAS f32x4*)(L.ccr + 4 * i) = *(const GAS f32x4*)(c_re + g * 1024 + 4 * i); *(LAS f32x4*)(L.cci + 4 * i) = *(const GAS f32x4*)(c_im + g * 1024 + 4 * i); }
    if (with_km) for (int i = tid; i < 2048; i += NTHREADS) *(LAS f32x4*)(L.km + 4 * i) = *(const GAS f32x4*)(S + S5SM_HEAD + 4 * i);
    __syncthreads();
}
__device__ __forceinline__ void s5_expand_tz(int g, LAS unsigned char* lds, bf16* TZ, int row_lo, int row_hi, int tid) {
    const S5Lds L = s5_lds(lds); LAS float* pwr = L.pwr; LAS float* pwi = L.pwi; LAS float* ccr = L.ccr; LAS float* cci = L.cci; LAS float* km = L.km;
    bf16* tz = TZ + (size_t)g * 512 * 640;
    for (int pc = row_lo * 80 + tid; pc < row_hi * 80; pc += NTHREADS) { const int row = pc / 80, c8 = pc % 80, j = row >> 4, n = row & 15; float v[8];
        if (c8 < 64) { const int i = c8 >> 1, m0 = (c8 & 1) * 8;
#pragma unroll
            for (int e = 0; e < 8; ++e) v[e] = (i <= j) ? km[((j - i) * 16 + n) * 16 + m0 + e] : 0.f; }
        else { const int p0 = (c8 - 64) * 4;
#pragma unroll
            for (int q = 0; q < 4; ++q) { const int p = p0 + q; const float cr = ccr[n * 64 + p], ci = cci[n * 64 + p], pr = pwr[p * 33 + j + 1], pi = pwi[p * 33 + j + 1];
                v[2 * q] = cr * pr - ci * pi; v[2 * q + 1] = -(cr * pi + ci * pr); } }
        v4u o; o.x = pk2(v[0], v[1]); o.y = pk2(v[2], v[3]); o.z = pk2(v[4], v[5]); o.w = pk2(v[6], v[7]);
        *(GAS v4u*)(tz + (size_t)row * 640 + c8 * 8) = o; }
}
__device__ __forceinline__ void s5_expand_w1t(int g, LAS unsigned char* lds, bf16* W1T, int row_lo, int row_hi, int tid) {
    const S5Lds L = s5_lds(lds); LAS float* pwr = L.pwr; LAS float* pwi = L.pwi; LAS float* bbr = L.bbr; LAS float* bbi = L.bbi;
    bf16* w1 = W1T + (size_t)g * 256 * 512;
    for (int pc = row_lo * 64 + tid; pc < row_hi * 64; pc += NTHREADS) { const int row = pc >> 6, c8 = pc & 63, p = row >> 1, ri = row & 1, i = c8 >> 1, m0 = (c8 & 1) * 8; float v[8];
        const float ar = pwr[p * 33 + 31 - i], ai = pwi[p * 33 + 31 - i];
#pragma unroll
        for (int e = 0; e < 8; ++e) { const float br = bbr[p * 16 + m0 + e], bi = bbi[p * 16 + m0 + e]; v[e] = ri ? (ar * bi + ai * br) : (ar * br - ai * bi); }
        v4u o; o.x = pk2(v[0], v[1]); o.y = pk2(v[2], v[3]); o.z = pk2(v[4], v[5]); o.w = pk2(v[6], v[7]);
        *(GAS v4u*)(w1 + (size_t)row * 512 + c8 * 8) = o; }
}

constexpr int KS_PITCH = 144, VS_PITCH = 520, ATT_KS = 0, ATT_VS = 256 * KS_PITCH;
static_assert(ATT_VS + 64 * VS_PITCH <= RING_BYTES, "attention LDS");
#define MFMA32(a, b, c) __builtin_amdgcn_mfma_f32_32x32x16_bf16(a, b, c, 0, 0, 0)
struct KVRegs { v4u k[4]; v4u v[4]; };
__device__ __forceinline__ void att_load(KVRegs& R, const bf16* Kg, int kpitch, const bf16* Vg, int vpitch, int tid) {
#pragma unroll
    for (int i = 0; i < 4; ++i) { const int p = tid + NTHREADS * i, row = p >> 3, c = p & 7; R.k[i] = *(const GAS v4u*)(Kg + (size_t)row * kpitch + c * 8); }
#pragma unroll
    for (int i = 0; i < 4; ++i) { const int p = tid + NTHREADS * i, row = p >> 5, c = p & 31; R.v[i] = *(const GAS v4u*)(Vg + (size_t)row * vpitch + c * 8); }
}
__device__ __forceinline__ void att_store(LAS unsigned char* lds, const KVRegs& R, int tid) {
#pragma unroll
    for (int i = 0; i < 4; ++i) { const int p = tid + NTHREADS * i, row = p >> 3, c = p & 7; *(LAS v4u*)(lds + ATT_KS + row * KS_PITCH + c * 16) = R.k[i]; }
#pragma unroll
    for (int i = 0; i < 4; ++i) { const int p = tid + NTHREADS * i, row = p >> 5, c = p & 31;
        LAS v2u* d = (LAS v2u*)(lds + ATT_VS + row * VS_PITCH + c * 16); d[0] = (v2u){R.v[i].x, R.v[i].y}; d[1] = (v2u){R.v[i].z, R.v[i].w}; }
}
__device__ __forceinline__ void att_stage(LAS unsigned char* lds, const bf16* Kg, int kpitch, const bf16* Vg, int vpitch, int tid) { KVRegs R; att_load(R, Kg, kpitch, Vg, vpitch, tid); att_store(lds, R, tid); }
__device__ __forceinline__ void att_qk(const LAS unsigned char* lds, const bf16x8 (&qf)[4], int kt, f32x16& p0, f32x16& p1, int lane) {
    const int r32 = lane & 31, hi = lane >> 5;
#pragma unroll
    for (int r = 0; r < 16; ++r) { p0[r] = 0.f; p1[r] = 0.f; }
    const LAS unsigned char* kb = lds + ATT_KS + (kt * 64 + r32) * KS_PITCH + hi * 16;
#pragma unroll
    for (int d0 = 0; d0 < 4; ++d0) { const bf16x8 k0 = *(const LAS bf16x8*)(kb + d0 * 32), k1 = *(const LAS bf16x8*)(kb + 32 * KS_PITCH + d0 * 32);
        p0 = MFMA32(k0, qf[d0], p0); p1 = MFMA32(k1, qf[d0], p1); }
}
template <int MODE> __device__ __forceinline__ void att_finish(const LAS unsigned char* lds, int kt, f32x16& p0, f32x16& p1, f32x16& o0, f32x16& o1, float& l, int qloc, bool rowoff, int lane) {
    const int r32 = lane & 31, hi = lane >> 5; const float NEG = -__builtin_inff();
    if (MODE == 1) { const int kv0 = kt * 64 + 4 * hi;
#pragma unroll
        for (int r = 0; r < 16; ++r) { const int kv = kv0 + (r & 3) + 8 * (r >> 2); if (kv > qloc) p0[r] = NEG; if (kv + 32 > qloc) p1[r] = NEG; } }
    float rs = 0.f;
#pragma unroll
    for (int r = 0; r < 16; ++r) { p0[r] = __builtin_amdgcn_exp2f(p0[r]); p1[r] = __builtin_amdgcn_exp2f(p1[r]); rs += p0[r] + p1[r]; }
    if (MODE == 2) rs = rowoff ? 0.f : rs;
    l += rs;
    bf16x8 pb[4];
#pragma unroll
    for (int s = 0; s < 2; ++s) { v4u w0, w1;
        w0.x = cvt_pk_bf16(p0[8 * s + 0], p0[8 * s + 1]); w0.y = cvt_pk_bf16(p0[8 * s + 2], p0[8 * s + 3]); w0.z = cvt_pk_bf16(p0[8 * s + 4], p0[8 * s + 5]); w0.w = cvt_pk_bf16(p0[8 * s + 6], p0[8 * s + 7]);
        w1.x = cvt_pk_bf16(p1[8 * s + 0], p1[8 * s + 1]); w1.y = cvt_pk_bf16(p1[8 * s + 2], p1[8 * s + 3]); w1.z = cvt_pk_bf16(p1[8 * s + 4], p1[8 * s + 5]); w1.w = cvt_pk_bf16(p1[8 * s + 6], p1[8 * s + 7]);
        if (MODE == 2) { if (rowoff) { w0 = (v4u){0u, 0u, 0u, 0u}; w1 = (v4u){0u, 0u, 0u, 0u}; } }
        pb[s] = __builtin_bit_cast(bf16x8, w0); pb[2 + s] = __builtin_bit_cast(bf16x8, w1); }
    const LAS unsigned char* vb = lds + ATT_VS + r32 * VS_PITCH + (kt * 64 + 4 * hi) * 2;
#pragma unroll
    for (int s = 0; s < 4; ++s) { const int ko = (32 * (s >> 1) + 16 * (s & 1)) * 2;
        const s16x4 a0 = *(const LAS s16x4*)(vb + ko), a1 = *(const LAS s16x4*)(vb + ko + 16);
        const s16x4 b0 = *(const LAS s16x4*)(vb + 32 * VS_PITCH + ko), b1 = *(const LAS s16x4*)(vb + 32 * VS_PITCH + ko + 16);
        const bf16x8 va = (bf16x8){a0[0], a0[1], a0[2], a0[3], a1[0], a1[1], a1[2], a1[3]}, vc = (bf16x8){b0[0], b0[1], b0[2], b0[3], b1[0], b1[1], b1[2], b1[3]};
        o0 = MFMA32(va, pb[s], o0); o1 = MFMA32(vc, pb[s], o1); }
}
template <int MODE> __device__ __forceinline__ void att_block(const LAS unsigned char* lds, const bf16x8 (&qf)[4], f32x16& o0, f32x16& o1, float& l, int nkt, int qloc, bool rowoff, int lane) {
    f32x16 pa0, pa1, pb0, pb1;
    att_qk(lds, qf, 0, pa0, pa1, lane);
    int kt = 0;
    for (; kt + 1 < nkt; kt += 2) {
        att_qk(lds, qf, kt + 1, pb0, pb1, lane);
        att_finish<MODE>(lds, kt, pa0, pa1, o0, o1, l, qloc, rowoff, lane);
        if (kt + 2 < nkt) att_qk(lds, qf, kt + 2, pa0, pa1, lane);
        att_finish<MODE>(lds, kt + 1, pb0, pb1, o0, o1, l, qloc, rowoff, lane);
    }
    if (kt < nkt) att_finish<MODE>(lds, kt, pa0, pa1, o0, o1, l, qloc, rowoff, lane);
}
__device__ __forceinline__ void att_load_q(const bf16* qrow  , float (&qv)[4][8], bf16x8 (&qf)[4]) {
    float ss = 0.f;
#pragma unroll
    for (int d0 = 0; d0 < 4; ++d0) { const v4u w = *(const GAS v4u*)(qrow + d0 * 16);
        qv[d0][0] = bf_lo(w.x); qv[d0][1] = bf_hi(w.x); qv[d0][2] = bf_lo(w.y); qv[d0][3] = bf_hi(w.y); qv[d0][4] = bf_lo(w.z); qv[d0][5] = bf_hi(w.z); qv[d0][6] = bf_lo(w.w); qv[d0][7] = bf_hi(w.w);
#pragma unroll
        for (int e = 0; e < 8; ++e) ss += qv[d0][e] * qv[d0][e]; }
    ss += __shfl_xor(ss, 32);
    const float sc = (1.f / sqrtf(ss * (1.f / 64.f) + RMS_EPS)) * (0.125f * 1.4426950408889634f);
#pragma unroll
    for (int d0 = 0; d0 < 4; ++d0) { v4u w; w.x = cvt_pk_bf16(qv[d0][0] * sc, qv[d0][1] * sc); w.y = cvt_pk_bf16(qv[d0][2] * sc, qv[d0][3] * sc); w.z = cvt_pk_bf16(qv[d0][4] * sc, qv[d0][5] * sc); w.w = cvt_pk_bf16(qv[d0][6] * sc, qv[d0][7] * sc);
        qf[d0] = __builtin_bit_cast(bf16x8, w); }
}
constexpr int ATT_OST = 73728, OST_PITCH = 144;
static_assert(ATT_OST >= ATT_VS + 64 * VS_PITCH && ATT_OST + 8 * 32 * OST_PITCH <= RING_BYTES, "attention output stage");
template <bool OUT8 = false  >
__device__ __forceinline__ void att_store_o(LAS unsigned char* lds, bf16* obase  , int opitch, const f32x16& o0, const f32x16& o1, float l, int lane, int wid) {
    const int r32 = lane & 31, hi = lane >> 5;
    l += __shfl_xor(l, 32); const float inv = 1.f / l;
    LAS unsigned char* st = lds + ATT_OST + wid * (32 * OST_PITCH);
    if constexpr (OUT8) {
        const float i8 = inv * 8.f;
#pragma unroll
        for (int a = 0; a < 4; ++a) {
            *(LAS unsigned*)(st + r32 * OST_PITCH + (8 * a + 4 * hi)) = pg8::pk4_fp8(__builtin_amdgcn_fmed3f(o0[4 * a] * i8, -440.f, 440.f), __builtin_amdgcn_fmed3f(o0[4 * a + 1] * i8, -440.f, 440.f), __builtin_amdgcn_fmed3f(o0[4 * a + 2] * i8, -440.f, 440.f), __builtin_amdgcn_fmed3f(o0[4 * a + 3] * i8, -440.f, 440.f));
            *(LAS unsigned*)(st + r32 * OST_PITCH + (32 + 8 * a + 4 * hi)) = pg8::pk4_fp8(__builtin_amdgcn_fmed3f(o1[4 * a] * i8, -440.f, 440.f), __builtin_amdgcn_fmed3f(o1[4 * a + 1] * i8, -440.f, 440.f), __builtin_amdgcn_fmed3f(o1[4 * a + 2] * i8, -440.f, 440.f), __builtin_amdgcn_fmed3f(o1[4 * a + 3] * i8, -440.f, 440.f)); }
        LDS_WAIT(); asm volatile("" ::: "memory");
#pragma unroll
        for (int i = 0; i < 2; ++i) { const int idx = lane + 64 * i, row = idx >> 2, c = idx & 3;
            const v4u v = *(const LAS v4u*)(st + row * OST_PITCH + c * 16);
            *(GAS v4u*)((unsigned char*)obase + (size_t)row * opitch + c * 16) = v; }
        LDS_WAIT(); asm volatile("" ::: "memory");
        return; }
#pragma unroll
    for (int a = 0; a < 4; ++a) {
        *(LAS v2u*)(st + r32 * OST_PITCH + (8 * a + 4 * hi) * 2) = (v2u){cvt_pk_bf16(o0[4 * a] * inv, o0[4 * a + 1] * inv), cvt_pk_bf16(o0[4 * a + 2] * inv, o0[4 * a + 3] * inv)};
        *(LAS v2u*)(st + r32 * OST_PITCH + (32 + 8 * a + 4 * hi) * 2) = (v2u){cvt_pk_bf16(o1[4 * a] * inv, o1[4 * a + 1] * inv), cvt_pk_bf16(o1[4 * a + 2] * inv, o1[4 * a + 3] * inv)}; }
    LDS_WAIT(); asm volatile("" ::: "memory");
#pragma unroll
    for (int i = 0; i < 4; ++i) { const int idx = lane + 64 * i, row = idx >> 3, c = idx & 7;
        const v4u v = *(const LAS v4u*)(st + row * OST_PITCH + c * 16);
        *(GAS v4u*)(obase + (size_t)row * opitch + c * 8) = v; }
    LDS_WAIT(); asm volatile("" ::: "memory");
}
template <bool OUT8 = false  >
__device__ __forceinline__ void mem_unit(LAS unsigned char* lds, const bf16* Q, int qpitch, const bf16* Kg, const bf16* Vg, bf16* O, int tid) {
    const int lane = tid & 63, wid = __builtin_amdgcn_readfirstlane(tid >> 6), r32 = lane & 31, hi = lane >> 5;
    att_stage(lds, Kg, 512, Vg, 2048, tid);
    float qv[4][8]; bf16x8 qf[4];
    att_load_q(Q + (size_t)(wid * 32 + r32) * qpitch + hi * 8, qv, qf);
    __syncthreads();
    f32x16 o0, o1; float l = 0.f;
#pragma unroll
    for (int r = 0; r < 16; ++r) { o0[r] = 0.f; o1[r] = 0.f; }
    att_block<0>(lds, qf, o0, o1, l, 4, 0, false, lane);
    if constexpr (OUT8) att_store_o<true>(lds, (bf16*)((unsigned char*)O + (size_t)(wid * 32) * 1024), 1024, o0, o1, l, lane, wid);
    else att_store_o(lds, O + (size_t)(wid * 32) * 1024, 1024, o0, o1, l, lane, wid);
    __syncthreads();
}
__device__ __forceinline__ void moba_unit(LAS unsigned char* lds, int b, int qh, int qblk, const bf16* KQ, const bf16* VT, const float* KMEANS, bf16* CAT, int tid) {
    const int lane = tid & 63, wid = __builtin_amdgcn_readfirstlane(tid >> 6), r32 = lane & 31, hi = lane >> 5, kvh = qh / 3;
    const size_t tok0 = (size_t)b * SEQ + (size_t)qblk * 256;
    att_stage(lds, KQ + tok0 * 1280 + kvh * 64, 1280, VT + (size_t)(kvh * 64) * T + tok0, T, tid);
    float qv[4][8]; bf16x8 qf[4];
    att_load_q(KQ + (tok0 + wid * 32 + r32) * 1280 + 256 + qh * 64 + hi * 8, qv, qf);
    unsigned sel = 0u;
    if (qblk > 0) {
        float gt[7];
#pragma unroll
        for (int j = 0; j < 7; ++j) { gt[j] = -3e38f;
            if (j < qblk) { const float* km = KMEANS + (size_t)((b * 4 + kvh) * 8 + j) * 64 + hi * 8; float a = 0.f;
#pragma unroll
                for (int d0 = 0; d0 < 4; ++d0) { const f32x4 k0 = *(const GAS f32x4*)(km + d0 * 16), k1 = *(const GAS f32x4*)(km + d0 * 16 + 4);
                    a += qv[d0][0] * k0[0] + qv[d0][1] * k0[1] + qv[d0][2] * k0[2] + qv[d0][3] * k0[3] + qv[d0][4] * k1[0] + qv[d0][5] * k1[1] + qv[d0][6] * k1[2] + qv[d0][7] * k1[3]; }
                a += __shfl_xor(a, 32); gt[j] = a; } }
#pragma unroll
        for (int j = 0; j < 7; ++j) { int rank = 0;
#pragma unroll
            for (int j2 = 0; j2 < 7; ++j2) if (j2 != j) rank += (gt[j2] > gt[j] || (gt[j2] == gt[j] && j2 < j)) ? 1 : 0;
            if (j < qblk && rank < 3) sel |= 1u << j; }
    }
    __syncthreads();
    f32x16 o0, o1; float l = 0.f;
#pragma unroll
    for (int r = 0; r < 16; ++r) { o0[r] = 0.f; o1[r] = 0.f; }
    att_block<1>(lds, qf, o0, o1, l, (wid >> 1) + 1, wid * 32 + r32, false, lane);
    for (int j = 0; j < qblk; ++j) {
        __syncthreads();
        { const size_t tk = (size_t)b * SEQ + (size_t)j * 256; att_stage(lds, KQ + tk * 1280 + kvh * 64, 1280, VT + (size_t)(kvh * 64) * T + tk, T, tid); }
        __syncthreads();
        const bool off = !((sel >> j) & 1u);
        if (!__all(off)) att_block<2>(lds, qf, o0, o1, l, 4, 0, off, lane);
    }
    att_store_o<true>(lds, (bf16*)((unsigned char*)CAT + (size_t)(tok0 + wid * 32) * 1024 + qh * 64), 1024, o0, o1, l, lane, wid);
    __syncthreads();
}

struct Args { const float* in[42]; float* out; unsigned char* ws; int ph_lo, ph_hi; };
constexpr int NPHASE = 21;
__global__ void __launch_bounds__(NTHREADS, 2) fwd_kernel(Args args) {
    extern __shared__ __attribute__((aligned(16))) unsigned char lds_raw[];
    LAS unsigned char* lds = (LAS unsigned char*)lds_raw;
    volatile LAS unsigned* MISC = (volatile LAS unsigned*)(lds + MISC_OFF);
    const int tid = threadIdx.x, lane = tid & 63, wave = __builtin_amdgcn_readfirstlane(tid >> 6);
    const int G = gridDim.x, bx = blockIdx.x;
    const int gw = bx * NWAVES + wave, NGW = G * NWAVES;
    unsigned char* ws = args.ws;
    gu32* ctl = (gu32*)(ws + WS_CTL);
    for (int u = tid; u < (LDS_BYTES - RING_BYTES) / 4; u += NTHREADS) ((LAS unsigned*)(lds + RING_BYTES))[u] = 0u;
    __syncthreads();
    const int lo = args.ph_lo, hi_ph = args.ph_hi;
    XcdBarrier bar; bar.bar = (unsigned*)(ctl + CW_BAR); bar.x = 0; bar.st = nullptr;
    if (hi_ph - lo > 1) bar = xcd_barrier_post((unsigned*)(ctl + CW_BAR), MISC + 8);
#define IN(k) (lo <= (k) && (k) < hi_ph)
#define SEAM(k) do { if (IN(k) && IN((k) + 1)) xcd_barrier(bar); } while (0)
    const float* const* in = args.in;
    float* OUT = args.out;
    bf16* W_MEMK = (bf16*)(ws + WS_WMEMK); bf16* W_MEMV = (bf16*)(ws + WS_WMEMV); bf16* W_KQ = (bf16*)(ws + WS_WKQ); bf16* W_V = (bf16*)(ws + WS_WV); bf16* W_OUT1 = (bf16*)(ws + WS_WOUT1);
    bf16* W_MGU = (bf16*)(ws + WS_WMGU); bf16* W_MD = (bf16*)(ws + WS_WMD);
    bf16* XB = (bf16*)(ws + WS_XB); bf16* CAT = (bf16*)(ws + WS_CAT); bf16* MEMN = (bf16*)(ws + WS_MEMN); bf16* MEMK = (bf16*)(ws + WS_MEMK); bf16* MEMVT = (bf16*)(ws + WS_MEMVT);
    bf16* XS = (bf16*)(ws + AR_XS); bf16* ACTM = (bf16*)(ws + AR_ACTM);
    bf16* W_IN0 = (bf16*)(ws + AR_WIN0); bf16* W_GLU = (bf16*)(ws + AR_WGLU); bf16* W_OUT0 = (bf16*)(ws + AR_WOUT0); bf16* W_FGU = (bf16*)(ws + AR_WFGU); bf16* W_FD = (bf16*)(ws + AR_WFD);
    bf16* TZ = (bf16*)(ws + AR_TZ); bf16* W1T = (bf16*)(ws + AR_W1T); bf16* UG = (bf16*)(ws + AR_UG); bf16* QM0 = (bf16*)(ws + AR_QM0); float* XC = (float*)(ws + AR_XC); bf16* GACT = (bf16*)(ws + AR_GACT);
    unsigned char* X8 = ws + AR_X8;
    float* S5SM = (float*)(ws + AR_S5SM);
    bf16* ACT0 = (bf16*)(ws + AR_ACT0); bf16* KQ = (bf16*)(ws + AR_KQ); bf16* VT = (bf16*)(ws + AR_VT);
    float* KMEANS = (float*)(ws + SM_KMEANS); float* LAM32 = (float*)(ws + SM_LAM32); int* PANEND = (int*)(ws + SM_PANEND);
    int* WGCNT = (int*)(ws + WS_MEMN + 3 * MiB);
    float* SS = (float*)(ws + WS_MEMN); float* ROWRS = (float*)(ws + WS_MEMN + MiB); float* TOKRS = (float*)(ws + WS_MEMN + 2 * MiB);
    int* TOKE = (int*)(ws + SM_TOKE); int* TOKLP = (int*)(ws + SM_TOKLP); float* TOKG = (float*)(ws + SM_TOKG); int* ROWTOK = (int*)(ws + SM_ROWTOK); float* ROWGATE = (float*)(ws + SM_ROWGATE);

    constexpr int I_SQ = 16 * 16, I_GLU = 12 * 12, I_M = 16 * 4, I_F = 16 * 44, I_FD = 44 * 16;
    constexpr int CVT_P0_END = I_SQ + 4 * I_M, CVT_P2_END = CVT_P0_END + I_GLU + 3 * I_SQ + 2 * I_M, NITEMS = CVT_P2_END + 2 * I_F + I_FD;
    static_assert(NITEMS == 4 * I_SQ + I_GLU + 6 * I_M + 2 * I_F + I_FD, "items");
#define CV_F8(NI, SRC, LDW, NPB, GAIN, DST, LDO, ROW0) if (r < (NI)) { const int kb = r / (NPB), n0 = (r % (NPB)) * 64; CvtDesc8 d; d.src = (SRC) + (size_t)(kb * 64) * (LDW) + n0; d.gain = (GAIN); d.dst = (unsigned char*)(DST) + (size_t)((ROW0) + n0) * (LDO) + kb * 64; d.ldw = (LDW); d.ldo = (LDO); d.k0 = kb * 64; \
                f32x4 a[4][4]; float gq[4][4]; cvt_load8(d, a, gq, MOE_WSCALE, lane); cvt_emit8(d, a, gq, scr, lane); continue; } r -= (NI);
#define CV_PLAIN(NI, SRC, LDW, NPB, GAIN, DST, LDO, ROW0) if (r < (NI)) { const int kb = r / (NPB), n0 = (r % (NPB)) * 64; cvt_item(SRC, LDW, kb * 64, n0, GAIN, DST, LDO, (ROW0) + n0, scr, lane); continue; } r -= (NI);
#define CVT_RUN(QWORD, LO, HI) do { LAS unsigned* scr = (LAS unsigned*)(lds + wave * 16384); \
        for (;;) { int it0 = 0; if (lane == 0) it0 = (LO) + (int)__hip_atomic_fetch_add((unsigned*)(ctl + CW_QUEUE + (QWORD)), 2u, __ATOMIC_RELAXED, __HIP_MEMORY_SCOPE_AGENT); \
            it0 = __builtin_amdgcn_readfirstlane(it0); \
            if (it0 >= (HI)) break; \
            for (int it = it0; it < it0 + 2 && it < (HI); ++it) { int r = it; \
            CV_PLAIN(I_SQ, in[3], 1024, 16, in[2], W_IN0, 1024, 0) \
            CV_PLAIN(I_M, in[15], 256, 4, in[14], W_MEMK, 1024, 0) \
            CV_PLAIN(I_M, in[32], 256, 4, in[31], W_MEMK, 1024, 256) \
            CV_PLAIN(I_M, in[16], 256, 4, in[14], W_MEMV, 1024, 0) \
            CV_PLAIN(I_M, in[33], 256, 4, in[31], W_MEMV, 1024, 256) \
            CV_PLAIN(I_GLU, in[12], 768, 12, nullptr, W_GLU, 768, 0) \
            CV_PLAIN(I_SQ, in[19], 1024, 16, nullptr, W_OUT0, 1024, 0) \
            CV_F8(I_SQ, in[29], 1024, 16, in[28], W_KQ, 1024, 256) \
            CV_F8(I_M, in[25], 256, 4, in[24], W_KQ, 1024, 0) \
            CV_F8(I_M, in[26], 256, 4, in[24], W_V, 1024, 0) \
            CV_F8(I_SQ, in[36], 1024, 16, nullptr, W_OUT1, 1024, 0) \
            if (r < 2 * I_F) { const int up = r / I_F; r -= up * I_F; const int kb = r / 44, n0 = (r % 44) * 64; \
                cvt_item(in[21 + up], DFF, kb * 64, n0, in[20], W_FGU, 1024, (n0 >> 7) * 256 + (n0 & 127) + up * 128, scr, lane); continue; } \
            r -= 2 * I_F; \
            CV_F8(I_FD, in[23], 1024, 16, nullptr, W_FD, DFF, 0) \
            } } } while (0)
    if (IN(0)) {
        if (bx < 48) s5_tables_small(bx, lds, in[4], in[5], in[6], in[7], in[8], in[9], in[10], S5SM, LAM32, tid);
        CVT_RUN(64, 0, CVT_P0_END);
        for (;;) {
            int r0 = 0; if (lane == 0) r0 = (int)__hip_atomic_fetch_add((unsigned*)(ctl + CW_QUEUE + 192), 16u, __ATOMIC_RELAXED, __HIP_MEMORY_SCOPE_AGENT);
            r0 = __builtin_amdgcn_readfirstlane(r0);
            if (r0 >= T + NB * 256) break;
            for (int mrow = r0; mrow < r0 + 16; ++mrow) { if (mrow < T) rms_row_to_bf16(in[0] + (size_t)mrow * D, XB + (size_t)mrow * D, lane); else rms_row_to_bf16(in[1] + (size_t)(mrow - T) * D, MEMN + (size_t)(mrow - T) * D, lane); } }
        for (int i = bx * NTHREADS + tid; i < 2 * RROWS; i += G * NTHREADS) ROWTOK[i] = -1;
    }
    SEAM(0);
    if (IN(1)) { pg8::Gemm g{XB, W_IN0, 1024, 1024, 1024}; pg8::StaticOrder S; S.init(T / 256, 4, G, bx); pg8::EpiProj0 E{UG, QM0};
        pg8::gemm_phase<pg8::EpiProj0, pg8::StaticOrder, true, true>(lds, g, S, E);
        if (bx < 192) { const int sg = bx >> 2, sq = bx & 3; s5_load(sg, lds, S5SM, in[9], in[10], false, tid); s5_expand_w1t(sg, lds, W1T, sq * 32, sq * 32 + 32, tid); __syncthreads(); } }
    SEAM(1);
    if (IN(2)) {
        if (bx < 96) { pg8::Gemm g{UG, W1T, 640, 512, 512}; pg8::BatchOrder S; S.init(48, 2, 1, 96, bx); pg8::EpiS5a E{XC};
          pg8::gemm_phase<pg8::EpiS5a, pg8::BatchOrder, true, true>(lds, g, S, E);
          if (tid < 256) { const int g = bx >> 1, mt = bx & 1, bl = tid >> 6, p = tid & 63;
            const float lr = LAM32[(g * 64 + p) * 2], li = LAM32[(g * 64 + p) * 2 + 1]; float hr = 0.f, hi_ = 0.f;
            const size_t row0 = (size_t)g * 512 + mt * 256 + bl * 64;
            for (int c = 0; c < 64; ++c) { const float xr = XC[(row0 + c) * 128 + 2 * p], xi = XC[(row0 + c) * 128 + 2 * p + 1];
                *(GAS unsigned*)(UG + (row0 + c) * 640 + 512 + 2 * p) = cvt_pk_bf16(hr, hi_);
                const float nr = lr * hr - li * hi_ + xr, ni = lr * hi_ + li * hr + xi; hr = nr; hi_ = ni; } } }
        else if (bx < 112) { pg8::Gemm g{MEMN, W_MEMK, 1024, 1024, 1024}; pg8::StaticOrder S; S.init(8, 2, 16, bx - 96); pg8::EpiPlain E{MEMK, 512, 0, 0};
          pg8::gemm_phase<pg8::EpiPlain, pg8::StaticOrder, true, true>(lds, g, S, E);
          pg8::Unit u; S.next(0, u); const int layer = u.pn; const float* kg = layer ? in[35] : in[18]; const float* qg = layer ? in[34] : in[17];
          const int c0 = lane * 4, d = c0 & 63; float gk[4];
#pragma unroll
          for (int e = 0; e < 4; ++e) gk[e] = kg[d + e] * qg[d + e];
          for (int rr = 0; rr < 32; ++rr) { bf16* p = MEMK + (size_t)(u.pm * 256 + wave * 32 + rr) * 512 + layer * 256 + c0; const v2u w = *(const GAS v2u*)p;
              float v[4] = {bf_lo(w.x), bf_hi(w.x), bf_lo(w.y), bf_hi(w.y)}; float ss = v[0] * v[0] + v[1] * v[1] + v[2] * v[2] + v[3] * v[3];
              ss += __shfl_xor(ss, 1); ss += __shfl_xor(ss, 2); ss += __shfl_xor(ss, 4); ss += __shfl_xor(ss, 8);
              const float r = 1.f / sqrtf(ss * (1.f / 64.f) + RMS_EPS);
              *(GAS v2u*)p = (v2u){cvt_pk_bf16(v[0] * r * gk[0], v[1] * r * gk[1]), cvt_pk_bf16(v[2] * r * gk[2], v[3] * r * gk[3])}; } }
        else if (bx < 128) { pg8::Gemm g{W_MEMV, MEMN, 1024, 1024, 1024}; pg8::StaticOrder S; S.init(2, 8, 16, bx - 112); pg8::EpiPlain E{MEMVT, 2048, 0, 0};
          pg8::gemm_phase<pg8::EpiPlain, pg8::StaticOrder, true, true>(lds, g, S, E); }
        else { int cur = -1;
          for (int it = (bx - 128) * 3; it < (bx - 128) * 3 + 3; ++it) { const int sg = it >> 3, part = it & 7;
              if (sg != cur) { __syncthreads(); s5_load(sg, lds, S5SM, in[9], in[10], true, tid); cur = sg; }
              s5_expand_tz(sg, lds, TZ, part * 64, part * 64 + 64, tid); }
          __syncthreads();
          CVT_RUN(256, CVT_P0_END, CVT_P2_END); }
    }
    SEAM(2);
    if (IN(4)) {
        if (bx < 192) { pg8::Gemm g{UG, TZ, 640, 640, 640}; pg8::BatchOrder S; S.init(48, 2, 2, 192, bx); pg8::EpiS5c E{UG, in[11], GACT};
            pg8::gemm_phase<pg8::EpiS5c, pg8::BatchOrder, true, true>(lds, g, S, E); }
        for (;;) {
            if (tid == 0) MISC[0] = __hip_atomic_fetch_add((unsigned*)(ctl + CW_QUEUE + 128), 1u, __ATOMIC_RELAXED, __HIP_MEMORY_SCOPE_AGENT);
            __syncthreads();
            const int u = (int)MISC[0];
            __syncthreads();
            if (u >= 256) break;
            const int b = u >> 5, h = (u >> 3) & 3, qt = u & 7; const size_t t0 = (size_t)b * SEQ + qt * 256;
            mem_unit(lds, QM0 + t0 * 256 + h * 64, 256, MEMK + (size_t)(b * 256) * 512 + h * 64, MEMVT + (size_t)(h * 64) * 2048 + b * 256, CAT + t0 * 1024 + 768 + h * 64, tid); }
    }
    SEAM(4);
    if (IN(5)) { pg8::Gemm g{GACT, W_GLU, T, 768, 768, 1}; pg8::StaticOrder S; S.init(T / 256, 3, G, bx); pg8::EpiGlu E{GACT, in[13], CAT};
        pg8::gemm_phase<pg8::EpiGlu, pg8::StaticOrder, true, true>(lds, g, S, E);
        pg8::Unit u0; if (!S.next(0, u0)) CVT_RUN(320, CVT_P2_END, NITEMS); }
    SEAM(5);
    if (IN(6)) { pg8::Gemm g{CAT, W_OUT0, 1024, 1024, 1024}; pg8::StaticOrder S; S.init(T / 256, 4, G, bx); pg8::EpiResidB<true> E{in[0], XB, SS, 1.f, nullptr};
        pg8::gemm_phase<pg8::EpiResidB<true>, pg8::StaticOrder, true, true>(lds, g, S, E); }
    SEAM(6);
    if (IN(8)) {
        pg8::Gemm g{XB, W_FGU, 1024, 1024, 1024}; pg8::EpiSwiglu<1, true> E{ACT0, DFF, 22, 0, SS, MOE_ASCALE};
        const int slot = (bx >> 3) & 3, n1 = (slot == 0) ? 0 : (slot == 1) ? 1 : (slot == 2) ? 3 : 4;
        { pg8::RangeOrder S; S.S.init(T / 256, 22, G, bx); S.i0 = 0; S.i1 = n1; pg8::gemm_phase<pg8::EpiSwiglu<1, true>, pg8::RangeOrder, true, true>(lds, g, S, E); }
        { LAS unsigned* scr = (LAS unsigned*)(lds + wave * 16384);
          constexpr int I_E = (1024 / 64) * (DFE / 64), I_ED = (DFE / 64) * (1024 / 64), I_MOE = NEXP * (2 * I_E + I_ED), SHARE = (I_MOE + 255) / 256;
#define MOE_DESC(D_, IT_) do { int r = (IT_); const int e = r / (2 * I_E + I_ED); r -= e * (2 * I_E + I_ED); \
              if (r < 2 * I_E) { const int up = r / I_E; r -= up * I_E; const int kb = r / (DFE / 64), n0 = (r % (DFE / 64)) * 64; \
                  (D_).src = in[39 + up] + (size_t)e * 1024 * DFE + (size_t)(kb * 64) * DFE + n0; (D_).ldw = DFE; (D_).gain = in[37]; (D_).k0 = kb * 64; (D_).ldo = 1024; \
                  (D_).dst = (unsigned char*)W_MGU + (size_t)(e * 7168 + (n0 >> 7) * 256 + (n0 & 127) + up * 128) * 1024 + kb * 64; } \
              else { r -= 2 * I_E; const int kb = r / 16, n0 = (r % 16) * 64; \
                  (D_).src = in[41] + (size_t)e * DFE * 1024 + (size_t)(kb * 64) * 1024 + n0; (D_).ldw = 1024; (D_).gain = nullptr; (D_).k0 = kb * 64; (D_).ldo = DFE; \
                  (D_).dst = (unsigned char*)W_MD + (size_t)(e * 1024 + n0) * DFE + kb * 64; } } while (0)
          static_assert(SHARE == 84 && I_MOE == 256 * 84, "share sizes");
          const int it_beg = (bx < 128) ? bx * 72 : 128 * 72 + (bx - 128) * 96, it_end = it_beg + ((bx < 128) ? 72 : 96);
          for (int it = it_beg + wave; it < it_end; it += NWAVES) { CvtDesc8 d0; f32x4 a0[4][4]; float g0[4][4]; MOE_DESC(d0, it); cvt_load8_dma(d0, a0, g0, MOE_WSCALE, (LAS unsigned char*)scr, lane); cvt_emit8(d0, a0, g0, scr, lane); }
#undef MOE_DESC
          __syncthreads(); }
        { pg8::RangeOrder S; S.S.init(T / 256, 22, G, bx); S.i0 = n1; S.i1 = 1 << 20; pg8::gemm_phase<pg8::EpiSwiglu<1, true>, pg8::RangeOrder, true, true>(lds, g, S, E); }
    }
    SEAM(8);
    if (IN(9)) { pg8::Gemm g{ACT0, W_FD, DFF / 2, DFF / 2, DFF / 2}; pg8::StaticOrder S; S.init(T / 256, 4, G, bx); pg8::EpiResidB<false, true> E{nullptr, XB, SS, 1.f / (MOE_WSCALE * MOE_ASCALE), X8};
        pg8::gemm_phase<pg8::EpiResidB<false, true>, pg8::StaticOrder, true, true, true>(lds, g, S, E); }
    SEAM(9);
    if (IN(11)) {
        { pg8::Gemm g{(bf16*)X8, W_KQ, 512, 512, 512}; pg8::StaticOrder S; S.init(T / 256, 5, G, bx); pg8::EpiPlainS<1> E{KQ, 1280, 0, 0, SS, 1.f / (MOE_WSCALE * 8.f)};
          pg8::gemm_phase<pg8::EpiPlainS<1>, pg8::StaticOrder, true, true, true>(lds, g, S, E);
          pg8::Unit u;
          for (int i = 0; S.next(i, u); ++i) if (u.pn == 0) {
            const int b = u.pm >> 3, blk = u.pm & 7; const size_t t0 = (size_t)u.pm * 256;
            const int c0 = lane * 4, d = c0 & 63; float gk[4], cs[4] = {0.f, 0.f, 0.f, 0.f};
#pragma unroll
            for (int e = 0; e < 4; ++e) gk[e] = in[27][d + e] * in[30][d + e];
            for (int rr = 0; rr < 32; ++rr) { bf16* p = KQ + (t0 + wave * 32 + rr) * 1280 + c0; const v2u w = *(const GAS v2u*)p;
                float v[4] = {bf_lo(w.x), bf_hi(w.x), bf_lo(w.y), bf_hi(w.y)}; float ss = v[0] * v[0] + v[1] * v[1] + v[2] * v[2] + v[3] * v[3];
                ss += __shfl_xor(ss, 1); ss += __shfl_xor(ss, 2); ss += __shfl_xor(ss, 4); ss += __shfl_xor(ss, 8);
                const float r = 1.f / sqrtf(ss * (1.f / 64.f) + RMS_EPS);
#pragma unroll
                for (int e = 0; e < 4; ++e) { v[e] *= r * gk[e]; cs[e] += v[e]; }
                *(GAS v2u*)p = (v2u){cvt_pk_bf16(v[0], v[1]), cvt_pk_bf16(v[2], v[3])}; }
            LAS float* red = (LAS float*)lds;
#pragma unroll
            for (int e = 0; e < 4; ++e) red[wave * 256 + c0 + e] = cs[e];
            __syncthreads();
            if (tid < 256) { float sm = 0.f;
#pragma unroll
                for (int w = 0; w < 8; ++w) sm += red[w * 256 + tid];
                KMEANS[(size_t)((b * 4 + (tid >> 6)) * 8 + blk) * 64 + (tid & 63)] = sm * (1.f / 256.f); }
            __syncthreads(); } }
        { pg8::Gemm g{W_V, (bf16*)X8, 512, 512, 512}; pg8::StaticOrder S; S.init(1, T / 256, 64, bx - 64); pg8::EpiPlainS<2> E{VT, T, 0, 0, SS, 1.f / (MOE_WSCALE * 8.f)};
          if (bx >= 64) pg8::gemm_phase<pg8::EpiPlainS<2>, pg8::StaticOrder, true, true, true>(lds, g, S, E); }
    }
    SEAM(11);

    if (IN(13)) {
        for (;;) {
            if (tid == 0) MISC[0] = __hip_atomic_fetch_add((unsigned*)(ctl + CW_QUEUE), 1u, __ATOMIC_RELAXED, __HIP_MEMORY_SCOPE_AGENT);
            __syncthreads();
            const int it = (int)MISC[0];
            __syncthreads();
            if (it >= 1024) break;
            if (it < 768) { const int qblk = 7 - it / 96, r = it % 96; moba_unit(lds, r / 12, r % 12, qblk, KQ, VT, KMEANS, CAT, tid); }
            else { const int u = it - 768, b = u >> 5, h = (u >> 3) & 3, qt = u & 7; const size_t t0 = (size_t)b * SEQ + qt * 256;
                mem_unit<true>(lds, KQ + t0 * 1280 + 1024 + h * 64, 1280, MEMK + (size_t)(b * 256) * 512 + 256 + h * 64, MEMVT + (size_t)(256 + h * 64) * 2048 + b * 256, (bf16*)((unsigned char*)CAT + t0 * 1024 + 768 + h * 64), tid); }
        }
    }
    SEAM(13);
    if (IN(14)) { pg8::Gemm g{CAT, W_OUT1, 512, 512, 512}; pg8::StaticOrder S; S.init(T / 256, 4, G, bx); pg8::EpiResidB<false> E{nullptr, XB, SS, 1.f / (MOE_WSCALE * 8.f), nullptr};
        pg8::gemm_phase<pg8::EpiResidB<false>, pg8::StaticOrder, true, true, true>(lds, g, S, E); }
    SEAM(14);
    if (IN(15)) {
        LAS float* wrt = (LAS float*)lds;
        LAS int* el = (LAS int*)(lds + 32768);
        for (int i = tid; i < 8192; i += NTHREADS) { const int k = i >> 3, e = i & 7; wrt[e * 1024 + k] = in[37][k] * in[38][i]; }
        __syncthreads();
        const int tpw = T / G;
        for (int tl = wave; tl < tpw; tl += NWAVES) { const int t = bx * tpw + tl;
            const GAS v2u* xr = (const GAS v2u*)(XB + (size_t)t * D) + lane; f32x4 v[4]; float s = 0.f;
#pragma unroll
            for (int j = 0; j < 4; ++j) { const v2u w = xr[64 * j]; v[j] = (f32x4){bf_lo(w.x), bf_hi(w.x), bf_lo(w.y), bf_hi(w.y)}; s += (v[j].x * v[j].x + v[j].y * v[j].y) + (v[j].z * v[j].z + v[j].w * v[j].w); }
            const float r = 1.f / sqrtf(wave_sum(s) * (1.f / 1024.f) + RMS_EPS);
#pragma unroll
            for (int j = 0; j < 4; ++j) v[j] = v[j] * r;
            float lg[8];
#pragma unroll
            for (int e = 0; e < 8; ++e) { float a = 0.f;
#pragma unroll
                for (int j = 0; j < 4; ++j) { const f32x4 w = *(const LAS f32x4*)(wrt + e * 1024 + 256 * j + 4 * lane); a += v[j].x * w.x + v[j].y * w.y + v[j].z * w.z + v[j].w * w.w; }
                lg[e] = wave_sum(a); }
            int i0 = 0; float v0 = lg[0];
#pragma unroll
            for (int e = 1; e < 8; ++e) if (lg[e] > v0) { v0 = lg[e]; i0 = e; }
            int i1 = -1; float v1 = -3e38f;
#pragma unroll
            for (int e = 0; e < 8; ++e) if (e != i0 && lg[e] > v1) { v1 = lg[e]; i1 = e; }
            const float e1 = __expf(v1 - v0), g0 = 1.f / (1.f + e1), g1 = e1 * g0;
            if (lane == 0) { el[tl] = i0 * 8 + i1; TOKE[2 * t] = i0; TOKE[2 * t + 1] = i1; TOKG[2 * t] = g0; TOKG[2 * t + 1] = g1; TOKRS[t] = r; } }
        __syncthreads();
        if (tid < tpw) { const int pd = el[tid]; int lp = 0; for (int j = 0; j < tid; ++j) lp += (el[j] == pd) ? 1 : 0; TOKLP[(size_t)bx * tpw + tid] = lp; }
        if (tid >= 64 && tid < 128) { const int pd = tid - 64; int n = 0; for (int j = 0; j < tpw; ++j) n += (el[j] == pd) ? 1 : 0; WGCNT[bx * 64 + pd] = n; }
        __syncthreads();
    }
    SEAM(15);
    if (IN(16)) {
        LAS int* tab = (LAS int*)lds; LAS int* Cp = tab + 16384; LAS int* PRE = Cp + 64; LAS int* Fp = PRE + 64; LAS int* bAu = Fp + 64; LAS int* bAf = bAu + 64; LAS int* bBu = bAf + 64; LAS int* bBf = bBu + 64;
        LAS int* offA = bBf + 64; LAS int* offB = offA + 8; LAS int* UA = offB + 8; LAS int* VB = UA + 8;
        for (int i = tid; i < G * 64; i += NTHREADS) tab[i] = WGCNT[i];
        __syncthreads();
        if (tid < 64) { int tot = 0, pre = 0; for (int w = 0; w < G; ++w) { const int v = tab[w * 64 + tid]; if (w < bx) pre += v; tot += v; } Cp[tid] = tot; PRE[tid] = pre; Fp[tid] = 0; }
        __syncthreads();
        if (tid == 0) {
            int n0[8], rr[8], sup[8], dem[8]; int srem = 0;
            for (int e = 0; e < 8; ++e) { int n = 0; for (int b2 = 0; b2 < 8; ++b2) n += Cp[e * 8 + b2]; n0[e] = n; rr[e] = n & 255; srem += rr[e]; sup[e] = rr[e]; dem[e] = 0; }
            const int mup = srem >> 8;
            for (int it = 0; it < mup; ++it) { int be = -1, bv = -1; for (int e = 0; e < 8; ++e) if (dem[e] == 0 && sup[e] > bv) { bv = sup[e]; be = e; }
                if (be >= 0) { dem[be] = 256 - rr[be]; sup[be] = 0; } }
            for (int a = 0; a < 8; ++a) for (int b2 = 0; b2 < 8; ++b2) if (a != b2 && sup[a] > 0 && dem[b2] > 0) { int f = sup[a] < dem[b2] ? sup[a] : dem[b2]; if (Cp[a * 8 + b2] < f) f = Cp[a * 8 + b2];
                Fp[a * 8 + b2] = f; sup[a] -= f; dem[b2] -= f; }
            int oa = 0, ob = 0;
            for (int e = 0; e < 8; ++e) { int ua = 0, vb = 0, fin = 0, fout = 0;
                for (int x = 0; x < 8; ++x) { ua += Cp[e * 8 + x] - Fp[e * 8 + x]; vb += Cp[x * 8 + e] - Fp[x * 8 + e]; fin += Fp[x * 8 + e]; fout += Fp[e * 8 + x]; }
                UA[e] = ua; VB[e] = vb; offA[e] = oa * 256; offB[e] = ob * 256; oa += (ua + fin + 255) >> 8; ob += (vb + fout + 255) >> 8;
                if (bx == 0) { PANEND[e] = oa; PANEND[8 + e] = ob; } }
        }
        __syncthreads();
        if (tid < 64) { const int a = tid >> 3, b2 = tid & 7; int s1 = 0, s2 = 0, s3 = 0, s4 = 0;
            for (int x = 0; x < b2; ++x) { s1 += Cp[a * 8 + x] - Fp[a * 8 + x]; s4 += Fp[a * 8 + x]; }
            for (int x = 0; x < a; ++x) { s2 += Fp[x * 8 + b2]; s3 += Cp[x * 8 + b2] - Fp[x * 8 + b2]; }
            bAu[tid] = offA[a] + s1 - Fp[tid]; bAf[tid] = offA[b2] + UA[b2] + s2; bBu[tid] = offB[b2] + s3 - Fp[tid]; bBf[tid] = offB[a] + VB[a] + s4; }
        __syncthreads();
        const int tpw = T / G;
        for (int tl = wave; tl < tpw; tl += NWAVES) { const int t = bx * tpw + tl;
            const int pd = TOKE[2 * t] * 8 + TOKE[2 * t + 1], q = PRE[pd] + TOKLP[(size_t)bx * tpw + tl]; const bool fl = q < Fp[pd];
            const int rowA = q + (fl ? bAf[pd] : bAu[pd]), rowB = q + (fl ? bBf[pd] : bBu[pd]);
            const float rs_ = TOKRS[t];
            if (lane == 0) { ROWTOK[rowA] = t; ROWGATE[rowA] = TOKG[2 * t + (fl ? 1 : 0)]; ROWRS[rowA] = rs_;
                             ROWTOK[RROWS + rowB] = t; ROWGATE[RROWS + rowB] = TOKG[2 * t + (fl ? 0 : 1)]; ROWRS[RROWS + rowB] = rs_; }
            const GAS v4u* src = (const GAS v4u*)(XB + (size_t)t * D);
            GAS v2u* dA = (GAS v2u*)((unsigned char*)XS + (size_t)rowA * D); GAS v2u* dB = (GAS v2u*)((unsigned char*)XS + ((size_t)RROWS + rowB) * D);
#pragma unroll
            for (int h = 0; h < 2; ++h) { const v4u w = src[64 * h + lane];
                const v2u o = (v2u){pg8::pk4_fp8(bf_lo(w.x) * rs_, bf_hi(w.x) * rs_, bf_lo(w.y) * rs_, bf_hi(w.y) * rs_), pg8::pk4_fp8(bf_lo(w.z) * rs_, bf_hi(w.z) * rs_, bf_lo(w.w) * rs_, bf_hi(w.w) * rs_)};
                dA[64 * h + lane] = o; dB[64 * h + lane] = o; } }
        __syncthreads();
    }
    SEAM(16);
#define MOE_ROUND(PH, KK, FIRST_) \
    if (IN(PH)) { pg8::GroupOrder S; for (int e = 0; e < 8; ++e) S.pe[e] = PANEND[(KK) * 8 + e]; S.npe = 28; S.S.init(S.pe[7], 28, G, bx); \
        pg8::Gemm g{XS + (size_t)(KK) * RROWS * (D / 2), W_MGU, 512, 512, 512}; pg8::EpiSwigluF8 E{(unsigned char*)ACTM + (size_t)(KK) * RROWS * DFE, DFE, 28, 0, 1.f / MOE_WSCALE, MOE_ASCALE}; \
        pg8::gemm_phase<pg8::EpiSwigluF8, pg8::GroupOrder, true, true, true>(lds, g, S, E); } \
    SEAM(PH); \
    if (IN((PH) + 1)) { volatile LAS unsigned* tb = MISC + 16; \
        if (tid < 8) tb[tid] = (unsigned)PANEND[(KK) * 8 + tid]; \
        if (tid == 8) { const int npan = PANEND[(KK) * 8 + 7]; const int nun = npan * 4, tl = nun - G; \
            tb[8] = (unsigned)nun; tb[9] = (tl <= G / 4) ? 4u : (tl <= G / 2) ? 2u : 1u; tb[10] = (unsigned)npan; tb[11] = (unsigned)bx; tb[12] = 8u; tb[13] = 4u; tb[14] = (unsigned)(DFE / 128); tb[15] = (unsigned)G; \
            const unsigned long long sl = (unsigned long long)((KK) == 0 ? (unsigned char*)CAT : (unsigned char*)XS + 36 * MiB), fl = (unsigned long long)(unsigned*)(ctl + CW_SKFLAG + (KK) * 256 * 64); \
            tb[16] = (unsigned)sl; tb[17] = (unsigned)(sl >> 32); tb[18] = (unsigned)fl; tb[19] = (unsigned)(fl >> 32); } \
        __syncthreads(); \
        pg8::GroupStream S; S.tab = (const LAS unsigned*)(lds + MISC_OFF + 64); \
        pg8::Gemm g{ACTM + (size_t)(KK) * RROWS * (DFE / 2), W_MD, DFE / 2, DFE / 2, DFE / 2}; pg8::EpiMoeDown<FIRST_> E{OUT, ROWTOK + (KK) * RROWS, ROWGATE + (KK) * RROWS, 0, XB, 1.f / (MOE_WSCALE * MOE_ASCALE)}; \
        pg8::gemm_phase<pg8::EpiMoeDown<FIRST_>, pg8::GroupStream, true, true, true>(lds, g, S, E); }
    MOE_ROUND(17, 1, true)
    MOE_ROUND(19, 0, false)

#undef IN
#undef SEAM
}

extern "C" void kernel_launch(void* const* d_in, const int* in_sizes, int n_in, void* d_out, int out_size, void* d_ws, size_t ws_size, hipStream_t stream) {
    static int grid = 0;
    if (grid == 0) {
        if (n_in != 42 || in_sizes[0] != T * D || out_size != T * D || ws_size < WS_END) { fprintf(stderr, "kernel_launch: unexpected shapes (n_in %d, in0 %d, out %d, ws %zu < %zu); nothing launched\n", n_in, n_in > 0 ? in_sizes[0] : -1, out_size, ws_size, (size_t)WS_END); grid = -1; return; }
        int dev = 0, cus = 0, per_cu = 0;
        if (hipGetDevice(&dev) != hipSuccess || hipDeviceGetAttribute(&cus, hipDeviceAttributeMultiprocessorCount, dev) != hipSuccess) { grid = -1; return; }
        if (hipFuncSetAttribute((const void*)fwd_kernel, hipFuncAttributeMaxDynamicSharedMemorySize, LDS_BYTES) != hipSuccess) { fprintf(stderr, "kernel_launch: hipFuncSetAttribute failed\n"); grid = -1; return; }
        if (hipOccupancyMaxActiveBlocksPerMultiprocessor(&per_cu, (const void*)fwd_kernel, NTHREADS, LDS_BYTES) != hipSuccess || per_cu < 1) { fprintf(stderr, "kernel_launch: occupancy query reports %d\n", per_cu); }
        (void)hipGetLastError();
        grid = 256;
        if (cus < 256) { fprintf(stderr, "kernel_launch: device has %d CUs, need 256\n", cus); grid = -1; return; }
    }
    if (grid < 0) return;
    if (hipMemsetAsync((char*)d_ws + WS_CTL, 0, CTL_ZERO_BYTES, stream) != hipSuccess) return;
    Args a{};
    for (int i = 0; i < 42; ++i) a.in[i] = (const float*)d_in[i];
    a.out = (float*)d_out; a.ws = (unsigned char*)d_ws;
#ifdef MK_SPLIT
    for (int p = 0; p < NPHASE; ++p) { a.ph_lo = p; a.ph_hi = p + 1; hipLaunchKernelGGL(fwd_kernel, dim3(grid), dim3(NTHREADS), LDS_BYTES, stream, a); }
#else
#ifndef STOP_AFTER
#define STOP_AFTER (NPHASE - 1)
#endif
    a.ph_lo = 0; a.ph_hi = STOP_AFTER + 1;
    hipLaunchKernelGGL(fwd_kernel, dim3(grid), dim3(NTHREADS), LDS_BYTES, stream, a);
#endif
}
```

```cpp
#include <hip/hip_runtime.h>
#include <cstdio>
#include <cstdint>

namespace pg8 {
#define PG8_LAS __attribute__((address_space(3)))
typedef unsigned short bf16_t;
typedef short bf16x8 __attribute__((ext_vector_type(8)));
typedef float f32x4 __attribute__((ext_vector_type(4)));
typedef unsigned u32x4 __attribute__((ext_vector_type(4)));
constexpr int BM = 256, BK = 64, HALF = 128, HTB = HALF * BK * 2  , STAGE_BYTES = 8 * HTB, NXCD = 8, WGM = 4;

__host__ __device__ __forceinline__ int lds_byte(int r, int c) { const int st = (r >> 4) * 2 + (c >> 5), rr = r & 15, cc = c & 31, ob = rr * 64 + cc * 2; return st * 1024 + (ob ^ (((ob >> 9) & 1) << 5)); }
__host__ __device__ __forceinline__ void stage_rc(int b, int& R, int& C) { const int st = b / 1024, sb = b % 1024, swz = sb ^ (((sb >> 9) & 1) << 5); R = (st >> 1) * 16 + swz / 64; C = (st & 1) * 32 + (swz % 64) / 2; }
__host__ __device__ __forceinline__ int perm32(int rho) { const int n = rho >> 4, i = rho & 15; return 8 * (i >> 2) + 4 * n + (i & 3); }

struct Unit { int pm, pn; int k0, nk, part; };
struct Gemm { const bf16_t* A; const bf16_t* Bt; int lda, ldb, K; int amode = 0; };

struct StaticOrder {
    static constexpr bool STREAMK = false;
    int nM, nN, nwg, G, c;
    __host__ __device__ __forceinline__ void init(int nM_, int nN_, int G_, int c_) { nM = nM_; nN = nN_; nwg = nM * nN; G = G_; c = c_; }
    __host__ __device__ __forceinline__ bool next(int i, Unit& u) const {
        const long L = (long)i * G + c; if (L >= nwg || c >= G) return false;
        u.k0 = 0; u.nk = 0; u.part = 0; map((int)L, u); return true;
    }
    __host__ __device__ __forceinline__ void map(int L, Unit& u) const {
        int wgid = L; { const int q = nwg / NXCD, r = nwg % NXCD, xcd = wgid % NXCD, off = wgid / NXCD; wgid = (xcd < r ? xcd * (q + 1) : r * (q + 1) + (xcd - r) * q) + off; }
        const int nig = WGM * nN, gid = wgid / nig, fm = gid * WGM, gsz = (nM - fm) < WGM ? (nM - fm) : WGM;
        u.pm = fm + ((wgid % nig) % gsz); u.pn = (wgid % nig) / gsz;
    }
};
struct RangeOrder {
    static constexpr bool STREAMK = false;
    StaticOrder S; int i0, i1;
    __host__ __device__ __forceinline__ bool next(int i, Unit& u) const { return (i0 + i < i1) && S.next(i0 + i, u); }
};
struct BatchOrder {
    static constexpr bool STREAMK = false;
    int nunits, tm, tn, G, c;
    __host__ __device__ __forceinline__ void init(int nb, int tm_, int tn_, int G_, int c_) { tm = tm_; tn = tn_; nunits = nb * tm * tn; G = G_; c = c_; }
    __host__ __device__ __forceinline__ bool next(int i, Unit& u) const {
        const int L = i * G + c; if (L >= nunits || c >= G) return false;
        const int b = L / (tm * tn), r = L % (tm * tn); u.pm = b * tm + r / tn; u.pn = b * tn + r % tn; u.k0 = 0; u.nk = 0; u.part = 0; return true;
    }
};
struct GroupOrder {
    static constexpr bool STREAMK = false;
    StaticOrder S; int npe; int pe[8];
    __host__ __device__ __forceinline__ bool next(int i, Unit& u) const {
        if (!S.next(i, u)) return false;
        int e = 0;
#pragma unroll
        for (int k = 0; k < 7; ++k) e += (u.pm >= pe[k]) ? 1 : 0;
        u.pn += e * npe; return true;
    }
};

typedef float f32x2_t __attribute__((ext_vector_type(2))); typedef __bf16 bf16x2_t __attribute__((ext_vector_type(2)));
struct GroupStream {
    static constexpr bool STREAMK = true;
    const PG8_LAS unsigned* tab;
    __device__ __forceinline__ int c() const { return (int)tab[11]; }
    __device__ __forceinline__ int split() const { return (int)tab[9]; }
    __device__ __forceinline__ unsigned target() const { return tab[12]; }
    __device__ __forceinline__ unsigned long long* slots() const { return (unsigned long long*)(((unsigned long long)tab[17] << 32) | tab[16]); }
    __device__ __forceinline__ unsigned* flags() const { return (unsigned*)(((unsigned long long)tab[19] << 32) | tab[18]); }
    __device__ __forceinline__ bool next(int i, Unit& u) const {
        const int nunits = (int)tab[8], sp = (int)tab[9], npe = (int)tab[13], ntk = (int)tab[14], G = (int)tab[15], c_ = (int)tab[11];
        int L, k0 = 0, nk = ntk, part = 0;
        if (i == 0) { L = c_; if (L >= nunits) return false; }
        else if (i == 1) { const int j = c_ / sp, p = c_ % sp; L = G + j; if (L >= nunits) return false; const int base = (ntk / sp) & ~1, xh = (ntk - sp * base) >> 1; nk = base + (p < xh ? 2 : 0); k0 = p * base + 2 * (p < xh ? p : xh); part = (sp == 1) ? 0 : (p == 0 ? 1 : 2); }
        else return false;
        StaticOrder S; S.init((int)tab[10], npe, 1, 0); S.map(L, u); int e = 0;
#pragma unroll
        for (int k = 0; k < 7; ++k) e += (u.pm >= (int)tab[k]) ? 1 : 0;
        u.pn += e * npe; u.k0 = k0; u.nk = nk; u.part = part; return true;
    }
};
constexpr int SK_SLOT_WORDS = 32 * 512;

__device__ __forceinline__ unsigned cvt_pk_bf16(float lo, float hi) { f32x2_t v = {lo, hi}; bf16x2_t b = __builtin_convertvector(v, bf16x2_t); return __builtin_bit_cast(unsigned, b); }
__device__ __forceinline__ float bf_lo(unsigned w) { return __builtin_bit_cast(float, w << 16); }
__device__ __forceinline__ float bf_hi(unsigned w) { return __builtin_bit_cast(float, w & 0xffff0000u); }
__device__ __forceinline__ float fsigmoid(float x) { return __builtin_amdgcn_rcpf(1.f + __builtin_amdgcn_exp2f(-1.4426950408889634f * x)); }
__device__ __forceinline__ float gelu_tanh(float y) { const float z = 0.7978845608028654f * (y + 0.044715f * y * y * y); return y * fsigmoid(2.f * z); }

#define EPI_LOOP_ROWS for (int ai = 0; ai < 2; ++ai) _Pragma("unroll") for (int m = 0; m < 4; ++m)
__device__ __forceinline__ u32x4 pack8(const f32x4& v0, const f32x4& v1) { u32x4 w; w.x = cvt_pk_bf16(v0[0], v0[1]); w.y = cvt_pk_bf16(v0[2], v0[3]); w.z = cvt_pk_bf16(v1[0], v1[1]); w.w = cvt_pk_bf16(v1[2], v1[3]); return w; }

__device__ __forceinline__ float rs_row(const float* SS, int row) {
    const f32x4 a = *(const f32x4*)(SS + (size_t)row * 16), b = *(const f32x4*)(SS + (size_t)row * 16 + 4), c = *(const f32x4*)(SS + (size_t)row * 16 + 8), d = *(const f32x4*)(SS + (size_t)row * 16 + 12);
    const float s = ((a[0] + a[1]) + (a[2] + a[3])) + ((b[0] + b[1]) + (b[2] + b[3])) + ((c[0] + c[1]) + (c[2] + c[3])) + ((d[0] + d[1]) + (d[2] + d[3]));
    return 1.f / __builtin_sqrtf(s * (1.f / 1024.f) + 1e-6f);
}
template <int SCALE  > struct EpiPlainS {
    static constexpr bool PERM = true, AFTER_DRAIN = false;
    bf16_t* O; int ldc; int pm0, pn0; const float* SS; float inv;
    __device__ __forceinline__ void operator()(const f32x4 (&acc)[2][2][4][2], const Unit& u, int wr, int wc, int fr, int fq) const {
        const int row0 = (u.pm - pm0) * BM + wr * 64 + fr, col0 = (u.pn - pn0) * BM + wc * 32 + 8 * fq;
        float cs[2][8];
        if (SCALE == 2) {
#pragma unroll
            for (int bj = 0; bj < 2; ++bj)
#pragma unroll
                for (int e = 0; e < 8; ++e) cs[bj][e] = rs_row(SS, u.pn * BM + bj * HALF + wc * 32 + 8 * fq + e) * inv; }
#pragma unroll
        EPI_LOOP_ROWS { bf16_t* rowp = O + (size_t)(row0 + ai * HALF + m * 16) * ldc + col0; float rs = 1.f; if (SCALE == 1) rs = rs_row(SS, u.pm * BM + wr * 64 + fr + ai * HALF + m * 16) * inv;
#pragma unroll
            for (int bj = 0; bj < 2; ++bj) { f32x4 v0 = acc[ai][bj][m][0], v1 = acc[ai][bj][m][1];
                if (SCALE == 1) { v0 = v0 * rs; v1 = v1 * rs; }
                if (SCALE == 2) { v0 = v0 * (f32x4){cs[bj][0], cs[bj][1], cs[bj][2], cs[bj][3]}; v1 = v1 * (f32x4){cs[bj][4], cs[bj][5], cs[bj][6], cs[bj][7]}; }
                *(u32x4*)(rowp + bj * HALF) = pack8(v0, v1); } }
    }
};
struct EpiPlain {
    static constexpr bool PERM = true, AFTER_DRAIN = false;
    bf16_t* O; int ldc; int pm0, pn0;
    __device__ __forceinline__ void operator()(const f32x4 (&acc)[2][2][4][2], const Unit& u, int wr, int wc, int fr, int fq) const {
        const int row0 = (u.pm - pm0) * BM + wr * 64 + fr, col0 = (u.pn - pn0) * BM + wc * 32 + 8 * fq;
#pragma unroll
        EPI_LOOP_ROWS { bf16_t* rowp = O + (size_t)(row0 + ai * HALF + m * 16) * ldc + col0;
#pragma unroll
            for (int bj = 0; bj < 2; ++bj) *(u32x4*)(rowp + bj * HALF) = pack8(acc[ai][bj][m][0], acc[ai][bj][m][1]); }
    }
};
struct EpiProj0 {
    static constexpr bool PERM = true, AFTER_DRAIN = false;
    bf16_t* UG; bf16_t* QM;
    __device__ __forceinline__ void operator()(const f32x4 (&acc)[2][2][4][2], const Unit& u, int wr, int wc, int fr, int fq) const {
        const int row0 = u.pm * BM + wr * 64 + fr;
#pragma unroll
        EPI_LOOP_ROWS { const int t = row0 + ai * HALF + m * 16;
#pragma unroll
            for (int bj = 0; bj < 2; ++bj) { const int c = u.pn * BM + bj * HALF + wc * 32 + 8 * fq; bf16_t* p;
                if (u.pn < 3) p = UG + ((size_t)((c >> 4) * 512 + (t >> 5))) * 640 + (t & 31) * 16 + (c & 15); else p = QM + (size_t)t * 256 + (c - 768);
                *(u32x4*)p = pack8(acc[ai][bj][m][0], acc[ai][bj][m][1]); } }
    }
};
struct EpiS5a {
    static constexpr bool PERM = true, AFTER_DRAIN = false;
    float* XC;
    __device__ __forceinline__ void operator()(const f32x4 (&acc)[2][2][4][2], const Unit& u, int wr, int wc, int fr, int fq) const {
        const int row0 = u.pm * BM + wr * 64 + fr, col0 = wc * 32 + 8 * fq;
#pragma unroll
        EPI_LOOP_ROWS { float* rowp = XC + (size_t)(row0 + ai * HALF + m * 16) * 128 + col0; *(f32x4*)rowp = acc[ai][0][m][0]; *(f32x4*)(rowp + 4) = acc[ai][0][m][1]; }
    }
};
struct EpiS5c {
    static constexpr bool PERM = true, AFTER_DRAIN = false;
    const bf16_t* UG; const float* dskip; bf16_t* GACT;
    __device__ __forceinline__ void operator()(const f32x4 (&acc)[2][2][4][2], const Unit& u, int wr, int wc, int fr, int fq) const {
        const int row0 = u.pm * BM + wr * 64 + fr, g = u.pm >> 1;
#pragma unroll
        for (int bj = 0; bj < 2; ++bj) { const int col8 = (u.pn & 1) * BM + bj * HALF + wc * 32 + 8 * fq, j = col8 >> 4, nb = col8 & 15;
            const f32x4 d0 = *(const f32x4*)(dskip + g * 16 + nb), d1 = *(const f32x4*)(dskip + g * 16 + nb + 4);
#pragma unroll
            EPI_LOOP_ROWS { const int R = row0 + ai * HALF + m * 16, chunk = R & 511, t = chunk * 32 + j;
                const u32x4 uu = *(const u32x4*)(UG + (size_t)R * 640 + j * 16 + nb);
                f32x4 v0 = acc[ai][bj][m][0], v1 = acc[ai][bj][m][1];
                v0[0] = gelu_tanh(v0[0] + d0[0] * bf_lo(uu.x)); v0[1] = gelu_tanh(v0[1] + d0[1] * bf_hi(uu.x)); v0[2] = gelu_tanh(v0[2] + d0[2] * bf_lo(uu.y)); v0[3] = gelu_tanh(v0[3] + d0[3] * bf_hi(uu.y));
                v1[0] = gelu_tanh(v1[0] + d1[0] * bf_lo(uu.z)); v1[1] = gelu_tanh(v1[1] + d1[1] * bf_hi(uu.z)); v1[2] = gelu_tanh(v1[2] + d1[2] * bf_lo(uu.w)); v1[3] = gelu_tanh(v1[3] + d1[3] * bf_hi(uu.w));
                *(u32x4*)(GACT + ((size_t)g * 16384 + t) * 16 + nb) = pack8(v0, v1); } }
    }
};
struct EpiGlu {
    static constexpr bool PERM = true, AFTER_DRAIN = false;
    const bf16_t* GACT; const float* bias; bf16_t* CAT;
    __device__ __forceinline__ void operator()(const f32x4 (&acc)[2][2][4][2], const Unit& u, int wr, int wc, int fr, int fq) const {
        const int row0 = u.pm * BM + wr * 64 + fr;
#pragma unroll
        for (int bj = 0; bj < 2; ++bj) { const int c = u.pn * BM + bj * HALF + wc * 32 + 8 * fq;
            const f32x4 b0 = *(const f32x4*)(bias + c), b1 = *(const f32x4*)(bias + c + 4);
#pragma unroll
            EPI_LOOP_ROWS { const int t = row0 + ai * HALF + m * 16;
                const u32x4 gg = *(const u32x4*)(GACT + ((size_t)(c >> 4) * 16384 + t) * 16 + (c & 15));
                f32x4 v0 = acc[ai][bj][m][0] + b0, v1 = acc[ai][bj][m][1] + b1;
                v0[0] = bf_lo(gg.x) * fsigmoid(v0[0]); v0[1] = bf_hi(gg.x) * fsigmoid(v0[1]); v0[2] = bf_lo(gg.y) * fsigmoid(v0[2]); v0[3] = bf_hi(gg.y) * fsigmoid(v0[3]);
                v1[0] = bf_lo(gg.z) * fsigmoid(v1[0]); v1[1] = bf_hi(gg.z) * fsigmoid(v1[1]); v1[2] = bf_lo(gg.w) * fsigmoid(v1[2]); v1[3] = bf_hi(gg.w) * fsigmoid(v1[3]);
                *(u32x4*)(CAT + (size_t)t * 1024 + c) = pack8(v0, v1); } }
    }
};
typedef unsigned u32x2_ __attribute__((ext_vector_type(2)));
__device__ __forceinline__ unsigned pk4_fp8(float a, float b, float c, float d) { int w = 0; w = __builtin_amdgcn_cvt_pk_fp8_f32(a, b, w, false); w = __builtin_amdgcn_cvt_pk_fp8_f32(c, d, w, true); return (unsigned)w; }
__device__ __forceinline__ float swiglu_fast(float ag, float au, float c1, float K) { const float e = __builtin_amdgcn_exp2f(ag * c1); return (ag * au) * __builtin_amdgcn_rcpf(__builtin_fmaf(e, K, K)); }
template <int SCALE  , bool OUT8 = false  > struct EpiSwiglu {
    static constexpr bool PERM = true, AFTER_DRAIN = false;
    bf16_t* O; int ldc; int npe; int pm0; const float* RS; float osc;
    __device__ __forceinline__ void operator()(const f32x4 (&acc)[2][2][4][2], const Unit& u, int wr, int wc, int fr, int fq) const {
        const int row0 = (u.pm - pm0) * BM + wr * 64 + fr, col0 = (u.pn % npe) * HALF + wc * 32 + 8 * fq;
#pragma unroll
        EPI_LOOP_ROWS { f32x4 v0, v1; const int r = row0 + ai * HALF + m * 16; const float rs = (SCALE == 1) ? rs_row(RS, r) : RS[r]; const float c1 = -1.4426950408889634f * rs, K = __builtin_amdgcn_rcpf(rs * rs * (OUT8 ? osc : 1.f));
#pragma unroll
            for (int e = 0; e < 4; ++e) { v0[e] = swiglu_fast(acc[ai][0][m][0][e], acc[ai][1][m][0][e], c1, K); v1[e] = swiglu_fast(acc[ai][0][m][1][e], acc[ai][1][m][1][e], c1, K); }
            if constexpr (OUT8) {
#pragma unroll
                for (int e = 0; e < 4; ++e) { v0[e] = __builtin_amdgcn_fmed3f(v0[e], -440.f, 440.f); v1[e] = __builtin_amdgcn_fmed3f(v1[e], -440.f, 440.f); }
                *(u32x2_*)((unsigned char*)O + (size_t)r * ldc + col0) = (u32x2_){pk4_fp8(v0[0], v0[1], v0[2], v0[3]), pk4_fp8(v1[0], v1[1], v1[2], v1[3])}; }
            else *(u32x4*)(O + (size_t)r * ldc + col0) = pack8(v0, v1); }
    }
};
struct EpiSwigluF8 {
    static constexpr bool PERM = true, AFTER_DRAIN = false;
    unsigned char* O; int ldc; int npe; int pm0; float inv, sc;
    __device__ __forceinline__ void operator()(const f32x4 (&acc)[2][2][4][2], const Unit& u, int wr, int wc, int fr, int fq) const {
        const int row0 = (u.pm - pm0) * BM + wr * 64 + fr, col0 = (u.pn % npe) * HALF + wc * 32 + 8 * fq;
        const float c1 = -1.4426950408889634f * inv, K = 1.f / (inv * inv * sc);
#pragma unroll
        EPI_LOOP_ROWS { f32x4 v0, v1; const int r = row0 + ai * HALF + m * 16;
#pragma unroll
            for (int e = 0; e < 4; ++e) { v0[e] = __builtin_amdgcn_fmed3f(swiglu_fast(acc[ai][0][m][0][e], acc[ai][1][m][0][e], c1, K), -440.f, 440.f); v1[e] = __builtin_amdgcn_fmed3f(swiglu_fast(acc[ai][0][m][1][e], acc[ai][1][m][1][e], c1, K), -440.f, 440.f); }
            *(u32x2_*)(O + (size_t)r * ldc + col0) = (u32x2_){pk4_fp8(v0[0], v0[1], v0[2], v0[3]), pk4_fp8(v1[0], v1[1], v1[2], v1[3])}; }
    }
};
template <bool F32BASE  , bool W8 = false  > struct EpiResidB {
    static constexpr bool PERM = true, AFTER_DRAIN = false;
    const float* R; bf16_t* XR; float* SS; float inv; unsigned char* X8;
    __device__ __forceinline__ void operator()(const f32x4 (&acc)[2][2][4][2], const Unit& u, int wr, int wc, int fr, int fq) const {
        const int row0 = u.pm * BM + wr * 64 + fr, col0 = u.pn * BM + wc * 32 + 8 * fq;
#pragma unroll
        EPI_LOOP_ROWS { const int row = row0 + ai * HALF + m * 16; const size_t o = (size_t)row * 1024 + col0; float ss = 0.f;
#pragma unroll
            for (int bj = 0; bj < 2; ++bj) { f32x4 r0, r1;
                if (F32BASE) { r0 = *(const f32x4*)(R + o + bj * HALF); r1 = *(const f32x4*)(R + o + bj * HALF + 4); }
                else { const u32x4 w = *(const u32x4*)(XR + o + bj * HALF); r0 = (f32x4){bf_lo(w.x), bf_hi(w.x), bf_lo(w.y), bf_hi(w.y)}; r1 = (f32x4){bf_lo(w.z), bf_hi(w.z), bf_lo(w.w), bf_hi(w.w)}; }
                r0 = r0 + acc[ai][bj][m][0] * inv; r1 = r1 + acc[ai][bj][m][1] * inv;
                ss += (r0[0] * r0[0] + r0[1] * r0[1]) + (r0[2] * r0[2] + r0[3] * r0[3]) + (r1[0] * r1[0] + r1[1] * r1[1]) + (r1[2] * r1[2] + r1[3] * r1[3]);
                *(u32x4*)(XR + o + bj * HALF) = pack8(r0, r1);
                if constexpr (W8) { f32x4 q0, q1;
#pragma unroll
                    for (int e = 0; e < 4; ++e) { q0[e] = __builtin_amdgcn_fmed3f(r0[e] * 8.f, -440.f, 440.f); q1[e] = __builtin_amdgcn_fmed3f(r1[e] * 8.f, -440.f, 440.f); }
                    *(u32x2_*)(X8 + o + bj * HALF) = (u32x2_){pk4_fp8(q0[0], q0[1], q0[2], q0[3]), pk4_fp8(q1[0], q1[1], q1[2], q1[3])}; } }
            ss += __shfl_xor(ss, 16); ss += __shfl_xor(ss, 32);
            if (fq == 0) SS[(size_t)row * 16 + u.pn * 4 + wc] = ss; }
    }
};
template <bool FIRST  > struct EpiMoeDown {
    static constexpr bool PERM = true, AFTER_DRAIN = false;
    float* OUT; const int* rowtok; const float* rowgate; int pm0; bf16_t* XR; float sc;
    __device__ __forceinline__ void operator()(const f32x4 (&acc)[2][2][4][2], const Unit& u, int wr, int wc, int fr, int fq) const {
        const int row0 = (u.pm - pm0) * BM + wr * 64 + fr, col0 = (u.pn & 3) * BM + wc * 32 + 8 * fq;
#pragma unroll
        EPI_LOOP_ROWS { const int r = row0 + ai * HALF + m * 16; const int t = rowtok[r]; const float gt = rowgate[r] * sc;
            if (t >= 0) { float* o = OUT + (size_t)t * 1024 + col0;
#pragma unroll
                for (int bj = 0; bj < 2; ++bj) { bf16_t* xp = XR + (size_t)t * 1024 + col0 + bj * HALF;
                    const u32x4 w = *(const u32x4*)xp; f32x4 r0 = (f32x4){bf_lo(w.x), bf_hi(w.x), bf_lo(w.y), bf_hi(w.y)}, r1 = (f32x4){bf_lo(w.z), bf_hi(w.z), bf_lo(w.w), bf_hi(w.w)};
                    r0 = r0 + acc[ai][bj][m][0] * gt; r1 = r1 + acc[ai][bj][m][1] * gt;
                    if (FIRST) *(u32x4*)xp = pack8(r0, r1);
                    else { *(f32x4*)(o + bj * HALF) = r0; *(f32x4*)(o + bj * HALF + 4) = r1; } } } }
    }
};

__device__ __forceinline__ void sk_store_partial(const f32x4 (&acc)[2][2][4][2], unsigned long long* slot, int tid) {
#pragma unroll
    for (int ai = 0; ai < 2; ++ai)
#pragma unroll
        for (int bj = 0; bj < 2; ++bj)
#pragma unroll
            for (int m = 0; m < 4; ++m)
#pragma unroll
                for (int n = 0; n < 2; ++n) { const f32x4 v = acc[ai][bj][m][n]; const unsigned long long w = (unsigned long long)cvt_pk_bf16(v[0], v[1]) | ((unsigned long long)cvt_pk_bf16(v[2], v[3]) << 32);
                    __hip_atomic_store(slot + (((ai * 2 + bj) * 4 + m) * 2 + n) * 512 + tid, w, __ATOMIC_RELAXED, __HIP_MEMORY_SCOPE_AGENT); }
}
__device__ __forceinline__ void sk_add_partial(f32x4 (&acc)[2][2][4][2], unsigned long long* slot, int tid) {
#pragma unroll
    for (int ai = 0; ai < 2; ++ai)
#pragma unroll
        for (int bj = 0; bj < 2; ++bj)
#pragma unroll
            for (int m = 0; m < 4; ++m)
#pragma unroll
                for (int n = 0; n < 2; ++n) { const unsigned long long w = __hip_atomic_load(slot + (((ai * 2 + bj) * 4 + m) * 2 + n) * 512 + tid, __ATOMIC_RELAXED, __HIP_MEMORY_SCOPE_AGENT);
                    const unsigned lo = (unsigned)w, hi = (unsigned)(w >> 32); acc[ai][bj][m][n] = acc[ai][bj][m][n] + (f32x4){bf_lo(lo), bf_hi(lo), bf_lo(hi), bf_hi(hi)};
                    if (n == 1 && (m & 1)) asm volatile("" ::: "memory"); }
}
typedef int i32x4_ __attribute__((ext_vector_type(4)));
typedef int i32x8_ __attribute__((ext_vector_type(8)));
template <class Epi, class Sched, bool ALIGN_EPI = false, bool SP2 = false, bool FP8 = false>
__device__ __forceinline__ void gemm_phase(PG8_LAS unsigned char* lds, const Gemm g, const Sched& S, const Epi& E) {
    const int tid = threadIdx.x, wid = __builtin_amdgcn_readfirstlane(tid >> 6), lane = tid & 63, wr = wid >> 2, wc = wid & 3, fr = lane & 15, fq = lane >> 4;
    const int K = g.K; int nt = K / BK;
    unsigned voffA[2], voffB[2];
#pragma unroll
    for (int i = 0; i < 2; ++i) { int R, C; stage_rc(tid * 16 + i * 8192, R, C); const int Rb = Epi::PERM ? ((R & ~31) + perm32(R & 31)) : R;
        voffA[i] = g.amode ? (unsigned)(((C >> 4) * g.lda + R) * 16 + (C & 15)) * 2u : (unsigned)(R * g.lda + C) * 2u; voffB[i] = (unsigned)(Rb * g.ldb + C) * 2u; }
    const size_t kstep = (size_t)(BK * 2);
    const size_t hstepA = g.amode ? (size_t)HALF * 32 : (size_t)HALF * g.lda * 2, hstepB = (size_t)HALF * g.ldb * 2;
    const size_t kstepA = g.amode ? (size_t)4 * g.lda * 32 : kstep;
    const size_t tstepA = 2 * hstepA, tstepB = 2 * hstepB;
    const unsigned ldsw = (unsigned)wid * 1024u;
    const int aoff = lds_byte(wr * 64 + fr, fq * 8), boff = lds_byte(wc * 32 + fr, fq * 8);
#define PG8_SA(b, h) (((b) * 2 + (h)) * HTB)
#define PG8_SB(b, h) ((4 + (b) * 2 + (h)) * HTB)
#define PG8_STAGE(bufoff, gbase, voff) do { _Pragma("unroll") for (int _i = 0; _i < 2; ++_i) \
        __builtin_amdgcn_global_load_lds((const unsigned*)((const char*)(gbase) + (voff)[_i]), (PG8_LAS unsigned*)(lds + (bufoff) + ldsw + _i * 8192), 16, 0, 0); } while (0)
#define PG8_LDA(dst, b, h) do { if constexpr (FP8) { _Pragma("unroll") for (int m = 0; m < 4; ++m) { const i32x4_ l_ = *(const PG8_LAS i32x4_*)(lds + PG8_SA(b, h) + aoff + m * 2048), h_ = *(const PG8_LAS i32x4_*)(lds + PG8_SA(b, h) + aoff + m * 2048 + 1024); dst##8[m] = __builtin_shufflevector(l_, h_, 0, 1, 2, 3, 4, 5, 6, 7); } } \
        else { _Pragma("unroll") for (int m = 0; m < 4; ++m) _Pragma("unroll") for (int k = 0; k < 2; ++k) dst[m][k] = *(const PG8_LAS bf16x8*)(lds + PG8_SA(b, h) + aoff + m * 2048 + k * 1024); } } while (0)
#define PG8_LDB(dst, b, h) do { if constexpr (FP8) { _Pragma("unroll") for (int n = 0; n < 2; ++n) { const i32x4_ l_ = *(const PG8_LAS i32x4_*)(lds + PG8_SB(b, h) + boff + n * 2048), h_ = *(const PG8_LAS i32x4_*)(lds + PG8_SB(b, h) + boff + n * 2048 + 1024); dst##8[n] = __builtin_shufflevector(l_, h_, 0, 1, 2, 3, 4, 5, 6, 7); } } \
        else { _Pragma("unroll") for (int n = 0; n < 2; ++n) _Pragma("unroll") for (int k = 0; k < 2; ++k) dst[n][k] = *(const PG8_LAS bf16x8*)(lds + PG8_SB(b, h) + boff + n * 2048 + k * 1024); } } while (0)
#define PG8_MMA(ai, bj, At, Bt) do { __builtin_amdgcn_s_setprio(1); \
        if constexpr (FP8) { _Pragma("unroll") for (int m = 0; m < 4; ++m) _Pragma("unroll") for (int n = 0; n < 2; ++n) \
            acc[ai][bj][m][n] = __builtin_amdgcn_mfma_scale_f32_16x16x128_f8f6f4(Bt##8[n], At##8[m], acc[ai][bj][m][n], 0, 0, 0, 0x7f7f7f7f, 0, 0x7f7f7f7f); \
            _Pragma("unroll") for (int m = 0; m < 4; ++m) _Pragma("unroll") for (int n = 0; n < 2; ++n) asm volatile("" : "+v"(acc[ai][bj][m][n])); } \
        else { _Pragma("unroll") for (int m = 0; m < 4; ++m) _Pragma("unroll") for (int n = 0; n < 2; ++n) _Pragma("unroll") for (int k = 0; k < 2; ++k) \
            acc[ai][bj][m][n] = __builtin_amdgcn_mfma_f32_16x16x32_bf16(Bt[n][k], At[m][k], acc[ai][bj][m][n], 0, 0, 0); } \
        __builtin_amdgcn_s_setprio(0); } while (0)
#define PG8_WAIT_V(n) asm volatile("s_waitcnt vmcnt(" #n ")" ::: "memory")
#define PG8_WAIT_L(n) asm volatile("s_waitcnt lgkmcnt(" #n ")" ::: "memory")
#define PG8_BAR __builtin_amdgcn_s_barrier()
#define PG8_SCHED __builtin_amdgcn_sched_barrier(0)
    Unit cur, nxt; int ui = 0;
    if (!S.next(0, cur)) return;
    f32x4 acc[2][2][4][2];
#pragma unroll
    for (int a = 0; a < 2; ++a)
#pragma unroll
        for (int b = 0; b < 2; ++b)
#pragma unroll
            for (int m = 0; m < 4; ++m)
#pragma unroll
                for (int n = 0; n < 2; ++n) acc[a][b][m][n] = (f32x4){0.f, 0.f, 0.f, 0.f};
    bf16x8 At[4][2], B0[2][2], B1[2][2];
    i32x8_ At8[4], B08[2], B18[2];
    const char* cA = (const char*)g.A + (size_t)cur.pm * tstepA; const char* cB = (const char*)g.Bt + (size_t)cur.pn * tstepB;
    if constexpr (Sched::STREAMK) { nt = cur.nk; cA += (size_t)cur.k0 * kstep; cB += (size_t)cur.k0 * kstep; }

    if constexpr (SP2) {
        PG8_STAGE(PG8_SB(0, 0), cB, voffB); PG8_STAGE(PG8_SB(0, 1), cB + hstepB, voffB); PG8_STAGE(PG8_SA(0, 0), cA, voffA); PG8_STAGE(PG8_SA(0, 1), cA + hstepA, voffA);
        if (wr == 1) PG8_BAR;
        PG8_WAIT_V(2); PG8_BAR;
        PG8_STAGE(PG8_SB(1, 0), cB + kstep, voffB); PG8_STAGE(PG8_SA(1, 0), cA + kstepA, voffA); PG8_STAGE(PG8_SB(1, 1), cB + hstepB + kstep, voffB);
        PG8_WAIT_V(6); PG8_BAR;
    } else {
        PG8_STAGE(PG8_SB(0, 0), cB, voffB); PG8_STAGE(PG8_SA(0, 0), cA, voffA); PG8_STAGE(PG8_SB(0, 1), cB + hstepB, voffB); PG8_STAGE(PG8_SA(0, 1), cA + hstepA, voffA);
        if (wr == 1) PG8_BAR;
        PG8_WAIT_V(4); PG8_BAR;
        PG8_STAGE(PG8_SB(1, 0), cB + kstep, voffB); PG8_STAGE(PG8_SA(1, 0), cA + kstepA, voffA); PG8_STAGE(PG8_SB(1, 1), cB + hstepB + kstep, voffB);
        PG8_WAIT_V(6); PG8_BAR;
    }
    for (;;) {
        const bool has_next = S.next(ui + 1, nxt);
        const char* nA = has_next ? (const char*)g.A + (size_t)nxt.pm * tstepA : cA; const char* nB = has_next ? (const char*)g.Bt + (size_t)nxt.pn * tstepB : cB;
        if constexpr (Sched::STREAMK) { if (has_next) { nA += (size_t)nxt.k0 * kstep; nB += (size_t)nxt.k0 * kstep; } }
        for (int t = 0; t < nt; t += 2) {
            const bool last = (t == nt - 2);
            const char* a1 = cA + (size_t)(t + 1) * kstepA;
            const char* a2 = last ? nA : cA + (size_t)(t + 2) * kstepA; const char* b2 = last ? nB : cB + (size_t)(t + 2) * kstep;
            const char* a3 = a2 + kstepA; const char* b3 = b2 + kstep;

            if constexpr (SP2) {
            PG8_LDB(B0, 0, 0); PG8_LDB(B1, 0, 1); PG8_SCHED; PG8_LDA(At, 0, 0); PG8_STAGE(PG8_SA(1, 1), a1 + hstepA, voffA);
            PG8_WAIT_V(8); PG8_WAIT_L(0); PG8_BAR; PG8_MMA(0, 0, At, B0); PG8_MMA(0, 1, At, B1); PG8_BAR; PG8_SCHED;
            PG8_LDA(At, 0, 1); PG8_STAGE(PG8_SB(0, 0), b2, voffB); PG8_STAGE(PG8_SB(0, 1), b2 + hstepB, voffB); PG8_STAGE(PG8_SA(0, 0), a2, voffA);
            PG8_WAIT_V(8); PG8_WAIT_L(0); PG8_BAR; PG8_MMA(1, 0, At, B0); PG8_MMA(1, 1, At, B1); PG8_BAR; PG8_SCHED;
            PG8_LDB(B0, 1, 0); PG8_LDB(B1, 1, 1); PG8_SCHED; PG8_LDA(At, 1, 0); PG8_STAGE(PG8_SA(0, 1), a2 + hstepA, voffA);
            PG8_WAIT_V(8); PG8_WAIT_L(0); PG8_BAR; PG8_MMA(0, 0, At, B0); PG8_MMA(0, 1, At, B1); PG8_BAR; PG8_SCHED;
            PG8_LDA(At, 1, 1); PG8_STAGE(PG8_SB(1, 0), b3, voffB); PG8_STAGE(PG8_SB(1, 1), b3 + hstepB, voffB); PG8_STAGE(PG8_SA(1, 0), a3, voffA);
            PG8_WAIT_V(8); PG8_WAIT_L(0); PG8_BAR; PG8_MMA(1, 0, At, B0); PG8_MMA(1, 1, At, B1); PG8_BAR; PG8_SCHED;
            } else {
            PG8_LDB(B0, 0, 0); PG8_SCHED; PG8_LDA(At, 0, 0); PG8_STAGE(PG8_SA(1, 1), a1 + hstepA, voffA);
            PG8_WAIT_L(8); PG8_BAR; PG8_WAIT_L(0); PG8_MMA(0, 0, At, B0); PG8_BAR; PG8_SCHED;
            PG8_LDB(B1, 0, 1); PG8_STAGE(PG8_SB(0, 0), b2, voffB);
            PG8_BAR; PG8_WAIT_L(0); PG8_MMA(0, 1, At, B1); PG8_BAR;
            PG8_LDA(At, 0, 1); PG8_STAGE(PG8_SA(0, 0), a2, voffA);
            PG8_BAR; PG8_WAIT_L(0); PG8_MMA(1, 0, At, B0); PG8_BAR; PG8_SCHED;
            PG8_STAGE(PG8_SB(0, 1), b2 + hstepB, voffB);
            PG8_WAIT_V(6); PG8_BAR; PG8_MMA(1, 1, At, B1); PG8_BAR;
            PG8_LDB(B0, 1, 0); PG8_SCHED; PG8_LDA(At, 1, 0); PG8_STAGE(PG8_SA(0, 1), a2 + hstepA, voffA);
            PG8_WAIT_L(8); PG8_BAR; PG8_WAIT_L(0); PG8_MMA(0, 0, At, B0); PG8_BAR; PG8_SCHED;
            PG8_LDB(B1, 1, 1); PG8_STAGE(PG8_SB(1, 0), b3, voffB);
            PG8_BAR; PG8_WAIT_L(0); PG8_MMA(0, 1, At, B1); PG8_BAR;
            PG8_LDA(At, 1, 1); PG8_STAGE(PG8_SA(1, 0), a3, voffA);
            PG8_BAR; PG8_WAIT_L(0); PG8_MMA(1, 0, At, B0); PG8_BAR; PG8_SCHED;
            PG8_STAGE(PG8_SB(1, 1), b3 + hstepB, voffB);
            PG8_WAIT_V(6); PG8_BAR; PG8_MMA(1, 1, At, B1); PG8_BAR;
            }
        }
        if constexpr (ALIGN_EPI) { if (wr == 0) PG8_BAR; }
        if constexpr (Sched::STREAMK) {
            if (cur.part == 2) { sk_store_partial(acc, S.slots() + (size_t)S.c() * SK_SLOT_WORDS, tid); PG8_WAIT_V(0);
                if (lane == 0) __hip_atomic_fetch_add(S.flags() + S.c() * 64, 1u, __ATOMIC_RELAXED, __HIP_MEMORY_SCOPE_AGENT); }
            else if (cur.part == 0) E(acc, cur, wr, wc, fr, fq);
        } else
        if constexpr (!Epi::AFTER_DRAIN) { E(acc, cur, wr, wc, fr, fq); }
        if (!has_next) break;
#pragma unroll
        for (int a = 0; a < 2; ++a)
#pragma unroll
            for (int b = 0; b < 2; ++b)
#pragma unroll
                for (int m = 0; m < 4; ++m)
#pragma unroll
                    for (int n = 0; n < 2; ++n) acc[a][b][m][n] = (f32x4){0.f, 0.f, 0.f, 0.f};
        cur = nxt; cA = nA; cB = nB; ++ui;
        if constexpr (Sched::STREAMK) nt = cur.nk;
        if constexpr (ALIGN_EPI) { if (wr == 1) PG8_BAR; }
    }
    PG8_WAIT_V(0);
    if constexpr (!ALIGN_EPI) { if (wr == 0) PG8_BAR; }
    PG8_BAR;
    if constexpr (Epi::AFTER_DRAIN) { E.fused(acc, cur, wr, wc, fr, fq, lds, wid, lane); }
    if constexpr (Sched::STREAMK) { if (cur.part == 1) {
        const int np = S.split();
        if (tid == 0) { for (int q = 1; q < np; ++q) { unsigned sp = 0; while (__hip_atomic_load(S.flags() + (S.c() + q) * 64, __ATOMIC_RELAXED, __HIP_MEMORY_SCOPE_AGENT) < S.target()) { __builtin_amdgcn_s_sleep(2); if (++sp > (1u << 22)) break; } } }
        __syncthreads();
        for (int q = 1; q < np; ++q) sk_add_partial(acc, S.slots() + (size_t)(S.c() + q) * SK_SLOT_WORDS, tid);
        E(acc, cur, wr, wc, fr, fq); } }
#undef PG8_SA
#undef PG8_SB
#undef PG8_STAGE
#undef PG8_LDA
#undef PG8_LDB
#undef PG8_MMA
#undef PG8_WAIT_V
#undef PG8_WAIT_L
#undef PG8_BAR
#undef PG8_SCHED
}
}


constexpr int NWAVES = 8, NTHREADS = 512;
constexpr int T = 16384, D = 1024, SEQ = 2048, NB = 8;
constexpr int DFF = 2816, DFE = 3584, NEXP = 8;
constexpr int RROWS = 18432;
constexpr float RMS_EPS = 1e-6f;
constexpr float MOE_WSCALE = 64.f, MOE_ASCALE = 8.f;

constexpr size_t MiB = 1u << 20;
constexpr size_t WS_CTL = 0, CTL_ZERO_BYTES = 256 * 1024;
constexpr size_t WS_SMALL = 1 * MiB;
constexpr size_t SM_KMEANS = WS_SMALL, SM_LAM32 = WS_SMALL + 64 * 1024, SM_WGCNT = WS_SMALL + 128 * 1024, SM_PANEND = WS_SMALL + 160 * 1024,
                 SM_TOKE = WS_SMALL + 192 * 1024, SM_TOKLP = WS_SMALL + 320 * 1024, SM_TOKG = WS_SMALL + 448 * 1024, SM_ROWTOK = WS_SMALL + 576 * 1024, SM_ROWGATE = WS_SMALL + 720 * 1024;
static_assert(SM_ROWGATE + 2 * RROWS * 4 <= 2 * MiB, "small tables");
constexpr size_t WS_WMEMK = 2 * MiB, WS_WMEMV = 3 * MiB, WS_WKQ = 4 * MiB, WS_WV = WS_WKQ + 2560 * 1024, WS_WOUT1 = 7 * MiB, WS_WMGU = 9 * MiB, WS_WMD = 121 * MiB;
constexpr size_t WS_XB = 177 * MiB, WS_CAT = 209 * MiB, WS_MEMN = 241 * MiB, WS_MEMK = 245 * MiB, WS_MEMVT = 247 * MiB;
constexpr size_t WS_ARENA = 249 * MiB, WS_END = 447 * MiB;
constexpr size_t AR_XS = WS_ARENA, AR_ACTM = WS_ARENA + 72 * MiB;
constexpr size_t AR_WIN0 = WS_ARENA, AR_WGLU = WS_ARENA + 2 * MiB, AR_WOUT0 = WS_ARENA + 4 * MiB, AR_WFGU = WS_ARENA + 6 * MiB, AR_WFD = WS_ARENA + 17 * MiB;
constexpr size_t AR_TZ = WS_ARENA + 23 * MiB, AR_W1T = WS_ARENA + 53 * MiB, AR_UG = WS_ARENA + 65 * MiB, AR_QM0 = WS_ARENA + 95 * MiB, AR_XC = WS_ARENA + 103 * MiB, AR_GACT = WS_ARENA + 115 * MiB;
constexpr size_t AR_X8 = WS_ARENA + 140 * MiB;
constexpr size_t AR_S5SM = WS_ARENA + 156 * MiB;
constexpr size_t AR_ACT0 = WS_ARENA + 23 * MiB;
constexpr size_t AR_KQ = WS_ARENA, AR_VT = WS_ARENA + 40 * MiB;
static_assert(AR_ACTM + (size_t)RROWS * DFE * 2 <= WS_END && AR_ACT0 + (size_t)T * DFF * 2 <= AR_GACT, "arena");
constexpr int CW_BAR = 4096, CW_QUEUE = 8192, CW_SKFLAG = 16384;
static_assert((CW_SKFLAG + 2 * 256 * 64 + 64) * 4 <= (int)CTL_ZERO_BYTES, "control words inside the per-call memset");

constexpr int RING_BYTES = 131072, MISC_OFF = RING_BYTES + 320, LDS_BYTES = 147456;

#define GAS __attribute__((address_space(1)))
#define LAS __attribute__((address_space(3)))
typedef unsigned short bf16;
typedef unsigned v4u __attribute__((ext_vector_type(4)));
typedef unsigned v2u __attribute__((ext_vector_type(2)));
typedef float f32x4 __attribute__((ext_vector_type(4)));
typedef float f32x16 __attribute__((ext_vector_type(16)));
typedef short bf16x8 __attribute__((ext_vector_type(8)));
typedef short s16x4 __attribute__((ext_vector_type(4)));
typedef GAS unsigned gu32;
#define LDS_WAIT() asm volatile("s_waitcnt lgkmcnt(0)" ::: "memory")
using pg8::cvt_pk_bf16; using pg8::bf_lo; using pg8::bf_hi;
__device__ __forceinline__ unsigned f2bf(float f) { unsigned u = __builtin_bit_cast(unsigned, f); return (u + 0x7fffu + ((u >> 16) & 1u)) >> 16; }
__device__ __forceinline__ unsigned pk2(float lo, float hi) { return f2bf(lo) | (f2bf(hi) << 16); }
__device__ __forceinline__ float wave_sum(float v) {
#pragma unroll
    for (int o = 1; o < 64; o <<= 1) v += __shfl_xor(v, o);
    return v;
}

#define XB_TMO      128
#define XB_XCNT(j)  (256  + 64 * (j))
#define XB_XSUB(j)  (1280 + 64 * (j))
#define XB_XGEN(j)  (2304 + 64 * (j))
#define XB_TOP      3328
#define XB_TOPGEN   3392
#define XCD_BAR_WORDS 3456
#define XB_SPIN_CAP (1u << 18)

__device__ __forceinline__ unsigned xb_ld(unsigned* p)              { return __hip_atomic_load(p, __ATOMIC_RELAXED, __HIP_MEMORY_SCOPE_AGENT); }
__device__ __forceinline__ unsigned xb_add(unsigned* p, unsigned v) { return __hip_atomic_fetch_add(p, v, __ATOMIC_RELAXED, __HIP_MEMORY_SCOPE_AGENT); }
__device__ __forceinline__ unsigned xb_xcc_id() { return (unsigned)__builtin_amdgcn_s_getreg((3 << 11) | 20) & 0xFu; }
#define XB_SPIN(cond, bar) do { unsigned _sp = 0; while (cond) { __builtin_amdgcn_s_sleep(1); \
    if ((++_sp & 255u) == 0u) { if (xb_ld(&(bar)[XB_TMO])) break; if (_sp > XB_SPIN_CAP) { atomicAdd(&(bar)[XB_TMO], 1u); break; } } } } while (0)

struct XcdBarrier {
    unsigned* bar; unsigned x;
    volatile LAS unsigned* st;
};

__device__ __forceinline__ XcdBarrier xcd_barrier_post(unsigned* bar, volatile LAS unsigned* st) {
    XcdBarrier b; b.bar = bar; b.x = xb_xcc_id(); b.st = st;
    if (threadIdx.x == 0) (void)xb_add(&bar[XB_XCNT(b.x)], 1u);
    return b;
}
__device__ __forceinline__ void xcd_barrier_complete(unsigned* bar, unsigned x, unsigned& nloc, unsigned& nx) {
    const unsigned G = gridDim.x * gridDim.y * gridDim.z;
    unsigned sum, cnt, mine, sp = 0u;
    for (;;) {
        sum = 0u; cnt = 0u; mine = 0u;
#pragma unroll
        for (unsigned j = 0; j < 16; ++j) { const unsigned c = xb_ld(&bar[XB_XCNT(j)]); sum += c; cnt += (c > 0u) ? 1u : 0u; mine = (j == x) ? c : mine; }
        if (sum == G) break;
        __builtin_amdgcn_s_sleep(1);
        if ((++sp & 255u) == 0u) { if (xb_ld(&bar[XB_TMO])) break; if (sp > XB_SPIN_CAP) { atomicAdd(&bar[XB_TMO], 1u); break; } }
    }
    nloc = mine > 0u ? mine : 1u; nx = cnt > 0u ? cnt : 1u;
}

__device__ __forceinline__ void xcd_barrier(const XcdBarrier& b) {
    asm volatile("s_waitcnt vmcnt(0)" ::: "memory");
    __syncthreads();
    if (threadIdx.x == 0) {
        unsigned* bar = b.bar;
        __builtin_amdgcn_s_waitcnt(0);
        unsigned nloc = b.st[0], nx = b.st[1];
        if (nloc == 0u) { xcd_barrier_complete(bar, b.x, nloc, nx); b.st[0] = nloc; b.st[1] = nx; }
        const unsigned old = xb_add(&bar[XB_XSUB(b.x)], 1u);
        const unsigned gen = old / nloc;
        if (old + 1u == (gen + 1u) * nloc) {
            __builtin_amdgcn_fence(__ATOMIC_RELEASE, "agent");
            asm volatile("s_waitcnt vmcnt(0)" ::: "memory");
            const unsigned og = xb_add(&bar[XB_TOP], 1u);
            const unsigned tg = og / nx;
            if (og + 1u == (tg + 1u) * nx) xb_add(&bar[XB_TOPGEN], 1u);
            else XB_SPIN(xb_ld(&bar[XB_TOPGEN]) == tg, bar);
            __builtin_amdgcn_fence(__ATOMIC_ACQUIRE, "agent");
            xb_add(&bar[XB_XGEN(b.x)], 1u);
            asm volatile("s_waitcnt vmcnt(0)" ::: "memory");
        } else {
            XB_SPIN(xb_ld(&bar[XB_XGEN(b.x)]) == gen, bar);
            __builtin_amdgcn_fence(__ATOMIC_ACQUIRE, "agent");
            asm volatile("s_waitcnt vmcnt(0)" ::: "memory");
        }
    }
    __syncthreads();
}


__device__ __forceinline__ void cvt_item(const float* W, int ldw, int k0, int n0, const float* gain, bf16* WT, int ldo, int orow0, LAS unsigned* scr, int lane) {
    const int nq = lane & 15, kr = lane >> 4;
    f32x4 a[8], b[8];
    const float* src = W + (size_t)(k0 + 2 * kr) * ldw + n0 + 4 * nq;
#pragma unroll
    for (int i = 0; i < 8; ++i) { a[i] = *(const GAS f32x4*)(src + (size_t)(8 * i) * ldw); b[i] = *(const GAS f32x4*)(src + (size_t)(8 * i + 1) * ldw); }
    if (gain) {
#pragma unroll
        for (int i = 0; i < 8; ++i) { const float ga = gain[k0 + 8 * i + 2 * kr], gb = gain[k0 + 8 * i + 2 * kr + 1]; a[i] = a[i] * ga; b[i] = b[i] * gb; } }
#pragma unroll
    for (int i = 0; i < 8; ++i) {
#pragma unroll
        for (int e = 0; e < 4; ++e) scr[(4 * nq + e) * 33 + 4 * i + kr] = cvt_pk_bf16(a[i][e], b[i][e]); }
    LDS_WAIT(); asm volatile("" ::: "memory");
#pragma unroll
    for (int j = 0; j < 8; ++j) { const int q = lane + 64 * j, n = q >> 3, c = q & 7; const LAS unsigned* sp = scr + n * 33 + 4 * c;
        v4u o; o.x = sp[0]; o.y = sp[1]; o.z = sp[2]; o.w = sp[3];
        *(GAS v4u*)(WT + (size_t)(orow0 + n) * ldo + k0 + 8 * c) = o; }
    LDS_WAIT(); asm volatile("" ::: "memory");
}
struct CvtDesc { const float* src; const float* gain; bf16* dst; int ldw, ldo, k0; };
__device__ __forceinline__ void cvt_load(const CvtDesc& d, f32x4 (&a)[8], f32x4 (&b)[8], float (&ga)[8], float (&gb)[8], int lane) {
    const int nq = lane & 15, kr = lane >> 4; const float* src = d.src + (size_t)(2 * kr) * d.ldw + 4 * nq;
    if (d.gain) {
#pragma unroll
        for (int i = 0; i < 8; ++i) { ga[i] = d.gain[d.k0 + 8 * i + 2 * kr]; gb[i] = d.gain[d.k0 + 8 * i + 2 * kr + 1]; } }
    else {
#pragma unroll
        for (int i = 0; i < 8; ++i) { ga[i] = 1.f; gb[i] = 1.f; } }
#pragma unroll
    for (int i = 0; i < 8; ++i) { a[i] = *(const GAS f32x4*)(src + (size_t)(8 * i) * d.ldw); b[i] = *(const GAS f32x4*)(src + (size_t)(8 * i + 1) * d.ldw); }
}
__device__ __forceinline__ void cvt_emit(const CvtDesc& d, f32x4 (&a)[8], f32x4 (&b)[8], const float (&ga)[8], const float (&gb)[8], LAS unsigned* scr, int lane) {
    const int nq = lane & 15, kr = lane >> 4;
#pragma unroll
    for (int i = 0; i < 8; ++i) {
#pragma unroll
        for (int e = 0; e < 4; ++e) scr[(4 * nq + e) * 33 + 4 * i + kr] = cvt_pk_bf16(a[i][e] * ga[i], b[i][e] * gb[i]); }
    LDS_WAIT(); asm volatile("" ::: "memory");
#pragma unroll
    for (int j = 0; j < 8; ++j) { const int q = lane + 64 * j, n = q >> 3, c = q & 7; const LAS unsigned* sp = scr + n * 33 + 4 * c;
        v4u o; o.x = sp[0]; o.y = sp[1]; o.z = sp[2]; o.w = sp[3];
        *(GAS v4u*)(d.dst + (size_t)n * d.ldo + 8 * c) = o; }
    LDS_WAIT(); asm volatile("" ::: "memory");
}
struct CvtDesc8 { const float* src; const float* gain; unsigned char* dst; int ldw, ldo, k0; };
__device__ __forceinline__ void cvt_load8(const CvtDesc8& d, f32x4 (&a)[4][4], float (&g)[4][4], float scale, int lane) {
    const int nq = lane & 15, kr = lane >> 4; const float* src = d.src + (size_t)(4 * kr) * d.ldw + 4 * nq;
#pragma unroll
    for (int i = 0; i < 4; ++i)
#pragma unroll
        for (int r = 0; r < 4; ++r) g[i][r] = d.gain ? d.gain[d.k0 + 16 * i + 4 * kr + r] * scale : scale;
#pragma unroll
    for (int i = 0; i < 4; ++i)
#pragma unroll
        for (int r = 0; r < 4; ++r) a[i][r] = __builtin_nontemporal_load((const GAS f32x4*)(src + (size_t)(16 * i + r) * d.ldw));
}
__device__ __forceinline__ void cvt_load8_dma(const CvtDesc8& d, f32x4 (&a)[4][4], float (&g)[4][4], float scale, LAS unsigned char* buf, int lane) {
    const int nq = lane & 15, kr = lane >> 4;
#pragma unroll
    for (int i = 0; i < 4; ++i)
#pragma unroll
        for (int r = 0; r < 4; ++r) g[i][r] = d.gain ? d.gain[d.k0 + 16 * i + 4 * kr + r] * scale : scale;
    const float* src = d.src + (size_t)kr * d.ldw + 4 * nq;
#pragma unroll
    for (int j = 0; j < 16; ++j) __builtin_amdgcn_global_load_lds((const unsigned*)(src + (size_t)(4 * j) * d.ldw), (LAS unsigned*)(buf + j * 1024), 16, 0, 2);
    asm volatile("s_waitcnt vmcnt(0)" ::: "memory");
#pragma unroll
    for (int i = 0; i < 4; ++i)
#pragma unroll
        for (int r = 0; r < 4; ++r) a[i][r] = *(const LAS f32x4*)(buf + (16 * i + 4 * kr + r) * 256 + nq * 16);
    LDS_WAIT(); asm volatile("" ::: "memory");
}
__device__ __forceinline__ void cvt_emit8(const CvtDesc8& d, f32x4 (&a)[4][4], const float (&g)[4][4], LAS unsigned* scr, int lane) {
    const int nq = lane & 15, kr = lane >> 4;
#pragma unroll
    for (int i = 0; i < 4; ++i)
#pragma unroll
        for (int e = 0; e < 4; ++e) scr[(4 * nq + e) * 17 + 4 * i + kr] = pg8::pk4_fp8(a[i][0][e] * g[i][0], a[i][1][e] * g[i][1], a[i][2][e] * g[i][2], a[i][3][e] * g[i][3]);
    LDS_WAIT(); asm volatile("" ::: "memory");
#pragma unroll
    for (int j = 0; j < 4; ++j) { const int q = lane + 64 * j, n = q >> 2, c = q & 3; const LAS unsigned* sp = scr + n * 17 + 4 * c;
        v4u o; o.x = sp[0]; o.y = sp[1]; o.z = sp[2]; o.w = sp[3];
        __builtin_nontemporal_store(o, (GAS v4u*)(d.dst + (size_t)n * d.ldo + 16 * c)); }
    LDS_WAIT(); asm volatile("" ::: "memory");
}
__device__ __forceinline__ void rms_row_to_bf16(const float* xrow, bf16* orow, int lane) {
    const GAS f32x4* xr = (const GAS f32x4*)xrow + lane;
    f32x4 v[4]; float s = 0.f;
#pragma unroll
    for (int j = 0; j < 4; ++j) { v[j] = xr[64 * j]; s += (v[j].x * v[j].x + v[j].y * v[j].y) + (v[j].z * v[j].z + v[j].w * v[j].w); }
    const float r = 1.f / sqrtf(wave_sum(s) * (1.f / 1024.f) + RMS_EPS);
    GAS unsigned long long* o8 = (GAS unsigned long long*)orow + lane;
#pragma unroll
    for (int j = 0; j < 4; ++j) o8[64 * j] = (unsigned long long)pk2(v[j].x * r, v[j].y * r) | ((unsigned long long)pk2(v[j].z * r, v[j].w * r) << 32);
}
__device__ __forceinline__ void dsincos(double a, double& s, double& c) {
    const double k = rint(a * 0.63661977236758134308);
    double r = fma(-k, 1.57079632679489655800e+00, a); r = fma(-k, 6.12323399573676603587e-17, r);
    const double z = r * r;
    double ps = 1.0 / 355687428096000.0;
    ps = fma(ps, z, -1.0 / 1307674368000.0); ps = fma(ps, z, 1.0 / 6227020800.0); ps = fma(ps, z, -1.0 / 39916800.0); ps = fma(ps, z, 1.0 / 362880.0);
    ps = fma(ps, z, -1.0 / 5040.0); ps = fma(ps, z, 1.0 / 120.0); ps = fma(ps, z, -1.0 / 6.0); ps = fma(ps * z, r, r);
    double pc = -1.0 / 6402373705728000.0;
    pc = fma(pc, z, 1.0 / 20922789888000.0); pc = fma(pc, z, -1.0 / 87178291200.0); pc = fma(pc, z, 1.0 / 479001600.0); pc = fma(pc, z, -1.0 / 3628800.0);
    pc = fma(pc, z, 1.0 / 40320.0); pc = fma(pc, z, -1.0 / 720.0); pc = fma(pc, z, 1.0 / 24.0); pc = fma(pc, z, -0.5); pc = fma(pc, z, 1.0);
    const long q = (long)k & 3;
    s = (q == 0) ? ps : (q == 1) ? pc : (q == 2) ? -ps : -pc;
    c = (q == 0) ? pc : (q == 1) ? -ps : (q == 2) ? -pc : ps;
}
__device__ __forceinline__ double dexp(double x) {
    const double k = rint(x * 1.44269504088896338700);
    double r = fma(-k, 6.93147180369123816490e-01, x); r = fma(-k, 1.90821492927058770002e-10, r);
    double p = 1.0 / 6227020800.0;
    p = fma(p, r, 1.0 / 479001600.0); p = fma(p, r, 1.0 / 39916800.0); p = fma(p, r, 1.0 / 3628800.0); p = fma(p, r, 1.0 / 362880.0); p = fma(p, r, 1.0 / 40320.0);
    p = fma(p, r, 1.0 / 5040.0); p = fma(p, r, 1.0 / 720.0); p = fma(p, r, 1.0 / 120.0); p = fma(p, r, 1.0 / 24.0); p = fma(p, r, 1.0 / 6.0); p = fma(p, r, 0.5); p = fma(p, r, 1.0); p = fma(p, r, 1.0);
    const long ki = (long)k;
    return p * __builtin_bit_cast(double, (unsigned long long)(1023 + ki) << 52);
}
constexpr int S5SM_PW = 64 * 33, S5SM_HEAD = 2 * S5SM_PW + 2048, S5SM_FLOATS = S5SM_HEAD + 8192;
struct S5Lds { LAS float* pwr; LAS float* pwi; LAS float* bbr; LAS float* bbi; LAS float* ccr; LAS float* cci; LAS float* km; };
__device__ __forceinline__ S5Lds s5_lds(LAS unsigned char* lds) { S5Lds L; L.pwr = (LAS float*)lds; L.pwi = L.pwr + S5SM_PW; L.bbr = L.pwi + S5SM_PW; L.bbi = L.bbr + 1024; L.ccr = L.bbi + 1024; L.cci = L.ccr + 1024; L.km = L.cci + 1024; return L; }
__device__ __forceinline__ void s5_tables_small(int g, LAS unsigned char* lds, const float* lam_re, const float* lam_im, const float* log_dt, const float* b_re, const float* b_im,
                                                const float* c_re, const float* c_im, float* S5SM, float* LAM32, int tid) {
    const S5Lds L = s5_lds(lds); LAS float* pwr = L.pwr; LAS float* pwi = L.pwi; LAS float* bbr = L.bbr; LAS float* bbi = L.bbi; LAS float* ccr = L.ccr; LAS float* cci = L.cci; LAS float* km = L.km;
    const double dt = dexp((double)log_dt[g]);
    for (int idx = tid; idx < 64 * 33; idx += NTHREADS) { const int p = idx / 33, tau = idx % 33;
        const double lr = lam_re[g * 64 + p], li = lam_im[g * 64 + p]; const double mag = dexp(lr * dt * tau); double s, c; dsincos(li * dt * tau, s, c);
        pwr[idx] = (float)(mag * c); pwi[idx] = (float)(mag * s); }
    for (int idx = tid; idx < 1024; idx += NTHREADS) { const int p = idx >> 4, m = idx & 15;
        const double lr = lam_re[g * 64 + p], li = lam_im[g * 64 + p]; const double mag = dexp(lr * dt); double s, c; dsincos(li * dt, s, c);
        const double ar = mag * c - 1.0, ai = mag * s, den = lr * lr + li * li, fr_ = (ar * lr + ai * li) / den, fi_ = (ai * lr - ar * li) / den;
        const double br = b_re[(g * 64 + p) * 16 + m], bi = b_im[(g * 64 + p) * 16 + m];
        bbr[idx] = (float)(fr_ * br - fi_ * bi); bbi[idx] = (float)(fr_ * bi + fi_ * br);
        ccr[idx] = c_re[g * 1024 + idx]; cci[idx] = c_im[g * 1024 + idx]; }
    __syncthreads();
    { const int half = tid >> 8, n = (tid >> 4) & 15, m = tid & 15; float acc[16];
#pragma unroll
      for (int t = 0; t < 16; ++t) acc[t] = 0.f;
      for (int p = 0; p < 64; ++p) { const float cr = ccr[n * 64 + p], ci = cci[n * 64 + p], br = bbr[p * 16 + m], bi = bbi[p * 16 + m]; const float zr = cr * br - ci * bi, zi = cr * bi + ci * br;
#pragma unroll
          for (int t = 0; t < 16; ++t) acc[t] += zr * pwr[p * 33 + 16 * half + t] - zi * pwi[p * 33 + 16 * half + t]; }
#pragma unroll
      for (int t = 0; t < 16; ++t) km[((16 * half + t) * 16 + n) * 16 + m] = acc[t]; }
    __syncthreads();
    float* S = S5SM + (size_t)g * S5SM_FLOATS;
    for (int i = tid; i < S5SM_HEAD; i += NTHREADS) S[i] = pwr[i];
    for (int i = tid; i < 8192; i += NTHREADS) S[S5SM_HEAD + i] = km[i];
    if (tid < 64) { LAM32[(g * 64 + tid) * 2] = pwr[tid * 33 + 32]; LAM32[(g * 64 + tid) * 2 + 1] = pwi[tid * 33 + 32]; }
    __syncthreads();
}
__device__ __forceinline__ void s5_load(int g, LAS unsigned char* lds, const float* S5SM, const float* c_re, const float* c_im, bool with_km, int tid) {
    const S5Lds L = s5_lds(lds); const float* S = S5SM + (size_t)g * S5SM_FLOATS;
    for (int i = tid; i < S5SM_HEAD / 4; i += NTHREADS) *(LAS f32x4*)(L.pwr + 4 * i) = *(const GAS f32x4*)(S + 4 * i);
    for (int i = tid; i < 256; i += NTHREADS) { *(LAS f32x4*)(L.ccr + 4 * i) = *(const GAS f32x4*)(c_re + g * 1024 + 4 * i); *(LAS f32x4*)(L.cci + 4 * i) = *(const GAS f32x4*)(c_im + g * 1024 + 4 * i); }
    if (with_km) for (int i = tid; i < 2048; i += NTHREADS) *(LAS f32x4*)(L.km + 4 * i) = *(const GAS f32x4*)(S + S5SM_HEAD + 4 * i);
    __syncthreads();
}
__device__ __forceinline__ void s5_expand_tz(int g, LAS unsigned char* lds, bf16* TZ, int row_lo, int row_hi, int tid) {
    const S5Lds L = s5_lds(lds); LAS float* pwr = L.pwr; LAS float* pwi = L.pwi; LAS float* ccr = L.ccr; LAS float* cci = L.cci; LAS float* km = L.km;
    bf16* tz = TZ + (size_t)g * 512 * 640;
    for (int pc = row_lo * 80 + tid; pc < row_hi * 80; pc += NTHREADS) { const int row = pc / 80, c8 = pc % 80, j = row >> 4, n = row & 15; float v[8];
        if (c8 < 64) { const int i = c8 >> 1, m0 = (c8 & 1) * 8;
#pragma unroll
            for (int e = 0; e < 8; ++e) v[e] = (i <= j) ? km[((j - i) * 16 + n) * 16 + m0 + e] : 0.f; }
        else { const int p0 = (c8 - 64) * 4;
#pragma unroll
            for (int q = 0; q < 4; ++q) { const int p = p0 + q; const float cr = ccr[n * 64 + p], ci = cci[n * 64 + p], pr = pwr[p * 33 + j + 1], pi = pwi[p * 33 + j + 1];
                v[2 * q] = cr * pr - ci * pi; v[2 * q + 1] = -(cr * pi + ci * pr); } }
        v4u o; o.x = pk2(v[0], v[1]); o.y = pk2(v[2], v[3]); o.z = pk2(v[4], v[5]); o.w = pk2(v[6], v[7]);
        *(GAS v4u*)(tz + (size_t)row * 640 + c8 * 8) = o; }
}
__device__ __forceinline__ void s5_expand_w1t(int g, LAS unsigned char* lds, bf16* W1T, int row_lo, int row_hi, int tid) {
    const S5Lds L = s5_lds(lds); LAS float* pwr = L.pwr; LAS float* pwi = L.pwi; LAS float* bbr = L.bbr; LAS float* bbi = L.bbi;
    bf16* w1 = W1T + (size_t)g * 256 * 512;
    for (int pc = row_lo * 64 + tid; pc < row_hi * 64; pc += NTHREADS) { const int row = pc >> 6, c8 = pc & 63, p = row >> 1, ri = row & 1, i = c8 >> 1, m0 = (c8 & 1) * 8; float v[8];
        const float ar = pwr[p * 33 + 31 - i], ai = pwi[p * 33 + 31 - i];
#pragma unroll
        for (int e = 0; e < 8; ++e) { const float br = bbr[p * 16 + m0 + e], bi = bbi[p * 16 + m0 + e]; v[e] = ri ? (ar * bi + ai * br) : (ar * br - ai * bi); }
        v4u o; o.x = pk2(v[0], v[1]); o.y = pk2(v[2], v[3]); o.z = pk2(v[4], v[5]); o.w = pk2(v[6], v[7]);
        *(GAS v4u*)(w1 + (size_t)row * 512 + c8 * 8) = o; }
}

constexpr int KS_PITCH = 144, VS_PITCH = 520, ATT_KS = 0, ATT_VS = 256 * KS_PITCH;
static_assert(ATT_VS + 64 * VS_PITCH <= RING_BYTES, "attention LDS");
#define MFMA32(a, b, c) __builtin_amdgcn_mfma_f32_32x32x16_bf16(a, b, c, 0, 0, 0)
struct KVRegs { v4u k[4]; v4u v[4]; };
__device__ __forceinline__ void att_load(KVRegs& R, const bf16* Kg, int kpitch, const bf16* Vg, int vpitch, int tid) {
#pragma unroll
    for (int i = 0; i < 4; ++i) { const int p = tid + NTHREADS * i, row = p >> 3, c = p & 7; R.k[i] = *(const GAS v4u*)(Kg + (size_t)row * kpitch + c * 8); }
#pragma unroll
    for (int i = 0; i < 4; ++i) { const int p = tid + NTHREADS * i, row = p >> 5, c = p & 31; R.v[i] = *(const GAS v4u*)(Vg + (size_t)row * vpitch + c * 8); }
}
__device__ __forceinline__ void att_store(LAS unsigned char* lds, const KVRegs& R, int tid) {
#pragma unroll
    for (int i = 0; i < 4; ++i) { const int p = tid + NTHREADS * i, row = p >> 3, c = p & 7; *(LAS v4u*)(lds + ATT_KS + row * KS_PITCH + c * 16) = R.k[i]; }
#pragma unroll
    for (int i = 0; i < 4; ++i) { const int p = tid + NTHREADS * i, row = p >> 5, c = p & 31;
        LAS v2u* d = (LAS v2u*)(lds + ATT_VS + row * VS_PITCH + c * 16); d[0] = (v2u){R.v[i].x, R.v[i].y}; d[1] = (v2u){R.v[i].z, R.v[i].w}; }
}
__device__ __forceinline__ void att_stage(LAS unsigned char* lds, const bf16* Kg, int kpitch, const bf16* Vg, int vpitch, int tid) { KVRegs R; att_load(R, Kg, kpitch, Vg, vpitch, tid); att_store(lds, R, tid); }
__device__ __forceinline__ void att_qk(const LAS unsigned char* lds, const bf16x8 (&qf)[4], int kt, f32x16& p0, f32x16& p1, int lane) {
    const int r32 = lane & 31, hi = lane >> 5;
#pragma unroll
    for (int r = 0; r < 16; ++r) { p0[r] = 0.f; p1[r] = 0.f; }
    const LAS unsigned char* kb = lds + ATT_KS + (kt * 64 + r32) * KS_PITCH + hi * 16;
#pragma unroll
    for (int d0 = 0; d0 < 4; ++d0) { const bf16x8 k0 = *(const LAS bf16x8*)(kb + d0 * 32), k1 = *(const LAS bf16x8*)(kb + 32 * KS_PITCH + d0 * 32);
        p0 = MFMA32(k0, qf[d0], p0); p1 = MFMA32(k1, qf[d0], p1); }
}
template <int MODE> __device__ __forceinline__ void att_finish(const LAS unsigned char* lds, int kt, f32x16& p0, f32x16& p1, f32x16& o0, f32x16& o1, float& l, int qloc, bool rowoff, int lane) {
    const int r32 = lane & 31, hi = lane >> 5; const float NEG = -__builtin_inff();
    if (MODE == 1) { const int kv0 = kt * 64 + 4 * hi;
#pragma unroll
        for (int r = 0; r < 16; ++r) { const int kv = kv0 + (r & 3) + 8 * (r >> 2); if (kv > qloc) p0[r] = NEG; if (kv + 32 > qloc) p1[r] = NEG; } }
    float rs = 0.f;
#pragma unroll
    for (int r = 0; r < 16; ++r) { p0[r] = __builtin_amdgcn_exp2f(p0[r]); p1[r] = __builtin_amdgcn_exp2f(p1[r]); rs += p0[r] + p1[r]; }
    if (MODE == 2) rs = rowoff ? 0.f : rs;
    l += rs;
    bf16x8 pb[4];
#pragma unroll
    for (int s = 0; s < 2; ++s) { v4u w0, w1;
        w0.x = cvt_pk_bf16(p0[8 * s + 0], p0[8 * s + 1]); w0.y = cvt_pk_bf16(p0[8 * s + 2], p0[8 * s + 3]); w0.z = cvt_pk_bf16(p0[8 * s + 4], p0[8 * s + 5]); w0.w = cvt_pk_bf16(p0[8 * s + 6], p0[8 * s + 7]);
        w1.x = cvt_pk_bf16(p1[8 * s + 0], p1[8 * s + 1]); w1.y = cvt_pk_bf16(p1[8 * s + 2], p1[8 * s + 3]); w1.z = cvt_pk_bf16(p1[8 * s + 4], p1[8 * s + 5]); w1.w = cvt_pk_bf16(p1[8 * s + 6], p1[8 * s + 7]);
        if (MODE == 2) { if (rowoff) { w0 = (v4u){0u, 0u, 0u, 0u}; w1 = (v4u){0u, 0u, 0u, 0u}; } }
        pb[s] = __builtin_bit_cast(bf16x8, w0); pb[2 + s] = __builtin_bit_cast(bf16x8, w1); }
    const LAS unsigned char* vb = lds + ATT_VS + r32 * VS_PITCH + (kt * 64 + 4 * hi) * 2;
#pragma unroll
    for (int s = 0; s < 4; ++s) { const int ko = (32 * (s >> 1) + 16 * (s & 1)) * 2;
        const s16x4 a0 = *(const LAS s16x4*)(vb + ko), a1 = *(const LAS s16x4*)(vb + ko + 16);
        const s16x4 b0 = *(const LAS s16x4*)(vb + 32 * VS_PITCH + ko), b1 = *(const LAS s16x4*)(vb + 32 * VS_PITCH + ko + 16);
        const bf16x8 va = (bf16x8){a0[0], a0[1], a0[2], a0[3], a1[0], a1[1], a1[2], a1[3]}, vc = (bf16x8){b0[0], b0[1], b0[2], b0[3], b1[0], b1[1], b1[2], b1[3]};
        o0 = MFMA32(va, pb[s], o0); o1 = MFMA32(vc, pb[s], o1); }
}
template <int MODE> __device__ __forceinline__ void att_block(const LAS unsigned char* lds, const bf16x8 (&qf)[4], f32x16& o0, f32x16& o1, float& l, int nkt, int qloc, bool rowoff, int lane) {
    f32x16 pa0, pa1, pb0, pb1;
    att_qk(lds, qf, 0, pa0, pa1, lane);
    int kt = 0;
    for (; kt + 1 < nkt; kt += 2) {
        att_qk(lds, qf, kt + 1, pb0, pb1, lane);
        att_finish<MODE>(lds, kt, pa0, pa1, o0, o1, l, qloc, rowoff, lane);
        if (kt + 2 < nkt) att_qk(lds, qf, kt + 2, pa0, pa1, lane);
        att_finish<MODE>(lds, kt + 1, pb0, pb1, o0, o1, l, qloc, rowoff, lane);
    }
    if (kt < nkt) att_finish<MODE>(lds, kt, pa0, pa1, o0, o1, l, qloc, rowoff, lane);
}
__device__ __forceinline__ void att_load_q(const bf16* qrow  , float (&qv)[4][8], bf16x8 (&qf)[4]) {
    float ss = 0.f;
#pragma unroll
    for (int d0 = 0; d0 < 4; ++d0) { const v4u w = *(const GAS v4u*)(qrow + d0 * 16);
        qv[d0][0] = bf_lo(w.x); qv[d0][1] = bf_hi(w.x); qv[d0][2] = bf_lo(w.y); qv[d0][3] = bf_hi(w.y); qv[d0][4] = bf_lo(w.z); qv[d0][5] = bf_hi(w.z); qv[d0][6] = bf_lo(w.w); qv[d0][7] = bf_hi(w.w);
#pragma unroll
        for (int e = 0; e < 8; ++e) ss += qv[d0][e] * qv[d0][e]; }
    ss += __shfl_xor(ss, 32);
    const float sc = (1.f / sqrtf(ss * (1.f / 64.f) + RMS_EPS)) * (0.125f * 1.4426950408889634f);
#pragma unroll
    for (int d0 = 0; d0 < 4; ++d0) { v4u w; w.x = cvt_pk_bf16(qv[d0][0] * sc, qv[d0][1] * sc); w.y = cvt_pk_bf16(qv[d0][2] * sc, qv[d0][3] * sc); w.z = cvt_pk_bf16(qv[d0][4] * sc, qv[d0][5] * sc); w.w = cvt_pk_bf16(qv[d0][6] * sc, qv[d0][7] * sc);
        qf[d0] = __builtin_bit_cast(bf16x8, w); }
}
constexpr int ATT_OST = 73728, OST_PITCH = 144;
static_assert(ATT_OST >= ATT_VS + 64 * VS_PITCH && ATT_OST + 8 * 32 * OST_PITCH <= RING_BYTES, "attention output stage");
template <bool OUT8 = false  >
__device__ __forceinline__ void att_store_o(LAS unsigned char* lds, bf16* obase  , int opitch, const f32x16& o0, const f32x16& o1, float l, int lane, int wid) {
    const int r32 = lane & 31, hi = lane >> 5;
    l += __shfl_xor(l, 32); const float inv = 1.f / l;
    LAS unsigned char* st = lds + ATT_OST + wid * (32 * OST_PITCH);
    if constexpr (OUT8) {
        const float i8 = inv * 8.f;
#pragma unroll
        for (int a = 0; a < 4; ++a) {
            *(LAS unsigned*)(st + r32 * OST_PITCH + (8 * a + 4 * hi)) = pg8::pk4_fp8(__builtin_amdgcn_fmed3f(o0[4 * a] * i8, -440.f, 440.f), __builtin_amdgcn_fmed3f(o0[4 * a + 1] * i8, -440.f, 440.f), __builtin_amdgcn_fmed3f(o0[4 * a + 2] * i8, -440.f, 440.f), __builtin_amdgcn_fmed3f(o0[4 * a + 3] * i8, -440.f, 440.f));
            *(LAS unsigned*)(st + r32 * OST_PITCH + (32 + 8 * a + 4 * hi)) = pg8::pk4_fp8(__builtin_amdgcn_fmed3f(o1[4 * a] * i8, -440.f, 440.f), __builtin_amdgcn_fmed3f(o1[4 * a + 1] * i8, -440.f, 440.f), __builtin_amdgcn_fmed3f(o1[4 * a + 2] * i8, -440.f, 440.f), __builtin_amdgcn_fmed3f(o1[4 * a + 3] * i8, -440.f, 440.f)); }
        LDS_WAIT(); asm volatile("" ::: "memory");
#pragma unroll
        for (int i = 0; i < 2; ++i) { const int idx = lane + 64 * i, row = idx >> 2, c = idx & 3;
            const v4u v = *(const LAS v4u*)(st + row * OST_PITCH + c * 16);
            *(GAS v4u*)((unsigned char*)obase + (size_t)row * opitch + c * 16) = v; }
        LDS_WAIT(); asm volatile("" ::: "memory");
        return; }
#pragma unroll
    for (int a = 0; a < 4; ++a) {
        *(LAS v2u*)(st + r32 * OST_PITCH + (8 * a + 4 * hi) * 2) = (v2u){cvt_pk_bf16(o0[4 * a] * inv, o0[4 * a + 1] * inv), cvt_pk_bf16(o0[4 * a + 2] * inv, o0[4 * a + 3] * inv)};
        *(LAS v2u*)(st + r32 * OST_PITCH + (32 + 8 * a + 4 * hi) * 2) = (v2u){cvt_pk_bf16(o1[4 * a] * inv, o1[4 * a + 1] * inv), cvt_pk_bf16(o1[4 * a + 2] * inv, o1[4 * a + 3] * inv)}; }
    LDS_WAIT(); asm volatile("" ::: "memory");
#pragma unroll
    for (int i = 0; i < 4; ++i) { const int idx = lane + 64 * i, row = idx >> 3, c = idx & 7;
        const v4u v = *(const LAS v4u*)(st + row * OST_PITCH + c * 16);
        *(GAS v4u*)(obase + (size_t)row * opitch + c * 8) = v; }
    LDS_WAIT(); asm volatile("" ::: "memory");
}
template <bool OUT8 = false  >
__device__ __forceinline__ void mem_unit(LAS unsigned char* lds, const bf16* Q, int qpitch, const bf16* Kg, const bf16* Vg, bf16* O, int tid) {
    const int lane = tid & 63, wid = __builtin_amdgcn_readfirstlane(tid >> 6), r32 = lane & 31, hi = lane >> 5;
    att_stage(lds, Kg, 512, Vg, 2048, tid);
    float qv[4][8]; bf16x8 qf[4];
    att_load_q(Q + (size_t)(wid * 32 + r32) * qpitch + hi * 8, qv, qf);
    __syncthreads();
    f32x16 o0, o1; float l = 0.f;
#pragma unroll
    for (int r = 0; r < 16; ++r) { o0[r] = 0.f; o1[r] = 0.f; }
    att_block<0>(lds, qf, o0, o1, l, 4, 0, false, lane);
    if constexpr (OUT8) att_store_o<true>(lds, (bf16*)((unsigned char*)O + (size_t)(wid * 32) * 1024), 1024, o0, o1, l, lane, wid);
    else att_store_o(lds, O + (size_t)(wid * 32) * 1024, 1024, o0, o1, l, lane, wid);
    __syncthreads();
}
__device__ __forceinline__ void moba_unit(LAS unsigned char* lds, int b, int qh, int qblk, const bf16* KQ, const bf16* VT, const float* KMEANS, bf16* CAT, int tid) {
    const int lane = tid & 63, wid = __builtin_amdgcn_readfirstlane(tid >> 6), r32 = lane & 31, hi = lane >> 5, kvh = qh / 3;
    const size_t tok0 = (size_t)b * SEQ + (size_t)qblk * 256;
    att_stage(lds, KQ + tok0 * 1280 + kvh * 64, 1280, VT + (size_t)(kvh * 64) * T + tok0, T, tid);
    float qv[4][8]; bf16x8 qf[4];
    att_load_q(KQ + (tok0 + wid * 32 + r32) * 1280 + 256 + qh * 64 + hi * 8, qv, qf);
    unsigned sel = 0u;
    if (qblk > 0) {
        float gt[7];
#pragma unroll
        for (int j = 0; j < 7; ++j) { gt[j] = -3e38f;
            if (j < qblk) { const float* km = KMEANS + (size_t)((b * 4 + kvh) * 8 + j) * 64 + hi * 8; float a = 0.f;
#pragma unroll
                for (int d0 = 0; d0 < 4; ++d0) { const f32x4 k0 = *(const GAS f32x4*)(km + d0 * 16), k1 = *(const GAS f32x4*)(km + d0 * 16 + 4);
                    a += qv[d0][0] * k0[0] + qv[d0][1] * k0[1] + qv[d0][2] * k0[2] + qv[d0][3] * k0[3] + qv[d0][4] * k1[0] + qv[d0][5] * k1[1] + qv[d0][6] * k1[2] + qv[d0][7] * k1[3]; }
                a += __shfl_xor(a, 32); gt[j] = a; } }
#pragma unroll
        for (int j = 0; j < 7; ++j) { int rank = 0;
#pragma unroll
            for (int j2 = 0; j2 < 7; ++j2) if (j2 != j) rank += (gt[j2] > gt[j] || (gt[j2] == gt[j] && j2 < j)) ? 1 : 0;
            if (j < qblk && rank < 3) sel |= 1u << j; }
    }
    __syncthreads();
    f32x16 o0, o1; float l = 0.f;
#pragma unroll
    for (int r = 0; r < 16; ++r) { o0[r] = 0.f; o1[r] = 0.f; }
    att_block<1>(lds, qf, o0, o1, l, (wid >> 1) + 1, wid * 32 + r32, false, lane);
    for (int j = 0; j < qblk; ++j) {
        __syncthreads();
        { const size_t tk = (size_t)b * SEQ + (size_t)j * 256; att_stage(lds, KQ + tk * 1280 + kvh * 64, 1280, VT + (size_t)(kvh * 64) * T + tk, T, tid); }
        __syncthreads();
        const bool off = !((sel >> j) & 1u);
        if (!__all(off)) att_block<2>(lds, qf, o0, o1, l, 4, 0, off, lane);
    }
    att_store_o<true>(lds, (bf16*)((unsigned char*)CAT + (size_t)(tok0 + wid * 32) * 1024 + qh * 64), 1024, o0, o1, l, lane, wid);
    __syncthreads();
}

struct Args { const float* in[42]; float* out; unsigned char* ws; int ph_lo, ph_hi; };
constexpr int NPHASE = 21;
__global__ void __launch_bounds__(NTHREADS, 2) fwd_kernel(Args args) {
    extern __shared__ __attribute__((aligned(16))) unsigned char lds_raw[];
    LAS unsigned char* lds = (LAS unsigned char*)lds_raw;
    volatile LAS unsigned* MISC = (volatile LAS unsigned*)(lds + MISC_OFF);
    const int tid = threadIdx.x, lane = tid & 63, wave = __builtin_amdgcn_readfirstlane(tid >> 6);
    const int G = gridDim.x, bx = blockIdx.x;
    const int gw = bx * NWAVES + wave, NGW = G * NWAVES;
    unsigned char* ws = args.ws;
    gu32* ctl = (gu32*)(ws + WS_CTL);
    for (int u = tid; u < (LDS_BYTES - RING_BYTES) / 4; u += NTHREADS) ((LAS unsigned*)(lds + RING_BYTES))[u] = 0u;
    __syncthreads();
    const int lo = args.ph_lo, hi_ph = args.ph_hi;
    XcdBarrier bar; bar.bar = (unsigned*)(ctl + CW_BAR); bar.x = 0; bar.st = nullptr;
    if (hi_ph - lo > 1) bar = xcd_barrier_post((unsigned*)(ctl + CW_BAR), MISC + 8);
#define IN(k) (lo <= (k) && (k) < hi_ph)
#define SEAM(k) do { if (IN(k) && IN((k) + 1)) xcd_barrier(bar); } while (0)
    const float* const* in = args.in;
    float* OUT = args.out;
    bf16* W_MEMK = (bf16*)(ws + WS_WMEMK); bf16* W_MEMV = (bf16*)(ws + WS_WMEMV); bf16* W_KQ = (bf16*)(ws + WS_WKQ); bf16* W_V = (bf16*)(ws + WS_WV); bf16* W_OUT1 = (bf16*)(ws + WS_WOUT1);
    bf16* W_MGU = (bf16*)(ws + WS_WMGU); bf16* W_MD = (bf16*)(ws + WS_WMD);
    bf16* XB = (bf16*)(ws + WS_XB); bf16* CAT = (bf16*)(ws + WS_CAT); bf16* MEMN = (bf16*)(ws + WS_MEMN); bf16* MEMK = (bf16*)(ws + WS_MEMK); bf16* MEMVT = (bf16*)(ws + WS_MEMVT);
    bf16* XS = (bf16*)(ws + AR_XS); bf16* ACTM = (bf16*)(ws + AR_ACTM);
    bf16* W_IN0 = (bf16*)(ws + AR_WIN0); bf16* W_GLU = (bf16*)(ws + AR_WGLU); bf16* W_OUT0 = (bf16*)(ws + AR_WOUT0); bf16* W_FGU = (bf16*)(ws + AR_WFGU); bf16* W_FD = (bf16*)(ws + AR_WFD);
    bf16* TZ = (bf16*)(ws + AR_TZ); bf16* W1T = (bf16*)(ws + AR_W1T); bf16* UG = (bf16*)(ws + AR_UG); bf16* QM0 = (bf16*)(ws + AR_QM0); float* XC = (float*)(ws + AR_XC); bf16* GACT = (bf16*)(ws + AR_GACT);
    unsigned char* X8 = ws + AR_X8;
    float* S5SM = (float*)(ws + AR_S5SM);
    bf16* ACT0 = (bf16*)(ws + AR_ACT0); bf16* KQ = (bf16*)(ws + AR_KQ); bf16* VT = (bf16*)(ws + AR_VT);
    float* KMEANS = (float*)(ws + SM_KMEANS); float* LAM32 = (float*)(ws + SM_LAM32); int* PANEND = (int*)(ws + SM_PANEND);
    int* WGCNT = (int*)(ws + WS_MEMN + 3 * MiB);
    float* SS = (float*)(ws + WS_MEMN); float* ROWRS = (float*)(ws + WS_MEMN + MiB); float* TOKRS = (float*)(ws + WS_MEMN + 2 * MiB);
    int* TOKE = (int*)(ws + SM_TOKE); int* TOKLP = (int*)(ws + SM_TOKLP); float* TOKG = (float*)(ws + SM_TOKG); int* ROWTOK = (int*)(ws + SM_ROWTOK); float* ROWGATE = (float*)(ws + SM_ROWGATE);

    constexpr int I_SQ = 16 * 16, I_GLU = 12 * 12, I_M = 16 * 4, I_F = 16 * 44, I_FD = 44 * 16;
    constexpr int CVT_P0_END = I_SQ + 4 * I_M, CVT_P2_END = CVT_P0_END + I_GLU + 3 * I_SQ + 2 * I_M, NITEMS = CVT_P2_END + 2 * I_F + I_FD;
    static_assert(NITEMS == 4 * I_SQ + I_GLU + 6 * I_M + 2 * I_F + I_FD, "items");
#define CV_F8(NI, SRC, LDW, NPB, GAIN, DST, LDO, ROW0) if (r < (NI)) { const int kb = r / (NPB), n0 = (r % (NPB)) * 64; CvtDesc8 d; d.src = (SRC) + (size_t)(kb * 64) * (LDW) + n0; d.gain = (GAIN); d.dst = (unsigned char*)(DST) + (size_t)((ROW0) + n0) * (LDO) + kb * 64; d.ldw = (LDW); d.ldo = (LDO); d.k0 = kb * 64; \
                f32x4 a[4][4]; float gq[4][4]; cvt_load8(d, a, gq, MOE_WSCALE, lane); cvt_emit8(d, a, gq, scr, lane); continue; } r -= (NI);
#define CV_PLAIN(NI, SRC, LDW, NPB, GAIN, DST, LDO, ROW0) if (r < (NI)) { const int kb = r / (NPB), n0 = (r % (NPB)) * 64; cvt_item(SRC, LDW, kb * 64, n0, GAIN, DST, LDO, (ROW0) + n0, scr, lane); continue; } r -= (NI);
#define CVT_RUN(QWORD, LO, HI) do { LAS unsigned* scr = (LAS unsigned*)(lds + wave * 16384); \
        for (;;) { int it0 = 0; if (lane == 0) it0 = (LO) + (int)__hip_atomic_fetch_add((unsigned*)(ctl + CW_QUEUE + (QWORD)), 2u, __ATOMIC_RELAXED, __HIP_MEMORY_SCOPE_AGENT); \
            it0 = __builtin_amdgcn_readfirstlane(it0); \
            if (it0 >= (HI)) break; \
            for (int it = it0; it < it0 + 2 && it < (HI); ++it) { int r = it; \
            CV_PLAIN(I_SQ, in[3], 1024, 16, in[2], W_IN0, 1024, 0) \
            CV_PLAIN(I_M, in[15], 256, 4, in[14], W_MEMK, 1024, 0) \
            CV_PLAIN(I_M, in[32], 256, 4, in[31], W_MEMK, 1024, 256) \
            CV_PLAIN(I_M, in[16], 256, 4, in[14], W_MEMV, 1024, 0) \
            CV_PLAIN(I_M, in[33], 256, 4, in[31], W_MEMV, 1024, 256) \
            CV_PLAIN(I_GLU, in[12], 768, 12, nullptr, W_GLU, 768, 0) \
            CV_PLAIN(I_SQ, in[19], 1024, 16, nullptr, W_OUT0, 1024, 0) \
            CV_F8(I_SQ, in[29], 1024, 16, in[28], W_KQ, 1024, 256) \
            CV_F8(I_M, in[25], 256, 4, in[24], W_KQ, 1024, 0) \
            CV_F8(I_M, in[26], 256, 4, in[24], W_V, 1024, 0) \
            CV_F8(I_SQ, in[36], 1024, 16, nullptr, W_OUT1, 1024, 0) \
            if (r < 2 * I_F) { const int up = r / I_F; r -= up * I_F; const int kb = r / 44, n0 = (r % 44) * 64; \
                cvt_item(in[21 + up], DFF, kb * 64, n0, in[20], W_FGU, 1024, (n0 >> 7) * 256 + (n0 & 127) + up * 128, scr, lane); continue; } \
            r -= 2 * I_F; \
            CV_F8(I_FD, in[23], 1024, 16, nullptr, W_FD, DFF, 0) \
            } } } while (0)
    if (IN(0)) {
        if (bx < 48) s5_tables_small(bx, lds, in[4], in[5], in[6], in[7], in[8], in[9], in[10], S5SM, LAM32, tid);
        CVT_RUN(64, 0, CVT_P0_END);
        for (;;) {
            int r0 = 0; if (lane == 0) r0 = (int)__hip_atomic_fetch_add((unsigned*)(ctl + CW_QUEUE + 192), 16u, __ATOMIC_RELAXED, __HIP_MEMORY_SCOPE_AGENT);
            r0 = __builtin_amdgcn_readfirstlane(r0);
            if (r0 >= T + NB * 256) break;
            for (int mrow = r0; mrow < r0 + 16; ++mrow) { if (mrow < T) rms_row_to_bf16(in[0] + (size_t)mrow * D, XB + (size_t)mrow * D, lane); else rms_row_to_bf16(in[1] + (size_t)(mrow - T) * D, MEMN + (size_t)(mrow - T) * D, lane); } }
        for (int i = bx * NTHREADS + tid; i < 2 * RROWS; i += G * NTHREADS) ROWTOK[i] = -1;
    }
    SEAM(0);
    if (IN(1)) { pg8::Gemm g{XB, W_IN0, 1024, 1024, 1024}; pg8::StaticOrder S; S.init(T / 256, 4, G, bx); pg8::EpiProj0 E{UG, QM0};
        pg8::gemm_phase<pg8::EpiProj0, pg8::StaticOrder, true, true>(lds, g, S, E);
        if (bx < 192) { const int sg = bx >> 2, sq = bx & 3; s5_load(sg, lds, S5SM, in[9], in[10], false, tid); s5_expand_w1t(sg, lds, W1T, sq * 32, sq * 32 + 32, tid); __syncthreads(); } }
    SEAM(1);
    if (IN(2)) {
        if (bx < 96) { pg8::Gemm g{UG, W1T, 640, 512, 512}; pg8::BatchOrder S; S.init(48, 2, 1, 96, bx); pg8::EpiS5a E{XC};
          pg8::gemm_phase<pg8::EpiS5a, pg8::BatchOrder, true, true>(lds, g, S, E);
          if (tid < 256) { const int g = bx >> 1, mt = bx & 1, bl = tid >> 6, p = tid & 63;
            const float lr = LAM32[(g * 64 + p) * 2], li = LAM32[(g * 64 + p) * 2 + 1]; float hr = 0.f, hi_ = 0.f;
            const size_t row0 = (size_t)g * 512 + mt * 256 + bl * 64;
            for (int c = 0; c < 64; ++c) { const float xr = XC[(row0 + c) * 128 + 2 * p], xi = XC[(row0 + c) * 128 + 2 * p + 1];
                *(GAS unsigned*)(UG + (row0 + c) * 640 + 512 + 2 * p) = cvt_pk_bf16(hr, hi_);
                const float nr = lr * hr - li * hi_ + xr, ni = lr * hi_ + li * hr + xi; hr = nr; hi_ = ni; } } }
        else if (bx < 112) { pg8::Gemm g{MEMN, W_MEMK, 1024, 1024, 1024}; pg8::StaticOrder S; S.init(8, 2, 16, bx - 96); pg8::EpiPlain E{MEMK, 512, 0, 0};
          pg8::gemm_phase<pg8::EpiPlain, pg8::StaticOrder, true, true>(lds, g, S, E);
          pg8::Unit u; S.next(0, u); const int layer = u.pn; const float* kg = layer ? in[35] : in[18]; const float* qg = layer ? in[34] : in[17];
          const int c0 = lane * 4, d = c0 & 63; float gk[4];
#pragma unroll
          for (int e = 0; e < 4; ++e) gk[e] = kg[d + e] * qg[d + e];
          for (int rr = 0; rr < 32; ++rr) { bf16* p = MEMK + (size_t)(u.pm * 256 + wave * 32 + rr) * 512 + layer * 256 + c0; const v2u w = *(const GAS v2u*)p;
              float v[4] = {bf_lo(w.x), bf_hi(w.x), bf_lo(w.y), bf_hi(w.y)}; float ss = v[0] * v[0] + v[1] * v[1] + v[2] * v[2] + v[3] * v[3];
              ss += __shfl_xor(ss, 1); ss += __shfl_xor(ss, 2); ss += __shfl_xor(ss, 4); ss += __shfl_xor(ss, 8);
              const float r = 1.f / sqrtf(ss * (1.f / 64.f) + RMS_EPS);
              *(GAS v2u*)p = (v2u){cvt_pk_bf16(v[0] * r * gk[0], v[1] * r * gk[1]), cvt_pk_bf16(v[2] * r * gk[2], v[3] * r * gk[3])}; } }
        else if (bx < 128) { pg8::Gemm g{W_MEMV, MEMN, 1024, 1024, 1024}; pg8::StaticOrder S; S.init(2, 8, 16, bx - 112); pg8::EpiPlain E{MEMVT, 2048, 0, 0};
          pg8::gemm_phase<pg8::EpiPlain, pg8::StaticOrder, true, true>(lds, g, S, E); }
        else { int cur = -1;
          for (int it = (bx - 128) * 3; it < (bx - 128) * 3 + 3; ++it) { const int sg = it >> 3, part = it & 7;
              if (sg != cur) { __syncthreads(); s5_load(sg, lds, S5SM, in[9], in[10], true, tid); cur = sg; }
              s5_expand_tz(sg, lds, TZ, part * 64, part * 64 + 64, tid); }
          __syncthreads();
          CVT_RUN(256, CVT_P0_END, CVT_P2_END); }
    }
    SEAM(2);
    if (IN(4)) {
        if (bx < 192) { pg8::Gemm g{UG, TZ, 640, 640, 640}; pg8::BatchOrder S; S.init(48, 2, 2, 192, bx); pg8::EpiS5c E{UG, in[11], GACT};
            pg8::gemm_phase<pg8::EpiS5c, pg8::BatchOrder, true, true>(lds, g, S, E); }
        for (;;) {
            if (tid == 0) MISC[0] = __hip_atomic_fetch_add((unsigned*)(ctl + CW_QUEUE + 128), 1u, __ATOMIC_RELAXED, __HIP_MEMORY_SCOPE_AGENT);
            __syncthreads();
            const int u = (int)MISC[0];
            __syncthreads();
            if (u >= 256) break;
            const int b = u >> 5, h = (u >> 3) & 3, qt = u & 7; const size_t t0 = (size_t)b * SEQ + qt * 256;
            mem_unit(lds, QM0 + t0 * 256 + h * 64, 256, MEMK + (size_t)(b * 256) * 512 + h * 64, MEMVT + (size_t)(h * 64) * 2048 + b * 256, CAT + t0 * 1024 + 768 + h * 64, tid); }
    }
    SEAM(4);
    if (IN(5)) { pg8::Gemm g{GACT, W_GLU, T, 768, 768, 1}; pg8::StaticOrder S; S.init(T / 256, 3, G, bx); pg8::EpiGlu E{GACT, in[13], CAT};
        pg8::gemm_phase<pg8::EpiGlu, pg8::StaticOrder, true, true>(lds, g, S, E);
        pg8::Unit u0; if (!S.next(0, u0)) CVT_RUN(320, CVT_P2_END, NITEMS); }
    SEAM(5);
    if (IN(6)) { pg8::Gemm g{CAT, W_OUT0, 1024, 1024, 1024}; pg8::StaticOrder S; S.init(T / 256, 4, G, bx); pg8::EpiResidB<true> E{in[0], XB, SS, 1.f, nullptr};
        pg8::gemm_phase<pg8::EpiResidB<true>, pg8::StaticOrder, true, true>(lds, g, S, E); }
    SEAM(6);
    if (IN(8)) {
        pg8::Gemm g{XB, W_FGU, 1024, 1024, 1024}; pg8::EpiSwiglu<1, true> E{ACT0, DFF, 22, 0, SS, MOE_ASCALE};
        const int slot = (bx >> 3) & 3, n1 = (slot == 0) ? 0 : (slot == 1) ? 1 : (slot == 2) ? 3 : 4;
        { pg8::RangeOrder S; S.S.init(T / 256, 22, G, bx); S.i0 = 0; S.i1 = n1; pg8::gemm_phase<pg8::EpiSwiglu<1, true>, pg8::RangeOrder, true, true>(lds, g, S, E); }
        { LAS unsigned* scr = (LAS unsigned*)(lds + wave * 16384);
          constexpr int I_E = (1024 / 64) * (DFE / 64), I_ED = (DFE / 64) * (1024 / 64), I_MOE = NEXP * (2 * I_E + I_ED), SHARE = (I_MOE + 255) / 256;
#define MOE_DESC(D_, IT_) do { int r = (IT_); const int e = r / (2 * I_E + I_ED); r -= e * (2 * I_E + I_ED); \
              if (r < 2 * I_E) { const int up = r / I_E; r -= up * I_E; const int kb = r / (DFE / 64), n0 = (r % (DFE / 64)) * 64; \
                  (D_).src = in[39 + up] + (size_t)e * 1024 * DFE + (size_t)(kb * 64) * DFE + n0; (D_).ldw = DFE; (D_).gain = in[37]; (D_).k0 = kb * 64; (D_).ldo = 1024; \
                  (D_).dst = (unsigned char*)W_MGU + (size_t)(e * 7168 + (n0 >> 7) * 256 + (n0 & 127) + up * 128) * 1024 + kb * 64; } \
              else { r -= 2 * I_E; const int kb = r / 16, n0 = (r % 16) * 64; \
                  (D_).src = in[41] + (size_t)e * DFE * 1024 + (size_t)(kb * 64) * 1024 + n0; (D_).ldw = 1024; (D_).gain = nullptr; (D_).k0 = kb * 64; (D_).ldo = DFE; \
                  (D_).dst = (unsigned char*)W_MD + (size_t)(e * 1024 + n0) * DFE + kb * 64; } } while (0)
          static_assert(SHARE == 84 && I_MOE == 256 * 84, "share sizes");
          const int it_beg = (bx < 128) ? bx * 72 : 128 * 72 + (bx - 128) * 96, it_end = it_beg + ((bx < 128) ? 72 : 96);
          for (int it = it_beg + wave; it < it_end; it += NWAVES) { CvtDesc8 d0; f32x4 a0[4][4]; float g0[4][4]; MOE_DESC(d0, it); cvt_load8_dma(d0, a0, g0, MOE_WSCALE, (LAS unsigned char*)scr, lane); cvt_emit8(d0, a0, g0, scr, lane); }
#undef MOE_DESC
          __syncthreads(); }
        { pg8::RangeOrder S; S.S.init(T / 256, 22, G, bx); S.i0 = n1; S.i1 = 1 << 20; pg8::gemm_phase<pg8::EpiSwiglu<1, true>, pg8::RangeOrder, true, true>(lds, g, S, E); }
    }
    SEAM(8);
    if (IN(9)) { pg8::Gemm g{ACT0, W_FD, DFF / 2, DFF / 2, DFF / 2}; pg8::StaticOrder S; S.init(T / 256, 4, G, bx); pg8::EpiResidB<false, true> E{nullptr, XB, SS, 1.f / (MOE_WSCALE * MOE_ASCALE), X8};
        pg8::gemm_phase<pg8::EpiResidB<false, true>, pg8::StaticOrder, true, true, true>(lds, g, S, E); }
    SEAM(9);
    if (IN(11)) {
        { pg8::Gemm g{(bf16*)X8, W_KQ, 512, 512, 512}; pg8::StaticOrder S; S.init(T / 256, 5, G, bx); pg8::EpiPlainS<1> E{KQ, 1280, 0, 0, SS, 1.f / (MOE_WSCALE * 8.f)};
          pg8::gemm_phase<pg8::EpiPlainS<1>, pg8::StaticOrder, true, true, true>(lds, g, S, E);
          pg8::Unit u;
          for (int i = 0; S.next(i, u); ++i) if (u.pn == 0) {
            const int b = u.pm >> 3, blk = u.pm & 7; const size_t t0 = (size_t)u.pm * 256;
            const int c0 = lane * 4, d = c0 & 63; float gk[4], cs[4] = {0.f, 0.f, 0.f, 0.f};
#pragma unroll
            for (int e = 0; e < 4; ++e) gk[e] = in[27][d + e] * in[30][d + e];
            for (int rr = 0; rr < 32; ++rr) { bf16* p = KQ + (t0 + wave * 32 + rr) * 1280 + c0; const v2u w = *(const GAS v2u*)p;
                float v[4] = {bf_lo(w.x), bf_hi(w.x), bf_lo(w.y), bf_hi(w.y)}; float ss = v[0] * v[0] + v[1] * v[1] + v[2] * v[2] + v[3] * v[3];
                ss += __shfl_xor(ss, 1); ss += __shfl_xor(ss, 2); ss += __shfl_xor(ss, 4); ss += __shfl_xor(ss, 8);
                const float r = 1.f / sqrtf(ss * (1.f / 64.f) + RMS_EPS);
#pragma unroll
                for (int e = 0; e < 4; ++e) { v[e] *= r * gk[e]; cs[e] += v[e]; }
                *(GAS v2u*)p = (v2u){cvt_pk_bf16(v[0], v[1]), cvt_pk_bf16(v[2], v[3])}; }
            LAS float* red = (LAS float*)lds;
#pragma unroll
            for (int e = 0; e < 4; ++e) red[wave * 256 + c0 + e] = cs[e];
            __syncthreads();
            if (tid < 256) { float sm = 0.f;
#pragma unroll
                for (int w = 0; w < 8; ++w) sm += red[w * 256 + tid];
                KMEANS[(size_t)((b * 4 + (tid >> 6)) * 8 + blk) * 64 + (tid & 63)] = sm * (1.f / 256.f); }
            __syncthreads(); } }
        { pg8::Gemm g{W_V, (bf16*)X8, 512, 512, 512}; pg8::StaticOrder S; S.init(1, T / 256, 64, bx - 64); pg8::EpiPlainS<2> E{VT, T, 0, 0, SS, 1.f / (MOE_WSCALE * 8.f)};
          if (bx >= 64) pg8::gemm_phase<pg8::EpiPlainS<2>, pg8::StaticOrder, true, true, true>(lds, g, S, E); }
    }
    SEAM(11);

    if (IN(13)) {
        for (;;) {
            if (tid == 0) MISC[0] = __hip_atomic_fetch_add((unsigned*)(ctl + CW_QUEUE), 1u, __ATOMIC_RELAXED, __HIP_MEMORY_SCOPE_AGENT);
            __syncthreads();
            const int it = (int)MISC[0];
            __syncthreads();
            if (it >= 1024) break;
            if (it < 768) { const int qblk = 7 - it / 96, r = it % 96; moba_unit(lds, r / 12, r % 12, qblk, KQ, VT, KMEANS, CAT, tid); }
            else { const int u = it - 768, b = u >> 5, h = (u >> 3) & 3, qt = u & 7; const size_t t0 = (size_t)b * SEQ + qt * 256;
                mem_unit<true>(lds, KQ + t0 * 1280 + 1024 + h * 64, 1280, MEMK + (size_t)(b * 256) * 512 + 256 + h * 64, MEMVT + (size_t)(256 + h * 64) * 2048 + b * 256, (bf16*)((unsigned char*)CAT + t0 * 1024 + 768 + h * 64), tid); }
        }
    }
    SEAM(13);
    if (IN(14)) { pg8::Gemm g{CAT, W_OUT1, 512, 512, 512}; pg8::StaticOrder S; S.init(T / 256, 4, G, bx); pg8::EpiResidB<false> E{nullptr, XB, SS, 1.f / (MOE_WSCALE * 8.f), nullptr};
        pg8::gemm_phase<pg8::EpiResidB<false>, pg8::StaticOrder, true, true, true>(lds, g, S, E); }
    SEAM(14);
    if (IN(15)) {
        LAS float* wrt = (LAS float*)lds;
        LAS int* el = (LAS int*)(lds + 32768);
        for (int i = tid; i < 8192; i += NTHREADS) { const int k = i >> 3, e = i & 7; wrt[e * 1024 + k] = in[37][k] * in[38][i]; }
        __syncthreads();
        const int tpw = T / G;
        for (int tl = wave; tl < tpw; tl += NWAVES) { const int t = bx * tpw + tl;
            const GAS v2u* xr = (const GAS v2u*)(XB + (size_t)t * D) + lane; f32x4 v[4]; float s = 0.f;
#pragma unroll
            for (int j = 0; j < 4; ++j) { const v2u w = xr[64 * j]; v[j] = (f32x4){bf_lo(w.x), bf_hi(w.x), bf_lo(w.y), bf_hi(w.y)}; s += (v[j].x * v[j].x + v[j].y * v[j].y) + (v[j].z * v[j].z + v[j].w * v[j].w); }
            const float r = 1.f / sqrtf(wave_sum(s) * (1.f / 1024.f) + RMS_EPS);
#pragma unroll
            for (int j = 0; j < 4; ++j) v[j] = v[j] * r;
            float lg[8];
#pragma unroll
            for (int e = 0; e < 8; ++e) { float a = 0.f;
#pragma unroll
                for (int j = 0; j < 4; ++j) { const f32x4 w = *(const LAS f32x4*)(wrt + e * 1024 + 256 * j + 4 * lane); a += v[j].x * w.x + v[j].y * w.y + v[j].z * w.z + v[j].w * w.w; }
                lg[e] = wave_sum(a); }
            int i0 = 0; float v0 = lg[0];
#pragma unroll
            for (int e = 1; e < 8; ++e) if (lg[e] > v0) { v0 = lg[e]; i0 = e; }
            int i1 = -1; float v1 = -3e38f;
#pragma unroll
            for (int e = 0; e < 8; ++e) if (e != i0 && lg[e] > v1) { v1 = lg[e]; i1 = e; }
            const float e1 = __expf(v1 - v0), g0 = 1.f / (1.f + e1), g1 = e1 * g0;
            if (lane == 0) { el[tl] = i0 * 8 + i1; TOKE[2 * t] = i0; TOKE[2 * t + 1] = i1; TOKG[2 * t] = g0; TOKG[2 * t + 1] = g1; TOKRS[t] = r; } }
        __syncthreads();
        if (tid < tpw) { const int pd = el[tid]; int lp = 0; for (int j = 0; j < tid; ++j) lp += (el[j] == pd) ? 1 : 0; TOKLP[(size_t)bx * tpw + tid] = lp; }
        if (tid >= 64 && tid < 128) { const int pd = tid - 64; int n = 0; for (int j = 0; j < tpw; ++j) n += (el[j] == pd) ? 1 : 0; WGCNT[bx * 64 + pd] = n; }
        __syncthreads();
    }
    SEAM(15);
    if (IN(16)) {
        LAS int* tab = (LAS int*)lds; LAS int* Cp = tab + 16384; LAS int* PRE = Cp + 64; LAS int* Fp = PRE + 64; LAS int* bAu = Fp + 64; LAS int* bAf = bAu + 64; LAS int* bBu = bAf + 64; LAS int* bBf = bBu + 64;
        LAS int* offA = bBf + 64; LAS int* offB = offA + 8; LAS int* UA = offB + 8; LAS int* VB = UA + 8;
        for (int i = tid; i < G * 64; i += NTHREADS) tab[i] = WGCNT[i];
        __syncthreads();
        if (tid < 64) { int tot = 0, pre = 0; for (int w = 0; w < G; ++w) { const int v = tab[w * 64 + tid]; if (w < bx) pre += v; tot += v; } Cp[tid] = tot; PRE[tid] = pre; Fp[tid] = 0; }
        __syncthreads();
        if (tid == 0) {
            int n0[8], rr[8], sup[8], dem[8]; int srem = 0;
            for (int e = 0; e < 8; ++e) { int n = 0; for (int b2 = 0; b2 < 8; ++b2) n += Cp[e * 8 + b2]; n0[e] = n; rr[e] = n & 255; srem += rr[e]; sup[e] = rr[e]; dem[e] = 0; }
            const int mup = srem >> 8;
            for (int it = 0; it < mup; ++it) { int be = -1, bv = -1; for (int e = 0; e < 8; ++e) if (dem[e] == 0 && sup[e] > bv) { bv = sup[e]; be = e; }
                if (be >= 0) { dem[be] = 256 - rr[be]; sup[be] = 0; } }
            for (int a = 0; a < 8; ++a) for (int b2 = 0; b2 < 8; ++b2) if (a != b2 && sup[a] > 0 && dem[b2] > 0) { int f = sup[a] < dem[b2] ? sup[a] : dem[b2]; if (Cp[a * 8 + b2] < f) f = Cp[a * 8 + b2];
                Fp[a * 8 + b2] = f; sup[a] -= f; dem[b2] -= f; }
            int oa = 0, ob = 0;
            for (int e = 0; e < 8; ++e) { int ua = 0, vb = 0, fin = 0, fout = 0;
                for (int x = 0; x < 8; ++x) { ua += Cp[e * 8 + x] - Fp[e * 8 + x]; vb += Cp[x * 8 + e] - Fp[x * 8 + e]; fin += Fp[x * 8 + e]; fout += Fp[e * 8 + x]; }
                UA[e] = ua; VB[e] = vb; offA[e] = oa * 256; offB[e] = ob * 256; oa += (ua + fin + 255) >> 8; ob += (vb + fout + 255) >> 8;
                if (bx == 0) { PANEND[e] = oa; PANEND[8 + e] = ob; } }
        }
        __syncthreads();
        if (tid < 64) { const int a = tid >> 3, b2 = tid & 7; int s1 = 0, s2 = 0, s3 = 0, s4 = 0;
            for (int x = 0; x < b2; ++x) { s1 += Cp[a * 8 + x] - Fp[a * 8 + x]; s4 += Fp[a * 8 + x]; }
            for (int x = 0; x < a; ++x) { s2 += Fp[x * 8 + b2]; s3 += Cp[x * 8 + b2] - Fp[x * 8 + b2]; }
            bAu[tid] = offA[a] + s1 - Fp[tid]; bAf[tid] = offA[b2] + UA[b2] + s2; bBu[tid] = offB[b2] + s3 - Fp[tid]; bBf[tid] = offB[a] + VB[a] + s4; }
        __syncthreads();
        const int tpw = T / G;
        for (int tl = wave; tl < tpw; tl += NWAVES) { const int t = bx * tpw + tl;
            const int pd = TOKE[2 * t] * 8 + TOKE[2 * t + 1], q = PRE[pd] + TOKLP[(size_t)bx * tpw + tl]; const bool fl = q < Fp[pd];
            const int rowA = q + (fl ? bAf[pd] : bAu[pd]), rowB = q + (fl ? bBf[pd] : bBu[pd]);
            const float rs_ = TOKRS[t];
            if (lane == 0) { ROWTOK[rowA] = t; ROWGATE[rowA] = TOKG[2 * t + (fl ? 1 : 0)]; ROWRS[rowA] = rs_;
                             ROWTOK[RROWS + rowB] = t; ROWGATE[RROWS + rowB] = TOKG[2 * t + (fl ? 0 : 1)]; ROWRS[RROWS + rowB] = rs_; }
            const GAS v4u* src = (const GAS v4u*)(XB + (size_t)t * D);
            GAS v2u* dA = (GAS v2u*)((unsigned char*)XS + (size_t)rowA * D); GAS v2u* dB = (GAS v2u*)((unsigned char*)XS + ((size_t)RROWS + rowB) * D);
#pragma unroll
            for (int h = 0; h < 2; ++h) { const v4u w = src[64 * h + lane];
                const v2u o = (v2u){pg8::pk4_fp8(bf_lo(w.x) * rs_, bf_hi(w.x) * rs_, bf_lo(w.y) * rs_, bf_hi(w.y) * rs_), pg8::pk4_fp8(bf_lo(w.z) * rs_, bf_hi(w.z) * rs_, bf_lo(w.w) * rs_, bf_hi(w.w) * rs_)};
                dA[64 * h + lane] = o; dB[64 * h + lane] = o; } }
        __syncthreads();
    }
    SEAM(16);
#define MOE_ROUND(PH, KK, FIRST_) \
    if (IN(PH)) { pg8::GroupOrder S; for (int e = 0; e < 8; ++e) S.pe[e] = PANEND[(KK) * 8 + e]; S.npe = 28; S.S.init(S.pe[7], 28, G, bx); \
        pg8::Gemm g{XS + (size_t)(KK) * RROWS * (D / 2), W_MGU, 512, 512, 512}; pg8::EpiSwigluF8 E{(unsigned char*)ACTM + (size_t)(KK) * RROWS * DFE, DFE, 28, 0, 1.f / MOE_WSCALE, MOE_ASCALE}; \
        pg8::gemm_phase<pg8::EpiSwigluF8, pg8::GroupOrder, true, true, true>(lds, g, S, E); } \
    SEAM(PH); \
    if (IN((PH) + 1)) { volatile LAS unsigned* tb = MISC + 16; \
        if (tid < 8) tb[tid] = (unsigned)PANEND[(KK) * 8 + tid]; \
        if (tid == 8) { const int npan = PANEND[(KK) * 8 + 7]; const int nun = npan * 4, tl = nun - G; \
            tb[8] = (unsigned)nun; tb[9] = (tl <= G / 4) ? 4u : (tl <= G / 2) ? 2u : 1u; tb[10] = (unsigned)npan; tb[11] = (unsigned)bx; tb[12] = 8u; tb[13] = 4u; tb[14] = (unsigned)(DFE / 128); tb[15] = (unsigned)G; \
            const unsigned long long sl = (unsigned long long)((KK) == 0 ? (unsigned char*)CAT : (unsigned char*)XS + 36 * MiB), fl = (unsigned long long)(unsigned*)(ctl + CW_SKFLAG + (KK) * 256 * 64); \
            tb[16] = (unsigned)sl; tb[17] = (unsigned)(sl >> 32); tb[18] = (unsigned)fl; tb[19] = (unsigned)(fl >> 32); } \
        __syncthreads(); \
        pg8::GroupStream S; S.tab = (const LAS unsigned*)(lds + MISC_OFF + 64); \
        pg8::Gemm g{ACTM + (size_t)(KK) * RROWS * (DFE / 2), W_MD, DFE / 2, DFE / 2, DFE / 2}; pg8::EpiMoeDown<FIRST_> E{OUT, ROWTOK + (KK) * RROWS, ROWGATE + (KK) * RROWS, 0, XB, 1.f / (MOE_WSCALE * MOE_ASCALE)}; \
        pg8::gemm_phase<pg8::EpiMoeDown<FIRST_>, pg8::GroupStream, true, true, true>(lds, g, S, E); }
    MOE_ROUND(17, 1, true)
    MOE_ROUND(19, 0, false)

#undef IN
#undef SEAM
}

extern "C" void kernel_launch(void* const* d_in, const int* in_sizes, int n_in, void* d_out, int out_size, void* d_ws, size_t ws_size, hipStream_t stream) {
    static int grid = 0;
    if (grid == 0) {
        if (n_in != 42 || in_sizes[0] != T * D || out_size != T * D || ws_size < WS_END) { fprintf(stderr, "kernel_launch: unexpected shapes (n_in %d, in0 %d, out %d, ws %zu < %zu); nothing launched\n", n_in, n_in > 0 ? in_sizes[0] : -1, out_size, ws_size, (size_t)WS_END); grid = -1; return; }
        int dev = 0, cus = 0, per_cu = 0;
        if (hipGetDevice(&dev) != hipSuccess || hipDeviceGetAttribute(&cus, hipDeviceAttributeMultiprocessorCount, dev) != hipSuccess) { grid = -1; return; }
        if (hipFuncSetAttribute((const void*)fwd_kernel, hipFuncAttributeMaxDynamicSharedMemorySize, LDS_BYTES) != hipSuccess) { fprintf(stderr, "kernel_launch: hipFuncSetAttribute failed\n"); grid = -1; return; }
        if (hipOccupancyMaxActiveBlocksPerMultiprocessor(&per_cu, (const void*)fwd_kernel, NTHREADS, LDS_BYTES) != hipSuccess || per_cu < 1) { fprintf(stderr, "kernel_launch: occupancy query reports %d\n", per_cu); }
        (void)hipGetLastError();
        grid = 256;
        if (cus < 256) { fprintf(stderr, "kernel_launch: device has %d CUs, need 256\n", cus); grid = -1; return; }
    }
    if (grid < 0) return;
    if (hipMemsetAsync((char*)d_ws + WS_CTL, 0, CTL_ZERO_BYTES, stream) != hipSuccess) return;
    Args a{};
    for (int i = 0; i < 42; ++i) a.in[i] = (const float*)d_in[i];
    a.out = (float*)d_out; a.ws = (unsigned char*)d_ws;
#ifdef MK_SPLIT
    for (int p = 0; p < NPHASE; ++p) { a.ph_lo = p; a.ph_hi = p + 1; hipLaunchKernelGGL(fwd_kernel, dim3(grid), dim3(NTHREADS), LDS_BYTES, stream, a); }
#else
#ifndef STOP_AFTER
#define STOP_AFTER (NPHASE - 1)
#endif
    a.ph_lo = 0; a.ph_hi = STOP_AFTER + 1;
    hipLaunchKernelGGL(fwd_kernel, dim3(grid), dim3(NTHREADS), LDS_BYTES, stream, a);
#endif
}
```

```cpp
#include <hip/hip_runtime.h>
#include <cstdio>
#include <cstdint>

namespace pg8 {
#define PG8_LAS __attribute__((address_space(3)))
typedef unsigned short bf16_t;
typedef short bf16x8 __attribute__((ext_vector_type(8)));
typedef float f32x4 __attribute__((ext_vector_type(4)));
typedef unsigned u32x4 __attribute__((ext_vector_type(4)));
constexpr int BM = 256, BK = 64, HALF = 128, HTB = HALF * BK * 2  , STAGE_BYTES = 8 * HTB, NXCD = 8, WGM = 4;

__host__ __device__ __forceinline__ int lds_byte(int r, int c) { const int st = (r >> 4) * 2 + (c >> 5), rr = r & 15, cc = c & 31, ob = rr * 64 + cc * 2; return st * 1024 + (ob ^ (((ob >> 9) & 1) << 5)); }
__host__ __device__ __forceinline__ void stage_rc(int b, int& R, int& C) { const int st = b / 1024, sb = b % 1024, swz = sb ^ (((sb >> 9) & 1) << 5); R = (st >> 1) * 16 + swz / 64; C = (st & 1) * 32 + (swz % 64) / 2; }
__host__ __device__ __forceinline__ int perm32(int rho) { const int n = rho >> 4, i = rho & 15; return 8 * (i >> 2) + 4 * n + (i & 3); }

struct Unit { int pm, pn; int k0, nk, part; };
struct Gemm { const bf16_t* A; const bf16_t* Bt; int lda, ldb, K; int amode = 0; };

struct StaticOrder {
    static constexpr bool STREAMK = false;
    int nM, nN, nwg, G, c;
    __host__ __device__ __forceinline__ void init(int nM_, int nN_, int G_, int c_) { nM = nM_; nN = nN_; nwg = nM * nN; G = G_; c = c_; }
    __host__ __device__ __forceinline__ bool next(int i, Unit& u) const {
        const long L = (long)i * G + c; if (L >= nwg || c >= G) return false;
        u.k0 = 0; u.nk = 0; u.part = 0; map((int)L, u); return true;
    }
    __host__ __device__ __forceinline__ void map(int L, Unit& u) const {
        int wgid = L; { const int q = nwg / NXCD, r = nwg % NXCD, xcd = wgid % NXCD, off = wgid / NXCD; wgid = (xcd < r ? xcd * (q + 1) : r * (q + 1) + (xcd - r) * q) + off; }
        const int nig = WGM * nN, gid = wgid / nig, fm = gid * WGM, gsz = (nM - fm) < WGM ? (nM - fm) : WGM;
        u.pm = fm + ((wgid % nig) % gsz); u.pn = (wgid % nig) / gsz;
    }
};
struct RangeOrder {
    static constexpr bool STREAMK = false;
    StaticOrder S; int i0, i1;
    __host__ __device__ __forceinline__ bool next(int i, Unit& u) const { return (i0 + i < i1) && S.next(i0 + i, u); }
};
struct BatchOrder {
    static constexpr bool STREAMK = false;
    int nunits, tm, tn, G, c;
    __host__ __device__ __forceinline__ void init(int nb, int tm_, int tn_, int G_, int c_) { tm = tm_; tn = tn_; nunits = nb * tm * tn; G = G_; c = c_; }
    __host__ __device__ __forceinline__ bool next(int i, Unit& u) const {
        const int L = i * G + c; if (L >= nunits || c >= G) return false;
        const int b = L / (tm * tn), r = L % (tm * tn); u.pm = b * tm + r / tn; u.pn = b * tn + r % tn; u.k0 = 0; u.nk = 0; u.part = 0; return true;
    }
};
struct GroupOrder {
    static constexpr bool STREAMK = false;
    StaticOrder S; int npe; int pe[8];
    __host__ __device__ __forceinline__ bool next(int i, Unit& u) const {
        if (!S.next(i, u)) return false;
        int e = 0;
#pragma unroll
        for (int k = 0; k < 7; ++k) e += (u.pm >= pe[k]) ? 1 : 0;
        u.pn += e * npe; return true;
    }
};

typedef float f32x2_t __attribute__((ext_vector_type(2))); typedef __bf16 bf16x2_t __attribute__((ext_vector_type(2)));
struct GroupStream {
    static constexpr bool STREAMK = true;
    const PG8_LAS unsigned* tab;
    __device__ __forceinline__ int c() const { return (int)tab[11]; }
    __device__ __forceinline__ int split() const { return (int)tab[9]; }
    __device__ __forceinline__ unsigned target() const { return tab[12]; }
    __device__ __forceinline__ unsigned long long* slots() const { return (unsigned long long*)(((unsigned long long)tab[17] << 32) | tab[16]); }
    __device__ __forceinline__ unsigned* flags() const { return (unsigned*)(((unsigned long long)tab[19] << 32) | tab[18]); }
    __device__ __forceinline__ bool next(int i, Unit& u) const {
        const int nunits = (int)tab[8], sp = (int)tab[9], npe = (int)tab[13], ntk = (int)tab[14], G = (int)tab[15], c_ = (int)tab[11];
        int L, k0 = 0, nk = ntk, part = 0;
        if (i == 0) { L = c_; if (L >= nunits) return false; }
        else if (i == 1) { const int j = c_ / sp, p = c_ % sp; L = G + j; if (L >= nunits) return false; const int base = (ntk / sp) & ~1, xh = (ntk - sp * base) >> 1; nk = base + (p < xh ? 2 : 0); k0 = p * base + 2 * (p < xh ? p : xh); part = (sp == 1) ? 0 : (p == 0 ? 1 : 2); }
        else return false;
        StaticOrder S; S.init((int)tab[10], npe, 1, 0); S.map(L, u); int e = 0;
#pragma unroll
        for (int k = 0; k < 7; ++k) e += (u.pm >= (int)tab[k]) ? 1 : 0;
        u.pn += e * npe; u.k0 = k0; u.nk = nk; u.part = part; return true;
    }
};
constexpr int SK_SLOT_WORDS = 32 * 512;

__device__ __forceinline__ unsigned cvt_pk_bf16(float lo, float hi) { f32x2_t v = {lo, hi}; bf16x2_t b = __builtin_convertvector(v, bf16x2_t); return __builtin_bit_cast(unsigned, b); }
__device__ __forceinline__ float bf_lo(unsigned w) { return __builtin_bit_cast(float, w << 16); }
__device__ __forceinline__ float bf_hi(unsigned w) { return __builtin_bit_cast(float, w & 0xffff0000u); }
__device__ __forceinline__ float fsigmoid(float x) { return __builtin_amdgcn_rcpf(1.f + __builtin_amdgcn_exp2f(-1.4426950408889634f * x)); }
__device__ __forceinline__ float gelu_tanh(float y) { const float z = 0.7978845608028654f * (y + 0.044715f * y * y * y); return y * fsigmoid(2.f * z); }

#define EPI_LOOP_ROWS for (int ai = 0; ai < 2; ++ai) _Pragma("unroll") for (int m = 0; m < 4; ++m)
__device__ __forceinline__ u32x4 pack8(const f32x4& v0, const f32x4& v1) { u32x4 w; w.x = cvt_pk_bf16(v0[0], v0[1]); w.y = cvt_pk_bf16(v0[2], v0[3]); w.z = cvt_pk_bf16(v1[0], v1[1]); w.w = cvt_pk_bf16(v1[2], v1[3]); return w; }

__device__ __forceinline__ float rs_row(const float* SS, int row) {
    const f32x4 a = *(const f32x4*)(SS + (size_t)row * 16), b = *(const f32x4*)(SS + (size_t)row * 16 + 4), c = *(const f32x4*)(SS + (size_t)row * 16 + 8), d = *(const f32x4*)(SS + (size_t)row * 16 + 12);
    const float s = ((a[0] + a[1]) + (a[2] + a[3])) + ((b[0] + b[1]) + (b[2] + b[3])) + ((c[0] + c[1]) + (c[2] + c[3])) + ((d[0] + d[1]) + (d[2] + d[3]));
    return 1.f / __builtin_sqrtf(s * (1.f / 1024.f) + 1e-6f);
}
template <int SCALE  > struct EpiPlainS {
    static constexpr bool PERM = true, AFTER_DRAIN = false;
    bf16_t* O; int ldc; int pm0, pn0; const float* SS; float inv;
    __device__ __forceinline__ void operator()(const f32x4 (&acc)[2][2][4][2], const Unit& u, int wr, int wc, int fr, int fq) const {
        const int row0 = (u.pm - pm0) * BM + wr * 64 + fr, col0 = (u.pn - pn0) * BM + wc * 32 + 8 * fq;
        float cs[2][8];
        if (SCALE == 2) {
#pragma unroll
            for (int bj = 0; bj < 2; ++bj)
#pragma unroll
                for (int e = 0; e < 8; ++e) cs[bj][e] = rs_row(SS, u.pn * BM + bj * HALF + wc * 32 + 8 * fq + e) * inv; }
#pragma unroll
        EPI_LOOP_ROWS { bf16_t* rowp = O + (size_t)(row0 + ai * HALF + m * 16) * ldc + col0; float rs = 1.f; if (SCALE == 1) rs = rs_row(SS, u.pm * BM + wr * 64 + fr + ai * HALF + m * 16) * inv;
#pragma unroll
            for (int bj = 0; bj < 2; ++bj) { f32x4 v0 = acc[ai][bj][m][0], v1 = acc[ai][bj][m][1];
                if (SCALE == 1) { v0 = v0 * rs; v1 = v1 * rs; }
                if (SCALE == 2) { v0 = v0 * (f32x4){cs[bj][0], cs[bj][1], cs[bj][2], cs[bj][3]}; v1 = v1 * (f32x4){cs[bj][4], cs[bj][5], cs[bj][6], cs[bj][7]}; }
                *(u32x4*)(rowp + bj * HALF) = pack8(v0, v1); } }
    }
};
struct EpiPlain {
    static constexpr bool PERM = true, AFTER_DRAIN = false;
    bf16_t* O; int ldc; int pm0, pn0;
    __device__ __forceinline__ void operator()(const f32x4 (&acc)[2][2][4][2], const Unit& u, int wr, int wc, int fr, int fq) const {
        const int row0 = (u.pm - pm0) * BM + wr * 64 + fr, col0 = (u.pn - pn0) * BM + wc * 32 + 8 * fq;
#pragma unroll
        EPI_LOOP_ROWS { bf16_t* rowp = O + (size_t)(row0 + ai * HALF + m * 16) * ldc + col0;
#pragma unroll
            for (int bj = 0; bj < 2; ++bj) *(u32x4*)(rowp + bj * HALF) = pack8(acc[ai][bj][m][0], acc[ai][bj][m][1]); }
    }
};
struct EpiProj0 {
    static constexpr bool PERM = true, AFTER_DRAIN = false;
    bf16_t* UG; bf16_t* QM;
    __device__ __forceinline__ void operator()(const f32x4 (&acc)[2][2][4][2], const Unit& u, int wr, int wc, int fr, int fq) const {
        const int row0 = u.pm * BM + wr * 64 + fr;
#pragma unroll
        EPI_LOOP_ROWS { const int t = row0 + ai * HALF + m * 16;
#pragma unroll
            for (int bj = 0; bj < 2; ++bj) { const int c = u.pn * BM + bj * HALF + wc * 32 + 8 * fq; bf16_t* p;
                if (u.pn < 3) p = UG + ((size_t)((c >> 4) * 512 + (t >> 5))) * 640 + (t & 31) * 16 + (c & 15); else p = QM + (size_t)t * 256 + (c - 768);
                *(u32x4*)p = pack8(acc[ai][bj][m][0], acc[ai][bj][m][1]); } }
    }
};
struct EpiS5a {
    static constexpr bool PERM = true, AFTER_DRAIN = false;
    float* XC;
    __device__ __forceinline__ void operator()(const f32x4 (&acc)[2][2][4][2], const Unit& u, int wr, int wc, int fr, int fq) const {
        const int row0 = u.pm * BM + wr * 64 + fr, col0 = wc * 32 + 8 * fq;
#pragma unroll
        EPI_LOOP_ROWS { float* rowp = XC + (size_t)(row0 + ai * HALF + m * 16) * 128 + col0; *(f32x4*)rowp = acc[ai][0][m][0]; *(f32x4*)(rowp + 4) = acc[ai][0][m][1]; }
    }
};
struct EpiS5c {
    static constexpr bool PERM = true, AFTER_DRAIN = false;
    const bf16_t* UG; const float* dskip; bf16_t* GACT;
    __device__ __forceinline__ void operator()(const f32x4 (&acc)[2][2][4][2], const Unit& u, int wr, int wc, int fr, int fq) const {
        const int row0 = u.pm * BM + wr * 64 + fr, g = u.pm >> 1;
#pragma unroll
        for (int bj = 0; bj < 2; ++bj) { const int col8 = (u.pn & 1) * BM + bj * HALF + wc * 32 + 8 * fq, j = col8 >> 4, nb = col8 & 15;
            const f32x4 d0 = *(const f32x4*)(dskip + g * 16 + nb), d1 = *(const f32x4*)(dskip + g * 16 + nb + 4);
#pragma unroll
            EPI_LOOP_ROWS { const int R = row0 + ai * HALF + m * 16, chunk = R & 511, t = chunk * 32 + j;
                const u32x4 uu = *(const u32x4*)(UG + (size_t)R * 640 + j * 16 + nb);
                f32x4 v0 = acc[ai][bj][m][0], v1 = acc[ai][bj][m][1];
                v0[0] = gelu_tanh(v0[0] + d0[0] * bf_lo(uu.x)); v0[1] = gelu_tanh(v0[1] + d0[1] * bf_hi(uu.x)); v0[2] = gelu_tanh(v0[2] + d0[2] * bf_lo(uu.y)); v0[3] = gelu_tanh(v0[3] + d0[3] * bf_hi(uu.y));
                v1[0] = gelu_tanh(v1[0] + d1[0] * bf_lo(uu.z)); v1[1] = gelu_tanh(v1[1] + d1[1] * bf_hi(uu.z)); v1[2] = gelu_tanh(v1[2] + d1[2] * bf_lo(uu.w)); v1[3] = gelu_tanh(v1[3] + d1[3] * bf_hi(uu.w));
                *(u32x4*)(GACT + ((size_t)g * 16384 + t) * 16 + nb) = pack8(v0, v1); } }
    }
};
struct EpiGlu {
    static constexpr bool PERM = true, AFTER_DRAIN = false;
    const bf16_t* GACT; const float* bias; bf16_t* CAT;
    __device__ __forceinline__ void operator()(const f32x4 (&acc)[2][2][4][2], const Unit& u, int wr, int wc, int fr, int fq) const {
        const int row0 = u.pm * BM + wr * 64 + fr;
#pragma unroll
        for (int bj = 0; bj < 2; ++bj) { const int c = u.pn * BM + bj * HALF + wc * 32 + 8 * fq;
            const f32x4 b0 = *(const f32x4*)(bias + c), b1 = *(const f32x4*)(bias + c + 4);
#pragma unroll
            EPI_LOOP_ROWS { const int t = row0 + ai * HALF + m * 16;
                const u32x4 gg = *(const u32x4*)(GACT + ((size_t)(c >> 4) * 16384 + t) * 16 + (c & 15));
                f32x4 v0 = acc[ai][bj][m][0] + b0, v1 = acc[ai][bj][m][1] + b1;
                v0[0] = bf_lo(gg.x) * fsigmoid(v0[0]); v0[1] = bf_hi(gg.x) * fsigmoid(v0[1]); v0[2] = bf_lo(gg.y) * fsigmoid(v0[2]); v0[3] = bf_hi(gg.y) * fsigmoid(v0[3]);
                v1[0] = bf_lo(gg.z) * fsigmoid(v1[0]); v1[1] = bf_hi(gg.z) * fsigmoid(v1[1]); v1[2] = bf_lo(gg.w) * fsigmoid(v1[2]); v1[3] = bf_hi(gg.w) * fsigmoid(v1[3]);
                *(u32x4*)(CAT + (size_t)t * 1024 + c) = pack8(v0, v1); } }
    }
};
typedef unsigned u32x2_ __attribute__((ext_vector_type(2)));
__device__ __forceinline__ unsigned pk4_fp8(float a, float b, float c, float d) { int w = 0; w = __builtin_amdgcn_cvt_pk_fp8_f32(a, b, w, false); w = __builtin_amdgcn_cvt_pk_fp8_f32(c, d, w, true); return (unsigned)w; }
__device__ __forceinline__ float swiglu_fast(float ag, float au, float c1, float K) { const float e = __builtin_amdgcn_exp2f(ag * c1); return (ag * au) * __builtin_amdgcn_rcpf(__builtin_fmaf(e, K, K)); }
template <int SCALE  , bool OUT8 = false  > struct EpiSwiglu {
    static constexpr bool PERM = true, AFTER_DRAIN = false;
    bf16_t* O; int ldc; int npe; int pm0; const float* RS; float osc;
    __device__ __forceinline__ void operator()(const f32x4 (&acc)[2][2][4][2], const Unit& u, int wr, int wc, int fr, int fq) const {
        const int row0 = (u.pm - pm0) * BM + wr * 64 + fr, col0 = (u.pn % npe) * HALF + wc * 32 + 8 * fq;
#pragma unroll
        EPI_LOOP_ROWS { f32x4 v0, v1; const int r = row0 + ai * HALF + m * 16; const float rs = (SCALE == 1) ? rs_row(RS, r) : RS[r]; const float c1 = -1.4426950408889634f * rs, K = __builtin_amdgcn_rcpf(rs * rs * (OUT8 ? osc : 1.f));
#pragma unroll
            for (int e = 0; e < 4; ++e) { v0[e] = swiglu_fast(acc[ai][0][m][0][e], acc[ai][1][m][0][e], c1, K); v1[e] = swiglu_fast(acc[ai][0][m][1][e], acc[ai][1][m][1][e], c1, K); }
            if constexpr (OUT8) {
#pragma unroll
                for (int e = 0; e < 4; ++e) { v0[e] = __builtin_amdgcn_fmed3f(v0[e], -440.f, 440.f); v1[e] = __builtin_amdgcn_fmed3f(v1[e], -440.f, 440.f); }
                *(u32x2_*)((unsigned char*)O + (size_t)r * ldc + col0) = (u32x2_){pk4_fp8(v0[0], v0[1], v0[2], v0[3]), pk4_fp8(v1[0], v1[1], v1[2], v1[3])}; }
            else *(u32x4*)(O + (size_t)r * ldc + col0) = pack8(v0, v1); }
    }
};
struct EpiSwigluF8 {
    static constexpr bool PERM = true, AFTER_DRAIN = false;
    unsigned char* O; int ldc; int npe; int pm0; float inv, sc;
    __device__ __forceinline__ void operator()(const f32x4 (&acc)[2][2][4][2], const Unit& u, int wr, int wc, int fr, int fq) const {
        const int row0 = (u.pm - pm0) * BM + wr * 64 + fr, col0 = (u.pn % npe) * HALF + wc * 32 + 8 * fq;
        const float c1 = -1.4426950408889634f * inv, K = 1.f / (inv * inv * sc);
#pragma unroll
        EPI_LOOP_ROWS { f32x4 v0, v1; const int r = row0 + ai * HALF + m * 16;
#pragma unroll
            for (int e = 0; e < 4; ++e) { v0[e] = __builtin_amdgcn_fmed3f(swiglu_fast(acc[ai][0][m][0][e], acc[ai][1][m][0][e], c1, K), -440.f, 440.f); v1[e] = __builtin_amdgcn_fmed3f(swiglu_fast(acc[ai][0][m][1][e], acc[ai][1][m][1][e], c1, K), -440.f, 440.f); }
            *(u32x2_*)(O + (size_t)r * ldc + col0) = (u32x2_){pk4_fp8(v0[0], v0[1], v0[2], v0[3]), pk4_fp8(v1[0], v1[1], v1[2], v1[3])}; }
    }
};
template <bool F32BASE  , bool W8 = false  > struct EpiResidB {
    static constexpr bool PERM = true, AFTER_DRAIN = false;
    const float* R; bf16_t* XR; float* SS; float inv; unsigned char* X8;
    __device__ __forceinline__ void operator()(const f32x4 (&acc)[2][2][4][2], const Unit& u, int wr, int wc, int fr, int fq) const {
        const int row0 = u.pm * BM + wr * 64 + fr, col0 = u.pn * BM + wc * 32 + 8 * fq;
#pragma unroll
        EPI_LOOP_ROWS { const int row = row0 + ai * HALF + m * 16; const size_t o = (size_t)row * 1024 + col0; float ss = 0.f; const float xs = F32BASE ? R[row] : 1.f;
#pragma unroll
            for (int bj = 0; bj < 2; ++bj) { f32x4 r0, r1;
                { const u32x4 w = *(const u32x4*)(XR + o + bj * HALF); r0 = (f32x4){bf_lo(w.x), bf_hi(w.x), bf_lo(w.y), bf_hi(w.y)}; r1 = (f32x4){bf_lo(w.z), bf_hi(w.z), bf_lo(w.w), bf_hi(w.w)}; }
                if (F32BASE) { r0 = r0 * xs; r1 = r1 * xs; }
                r0 = r0 + acc[ai][bj][m][0] * inv; r1 = r1 + acc[ai][bj][m][1] * inv;
                ss += (r0[0] * r0[0] + r0[1] * r0[1]) + (r0[2] * r0[2] + r0[3] * r0[3]) + (r1[0] * r1[0] + r1[1] * r1[1]) + (r1[2] * r1[2] + r1[3] * r1[3]);
                *(u32x4*)(XR + o + bj * HALF) = pack8(r0, r1);
                if constexpr (W8) { f32x4 q0, q1;
#pragma unroll
                    for (int e = 0; e < 4; ++e) { q0[e] = __builtin_amdgcn_fmed3f(r0[e] * 8.f, -440.f, 440.f); q1[e] = __builtin_amdgcn_fmed3f(r1[e] * 8.f, -440.f, 440.f); }
                    *(u32x2_*)(X8 + o + bj * HALF) = (u32x2_){pk4_fp8(q0[0], q0[1], q0[2], q0[3]), pk4_fp8(q1[0], q1[1], q1[2], q1[3])}; } }
            ss += __shfl_xor(ss, 16); ss += __shfl_xor(ss, 32);
            if (fq == 0) SS[(size_t)row * 16 + u.pn * 4 + wc] = ss; }
    }
};
template <bool FIRST  > struct EpiMoeDown {
    static constexpr bool PERM = true, AFTER_DRAIN = false;
    float* OUT; const int* rowtok; const float* rowgate; int pm0; bf16_t* XR; float sc;
    __device__ __forceinline__ void operator()(const f32x4 (&acc)[2][2][4][2], const Unit& u, int wr, int wc, int fr, int fq) const {
        const int row0 = (u.pm - pm0) * BM + wr * 64 + fr, col0 = (u.pn & 3) * BM + wc * 32 + 8 * fq;
#pragma unroll
        EPI_LOOP_ROWS { const int r = row0 + ai * HALF + m * 16; const int t = rowtok[r]; const float gt = rowgate[r] * sc;
            if (t >= 0) { float* o = OUT + (size_t)t * 1024 + col0;
#pragma unroll
                for (int bj = 0; bj < 2; ++bj) { bf16_t* xp = XR + (size_t)t * 1024 + col0 + bj * HALF;
                    const u32x4 w = *(const u32x4*)xp; f32x4 r0 = (f32x4){bf_lo(w.x), bf_hi(w.x), bf_lo(w.y), bf_hi(w.y)}, r1 = (f32x4){bf_lo(w.z), bf_hi(w.z), bf_lo(w.w), bf_hi(w.w)};
                    r0 = r0 + acc[ai][bj][m][0] * gt; r1 = r1 + acc[ai][bj][m][1] * gt;
                    if (FIRST) *(u32x4*)xp = pack8(r0, r1);
                    else { __builtin_nontemporal_store(r0, (f32x4*)(o + bj * HALF)); __builtin_nontemporal_store(r1, (f32x4*)(o + bj * HALF + 4)); } } } }
    }
};

__device__ __forceinline__ void sk_store_partial(const f32x4 (&acc)[2][2][4][2], unsigned long long* slot, int tid) {
#pragma unroll
    for (int ai = 0; ai < 2; ++ai)
#pragma unroll
        for (int bj = 0; bj < 2; ++bj)
#pragma unroll
            for (int m = 0; m < 4; ++m)
#pragma unroll
                for (int n = 0; n < 2; ++n) { const f32x4 v = acc[ai][bj][m][n]; const unsigned long long w = (unsigned long long)cvt_pk_bf16(v[0], v[1]) | ((unsigned long long)cvt_pk_bf16(v[2], v[3]) << 32);
                    __hip_atomic_store(slot + (((ai * 2 + bj) * 4 + m) * 2 + n) * 512 + tid, w, __ATOMIC_RELAXED, __HIP_MEMORY_SCOPE_AGENT); }
}
__device__ __forceinline__ void sk_add_partial(f32x4 (&acc)[2][2][4][2], unsigned long long* slot, int tid) {
#pragma unroll
    for (int ai = 0; ai < 2; ++ai)
#pragma unroll
        for (int bj = 0; bj < 2; ++bj)
#pragma unroll
            for (int m = 0; m < 4; ++m)
#pragma unroll
                for (int n = 0; n < 2; ++n) { const unsigned long long w = __hip_atomic_load(slot + (((ai * 2 + bj) * 4 + m) * 2 + n) * 512 + tid, __ATOMIC_RELAXED, __HIP_MEMORY_SCOPE_AGENT);
                    const unsigned lo = (unsigned)w, hi = (unsigned)(w >> 32); acc[ai][bj][m][n] = acc[ai][bj][m][n] + (f32x4){bf_lo(lo), bf_hi(lo), bf_lo(hi), bf_hi(hi)};
                    if (n == 1 && (m & 1)) asm volatile("" ::: "memory"); }
}
typedef int i32x4_ __attribute__((ext_vector_type(4)));
typedef int i32x8_ __attribute__((ext_vector_type(8)));
template <class Epi, class Sched, bool ALIGN_EPI = false, bool SP2 = false, bool FP8 = false>
__device__ __forceinline__ void gemm_phase(PG8_LAS unsigned char* lds, const Gemm g, const Sched& S, const Epi& E) {
    const int tid = threadIdx.x, wid = __builtin_amdgcn_readfirstlane(tid >> 6), lane = tid & 63, wr = wid >> 2, wc = wid & 3, fr = lane & 15, fq = lane >> 4;
    const int K = g.K; int nt = K / BK;
    unsigned voffA[2], voffB[2];
#pragma unroll
    for (int i = 0; i < 2; ++i) { int R, C; stage_rc(tid * 16 + i * 8192, R, C); const int Rb = Epi::PERM ? ((R & ~31) + perm32(R & 31)) : R;
        voffA[i] = g.amode ? (unsigned)(((C >> 4) * g.lda + R) * 16 + (C & 15)) * 2u : (unsigned)(R * g.lda + C) * 2u; voffB[i] = (unsigned)(Rb * g.ldb + C) * 2u; }
    const size_t kstep = (size_t)(BK * 2);
    const size_t hstepA = g.amode ? (size_t)HALF * 32 : (size_t)HALF * g.lda * 2, hstepB = (size_t)HALF * g.ldb * 2;
    const size_t kstepA = g.amode ? (size_t)4 * g.lda * 32 : kstep;
    const size_t tstepA = 2 * hstepA, tstepB = 2 * hstepB;
    const unsigned ldsw = (unsigned)wid * 1024u;
    const int aoff = lds_byte(wr * 64 + fr, fq * 8), boff = lds_byte(wc * 32 + fr, fq * 8);
#define PG8_SA(b, h) (((b) * 2 + (h)) * HTB)
#define PG8_SB(b, h) ((4 + (b) * 2 + (h)) * HTB)
#define PG8_STAGE(bufoff, gbase, voff) do { _Pragma("unroll") for (int _i = 0; _i < 2; ++_i) \
        __builtin_amdgcn_global_load_lds((const unsigned*)((const char*)(gbase) + (voff)[_i]), (PG8_LAS unsigned*)(lds + (bufoff) + ldsw + _i * 8192), 16, 0, 0); } while (0)
#define PG8_LDA(dst, b, h) do { if constexpr (FP8) { _Pragma("unroll") for (int m = 0; m < 4; ++m) { const i32x4_ l_ = *(const PG8_LAS i32x4_*)(lds + PG8_SA(b, h) + aoff + m * 2048), h_ = *(const PG8_LAS i32x4_*)(lds + PG8_SA(b, h) + aoff + m * 2048 + 1024); dst##8[m] = __builtin_shufflevector(l_, h_, 0, 1, 2, 3, 4, 5, 6, 7); } } \
        else { _Pragma("unroll") for (int m = 0; m < 4; ++m) _Pragma("unroll") for (int k = 0; k < 2; ++k) dst[m][k] = *(const PG8_LAS bf16x8*)(lds + PG8_SA(b, h) + aoff + m * 2048 + k * 1024); } } while (0)
#define PG8_LDB(dst, b, h) do { if constexpr (FP8) { _Pragma("unroll") for (int n = 0; n < 2; ++n) { const i32x4_ l_ = *(const PG8_LAS i32x4_*)(lds + PG8_SB(b, h) + boff + n * 2048), h_ = *(const PG8_LAS i32x4_*)(lds + PG8_SB(b, h) + boff + n * 2048 + 1024); dst##8[n] = __builtin_shufflevector(l_, h_, 0, 1, 2, 3, 4, 5, 6, 7); } } \
        else { _Pragma("unroll") for (int n = 0; n < 2; ++n) _Pragma("unroll") for (int k = 0; k < 2; ++k) dst[n][k] = *(const PG8_LAS bf16x8*)(lds + PG8_SB(b, h) + boff + n * 2048 + k * 1024); } } while (0)
#define PG8_MMA(ai, bj, At, Bt) do { __builtin_amdgcn_s_setprio(1); \
        if constexpr (FP8) { _Pragma("unroll") for (int m = 0; m < 4; ++m) _Pragma("unroll") for (int n = 0; n < 2; ++n) \
            acc[ai][bj][m][n] = __builtin_amdgcn_mfma_scale_f32_16x16x128_f8f6f4(Bt##8[n], At##8[m], acc[ai][bj][m][n], 0, 0, 0, 0x7f7f7f7f, 0, 0x7f7f7f7f); \
            _Pragma("unroll") for (int m = 0; m < 4; ++m) _Pragma("unroll") for (int n = 0; n < 2; ++n) asm volatile("" : "+v"(acc[ai][bj][m][n])); } \
        else { _Pragma("unroll") for (int m = 0; m < 4; ++m) _Pragma("unroll") for (int n = 0; n < 2; ++n) _Pragma("unroll") for (int k = 0; k < 2; ++k) \
            acc[ai][bj][m][n] = __builtin_amdgcn_mfma_f32_16x16x32_bf16(Bt[n][k], At[m][k], acc[ai][bj][m][n], 0, 0, 0); } \
        __builtin_amdgcn_s_setprio(0); } while (0)
#define PG8_WAIT_V(n) asm volatile("s_waitcnt vmcnt(" #n ")" ::: "memory")
#define PG8_WAIT_L(n) asm volatile("s_waitcnt lgkmcnt(" #n ")" ::: "memory")
#define PG8_BAR __builtin_amdgcn_s_barrier()
#define PG8_SCHED __builtin_amdgcn_sched_barrier(0)
    Unit cur, nxt; int ui = 0;
    if (!S.next(0, cur)) return;
    f32x4 acc[2][2][4][2];
#pragma unroll
    for (int a = 0; a < 2; ++a)
#pragma unroll
        for (int b = 0; b < 2; ++b)
#pragma unroll
            for (int m = 0; m < 4; ++m)
#pragma unroll
                for (int n = 0; n < 2; ++n) acc[a][b][m][n] = (f32x4){0.f, 0.f, 0.f, 0.f};
    bf16x8 At[4][2], B0[2][2], B1[2][2];
    i32x8_ At8[4], B08[2], B18[2];
    const char* cA = (const char*)g.A + (size_t)cur.pm * tstepA; const char* cB = (const char*)g.Bt + (size_t)cur.pn * tstepB;
    if constexpr (Sched::STREAMK) { nt = cur.nk; cA += (size_t)cur.k0 * kstep; cB += (size_t)cur.k0 * kstep; }

    if constexpr (SP2) {
        PG8_STAGE(PG8_SB(0, 0), cB, voffB); PG8_STAGE(PG8_SB(0, 1), cB + hstepB, voffB); PG8_STAGE(PG8_SA(0, 0), cA, voffA); PG8_STAGE(PG8_SA(0, 1), cA + hstepA, voffA);
        if (wr == 1) PG8_BAR;
        PG8_WAIT_V(2); PG8_BAR;
        PG8_STAGE(PG8_SB(1, 0), cB + kstep, voffB); PG8_STAGE(PG8_SA(1, 0), cA + kstepA, voffA); PG8_STAGE(PG8_SB(1, 1), cB + hstepB + kstep, voffB);
        PG8_WAIT_V(6); PG8_BAR;
    } else {
        PG8_STAGE(PG8_SB(0, 0), cB, voffB); PG8_STAGE(PG8_SA(0, 0), cA, voffA); PG8_STAGE(PG8_SB(0, 1), cB + hstepB, voffB); PG8_STAGE(PG8_SA(0, 1), cA + hstepA, voffA);
        if (wr == 1) PG8_BAR;
        PG8_WAIT_V(4); PG8_BAR;
        PG8_STAGE(PG8_SB(1, 0), cB + kstep, voffB); PG8_STAGE(PG8_SA(1, 0), cA + kstepA, voffA); PG8_STAGE(PG8_SB(1, 1), cB + hstepB + kstep, voffB);
        PG8_WAIT_V(6); PG8_BAR;
    }
    for (;;) {
        const bool has_next = S.next(ui + 1, nxt);
        const char* nA = has_next ? (const char*)g.A + (size_t)nxt.pm * tstepA : cA; const char* nB = has_next ? (const char*)g.Bt + (size_t)nxt.pn * tstepB : cB;
        if constexpr (Sched::STREAMK) { if (has_next) { nA += (size_t)nxt.k0 * kstep; nB += (size_t)nxt.k0 * kstep; } }
        for (int t = 0; t < nt; t += 2) {
            const bool last = (t == nt - 2);
            const char* a1 = cA + (size_t)(t + 1) * kstepA;
            const char* a2 = last ? nA : cA + (size_t)(t + 2) * kstepA; const char* b2 = last ? nB : cB + (size_t)(t + 2) * kstep;
            const char* a3 = a2 + kstepA; const char* b3 = b2 + kstep;

            if constexpr (SP2) {
            PG8_LDB(B0, 0, 0); PG8_LDB(B1, 0, 1); PG8_SCHED; PG8_LDA(At, 0, 0); PG8_STAGE(PG8_SA(1, 1), a1 + hstepA, voffA);
            PG8_WAIT_V(8); PG8_WAIT_L(0); PG8_BAR; PG8_MMA(0, 0, At, B0); PG8_MMA(0, 1, At, B1); PG8_BAR; PG8_SCHED;
            PG8_LDA(At, 0, 1); PG8_STAGE(PG8_SB(0, 0), b2, voffB); PG8_STAGE(PG8_SB(0, 1), b2 + hstepB, voffB); PG8_STAGE(PG8_SA(0, 0), a2, voffA);
            PG8_WAIT_V(8); PG8_WAIT_L(0); PG8_BAR; PG8_MMA(1, 0, At, B0); PG8_MMA(1, 1, At, B1); PG8_BAR; PG8_SCHED;
            PG8_LDB(B0, 1, 0); PG8_LDB(B1, 1, 1); PG8_SCHED; PG8_LDA(At, 1, 0); PG8_STAGE(PG8_SA(0, 1), a2 + hstepA, voffA);
            PG8_WAIT_V(8); PG8_WAIT_L(0); PG8_BAR; PG8_MMA(0, 0, At, B0); PG8_MMA(0, 1, At, B1); PG8_BAR; PG8_SCHED;
            PG8_LDA(At, 1, 1); PG8_STAGE(PG8_SB(1, 0), b3, voffB); PG8_STAGE(PG8_SB(1, 1), b3 + hstepB, voffB); PG8_STAGE(PG8_SA(1, 0), a3, voffA);
            PG8_WAIT_V(8); PG8_WAIT_L(0); PG8_BAR; PG8_MMA(1, 0, At, B0); PG8_MMA(1, 1, At, B1); PG8_BAR; PG8_SCHED;
            } else {
            PG8_LDB(B0, 0, 0); PG8_SCHED; PG8_LDA(At, 0, 0); PG8_STAGE(PG8_SA(1, 1), a1 + hstepA, voffA);
            PG8_WAIT_L(8); PG8_BAR; PG8_WAIT_L(0); PG8_MMA(0, 0, At, B0); PG8_BAR; PG8_SCHED;
            PG8_LDB(B1, 0, 1); PG8_STAGE(PG8_SB(0, 0), b2, voffB);
            PG8_BAR; PG8_WAIT_L(0); PG8_MMA(0, 1, At, B1); PG8_BAR;
            PG8_LDA(At, 0, 1); PG8_STAGE(PG8_SA(0, 0), a2, voffA);
            PG8_BAR; PG8_WAIT_L(0); PG8_MMA(1, 0, At, B0); PG8_BAR; PG8_SCHED;
            PG8_STAGE(PG8_SB(0, 1), b2 + hstepB, voffB);
            PG8_WAIT_V(6); PG8_BAR; PG8_MMA(1, 1, At, B1); PG8_BAR;
            PG8_LDB(B0, 1, 0); PG8_SCHED; PG8_LDA(At, 1, 0); PG8_STAGE(PG8_SA(0, 1), a2 + hstepA, voffA);
            PG8_WAIT_L(8); PG8_BAR; PG8_WAIT_L(0); PG8_MMA(0, 0, At, B0); PG8_BAR; PG8_SCHED;
            PG8_LDB(B1, 1, 1); PG8_STAGE(PG8_SB(1, 0), b3, voffB);
            PG8_BAR; PG8_WAIT_L(0); PG8_MMA(0, 1, At, B1); PG8_BAR;
            PG8_LDA(At, 1, 1); PG8_STAGE(PG8_SA(1, 0), a3, voffA);
            PG8_BAR; PG8_WAIT_L(0); PG8_MMA(1, 0, At, B0); PG8_BAR; PG8_SCHED;
            PG8_STAGE(PG8_SB(1, 1), b3 + hstepB, voffB);
            PG8_WAIT_V(6); PG8_BAR; PG8_MMA(1, 1, At, B1); PG8_BAR;
            }
        }
        if constexpr (ALIGN_EPI) { if (wr == 0) PG8_BAR; }
        if constexpr (Sched::STREAMK) {
            if (cur.part == 2) { sk_store_partial(acc, S.slots() + (size_t)S.c() * SK_SLOT_WORDS, tid); PG8_WAIT_V(0);
                if (lane == 0) __hip_atomic_fetch_add(S.flags() + S.c() * 64, 1u, __ATOMIC_RELAXED, __HIP_MEMORY_SCOPE_AGENT); }
            else if (cur.part == 0) E(acc, cur, wr, wc, fr, fq);
        } else
        if constexpr (!Epi::AFTER_DRAIN) { E(acc, cur, wr, wc, fr, fq); }
        if (!has_next) break;
#pragma unroll
        for (int a = 0; a < 2; ++a)
#pragma unroll
            for (int b = 0; b < 2; ++b)
#pragma unroll
                for (int m = 0; m < 4; ++m)
#pragma unroll
                    for (int n = 0; n < 2; ++n) acc[a][b][m][n] = (f32x4){0.f, 0.f, 0.f, 0.f};
        cur = nxt; cA = nA; cB = nB; ++ui;
        if constexpr (Sched::STREAMK) nt = cur.nk;
        if constexpr (ALIGN_EPI) { if (wr == 1) PG8_BAR; }
    }
    PG8_WAIT_V(0);
    if constexpr (!ALIGN_EPI) { if (wr == 0) PG8_BAR; }
    PG8_BAR;
    if constexpr (Epi::AFTER_DRAIN) { E.fused(acc, cur, wr, wc, fr, fq, lds, wid, lane); }
    if constexpr (Sched::STREAMK) { if (cur.part == 1) {
        const int np = S.split();
        if (tid == 0) { for (int q = 1; q < np; ++q) { unsigned sp = 0; while (__hip_atomic_load(S.flags() + (S.c() + q) * 64, __ATOMIC_RELAXED, __HIP_MEMORY_SCOPE_AGENT) < S.target()) { __builtin_amdgcn_s_sleep(2); if (++sp > (1u << 22)) break; } } }
        __syncthreads();
        for (int q = 1; q < np; ++q) sk_add_partial(acc, S.slots() + (size_t)(S.c() + q) * SK_SLOT_WORDS, tid);
        E(acc, cur, wr, wc, fr, fq); } }
#undef PG8_SA
#undef PG8_SB
#undef PG8_STAGE
#undef PG8_LDA
#undef PG8_LDB
#undef PG8_MMA
#undef PG8_WAIT_V
#undef PG8_WAIT_L
#undef PG8_BAR
#undef PG8_SCHED
}
}


constexpr int NWAVES = 8, NTHREADS = 512;
constexpr int T = 16384, D = 1024, SEQ = 2048, NB = 8;
constexpr int DFF = 2816, DFE = 3584, NEXP = 8;
constexpr int RROWS = 18432;
constexpr float RMS_EPS = 1e-6f;
constexpr float MOE_WSCALE = 64.f, MOE_ASCALE = 8.f;

constexpr size_t MiB = 1u << 20;
constexpr size_t WS_CTL = 0, CTL_ZERO_BYTES = 256 * 1024;
constexpr size_t WS_SMALL = 1 * MiB;
constexpr size_t SM_KMEANS = WS_SMALL, SM_LAM32 = WS_SMALL + 64 * 1024, SM_WGCNT = WS_SMALL + 128 * 1024, SM_PANEND = WS_SMALL + 160 * 1024,
                 SM_TOKE = WS_SMALL + 192 * 1024, SM_TOKLP = WS_SMALL + 320 * 1024, SM_TOKG = WS_SMALL + 448 * 1024, SM_ROWTOK = WS_SMALL + 576 * 1024, SM_ROWGATE = WS_SMALL + 720 * 1024;
static_assert(SM_ROWGATE + 2 * RROWS * 4 <= 2 * MiB, "small tables");
constexpr size_t WS_WMEMK = 2 * MiB, WS_WMEMV = 3 * MiB, WS_WKQ = 4 * MiB, WS_WV = WS_WKQ + 2560 * 1024, WS_WOUT1 = 7 * MiB, WS_WMGU = 9 * MiB, WS_WMD = 121 * MiB;
constexpr size_t WS_XB = 177 * MiB, WS_CAT = 209 * MiB, WS_MEMN = 241 * MiB, WS_MEMK = 245 * MiB, WS_MEMVT = 247 * MiB;
constexpr size_t WS_ARENA = 249 * MiB, WS_END = 447 * MiB;
constexpr size_t AR_XS = WS_ARENA, AR_ACTM = WS_ARENA + 72 * MiB;
constexpr size_t AR_WIN0 = WS_ARENA, AR_WGLU = WS_ARENA + 2 * MiB, AR_WOUT0 = WS_ARENA + 4 * MiB, AR_WFGU = WS_ARENA + 6 * MiB, AR_WFD = WS_ARENA + 17 * MiB;
constexpr size_t AR_TZ = WS_ARENA + 23 * MiB, AR_W1T = WS_ARENA + 53 * MiB, AR_UG = WS_ARENA + 65 * MiB, AR_QM0 = WS_ARENA + 95 * MiB, AR_XC = WS_ARENA + 103 * MiB, AR_GACT = WS_ARENA + 115 * MiB;
constexpr size_t AR_X8 = WS_ARENA + 140 * MiB;
constexpr size_t AR_S5SM = WS_ARENA + 156 * MiB;
constexpr size_t AR_ACT0 = WS_ARENA + 23 * MiB;
constexpr size_t AR_KQ = WS_ARENA, AR_VT = WS_ARENA + 40 * MiB;
static_assert(AR_ACTM + (size_t)RROWS * DFE * 2 <= WS_END && AR_ACT0 + (size_t)T * DFF * 2 <= AR_GACT, "arena");
constexpr int CW_BAR = 4096, CW_QUEUE = 8192, CW_SKFLAG = 16384;
static_assert((CW_SKFLAG + 2 * 256 * 64 + 64) * 4 <= (int)CTL_ZERO_BYTES, "control words inside the per-call memset");

constexpr int RING_BYTES = 131072, MISC_OFF = RING_BYTES + 320, LDS_BYTES = 147456;

#define GAS __attribute__((address_space(1)))
#define LAS __attribute__((address_space(3)))
typedef unsigned short bf16;
typedef unsigned v4u __attribute__((ext_vector_type(4)));
typedef unsigned v2u __attribute__((ext_vector_type(2)));
typedef float f32x4 __attribute__((ext_vector_type(4)));
typedef float f32x16 __attribute__((ext_vector_type(16)));
typedef short bf16x8 __attribute__((ext_vector_type(8)));
typedef short s16x4 __attribute__((ext_vector_type(4)));
typedef GAS unsigned gu32;
#define LDS_WAIT() asm volatile("s_waitcnt lgkmcnt(0)" ::: "memory")
using pg8::cvt_pk_bf16; using pg8::bf_lo; using pg8::bf_hi;
__device__ __forceinline__ unsigned f2bf(float f) { unsigned u = __builtin_bit_cast(unsigned, f); return (u + 0x7fffu + ((u >> 16) & 1u)) >> 16; }
__device__ __forceinline__ unsigned pk2(float lo, float hi) { return f2bf(lo) | (f2bf(hi) << 16); }
__device__ __forceinline__ float wave_sum(float v) {
#pragma unroll
    for (int o = 1; o < 64; o <<= 1) v += __shfl_xor(v, o);
    return v;
}

#define XB_TMO      128
#define XB_XCNT(j)  (256  + 64 * (j))
#define XB_XSUB(j)  (1280 + 64 * (j))
#define XB_XGEN(j)  (2304 + 64 * (j))
#define XB_TOP      3328
#define XB_TOPGEN   3392
#define XCD_BAR_WORDS 3456
#define XB_SPIN_CAP (1u << 18)

__device__ __forceinline__ unsigned xb_ld(unsigned* p)              { return __hip_atomic_load(p, __ATOMIC_RELAXED, __HIP_MEMORY_SCOPE_AGENT); }
__device__ __forceinline__ unsigned xb_add(unsigned* p, unsigned v) { return __hip_atomic_fetch_add(p, v, __ATOMIC_RELAXED, __HIP_MEMORY_SCOPE_AGENT); }
__device__ __forceinline__ unsigned xb_xcc_id() { return (unsigned)__builtin_amdgcn_s_getreg((3 << 11) | 20) & 0xFu; }
#define XB_SPIN(cond, bar) do { unsigned _sp = 0; while (cond) { __builtin_amdgcn_s_sleep(1); \
    if ((++_sp & 255u) == 0u) { if (xb_ld(&(bar)[XB_TMO])) break; if (_sp > XB_SPIN_CAP) { atomicAdd(&(bar)[XB_TMO], 1u); break; } } } } while (0)

struct XcdBarrier {
    unsigned* bar; unsigned x;
    volatile LAS unsigned* st;
};

__device__ __forceinline__ XcdBarrier xcd_barrier_post(unsigned* bar, volatile LAS unsigned* st) {
    XcdBarrier b; b.bar = bar; b.x = xb_xcc_id(); b.st = st;
    if (threadIdx.x == 0) (void)xb_add(&bar[XB_XCNT(b.x)], 1u);
    return b;
}
__device__ __forceinline__ void xcd_barrier_complete(unsigned* bar, unsigned x, unsigned& nloc, unsigned& nx) {
    const unsigned G = gridDim.x * gridDim.y * gridDim.z;
    unsigned sum, cnt, mine, sp = 0u;
    for (;;) {
        sum = 0u; cnt = 0u; mine = 0u;
#pragma unroll
        for (unsigned j = 0; j < 16; ++j) { const unsigned c = xb_ld(&bar[XB_XCNT(j)]); sum += c; cnt += (c > 0u) ? 1u : 0u; mine = (j == x) ? c : mine; }
        if (sum == G) break;
        __builtin_amdgcn_s_sleep(1);
        if ((++sp & 255u) == 0u) { if (xb_ld(&bar[XB_TMO])) break; if (sp > XB_SPIN_CAP) { atomicAdd(&bar[XB_TMO], 1u); break; } }
    }
    nloc = mine > 0u ? mine : 1u; nx = cnt > 0u ? cnt : 1u;
}

__device__ __forceinline__ void xcd_barrier(const XcdBarrier& b) {
    asm volatile("s_waitcnt vmcnt(0)" ::: "memory");
    __syncthreads();
    if (threadIdx.x == 0) {
        unsigned* bar = b.bar;
        __builtin_amdgcn_s_waitcnt(0);
        unsigned nloc = b.st[0], nx = b.st[1];
        if (nloc == 0u) { xcd_barrier_complete(bar, b.x, nloc, nx); b.st[0] = nloc; b.st[1] = nx; }
        const unsigned old = xb_add(&bar[XB_XSUB(b.x)], 1u);
        const unsigned gen = old / nloc;
        if (old + 1u == (gen + 1u) * nloc) {
            __builtin_amdgcn_fence(__ATOMIC_RELEASE, "agent");
            asm volatile("s_waitcnt vmcnt(0)" ::: "memory");
            const unsigned og = xb_add(&bar[XB_TOP], 1u);
            const unsigned tg = og / nx;
            if (og + 1u == (tg + 1u) * nx) xb_add(&bar[XB_TOPGEN], 1u);
            else XB_SPIN(xb_ld(&bar[XB_TOPGEN]) == tg, bar);
            __builtin_amdgcn_fence(__ATOMIC_ACQUIRE, "agent");
            xb_add(&bar[XB_XGEN(b.x)], 1u);
            asm volatile("s_waitcnt vmcnt(0)" ::: "memory");
        } else {
            XB_SPIN(xb_ld(&bar[XB_XGEN(b.x)]) == gen, bar);
            __builtin_amdgcn_fence(__ATOMIC_ACQUIRE, "agent");
            asm volatile("s_waitcnt vmcnt(0)" ::: "memory");
        }
    }
    __syncthreads();
}


__device__ __forceinline__ void cvt_item(const float* W, int ldw, int k0, int n0, const float* gain, bf16* WT, int ldo, int orow0, LAS unsigned* scr, int lane) {
    const int nq = lane & 15, kr = lane >> 4;
    f32x4 a[8], b[8];
    const float* src = W + (size_t)(k0 + 2 * kr) * ldw + n0 + 4 * nq;
#pragma unroll
    for (int i = 0; i < 8; ++i) { a[i] = *(const GAS f32x4*)(src + (size_t)(8 * i) * ldw); b[i] = *(const GAS f32x4*)(src + (size_t)(8 * i + 1) * ldw); }
    if (gain) {
#pragma unroll
        for (int i = 0; i < 8; ++i) { const float ga = gain[k0 + 8 * i + 2 * kr], gb = gain[k0 + 8 * i + 2 * kr + 1]; a[i] = a[i] * ga; b[i] = b[i] * gb; } }
#pragma unroll
    for (int i = 0; i < 8; ++i) {
#pragma unroll
        for (int e = 0; e < 4; ++e) scr[(4 * nq + e) * 33 + 4 * i + kr] = cvt_pk_bf16(a[i][e], b[i][e]); }
    LDS_WAIT(); asm volatile("" ::: "memory");
#pragma unroll
    for (int j = 0; j < 8; ++j) { const int q = lane + 64 * j, n = q >> 3, c = q & 7; const LAS unsigned* sp = scr + n * 33 + 4 * c;
        v4u o; o.x = sp[0]; o.y = sp[1]; o.z = sp[2]; o.w = sp[3];
        *(GAS v4u*)(WT + (size_t)(orow0 + n) * ldo + k0 + 8 * c) = o; }
    LDS_WAIT(); asm volatile("" ::: "memory");
}
struct CvtDesc { const float* src; const float* gain; bf16* dst; int ldw, ldo, k0; };
__device__ __forceinline__ void cvt_load(const CvtDesc& d, f32x4 (&a)[8], f32x4 (&b)[8], float (&ga)[8], float (&gb)[8], int lane) {
    const int nq = lane & 15, kr = lane >> 4; const float* src = d.src + (size_t)(2 * kr) * d.ldw + 4 * nq;
    if (d.gain) {
#pragma unroll
        for (int i = 0; i < 8; ++i) { ga[i] = d.gain[d.k0 + 8 * i + 2 * kr]; gb[i] = d.gain[d.k0 + 8 * i + 2 * kr + 1]; } }
    else {
#pragma unroll
        for (int i = 0; i < 8; ++i) { ga[i] = 1.f; gb[i] = 1.f; } }
#pragma unroll
    for (int i = 0; i < 8; ++i) { a[i] = *(const GAS f32x4*)(src + (size_t)(8 * i) * d.ldw); b[i] = *(const GAS f32x4*)(src + (size_t)(8 * i + 1) * d.ldw); }
}
__device__ __forceinline__ void cvt_emit(const CvtDesc& d, f32x4 (&a)[8], f32x4 (&b)[8], const float (&ga)[8], const float (&gb)[8], LAS unsigned* scr, int lane) {
    const int nq = lane & 15, kr = lane >> 4;
#pragma unroll
    for (int i = 0; i < 8; ++i) {
#pragma unroll
        for (int e = 0; e < 4; ++e) scr[(4 * nq + e) * 33 + 4 * i + kr] = cvt_pk_bf16(a[i][e] * ga[i], b[i][e] * gb[i]); }
    LDS_WAIT(); asm volatile("" ::: "memory");
#pragma unroll
    for (int j = 0; j < 8; ++j) { const int q = lane + 64 * j, n = q >> 3, c = q & 7; const LAS unsigned* sp = scr + n * 33 + 4 * c;
        v4u o; o.x = sp[0]; o.y = sp[1]; o.z = sp[2]; o.w = sp[3];
        *(GAS v4u*)(d.dst + (size_t)n * d.ldo + 8 * c) = o; }
    LDS_WAIT(); asm volatile("" ::: "memory");
}
struct CvtDesc8 { const float* src; const float* gain; unsigned char* dst; int ldw, ldo, k0; };
__device__ __forceinline__ void cvt_load8(const CvtDesc8& d, f32x4 (&a)[4][4], float (&g)[4][4], float scale, int lane) {
    const int nq = lane & 15, kr = lane >> 4; const float* src = d.src + (size_t)(4 * kr) * d.ldw + 4 * nq;
#pragma unroll
    for (int i = 0; i < 4; ++i)
#pragma unroll
        for (int r = 0; r < 4; ++r) g[i][r] = d.gain ? d.gain[d.k0 + 16 * i + 4 * kr + r] * scale : scale;
#pragma unroll
    for (int i = 0; i < 4; ++i)
#pragma unroll
        for (int r = 0; r < 4; ++r) a[i][r] = __builtin_nontemporal_load((const GAS f32x4*)(src + (size_t)(16 * i + r) * d.ldw));
}
__device__ __forceinline__ void cvt_load8_dma(const CvtDesc8& d, f32x4 (&a)[4][4], float (&g)[4][4], float scale, LAS unsigned char* buf, int lane) {
    const int nq = lane & 15, kr = lane >> 4;
#pragma unroll
    for (int i = 0; i < 4; ++i)
#pragma unroll
        for (int r = 0; r < 4; ++r) g[i][r] = d.gain ? d.gain[d.k0 + 16 * i + 4 * kr + r] * scale : scale;
    const float* src = d.src + (size_t)kr * d.ldw + 4 * nq;
#pragma unroll
    for (int j = 0; j < 16; ++j) __builtin_amdgcn_global_load_lds((const unsigned*)(src + (size_t)(4 * j) * d.ldw), (LAS unsigned*)(buf + j * 1024), 16, 0, 2);
    asm volatile("s_waitcnt vmcnt(0)" ::: "memory");
#pragma unroll
    for (int i = 0; i < 4; ++i)
#pragma unroll
        for (int r = 0; r < 4; ++r) a[i][r] = *(const LAS f32x4*)(buf + (16 * i + 4 * kr + r) * 256 + nq * 16);
    LDS_WAIT(); asm volatile("" ::: "memory");
}
__device__ __forceinline__ void cvt_emit8(const CvtDesc8& d, f32x4 (&a)[4][4], const float (&g)[4][4], LAS unsigned* scr, int lane) {
    const int nq = lane & 15, kr = lane >> 4;
#pragma unroll
    for (int i = 0; i < 4; ++i)
#pragma unroll
        for (int e = 0; e < 4; ++e) scr[(4 * nq + e) * 17 + 4 * i + kr] = pg8::pk4_fp8(a[i][0][e] * g[i][0], a[i][1][e] * g[i][1], a[i][2][e] * g[i][2], a[i][3][e] * g[i][3]);
    LDS_WAIT(); asm volatile("" ::: "memory");
#pragma unroll
    for (int j = 0; j < 4; ++j) { const int q = lane + 64 * j, n = q >> 2, c = q & 3; const LAS unsigned* sp = scr + n * 17 + 4 * c;
        v4u o; o.x = sp[0]; o.y = sp[1]; o.z = sp[2]; o.w = sp[3];
        __builtin_nontemporal_store(o, (GAS v4u*)(d.dst + (size_t)n * d.ldo + 16 * c)); }
    LDS_WAIT(); asm volatile("" ::: "memory");
}
__device__ __forceinline__ void rms_row_to_bf16(const float* xrow, bf16* orow, int lane, float* rms_out = nullptr) {
    const GAS f32x4* xr = (const GAS f32x4*)xrow + lane;
    f32x4 v[4]; float s = 0.f;
#pragma unroll
    for (int j = 0; j < 4; ++j) { v[j] = xr[64 * j]; s += (v[j].x * v[j].x + v[j].y * v[j].y) + (v[j].z * v[j].z + v[j].w * v[j].w); }
    const float rms = sqrtf(wave_sum(s) * (1.f / 1024.f) + RMS_EPS), r = 1.f / rms;
    if (rms_out != nullptr && lane == 0) *rms_out = rms;
    GAS unsigned long long* o8 = (GAS unsigned long long*)orow + lane;
#pragma unroll
    for (int j = 0; j < 4; ++j) o8[64 * j] = (unsigned long long)pk2(v[j].x * r, v[j].y * r) | ((unsigned long long)pk2(v[j].z * r, v[j].w * r) << 32);
}
__device__ __forceinline__ void dsincos(double a, double& s, double& c) {
    const double k = rint(a * 0.63661977236758134308);
    double r = fma(-k, 1.57079632679489655800e+00, a); r = fma(-k, 6.12323399573676603587e-17, r);
    const double z = r * r;
    double ps = 1.0 / 355687428096000.0;
    ps = fma(ps, z, -1.0 / 1307674368000.0); ps = fma(ps, z, 1.0 / 6227020800.0); ps = fma(ps, z, -1.0 / 39916800.0); ps = fma(ps, z, 1.0 / 362880.0);
    ps = fma(ps, z, -1.0 / 5040.0); ps = fma(ps, z, 1.0 / 120.0); ps = fma(ps, z, -1.0 / 6.0); ps = fma(ps * z, r, r);
    double pc = -1.0 / 6402373705728000.0;
    pc = fma(pc, z, 1.0 / 20922789888000.0); pc = fma(pc, z, -1.0 / 87178291200.0); pc = fma(pc, z, 1.0 / 479001600.0); pc = fma(pc, z, -1.0 / 3628800.0);
    pc = fma(pc, z, 1.0 / 40320.0); pc = fma(pc, z, -1.0 / 720.0); pc = fma(pc, z, 1.0 / 24.0); pc = fma(pc, z, -0.5); pc = fma(pc, z, 1.0);
    const long q = (long)k & 3;
    s = (q == 0) ? ps : (q == 1) ? pc : (q == 2) ? -ps : -pc;
    c = (q == 0) ? pc : (q == 1) ? -ps : (q == 2) ? -pc : ps;
}
__device__ __forceinline__ double dexp(double x) {
    const double k = rint(x * 1.44269504088896338700);
    double r = fma(-k, 6.93147180369123816490e-01, x); r = fma(-k, 1.90821492927058770002e-10, r);
    double p = 1.0 / 6227020800.0;
    p = fma(p, r, 1.0 / 479001600.0); p = fma(p, r, 1.0 / 39916800.0); p = fma(p, r, 1.0 / 3628800.0); p = fma(p, r, 1.0 / 362880.0); p = fma(p, r, 1.0 / 40320.0);
    p = fma(p, r, 1.0 / 5040.0); p = fma(p, r, 1.0 / 720.0); p = fma(p, r, 1.0 / 120.0); p = fma(p, r, 1.0 / 24.0); p = fma(p, r, 1.0 / 6.0); p = fma(p, r, 0.5); p = fma(p, r, 1.0); p = fma(p, r, 1.0);
    const long ki = (long)k;
    return p * __builtin_bit_cast(double, (unsigned long long)(1023 + ki) << 52);
}
constexpr int S5SM_PW = 64 * 33, S5SM_HEAD = 2 * S5SM_PW + 2048, S5SM_FLOATS = S5SM_HEAD + 8192;
struct S5Lds { LAS float* pwr; LAS float* pwi; LAS float* bbr; LAS float* bbi; LAS float* ccr; LAS float* cci; LAS float* km; };
__device__ __forceinline__ S5Lds s5_lds(LAS unsigned char* lds) { S5Lds L; L.pwr = (LAS float*)lds; L.pwi = L.pwr + S5SM_PW; L.bbr = L.pwi + S5SM_PW; L.bbi = L.bbr + 1024; L.ccr = L.bbi + 1024; L.cci = L.ccr + 1024; L.km = L.cci + 1024; return L; }
__device__ __forceinline__ void s5_tables_small(int g, LAS unsigned char* lds, const float* lam_re, const float* lam_im, const float* log_dt, const float* b_re, const float* b_im,
                                                const float* c_re, const float* c_im, float* S5SM, float* LAM32, int tid) {
    const S5Lds L = s5_lds(lds); LAS float* pwr = L.pwr; LAS float* pwi = L.pwi; LAS float* bbr = L.bbr; LAS float* bbi = L.bbi; LAS float* ccr = L.ccr; LAS float* cci = L.cci; LAS float* km = L.km;
    const double dt = dexp((double)log_dt[g]);
    for (int idx = tid; idx < 64 * 33; idx += NTHREADS) { const int p = idx / 33, tau = idx % 33;
        const double lr = lam_re[g * 64 + p], li = lam_im[g * 64 + p]; const double mag = dexp(lr * dt * tau); double s, c; dsincos(li * dt * tau, s, c);
        pwr[idx] = (float)(mag * c); pwi[idx] = (float)(mag * s); }
    for (int idx = tid; idx < 1024; idx += NTHREADS) { const int p = idx >> 4, m = idx & 15;
        const double lr = lam_re[g * 64 + p], li = lam_im[g * 64 + p]; const double mag = dexp(lr * dt); double s, c; dsincos(li * dt, s, c);
        const double ar = mag * c - 1.0, ai = mag * s, den = lr * lr + li * li, fr_ = (ar * lr + ai * li) / den, fi_ = (ai * lr - ar * li) / den;
        const double br = b_re[(g * 64 + p) * 16 + m], bi = b_im[(g * 64 + p) * 16 + m];
        bbr[idx] = (float)(fr_ * br - fi_ * bi); bbi[idx] = (float)(fr_ * bi + fi_ * br);
        ccr[idx] = c_re[g * 1024 + idx]; cci[idx] = c_im[g * 1024 + idx]; }
    __syncthreads();
    { const int half = tid >> 8, n = (tid >> 4) & 15, m = tid & 15; float acc[16];
#pragma unroll
      for (int t = 0; t < 16; ++t) acc[t] = 0.f;
      for (int p = 0; p < 64; ++p) { const float cr = ccr[n * 64 + p], ci = cci[n * 64 + p], br = bbr[p * 16 + m], bi = bbi[p * 16 + m]; const float zr = cr * br - ci * bi, zi = cr * bi + ci * br;
#pragma unroll
          for (int t = 0; t < 16; ++t) acc[t] += zr * pwr[p * 33 + 16 * half + t] - zi * pwi[p * 33 + 16 * half + t]; }
#pragma unroll
      for (int t = 0; t < 16; ++t) km[((16 * half + t) * 16 + n) * 16 + m] = acc[t]; }
    __syncthreads();
    float* S = S5SM + (size_t)g * S5SM_FLOATS;
    for (int i = tid; i < S5SM_HEAD; i += NTHREADS) S[i] = pwr[i];
    for (int i = tid; i < 8192; i += NTHREADS) S[S5SM_HEAD + i] = km[i];
    if (tid < 64) { LAM32[(g * 64 + tid) * 2] = pwr[tid * 33 + 32]; LAM32[(g * 64 + tid) * 2 + 1] = pwi[tid * 33 + 32]; }
    __syncthreads();
}
__device__ __forceinline__ void s5_load(int g, LAS unsigned char* lds, const float* S5SM, const float* c_re, const float* c_im, bool with_km, int tid) {
    const S5Lds L = s5_lds(lds); const float* S = S5SM + (size_t)g * S5SM_FLOATS;
    for (int i = tid; i < S5SM_HEAD / 4; i += NTHREADS) *(LAS f32x4*)(L.pwr + 4 * i) = *(const GAS f32x4*)(S + 4 * i);
    for (int i = tid; i < 256; i += NTHREADS) { *(LAS f32x4*)(L.ccr + 4 * i) = *(const GAS f32x4*)(c_re + g * 1024 + 4 * i); *(LAS f32x4*)(L.cci + 4 * i) = *(const GAS f32x4*)(c_im + g * 1024 + 4 * i); }
    if (with_km) for (int i = tid; i < 2048; i += NTHREADS) *(LAS f32x4*)(L.km + 4 * i) = *(const GAS f32x4*)(S + S5SM_HEAD + 4 * i);
    __syncthreads();
}
__device__ __forceinline__ void s5_expand_tz(int g, LAS unsigned char* lds, bf16* TZ, int row_lo, int row_hi, int tid) {
    const S5Lds L = s5_lds(lds); LAS float* pwr = L.pwr; LAS float* pwi = L.pwi; LAS float* ccr = L.ccr; LAS float* cci = L.cci; LAS float* km = L.km;
    bf16* tz = TZ + (size_t)g * 512 * 640;
    for (int pc = row_lo * 80 + tid; pc < row_hi * 80; pc += NTHREADS) { const int row = pc / 80, c8 = pc % 80, j = row >> 4, n = row & 15; float v[8];
        if (c8 < 64) { const int i = c8 >> 1, m0 = (c8 & 1) * 8;
#pragma unroll
            for (int e = 0; e < 8; ++e) v[e] = (i <= j) ? km[((j - i) * 16 + n) * 16 + m0 + e] : 0.f; }
        else { const int p0 = (c8 - 64) * 4;
#pragma unroll
            for (int q = 0; q < 4; ++q) { const int p = p0 + q; const float cr = ccr[n * 64 + p], ci = cci[n * 64 + p], pr = pwr[p * 33 + j + 1], pi = pwi[p * 33 + j + 1];
                v[2 * q] = cr * pr - ci * pi; v[2 * q + 1] = -(cr * pi + ci * pr); } }
        v4u o; o.x = pk2(v[0], v[1]); o.y = pk2(v[2], v[3]); o.z = pk2(v[4], v[5]); o.w = pk2(v[6], v[7]);
        *(GAS v4u*)(tz + (size_t)row * 640 + c8 * 8) = o; }
}
__device__ __forceinline__ void s5_expand_w1t(int g, LAS unsigned char* lds, bf16* W1T, int row_lo, int row_hi, int tid) {
    const S5Lds L = s5_lds(lds); LAS float* pwr = L.pwr; LAS float* pwi = L.pwi; LAS float* bbr = L.bbr; LAS float* bbi = L.bbi;
    bf16* w1 = W1T + (size_t)g * 256 * 512;
    for (int pc = row_lo * 64 + tid; pc < row_hi * 64; pc += NTHREADS) { const int row = pc >> 6, c8 = pc & 63, p = row >> 1, ri = row & 1, i = c8 >> 1, m0 = (c8 & 1) * 8; float v[8];
        const float ar = pwr[p * 33 + 31 - i], ai = pwi[p * 33 + 31 - i];
#pragma unroll
        for (int e = 0; e < 8; ++e) { const float br = bbr[p * 16 + m0 + e], bi = bbi[p * 16 + m0 + e]; v[e] = ri ? (ar * bi + ai * br) : (ar * br - ai * bi); }
        v4u o; o.x = pk2(v[0], v[1]); o.y = pk2(v[2], v[3]); o.z = pk2(v[4], v[5]); o.w = pk2(v[6], v[7]);
        *(GAS v4u*)(w1 + (size_t)row * 512 + c8 * 8) = o; }
}

constexpr int KS_PITCH = 144, VS_PITCH = 520, ATT_KS = 0, ATT_VS = 256 * KS_PITCH;
static_assert(ATT_VS + 64 * VS_PITCH <= RING_BYTES, "attention LDS");
#define MFMA32(a, b, c) __builtin_amdgcn_mfma_f32_32x32x16_bf16(a, b, c, 0, 0, 0)
struct KVRegs { v4u k[4]; v4u v[4]; };
__device__ __forceinline__ void att_load(KVRegs& R, const bf16* Kg, int kpitch, const bf16* Vg, int vpitch, int tid) {
#pragma unroll
    for (int i = 0; i < 4; ++i) { const int p = tid + NTHREADS * i, row = p >> 3, c = p & 7; R.k[i] = *(const GAS v4u*)(Kg + (size_t)row * kpitch + c * 8); }
#pragma unroll
    for (int i = 0; i < 4; ++i) { const int p = tid + NTHREADS * i, row = p >> 5, c = p & 31; R.v[i] = *(const GAS v4u*)(Vg + (size_t)row * vpitch + c * 8); }
}
__device__ __forceinline__ void att_store(LAS unsigned char* lds, const KVRegs& R, int tid) {
#pragma unroll
    for (int i = 0; i < 4; ++i) { const int p = tid + NTHREADS * i, row = p >> 3, c = p & 7; *(LAS v4u*)(lds + ATT_KS + row * KS_PITCH + c * 16) = R.k[i]; }
#pragma unroll
    for (int i = 0; i < 4; ++i) { const int p = tid + NTHREADS * i, row = p >> 5, c = p & 31;
        LAS v2u* d = (LAS v2u*)(lds + ATT_VS + row * VS_PITCH + c * 16); d[0] = (v2u){R.v[i].x, R.v[i].y}; d[1] = (v2u){R.v[i].z, R.v[i].w}; }
}
__device__ __forceinline__ void att_stage(LAS unsigned char* lds, const bf16* Kg, int kpitch, const bf16* Vg, int vpitch, int tid) { KVRegs R; att_load(R, Kg, kpitch, Vg, vpitch, tid); att_store(lds, R, tid); }
__device__ __forceinline__ void att_qk(const LAS unsigned char* lds, const bf16x8 (&qf)[4], int kt, f32x16& p0, f32x16& p1, int lane) {
    const int r32 = lane & 31, hi = lane >> 5;
#pragma unroll
    for (int r = 0; r < 16; ++r) { p0[r] = 0.f; p1[r] = 0.f; }
    const LAS unsigned char* kb = lds + ATT_KS + (kt * 64 + r32) * KS_PITCH + hi * 16;
#pragma unroll
    for (int d0 = 0; d0 < 4; ++d0) { const bf16x8 k0 = *(const LAS bf16x8*)(kb + d0 * 32), k1 = *(const LAS bf16x8*)(kb + 32 * KS_PITCH + d0 * 32);
        p0 = MFMA32(k0, qf[d0], p0); p1 = MFMA32(k1, qf[d0], p1); }
}
template <int MODE> __device__ __forceinline__ void att_finish(const LAS unsigned char* lds, int kt, f32x16& p0, f32x16& p1, f32x16& o0, f32x16& o1, float& l, int qloc, bool rowoff, int lane) {
    const int r32 = lane & 31, hi = lane >> 5; const float NEG = -__builtin_inff();
    if (MODE == 1) { const int kv0 = kt * 64 + 4 * hi;
#pragma unroll
        for (int r = 0; r < 16; ++r) { const int kv = kv0 + (r & 3) + 8 * (r >> 2); if (kv > qloc) p0[r] = NEG; if (kv + 32 > qloc) p1[r] = NEG; } }
    float rs = 0.f;
#pragma unroll
    for (int r = 0; r < 16; ++r) { p0[r] = __builtin_amdgcn_exp2f(p0[r]); p1[r] = __builtin_amdgcn_exp2f(p1[r]); rs += p0[r] + p1[r]; }
    if (MODE == 2) rs = rowoff ? 0.f : rs;
    l += rs;
    bf16x8 pb[4];
#pragma unroll
    for (int s = 0; s < 2; ++s) { v4u w0, w1;
        w0.x = cvt_pk_bf16(p0[8 * s + 0], p0[8 * s + 1]); w0.y = cvt_pk_bf16(p0[8 * s + 2], p0[8 * s + 3]); w0.z = cvt_pk_bf16(p0[8 * s + 4], p0[8 * s + 5]); w0.w = cvt_pk_bf16(p0[8 * s + 6], p0[8 * s + 7]);
        w1.x = cvt_pk_bf16(p1[8 * s + 0], p1[8 * s + 1]); w1.y = cvt_pk_bf16(p1[8 * s + 2], p1[8 * s + 3]); w1.z = cvt_pk_bf16(p1[8 * s + 4], p1[8 * s + 5]); w1.w = cvt_pk_bf16(p1[8 * s + 6], p1[8 * s + 7]);
        if (MODE == 2) { if (rowoff) { w0 = (v4u){0u, 0u, 0u, 0u}; w1 = (v4u){0u, 0u, 0u, 0u}; } }
        pb[s] = __builtin_bit_cast(bf16x8, w0); pb[2 + s] = __builtin_bit_cast(bf16x8, w1); }
    const LAS unsigned char* vb = lds + ATT_VS + r32 * VS_PITCH + (kt * 64 + 4 * hi) * 2;
#pragma unroll
    for (int s = 0; s < 4; ++s) { const int ko = (32 * (s >> 1) + 16 * (s & 1)) * 2;
        const s16x4 a0 = *(const LAS s16x4*)(vb + ko), a1 = *(const LAS s16x4*)(vb + ko + 16);
        const s16x4 b0 = *(const LAS s16x4*)(vb + 32 * VS_PITCH + ko), b1 = *(const LAS s16x4*)(vb + 32 * VS_PITCH + ko + 16);
        const bf16x8 va = (bf16x8){a0[0], a0[1], a0[2], a0[3], a1[0], a1[1], a1[2], a1[3]}, vc = (bf16x8){b0[0], b0[1], b0[2], b0[3], b1[0], b1[1], b1[2], b1[3]};
        o0 = MFMA32(va, pb[s], o0); o1 = MFMA32(vc, pb[s], o1); }
}
template <int MODE> __device__ __forceinline__ void att_block(const LAS unsigned char* lds, const bf16x8 (&qf)[4], f32x16& o0, f32x16& o1, float& l, int nkt, int qloc, bool rowoff, int lane) {
    f32x16 pa0, pa1, pb0, pb1;
    att_qk(lds, qf, 0, pa0, pa1, lane);
    int kt = 0;
    for (; kt + 1 < nkt; kt += 2) {
        att_qk(lds, qf, kt + 1, pb0, pb1, lane);
        att_finish<MODE>(lds, kt, pa0, pa1, o0, o1, l, qloc, rowoff, lane);
        if (kt + 2 < nkt) att_qk(lds, qf, kt + 2, pa0, pa1, lane);
        att_finish<MODE>(lds, kt + 1, pb0, pb1, o0, o1, l, qloc, rowoff, lane);
    }
    if (kt < nkt) att_finish<MODE>(lds, kt, pa0, pa1, o0, o1, l, qloc, rowoff, lane);
}
__device__ __forceinline__ void att_load_q(const bf16* qrow  , float (&qv)[4][8], bf16x8 (&qf)[4]) {
    float ss = 0.f;
#pragma unroll
    for (int d0 = 0; d0 < 4; ++d0) { const v4u w = *(const GAS v4u*)(qrow + d0 * 16);
        qv[d0][0] = bf_lo(w.x); qv[d0][1] = bf_hi(w.x); qv[d0][2] = bf_lo(w.y); qv[d0][3] = bf_hi(w.y); qv[d0][4] = bf_lo(w.z); qv[d0][5] = bf_hi(w.z); qv[d0][6] = bf_lo(w.w); qv[d0][7] = bf_hi(w.w);
#pragma unroll
        for (int e = 0; e < 8; ++e) ss += qv[d0][e] * qv[d0][e]; }
    ss += __shfl_xor(ss, 32);
    const float sc = (1.f / sqrtf(ss * (1.f / 64.f) + RMS_EPS)) * (0.125f * 1.4426950408889634f);
#pragma unroll
    for (int d0 = 0; d0 < 4; ++d0) { v4u w; w.x = cvt_pk_bf16(qv[d0][0] * sc, qv[d0][1] * sc); w.y = cvt_pk_bf16(qv[d0][2] * sc, qv[d0][3] * sc); w.z = cvt_pk_bf16(qv[d0][4] * sc, qv[d0][5] * sc); w.w = cvt_pk_bf16(qv[d0][6] * sc, qv[d0][7] * sc);
        qf[d0] = __builtin_bit_cast(bf16x8, w); }
}
constexpr int ATT_OST = 73728, OST_PITCH = 144;
static_assert(ATT_OST >= ATT_VS + 64 * VS_PITCH && ATT_OST + 8 * 32 * OST_PITCH <= RING_BYTES, "attention output stage");
template <bool OUT8 = false  >
__device__ __forceinline__ void att_store_o(LAS unsigned char* lds, bf16* obase  , int opitch, const f32x16& o0, const f32x16& o1, float l, int lane, int wid) {
    const int r32 = lane & 31, hi = lane >> 5;
    l += __shfl_xor(l, 32); const float inv = 1.f / l;
    LAS unsigned char* st = lds + ATT_OST + wid * (32 * OST_PITCH);
    if constexpr (OUT8) {
        const float i8 = inv * 8.f;
#pragma unroll
        for (int a = 0; a < 4; ++a) {
            *(LAS unsigned*)(st + r32 * OST_PITCH + (8 * a + 4 * hi)) = pg8::pk4_fp8(__builtin_amdgcn_fmed3f(o0[4 * a] * i8, -440.f, 440.f), __builtin_amdgcn_fmed3f(o0[4 * a + 1] * i8, -440.f, 440.f), __builtin_amdgcn_fmed3f(o0[4 * a + 2] * i8, -440.f, 440.f), __builtin_amdgcn_fmed3f(o0[4 * a + 3] * i8, -440.f, 440.f));
            *(LAS unsigned*)(st + r32 * OST_PITCH + (32 + 8 * a + 4 * hi)) = pg8::pk4_fp8(__builtin_amdgcn_fmed3f(o1[4 * a] * i8, -440.f, 440.f), __builtin_amdgcn_fmed3f(o1[4 * a + 1] * i8, -440.f, 440.f), __builtin_amdgcn_fmed3f(o1[4 * a + 2] * i8, -440.f, 440.f), __builtin_amdgcn_fmed3f(o1[4 * a + 3] * i8, -440.f, 440.f)); }
        LDS_WAIT(); asm volatile("" ::: "memory");
#pragma unroll
        for (int i = 0; i < 2; ++i) { const int idx = lane + 64 * i, row = idx >> 2, c = idx & 3;
            const v4u v = *(const LAS v4u*)(st + row * OST_PITCH + c * 16);
            *(GAS v4u*)((unsigned char*)obase + (size_t)row * opitch + c * 16) = v; }
        LDS_WAIT(); asm volatile("" ::: "memory");
        return; }
#pragma unroll
    for (int a = 0; a < 4; ++a) {
        *(LAS v2u*)(st + r32 * OST_PITCH + (8 * a + 4 * hi) * 2) = (v2u){cvt_pk_bf16(o0[4 * a] * inv, o0[4 * a + 1] * inv), cvt_pk_bf16(o0[4 * a + 2] * inv, o0[4 * a + 3] * inv)};
        *(LAS v2u*)(st + r32 * OST_PITCH + (32 + 8 * a + 4 * hi) * 2) = (v2u){cvt_pk_bf16(o1[4 * a] * inv, o1[4 * a + 1] * inv), cvt_pk_bf16(o1[4 * a + 2] * inv, o1[4 * a + 3] * inv)}; }
    LDS_WAIT(); asm volatile("" ::: "memory");
#pragma unroll
    for (int i = 0; i < 4; ++i) { const int idx = lane + 64 * i, row = idx >> 3, c = idx & 7;
        const v4u v = *(const LAS v4u*)(st + row * OST_PITCH + c * 16);
        *(GAS v4u*)(obase + (size_t)row * opitch + c * 8) = v; }
    LDS_WAIT(); asm volatile("" ::: "memory");
}
template <bool OUT8 = false  >
__device__ __forceinline__ void mem_unit(LAS unsigned char* lds, const bf16* Q, int qpitch, const bf16* Kg, const bf16* Vg, bf16* O, int tid) {
    const int lane = tid & 63, wid = __builtin_amdgcn_readfirstlane(tid >> 6), r32 = lane & 31, hi = lane >> 5;
    att_stage(lds, Kg, 512, Vg, 2048, tid);
    float qv[4][8]; bf16x8 qf[4];
    att_load_q(Q + (size_t)(wid * 32 + r32) * qpitch + hi * 8, qv, qf);
    __syncthreads();
    f32x16 o0, o1; float l = 0.f;
#pragma unroll
    for (int r = 0; r < 16; ++r) { o0[r] = 0.f; o1[r] = 0.f; }
    att_block<0>(lds, qf, o0, o1, l, 4, 0, false, lane);
    if constexpr (OUT8) att_store_o<true>(lds, (bf16*)((unsigned char*)O + (size_t)(wid * 32) * 1024), 1024, o0, o1, l, lane, wid);
    else att_store_o(lds, O + (size_t)(wid * 32) * 1024, 1024, o0, o1, l, lane, wid);
    __syncthreads();
}
__device__ __forceinline__ void moba_unit(LAS unsigned char* lds, int b, int qh, int qblk, const bf16* KQ, const bf16* VT, const float* KMEANS, bf16* CAT, int tid) {
    const int lane = tid & 63, wid = __builtin_amdgcn_readfirstlane(tid >> 6), r32 = lane & 31, hi = lane >> 5, kvh = qh / 3;
    const size_t tok0 = (size_t)b * SEQ + (size_t)qblk * 256;
    att_stage(lds, KQ + tok0 * 1280 + kvh * 64, 1280, VT + (size_t)(kvh * 64) * T + tok0, T, tid);
    float qv[4][8]; bf16x8 qf[4];
    att_load_q(KQ + (tok0 + wid * 32 + r32) * 1280 + 256 + qh * 64 + hi * 8, qv, qf);
    unsigned sel = 0u;
    if (qblk > 0) {
        float gt[7];
#pragma unroll
        for (int j = 0; j < 7; ++j) { gt[j] = -3e38f;
            if (j < qblk) { const float* km = KMEANS + (size_t)((b * 4 + kvh) * 8 + j) * 64 + hi * 8; float a = 0.f;
#pragma unroll
                for (int d0 = 0; d0 < 4; ++d0) { const f32x4 k0 = *(const GAS f32x4*)(km + d0 * 16), k1 = *(const GAS f32x4*)(km + d0 * 16 + 4);
                    a += qv[d0][0] * k0[0] + qv[d0][1] * k0[1] + qv[d0][2] * k0[2] + qv[d0][3] * k0[3] + qv[d0][4] * k1[0] + qv[d0][5] * k1[1] + qv[d0][6] * k1[2] + qv[d0][7] * k1[3]; }
                a += __shfl_xor(a, 32); gt[j] = a; } }
#pragma unroll
        for (int j = 0; j < 7; ++j) { int rank = 0;
#pragma unroll
            for (int j2 = 0; j2 < 7; ++j2) if (j2 != j) rank += (gt[j2] > gt[j] || (gt[j2] == gt[j] && j2 < j)) ? 1 : 0;
            if (j < qblk && rank < 3) sel |= 1u << j; }
    }
    __syncthreads();
    f32x16 o0, o1; float l = 0.f;
#pragma unroll
    for (int r = 0; r < 16; ++r) { o0[r] = 0.f; o1[r] = 0.f; }
    att_block<1>(lds, qf, o0, o1, l, (wid >> 1) + 1, wid * 32 + r32, false, lane);
    for (int j = 0; j < qblk; ++j) {
        __syncthreads();
        { const size_t tk = (size_t)b * SEQ + (size_t)j * 256; att_stage(lds, KQ + tk * 1280 + kvh * 64, 1280, VT + (size_t)(kvh * 64) * T + tk, T, tid); }
        __syncthreads();
        const bool off = !((sel >> j) & 1u);
        if (!__all(off)) att_block<2>(lds, qf, o0, o1, l, 4, 0, off, lane);
    }
    att_store_o<true>(lds, (bf16*)((unsigned char*)CAT + (size_t)(tok0 + wid * 32) * 1024 + qh * 64), 1024, o0, o1, l, lane, wid);
    __syncthreads();
}

struct Args { const float* in[42]; float* out; unsigned char* ws; int ph_lo, ph_hi; };
constexpr int NPHASE = 21;
__global__ void __launch_bounds__(NTHREADS, 2) fwd_kernel(Args args) {
    extern __shared__ __attribute__((aligned(16))) unsigned char lds_raw[];
    LAS unsigned char* lds = (LAS unsigned char*)lds_raw;
    volatile LAS unsigned* MISC = (volatile LAS unsigned*)(lds + MISC_OFF);
    const int tid = threadIdx.x, lane = tid & 63, wave = __builtin_amdgcn_readfirstlane(tid >> 6);
    const int G = gridDim.x, bx = blockIdx.x;
    const int gw = bx * NWAVES + wave, NGW = G * NWAVES;
    unsigned char* ws = args.ws;
    gu32* ctl = (gu32*)(ws + WS_CTL);
    for (int u = tid; u < (LDS_BYTES - RING_BYTES) / 4; u += NTHREADS) ((LAS unsigned*)(lds + RING_BYTES))[u] = 0u;
    __syncthreads();
    const int lo = args.ph_lo, hi_ph = args.ph_hi;
    XcdBarrier bar; bar.bar = (unsigned*)(ctl + CW_BAR); bar.x = 0; bar.st = nullptr;
    if (hi_ph - lo > 1) bar = xcd_barrier_post((unsigned*)(ctl + CW_BAR), MISC + 8);
#define IN(k) (lo <= (k) && (k) < hi_ph)
#define SEAM(k) do { if (IN(k) && IN((k) + 1)) xcd_barrier(bar); } while (0)
    const float* const* in = args.in;
    float* OUT = args.out;
    bf16* W_MEMK = (bf16*)(ws + WS_WMEMK); bf16* W_MEMV = (bf16*)(ws + WS_WMEMV); bf16* W_KQ = (bf16*)(ws + WS_WKQ); bf16* W_V = (bf16*)(ws + WS_WV); bf16* W_OUT1 = (bf16*)(ws + WS_WOUT1);
    bf16* W_MGU = (bf16*)(ws + WS_WMGU); bf16* W_MD = (bf16*)(ws + WS_WMD);
    bf16* XB = (bf16*)(ws + WS_XB); bf16* CAT = (bf16*)(ws + WS_CAT); bf16* MEMN = (bf16*)(ws + WS_MEMN); bf16* MEMK = (bf16*)(ws + WS_MEMK); bf16* MEMVT = (bf16*)(ws + WS_MEMVT);
    bf16* XS = (bf16*)(ws + AR_XS); bf16* ACTM = (bf16*)(ws + AR_ACTM);
    bf16* W_IN0 = (bf16*)(ws + AR_WIN0); bf16* W_GLU = (bf16*)(ws + AR_WGLU); bf16* W_OUT0 = (bf16*)(ws + AR_WOUT0); bf16* W_FGU = (bf16*)(ws + AR_WFGU); bf16* W_FD = (bf16*)(ws + AR_WFD);
    bf16* TZ = (bf16*)(ws + AR_TZ); bf16* W1T = (bf16*)(ws + AR_W1T); bf16* UG = (bf16*)(ws + AR_UG); bf16* QM0 = (bf16*)(ws + AR_QM0); float* XC = (float*)(ws + AR_XC); bf16* GACT = (bf16*)(ws + AR_GACT);
    unsigned char* X8 = ws + AR_X8;
    float* S5SM = (float*)(ws + AR_S5SM);
    bf16* ACT0 = (bf16*)(ws + AR_ACT0); bf16* KQ = (bf16*)(ws + AR_KQ); bf16* VT = (bf16*)(ws + AR_VT);
    float* KMEANS = (float*)(ws + SM_KMEANS); float* LAM32 = (float*)(ws + SM_LAM32); int* PANEND = (int*)(ws + SM_PANEND);
    int* WGCNT = (int*)(ws + WS_MEMN + 3 * MiB);
    float* XSC = (float*)(ws + WS_SMALL + 896 * 1024);
    float* SS = (float*)(ws + WS_MEMN); float* ROWRS = (float*)(ws + WS_MEMN + MiB); float* TOKRS = (float*)(ws + WS_MEMN + 2 * MiB);
    int* TOKE = (int*)(ws + SM_TOKE); int* TOKLP = (int*)(ws + SM_TOKLP); float* TOKG = (float*)(ws + SM_TOKG); int* ROWTOK = (int*)(ws + SM_ROWTOK); float* ROWGATE = (float*)(ws + SM_ROWGATE);

    constexpr int I_SQ = 16 * 16, I_GLU = 12 * 12, I_M = 16 * 4, I_F = 16 * 44, I_FD = 44 * 16;
    constexpr int CVT_P0_END = I_SQ + 4 * I_M, CVT_P2_END = CVT_P0_END + I_GLU + 3 * I_SQ + 2 * I_M, NITEMS = CVT_P2_END + 2 * I_F + I_FD;
    static_assert(NITEMS == 4 * I_SQ + I_GLU + 6 * I_M + 2 * I_F + I_FD, "items");
#define CV_F8(NI, SRC, LDW, NPB, GAIN, DST, LDO, ROW0) if (r < (NI)) { const int kb = r / (NPB), n0 = (r % (NPB)) * 64; CvtDesc8 d; d.src = (SRC) + (size_t)(kb * 64) * (LDW) + n0; d.gain = (GAIN); d.dst = (unsigned char*)(DST) + (size_t)((ROW0) + n0) * (LDO) + kb * 64; d.ldw = (LDW); d.ldo = (LDO); d.k0 = kb * 64; \
                f32x4 a[4][4]; float gq[4][4]; cvt_load8(d, a, gq, MOE_WSCALE, lane); cvt_emit8(d, a, gq, scr, lane); continue; } r -= (NI);
#define CV_PLAIN(NI, SRC, LDW, NPB, GAIN, DST, LDO, ROW0) if (r < (NI)) { const int kb = r / (NPB), n0 = (r % (NPB)) * 64; cvt_item(SRC, LDW, kb * 64, n0, GAIN, DST, LDO, (ROW0) + n0, scr, lane); continue; } r -= (NI);
#define CVT_RUN(QWORD, LO, HI) do { LAS unsigned* scr = (LAS unsigned*)(lds + wave * 16384); \
        for (;;) { int it0 = 0; if (lane == 0) it0 = (LO) + (int)__hip_atomic_fetch_add((unsigned*)(ctl + CW_QUEUE + (QWORD)), 2u, __ATOMIC_RELAXED, __HIP_MEMORY_SCOPE_AGENT); \
            it0 = __builtin_amdgcn_readfirstlane(it0); \
            if (it0 >= (HI)) break; \
            for (int it = it0; it < it0 + 2 && it < (HI); ++it) { int r = it; \
            CV_PLAIN(I_SQ, in[3], 1024, 16, in[2], W_IN0, 1024, 0) \
            CV_PLAIN(I_M, in[15], 256, 4, in[14], W_MEMK, 1024, 0) \
            CV_PLAIN(I_M, in[32], 256, 4, in[31], W_MEMK, 1024, 256) \
            CV_PLAIN(I_M, in[16], 256, 4, in[14], W_MEMV, 1024, 0) \
            CV_PLAIN(I_M, in[33], 256, 4, in[31], W_MEMV, 1024, 256) \
            CV_PLAIN(I_GLU, in[12], 768, 12, nullptr, W_GLU, 768, 0) \
            CV_PLAIN(I_SQ, in[19], 1024, 16, nullptr, W_OUT0, 1024, 0) \
            CV_F8(I_SQ, in[29], 1024, 16, in[28], W_KQ, 1024, 256) \
            CV_F8(I_M, in[25], 256, 4, in[24], W_KQ, 1024, 0) \
            CV_F8(I_M, in[26], 256, 4, in[24], W_V, 1024, 0) \
            CV_F8(I_SQ, in[36], 1024, 16, nullptr, W_OUT1, 1024, 0) \
            if (r < 2 * I_F) { const int up = r / I_F; r -= up * I_F; const int kb = r / 44, n0 = (r % 44) * 64; \
                cvt_item(in[21 + up], DFF, kb * 64, n0, in[20], W_FGU, 1024, (n0 >> 7) * 256 + (n0 & 127) + up * 128, scr, lane); continue; } \
            r -= 2 * I_F; \
            CV_F8(I_FD, in[23], 1024, 16, nullptr, W_FD, DFF, 0) \
            } } } while (0)
    if (IN(0)) {
        if (bx < 48) s5_tables_small(bx, lds, in[4], in[5], in[6], in[7], in[8], in[9], in[10], S5SM, LAM32, tid);
        CVT_RUN(64, 0, CVT_P0_END);
        for (;;) {
            int r0 = 0; if (lane == 0) r0 = (int)__hip_atomic_fetch_add((unsigned*)(ctl + CW_QUEUE + 192), 16u, __ATOMIC_RELAXED, __HIP_MEMORY_SCOPE_AGENT);
            r0 = __builtin_amdgcn_readfirstlane(r0);
            if (r0 >= T + NB * 256) break;
            for (int mrow = r0; mrow < r0 + 16; ++mrow) { if (mrow < T) rms_row_to_bf16(in[0] + (size_t)mrow * D, XB + (size_t)mrow * D, lane, XSC + mrow); else rms_row_to_bf16(in[1] + (size_t)(mrow - T) * D, MEMN + (size_t)(mrow - T) * D, lane); } }
        for (int i = bx * NTHREADS + tid; i < 2 * RROWS; i += G * NTHREADS) ROWTOK[i] = -1;
    }
    SEAM(0);
    if (IN(1)) { pg8::Gemm g{XB, W_IN0, 1024, 1024, 1024}; pg8::StaticOrder S; S.init(T / 256, 4, G, bx); pg8::EpiProj0 E{UG, QM0};
        pg8::gemm_phase<pg8::EpiProj0, pg8::StaticOrder, true, true>(lds, g, S, E);
        if (bx < 192) { const int sg = bx >> 2, sq = bx & 3; s5_load(sg, lds, S5SM, in[9], in[10], false, tid); s5_expand_w1t(sg, lds, W1T, sq * 32, sq * 32 + 32, tid); __syncthreads(); } }
    SEAM(1);
    if (IN(2)) {
        if (bx < 96) { pg8::Gemm g{UG, W1T, 640, 512, 512}; pg8::BatchOrder S; S.init(48, 2, 1, 96, bx); pg8::EpiS5a E{XC};
          pg8::gemm_phase<pg8::EpiS5a, pg8::BatchOrder, true, true>(lds, g, S, E);
          if (tid < 256) { const int g = bx >> 1, mt = bx & 1, bl = tid >> 6, p = tid & 63;
            const float lr = LAM32[(g * 64 + p) * 2], li = LAM32[(g * 64 + p) * 2 + 1]; float hr = 0.f, hi_ = 0.f;
            const size_t row0 = (size_t)g * 512 + mt * 256 + bl * 64;
            for (int c = 0; c < 64; ++c) { const float xr = XC[(row0 + c) * 128 + 2 * p], xi = XC[(row0 + c) * 128 + 2 * p + 1];
                *(GAS unsigned*)(UG + (row0 + c) * 640 + 512 + 2 * p) = cvt_pk_bf16(hr, hi_);
                const float nr = lr * hr - li * hi_ + xr, ni = lr * hi_ + li * hr + xi; hr = nr; hi_ = ni; } } }
        else if (bx < 112) { pg8::Gemm g{MEMN, W_MEMK, 1024, 1024, 1024}; pg8::StaticOrder S; S.init(8, 2, 16, bx - 96); pg8::EpiPlain E{MEMK, 512, 0, 0};
          pg8::gemm_phase<pg8::EpiPlain, pg8::StaticOrder, true, true>(lds, g, S, E);
          pg8::Unit u; S.next(0, u); const int layer = u.pn; const float* kg = layer ? in[35] : in[18]; const float* qg = layer ? in[34] : in[17];
          const int c0 = lane * 4, d = c0 & 63; float gk[4];
#pragma unroll
          for (int e = 0; e < 4; ++e) gk[e] = kg[d + e] * qg[d + e];
          for (int rr = 0; rr < 32; ++rr) { bf16* p = MEMK + (size_t)(u.pm * 256 + wave * 32 + rr) * 512 + layer * 256 + c0; const v2u w = *(const GAS v2u*)p;
              float v[4] = {bf_lo(w.x), bf_hi(w.x), bf_lo(w.y), bf_hi(w.y)}; float ss = v[0] * v[0] + v[1] * v[1] + v[2] * v[2] + v[3] * v[3];
              ss += __shfl_xor(ss, 1); ss += __shfl_xor(ss, 2); ss += __shfl_xor(ss, 4); ss += __shfl_xor(ss, 8);
              const float r = 1.f / sqrtf(ss * (1.f / 64.f) + RMS_EPS);
              *(GAS v2u*)p = (v2u){cvt_pk_bf16(v[0] * r * gk[0], v[1] * r * gk[1]), cvt_pk_bf16(v[2] * r * gk[2], v[3] * r * gk[3])}; } }
        else if (bx < 128) { pg8::Gemm g{W_MEMV, MEMN, 1024, 1024, 1024}; pg8::StaticOrder S; S.init(2, 8, 16, bx - 112); pg8::EpiPlain E{MEMVT, 2048, 0, 0};
          pg8::gemm_phase<pg8::EpiPlain, pg8::StaticOrder, true, true>(lds, g, S, E); }
        else { int cur = -1;
          for (int it = (bx - 128) * 3; it < (bx - 128) * 3 + 3; ++it) { const int sg = it >> 3, part = it & 7;
              if (sg != cur) { __syncthreads(); s5_load(sg, lds, S5SM, in[9], in[10], true, tid); cur = sg; }
              s5_expand_tz(sg, lds, TZ, part * 64, part * 64 + 64, tid); }
          __syncthreads();
          CVT_RUN(256, CVT_P0_END, CVT_P2_END); }
    }
    SEAM(2);
    if (IN(4)) {
        if (bx < 192) { pg8::Gemm g{UG, TZ, 640, 640, 640}; pg8::BatchOrder S; S.init(48, 2, 2, 192, bx); pg8::EpiS5c E{UG, in[11], GACT};
            pg8::gemm_phase<pg8::EpiS5c, pg8::BatchOrder, true, true>(lds, g, S, E); }
        for (;;) {
            if (tid == 0) MISC[0] = __hip_atomic_fetch_add((unsigned*)(ctl + CW_QUEUE + 128), 1u, __ATOMIC_RELAXED, __HIP_MEMORY_SCOPE_AGENT);
            __syncthreads();
            const int u = (int)MISC[0];
            __syncthreads();
            if (u >= 256) break;
            const int b = u >> 5, h = (u >> 3) & 3, qt = u & 7; const size_t t0 = (size_t)b * SEQ + qt * 256;
            mem_unit(lds, QM0 + t0 * 256 + h * 64, 256, MEMK + (size_t)(b * 256) * 512 + h * 64, MEMVT + (size_t)(h * 64) * 2048 + b * 256, CAT + t0 * 1024 + 768 + h * 64, tid); }
    }
    SEAM(4);
    if (IN(5)) { pg8::Gemm g{GACT, W_GLU, T, 768, 768, 1}; pg8::StaticOrder S; S.init(T / 256, 3, G, bx); pg8::EpiGlu E{GACT, in[13], CAT};
        pg8::gemm_phase<pg8::EpiGlu, pg8::StaticOrder, true, true>(lds, g, S, E);
        pg8::Unit u0; if (!S.next(0, u0)) CVT_RUN(320, CVT_P2_END, NITEMS); }
    SEAM(5);
    if (IN(6)) { pg8::Gemm g{CAT, W_OUT0, 1024, 1024, 1024}; pg8::StaticOrder S; S.init(T / 256, 4, G, bx); pg8::EpiResidB<true> E{XSC, XB, SS, 1.f, nullptr};
        pg8::gemm_phase<pg8::EpiResidB<true>, pg8::StaticOrder, true, true>(lds, g, S, E); }
    SEAM(6);
    if (IN(8)) {
        pg8::Gemm g{XB, W_FGU, 1024, 1024, 1024}; pg8::EpiSwiglu<1, true> E{ACT0, DFF, 22, 0, SS, MOE_ASCALE};
        const int slot = (bx >> 3) & 3, n1 = (slot == 0) ? 0 : (slot == 1) ? 1 : (slot == 2) ? 3 : 4;
        { pg8::RangeOrder S; S.S.init(T / 256, 22, G, bx); S.i0 = 0; S.i1 = n1; pg8::gemm_phase<pg8::EpiSwiglu<1, true>, pg8::RangeOrder, true, true>(lds, g, S, E); }
        { LAS unsigned* scr = (LAS unsigned*)(lds + wave * 16384);
          constexpr int I_E = (1024 / 64) * (DFE / 64), I_ED = (DFE / 64) * (1024 / 64), I_MOE = NEXP * (2 * I_E + I_ED), SHARE = (I_MOE + 255) / 256;
#define MOE_DESC(D_, IT_) do { int r = (IT_); const int e = r / (2 * I_E + I_ED); r -= e * (2 * I_E + I_ED); \
              if (r < 2 * I_E) { const int up = r / I_E; r -= up * I_E; const int kb = r / (DFE / 64), n0 = (r % (DFE / 64)) * 64; \
                  (D_).src = in[39 + up] + (size_t)e * 1024 * DFE + (size_t)(kb * 64) * DFE + n0; (D_).ldw = DFE; (D_).gain = in[37]; (D_).k0 = kb * 64; (D_).ldo = 1024; \
                  (D_).dst = (unsigned char*)W_MGU + (size_t)(e * 7168 + (n0 >> 7) * 256 + (n0 & 127) + up * 128) * 1024 + kb * 64; } \
              else { r -= 2 * I_E; const int kb = r / 16, n0 = (r % 16) * 64; \
                  (D_).src = in[41] + (size_t)e * DFE * 1024 + (size_t)(kb * 64) * 1024 + n0; (D_).ldw = 1024; (D_).gain = nullptr; (D_).k0 = kb * 64; (D_).ldo = DFE; \
                  (D_).dst = (unsigned char*)W_MD + (size_t)(e * 1024 + n0) * DFE + kb * 64; } } while (0)
          static_assert(SHARE == 84 && I_MOE == 256 * 84, "share sizes");
          const int it_beg = (bx < 128) ? bx * 72 : 128 * 72 + (bx - 128) * 96, it_end = it_beg + ((bx < 128) ? 72 : 96);
          for (int it = it_beg + wave; it < it_end; it += NWAVES) { CvtDesc8 d0; f32x4 a0[4][4]; float g0[4][4]; MOE_DESC(d0, it); cvt_load8_dma(d0, a0, g0, MOE_WSCALE, (LAS unsigned char*)scr, lane); cvt_emit8(d0, a0, g0, scr, lane); }
#undef MOE_DESC
          __syncthreads(); }
        { pg8::RangeOrder S; S.S.init(T / 256, 22, G, bx); S.i0 = n1; S.i1 = 1 << 20; pg8::gemm_phase<pg8::EpiSwiglu<1, true>, pg8::RangeOrder, true, true>(lds, g, S, E); }
    }
    SEAM(8);
    if (IN(9)) { pg8::Gemm g{ACT0, W_FD, DFF / 2, DFF / 2, DFF / 2}; pg8::StaticOrder S; S.init(T / 256, 4, G, bx); pg8::EpiResidB<false, true> E{nullptr, XB, SS, 1.f / (MOE_WSCALE * MOE_ASCALE), X8};
        pg8::gemm_phase<pg8::EpiResidB<false, true>, pg8::StaticOrder, true, true, true>(lds, g, S, E); }
    SEAM(9);
    if (IN(11)) {
        { pg8::Gemm g{(bf16*)X8, W_KQ, 512, 512, 512}; pg8::StaticOrder S; S.init(T / 256, 5, G, bx); pg8::EpiPlainS<1> E{KQ, 1280, 0, 0, SS, 1.f / (MOE_WSCALE * 8.f)};
          pg8::gemm_phase<pg8::EpiPlainS<1>, pg8::StaticOrder, true, true, true>(lds, g, S, E);
          pg8::Unit u;
          for (int i = 0; S.next(i, u); ++i) if (u.pn == 0) {
            const int b = u.pm >> 3, blk = u.pm & 7; const size_t t0 = (size_t)u.pm * 256;
            const int c0 = lane * 4, d = c0 & 63; float gk[4], cs[4] = {0.f, 0.f, 0.f, 0.f};
#pragma unroll
            for (int e = 0; e < 4; ++e) gk[e] = in[27][d + e] * in[30][d + e];
            for (int rr = 0; rr < 32; ++rr) { bf16* p = KQ + (t0 + wave * 32 + rr) * 1280 + c0; const v2u w = *(const GAS v2u*)p;
                float v[4] = {bf_lo(w.x), bf_hi(w.x), bf_lo(w.y), bf_hi(w.y)}; float ss = v[0] * v[0] + v[1] * v[1] + v[2] * v[2] + v[3] * v[3];
                ss += __shfl_xor(ss, 1); ss += __shfl_xor(ss, 2); ss += __shfl_xor(ss, 4); ss += __shfl_xor(ss, 8);
                const float r = 1.f / sqrtf(ss * (1.f / 64.f) + RMS_EPS);
#pragma unroll
                for (int e = 0; e < 4; ++e) { v[e] *= r * gk[e]; cs[e] += v[e]; }
                *(GAS v2u*)p = (v2u){cvt_pk_bf16(v[0], v[1]), cvt_pk_bf16(v[2], v[3])}; }
            LAS float* red = (LAS float*)lds;
#pragma unroll
            for (int e = 0; e < 4; ++e) red[wave * 256 + c0 + e] = cs[e];
            __syncthreads();
            if (tid < 256) { float sm = 0.f;
#pragma unroll
                for (int w = 0; w < 8; ++w) sm += red[w * 256 + tid];
                KMEANS[(size_t)((b * 4 + (tid >> 6)) * 8 + blk) * 64 + (tid & 63)] = sm * (1.f / 256.f); }
            __syncthreads(); } }
        { pg8::Gemm g{W_V, (bf16*)X8, 512, 512, 512}; pg8::StaticOrder S; S.init(1, T / 256, 64, bx - 64); pg8::EpiPlainS<2> E{VT, T, 0, 0, SS, 1.f / (MOE_WSCALE * 8.f)};
          if (bx >= 64) pg8::gemm_phase<pg8::EpiPlainS<2>, pg8::StaticOrder, true, true, true>(lds, g, S, E); }
    }
    SEAM(11);

    if (IN(13)) {
        for (;;) {
            if (tid == 0) MISC[0] = __hip_atomic_fetch_add((unsigned*)(ctl + CW_QUEUE), 1u, __ATOMIC_RELAXED, __HIP_MEMORY_SCOPE_AGENT);
            __syncthreads();
            const int it = (int)MISC[0];
            __syncthreads();
            if (it >= 1024) break;
            if (it < 768) { const int qblk = 7 - it / 96, r = it % 96; moba_unit(lds, r / 12, r % 12, qblk, KQ, VT, KMEANS, CAT, tid); }
            else { const int u = it - 768, b = u >> 5, h = (u >> 3) & 3, qt = u & 7; const size_t t0 = (size_t)b * SEQ + qt * 256;
                mem_unit<true>(lds, KQ + t0 * 1280 + 1024 + h * 64, 1280, MEMK + (size_t)(b * 256) * 512 + 256 + h * 64, MEMVT + (size_t)(256 + h * 64) * 2048 + b * 256, (bf16*)((unsigned char*)CAT + t0 * 1024 + 768 + h * 64), tid); }
        }
    }
    SEAM(13);
    if (IN(14)) { pg8::Gemm g{CAT, W_OUT1, 512, 512, 512}; pg8::StaticOrder S; S.init(T / 256, 4, G, bx); pg8::EpiResidB<false> E{nullptr, XB, SS, 1.f / (MOE_WSCALE * 8.f), nullptr};
        pg8::gemm_phase<pg8::EpiResidB<false>, pg8::StaticOrder, true, true, true>(lds, g, S, E); }
    SEAM(14);
    if (IN(15)) {
        LAS float* wrt = (LAS float*)lds;
        LAS int* el = (LAS int*)(lds + 32768);
        for (int i = tid; i < 8192; i += NTHREADS) { const int k = i >> 3, e = i & 7; wrt[e * 1024 + k] = in[37][k] * in[38][i]; }
        __syncthreads();
        const int tpw = T / G;
        for (int tl = wave; tl < tpw; tl += NWAVES) { const int t = bx * tpw + tl;
            const GAS v2u* xr = (const GAS v2u*)(XB + (size_t)t * D) + lane; f32x4 v[4]; float s = 0.f;
#pragma unroll
            for (int j = 0; j < 4; ++j) { const v2u w = xr[64 * j]; v[j] = (f32x4){bf_lo(w.x), bf_hi(w.x), bf_lo(w.y), bf_hi(w.y)}; s += (v[j].x * v[j].x + v[j].y * v[j].y) + (v[j].z * v[j].z + v[j].w * v[j].w); }
            const float r = 1.f / sqrtf(wave_sum(s) * (1.f / 1024.f) + RMS_EPS);
#pragma unroll
            for (int j = 0; j < 4; ++j) v[j] = v[j] * r;
            float lg[8];
#pragma unroll
            for (int e = 0; e < 8; ++e) { float a = 0.f;
#pragma unroll
                for (int j = 0; j < 4; ++j) { const f32x4 w = *(const LAS f32x4*)(wrt + e * 1024 + 256 * j + 4 * lane); a += v[j].x * w.x + v[j].y * w.y + v[j].z * w.z + v[j].w * w.w; }
                lg[e] = wave_sum(a); }
            int i0 = 0; float v0 = lg[0];
#pragma unroll
            for (int e = 1; e < 8; ++e) if (lg[e] > v0) { v0 = lg[e]; i0 = e; }
            int i1 = -1; float v1 = -3e38f;
#pragma unroll
            for (int e = 0; e < 8; ++e) if (e != i0 && lg[e] > v1) { v1 = lg[e]; i1 = e; }
            const float e1 = __expf(v1 - v0), g0 = 1.f / (1.f + e1), g1 = e1 * g0;
            if (lane == 0) { el[tl] = i0 * 8 + i1; TOKE[2 * t] = i0; TOKE[2 * t + 1] = i1; TOKG[2 * t] = g0; TOKG[2 * t + 1] = g1; TOKRS[t] = r; } }
        __syncthreads();
        if (tid < tpw) { const int pd = el[tid]; int lp = 0; for (int j = 0; j < tid; ++j) lp += (el[j] == pd) ? 1 : 0; TOKLP[(size_t)bx * tpw + tid] = lp; }
        if (tid >= 64 && tid < 128) { const int pd = tid - 64; int n = 0; for (int j = 0; j < tpw; ++j) n += (el[j] == pd) ? 1 : 0; WGCNT[bx * 64 + pd] = n; }
        __syncthreads();
    }
    SEAM(15);
    if (IN(16)) {
        LAS int* tab = (LAS int*)lds; LAS int* Cp = tab + 16384; LAS int* PRE = Cp + 64; LAS int* Fp = PRE + 64; LAS int* bAu = Fp + 64; LAS int* bAf = bAu + 64; LAS int* bBu = bAf + 64; LAS int* bBf = bBu + 64;
        LAS int* offA = bBf + 64; LAS int* offB = offA + 8; LAS int* UA = offB + 8; LAS int* VB = UA + 8;
        for (int i = tid; i < G * 64; i += NTHREADS) tab[i] = WGCNT[i];
        __syncthreads();
        if (tid < 64) { int tot = 0, pre = 0; for (int w = 0; w < G; ++w) { const int v = tab[w * 64 + tid]; if (w < bx) pre += v; tot += v; } Cp[tid] = tot; PRE[tid] = pre; Fp[tid] = 0; }
        __syncthreads();
        if (tid == 0) {
            int n0[8], rr[8], sup[8], dem[8]; int srem = 0;
            for (int e = 0; e < 8; ++e) { int n = 0; for (int b2 = 0; b2 < 8; ++b2) n += Cp[e * 8 + b2]; n0[e] = n; rr[e] = n & 255; srem += rr[e]; sup[e] = rr[e]; dem[e] = 0; }
            const int mup = srem >> 8;
            for (int it = 0; it < mup; ++it) { int be = -1, bv = -1; for (int e = 0; e < 8; ++e) if (dem[e] == 0 && sup[e] > bv) { bv = sup[e]; be = e; }
                if (be >= 0) { dem[be] = 256 - rr[be]; sup[be] = 0; } }
            for (int a = 0; a < 8; ++a) for (int b2 = 0; b2 < 8; ++b2) if (a != b2 && sup[a] > 0 && dem[b2] > 0) { int f = sup[a] < dem[b2] ? sup[a] : dem[b2]; if (Cp[a * 8 + b2] < f) f = Cp[a * 8 + b2];
                Fp[a * 8 + b2] = f; sup[a] -= f; dem[b2] -= f; }
            int oa = 0, ob = 0;
            for (int e = 0; e < 8; ++e) { int ua = 0, vb = 0, fin = 0, fout = 0;
                for (int x = 0; x < 8; ++x) { ua += Cp[e * 8 + x] - Fp[e * 8 + x]; vb += Cp[x * 8 + e] - Fp[x * 8 + e]; fin += Fp[x * 8 + e]; fout += Fp[e * 8 + x]; }
                UA[e] = ua; VB[e] = vb; offA[e] = oa * 256; offB[e] = ob * 256; oa += (ua + fin + 255) >> 8; ob += (vb + fout + 255) >> 8;
                if (bx == 0) { PANEND[e] = oa; PANEND[8 + e] = ob; } }
        }
        __syncthreads();
        if (tid < 64) { const int a = tid >> 3, b2 = tid & 7; int s1 = 0, s2 = 0, s3 = 0, s4 = 0;
            for (int x = 0; x < b2; ++x) { s1 += Cp[a * 8 + x] - Fp[a * 8 + x]; s4 += Fp[a * 8 + x]; }
            for (int x = 0; x < a; ++x) { s2 += Fp[x * 8 + b2]; s3 += Cp[x * 8 + b2] - Fp[x * 8 + b2]; }
            bAu[tid] = offA[a] + s1 - Fp[tid]; bAf[tid] = offA[b2] + UA[b2] + s2; bBu[tid] = offB[b2] + s3 - Fp[tid]; bBf[tid] = offB[a] + VB[a] + s4; }
        __syncthreads();
        const int tpw = T / G;
        for (int tl = wave; tl < tpw; tl += NWAVES) { const int t = bx * tpw + tl;
            const int pd = TOKE[2 * t] * 8 + TOKE[2 * t + 1], q = PRE[pd] + TOKLP[(size_t)bx * tpw + tl]; const bool fl = q < Fp[pd];
            const int rowA = q + (fl ? bAf[pd] : bAu[pd]), rowB = q + (fl ? bBf[pd] : bBu[pd]);
            const float rs_ = TOKRS[t];
            if (lane == 0) { ROWTOK[rowA] = t; ROWGATE[rowA] = TOKG[2 * t + (fl ? 1 : 0)]; ROWRS[rowA] = rs_;
                             ROWTOK[RROWS + rowB] = t; ROWGATE[RROWS + rowB] = TOKG[2 * t + (fl ? 0 : 1)]; ROWRS[RROWS + rowB] = rs_; }
            const GAS v4u* src = (const GAS v4u*)(XB + (size_t)t * D);
            GAS v2u* dA = (GAS v2u*)((unsigned char*)XS + (size_t)rowA * D); GAS v2u* dB = (GAS v2u*)((unsigned char*)XS + ((size_t)RROWS + rowB) * D);
#pragma unroll
            for (int h = 0; h < 2; ++h) { const v4u w = src[64 * h + lane];
                const v2u o = (v2u){pg8::pk4_fp8(bf_lo(w.x) * rs_, bf_hi(w.x) * rs_, bf_lo(w.y) * rs_, bf_hi(w.y) * rs_), pg8::pk4_fp8(bf_lo(w.z) * rs_, bf_hi(w.z) * rs_, bf_lo(w.w) * rs_, bf_hi(w.w) * rs_)};
                dA[64 * h + lane] = o; dB[64 * h + lane] = o; } }
        __syncthreads();
    }
    SEAM(16);
#define MOE_ROUND(PH, KK, FIRST_) \
    if (IN(PH)) { pg8::GroupOrder S; for (int e = 0; e < 8; ++e) S.pe[e] = PANEND[(KK) * 8 + e]; S.npe = 28; S.S.init(S.pe[7], 28, G, bx); \
        pg8::Gemm g{XS + (size_t)(KK) * RROWS * (D / 2), W_MGU, 512, 512, 512}; pg8::EpiSwigluF8 E{(unsigned char*)ACTM + (size_t)(KK) * RROWS * DFE, DFE, 28, 0, 1.f / MOE_WSCALE, MOE_ASCALE}; \
        pg8::gemm_phase<pg8::EpiSwigluF8, pg8::GroupOrder, true, true, true>(lds, g, S, E); } \
    SEAM(PH); \
    if (IN((PH) + 1)) { volatile LAS unsigned* tb = MISC + 16; \
        if (tid < 8) tb[tid] = (unsigned)PANEND[(KK) * 8 + tid]; \
        if (tid == 8) { const int npan = PANEND[(KK) * 8 + 7]; const int nun = npan * 4, tl = nun - G; \
            tb[8] = (unsigned)nun; tb[9] = (tl <= G / 4) ? 4u : (tl <= G / 2) ? 2u : 1u; tb[10] = (unsigned)npan; tb[11] = (unsigned)bx; tb[12] = 8u; tb[13] = 4u; tb[14] = (unsigned)(DFE / 128); tb[15] = (unsigned)G; \
            const unsigned long long sl = (unsigned long long)((KK) == 0 ? (unsigned char*)CAT : (unsigned char*)XS + 36 * MiB), fl = (unsigned long long)(unsigned*)(ctl + CW_SKFLAG + (KK) * 256 * 64); \
            tb[16] = (unsigned)sl; tb[17] = (unsigned)(sl >> 32); tb[18] = (unsigned)fl; tb[19] = (unsigned)(fl >> 32); } \
        __syncthreads(); \
        pg8::GroupStream S; S.tab = (const LAS unsigned*)(lds + MISC_OFF + 64); \
        pg8::Gemm g{ACTM + (size_t)(KK) * RROWS * (DFE / 2), W_MD, DFE / 2, DFE / 2, DFE / 2}; pg8::EpiMoeDown<FIRST_> E{OUT, ROWTOK + (KK) * RROWS, ROWGATE + (KK) * RROWS, 0, XB, 1.f / (MOE_WSCALE * MOE_ASCALE)}; \
        pg8::gemm_phase<pg8::EpiMoeDown<FIRST_>, pg8::GroupStream, true, true, true>(lds, g, S, E); }
    MOE_ROUND(17, 1, true)
    MOE_ROUND(19, 0, false)

#undef IN
#undef SEAM
}

extern "C" void kernel_launch(void* const* d_in, const int* in_sizes, int n_in, void* d_out, int out_size, void* d_ws, size_t ws_size, hipStream_t stream) {
    static int grid = 0;
    if (grid == 0) {
        if (n_in != 42 || in_sizes[0] != T * D || out_size != T * D || ws_size < WS_END) { fprintf(stderr, "kernel_launch: unexpected shapes (n_in %d, in0 %d, out %d, ws %zu < %zu); nothing launched\n", n_in, n_in > 0 ? in_sizes[0] : -1, out_size, ws_size, (size_t)WS_END); grid = -1; return; }
        int dev = 0, cus = 0, per_cu = 0;
        if (hipGetDevice(&dev) != hipSuccess || hipDeviceGetAttribute(&cus, hipDeviceAttributeMultiprocessorCount, dev) != hipSuccess) { grid = -1; return; }
        if (hipFuncSetAttribute((const void*)fwd_kernel, hipFuncAttributeMaxDynamicSharedMemorySize, LDS_BYTES) != hipSuccess) { fprintf(stderr, "kernel_launch: hipFuncSetAttribute failed\n"); grid = -1; return; }
        if (hipOccupancyMaxActiveBlocksPerMultiprocessor(&per_cu, (const void*)fwd_kernel, NTHREADS, LDS_BYTES) != hipSuccess || per_cu < 1) { fprintf(stderr, "kernel_launch: occupancy query reports %d\n", per_cu); }
        (void)hipGetLastError();
        grid = 256;
        if (cus < 256) { fprintf(stderr, "kernel_launch: device has %d CUs, need 256\n", cus); grid = -1; return; }
    }
    if (grid < 0) return;
    if (hipMemsetAsync((char*)d_ws + WS_CTL, 0, CTL_ZERO_BYTES, stream) != hipSuccess) return;
    Args a{};
    for (int i = 0; i < 42; ++i) a.in[i] = (const float*)d_in[i];
    a.out = (float*)d_out; a.ws = (unsigned char*)d_ws;
#ifdef MK_SPLIT
    for (int p = 0; p < NPHASE; ++p) { a.ph_lo = p; a.ph_hi = p + 1; hipLaunchKernelGGL(fwd_kernel, dim3(grid), dim3(NTHREADS), LDS_BYTES, stream, a); }
#else
#ifndef STOP_AFTER
#define STOP_AFTER (NPHASE - 1)
#endif
    a.ph_lo = 0; a.ph_hi = STOP_AFTER + 1;
    hipLaunchKernelGGL(fwd_kernel, dim3(grid), dim3(NTHREADS), LDS_BYTES, stream, a);
#endif
}
```

```cpp
#include <hip/hip_runtime.h>
#include <cstdio>
#include <cstdint>

namespace pg8 {
#define PG8_LAS __attribute__((address_space(3)))
typedef unsigned short bf16_t;
typedef short bf16x8 __attribute__((ext_vector_type(8)));
typedef float f32x4 __attribute__((ext_vector_type(4)));
typedef unsigned u32x4 __attribute__((ext_vector_type(4)));
constexpr int BM = 256, BK = 64, HALF = 128, HTB = HALF * BK * 2  , STAGE_BYTES = 8 * HTB, NXCD = 8, WGM = 4;

__host__ __device__ __forceinline__ int lds_byte(int r, int c) { const int st = (r >> 4) * 2 + (c >> 5), rr = r & 15, cc = c & 31, ob = rr * 64 + cc * 2; return st * 1024 + (ob ^ (((ob >> 9) & 1) << 5)); }
__host__ __device__ __forceinline__ void stage_rc(int b, int& R, int& C) { const int st = b / 1024, sb = b % 1024, swz = sb ^ (((sb >> 9) & 1) << 5); R = (st >> 1) * 16 + swz / 64; C = (st & 1) * 32 + (swz % 64) / 2; }
__host__ __device__ __forceinline__ int perm32(int rho) { const int n = rho >> 4, i = rho & 15; return 8 * (i >> 2) + 4 * n + (i & 3); }

struct Unit { int pm, pn; int k0, nk, part; };
struct Gemm { const bf16_t* A; const bf16_t* Bt; int lda, ldb, K; int amode = 0; };

struct StaticOrder {
    static constexpr bool STREAMK = false;
    int nM, nN, nwg, G, c;
    __host__ __device__ __forceinline__ void init(int nM_, int nN_, int G_, int c_) { nM = nM_; nN = nN_; nwg = nM * nN; G = G_; c = c_; }
    __host__ __device__ __forceinline__ bool next(int i, Unit& u) const {
        const long L = (long)i * G + c; if (L >= nwg || c >= G) return false;
        u.k0 = 0; u.nk = 0; u.part = 0; map((int)L, u); return true;
    }
    __host__ __device__ __forceinline__ void map(int L, Unit& u) const {
        int wgid = L; { const int q = nwg / NXCD, r = nwg % NXCD, xcd = wgid % NXCD, off = wgid / NXCD; wgid = (xcd < r ? xcd * (q + 1) : r * (q + 1) + (xcd - r) * q) + off; }
        const int nig = WGM * nN, gid = wgid / nig, fm = gid * WGM, gsz = (nM - fm) < WGM ? (nM - fm) : WGM;
        u.pm = fm + ((wgid % nig) % gsz); u.pn = (wgid % nig) / gsz;
    }
};
struct RangeOrder {
    static constexpr bool STREAMK = false;
    StaticOrder S; int i0, i1;
    __host__ __device__ __forceinline__ bool next(int i, Unit& u) const { return (i0 + i < i1) && S.next(i0 + i, u); }
};
struct BatchOrder {
    static constexpr bool STREAMK = false;
    int nunits, tm, tn, G, c;
    __host__ __device__ __forceinline__ void init(int nb, int tm_, int tn_, int G_, int c_) { tm = tm_; tn = tn_; nunits = nb * tm * tn; G = G_; c = c_; }
    __host__ __device__ __forceinline__ bool next(int i, Unit& u) const {
        const int L = i * G + c; if (L >= nunits || c >= G) return false;
        const int b = L / (tm * tn), r = L % (tm * tn); u.pm = b * tm + r / tn; u.pn = b * tn + r % tn; u.k0 = 0; u.nk = 0; u.part = 0; return true;
    }
};
struct GroupOrder {
    static constexpr bool STREAMK = false;
    StaticOrder S; int npe; int pe[8];
    __host__ __device__ __forceinline__ bool next(int i, Unit& u) const {
        if (!S.next(i, u)) return false;
        int e = 0;
#pragma unroll
        for (int k = 0; k < 7; ++k) e += (u.pm >= pe[k]) ? 1 : 0;
        u.pn += e * npe; return true;
    }
};

typedef float f32x2_t __attribute__((ext_vector_type(2))); typedef __bf16 bf16x2_t __attribute__((ext_vector_type(2)));
struct GroupStream {
    static constexpr bool STREAMK = true;
    const PG8_LAS unsigned* tab;
    __device__ __forceinline__ int c() const { return (int)tab[11]; }
    __device__ __forceinline__ int split() const { return (int)tab[9]; }
    __device__ __forceinline__ unsigned target() const { return tab[12]; }
    __device__ __forceinline__ unsigned long long* slots() const { return (unsigned long long*)(((unsigned long long)tab[17] << 32) | tab[16]); }
    __device__ __forceinline__ unsigned* flags() const { return (unsigned*)(((unsigned long long)tab[19] << 32) | tab[18]); }
    __device__ __forceinline__ bool next(int i, Unit& u) const {
        const int nunits = (int)tab[8], sp = (int)tab[9], npe = (int)tab[13], ntk = (int)tab[14], G = (int)tab[15], c_ = (int)tab[11];
        int L, k0 = 0, nk = ntk, part = 0;
        if (i == 0) { L = c_; if (L >= nunits) return false; }
        else if (i == 1) { const int j = c_ / sp, p = c_ % sp; L = G + j; if (L >= nunits) return false; const int base = (ntk / sp) & ~1, xh = (ntk - sp * base) >> 1; nk = base + (p < xh ? 2 : 0); k0 = p * base + 2 * (p < xh ? p : xh); part = (sp == 1) ? 0 : (p == 0 ? 1 : 2); }
        else return false;
        StaticOrder S; S.init((int)tab[10], npe, 1, 0); S.map(L, u); int e = 0;
#pragma unroll
        for (int k = 0; k < 7; ++k) e += (u.pm >= (int)tab[k]) ? 1 : 0;
        u.pn += e * npe; u.k0 = k0; u.nk = nk; u.part = part; return true;
    }
};
constexpr int SK_SLOT_WORDS = 32 * 512;

__device__ __forceinline__ unsigned cvt_pk_bf16(float lo, float hi) { f32x2_t v = {lo, hi}; bf16x2_t b = __builtin_convertvector(v, bf16x2_t); return __builtin_bit_cast(unsigned, b); }
__device__ __forceinline__ float bf_lo(unsigned w) { return __builtin_bit_cast(float, w << 16); }
__device__ __forceinline__ float bf_hi(unsigned w) { return __builtin_bit_cast(float, w & 0xffff0000u); }
__device__ __forceinline__ float fsigmoid(float x) { return __builtin_amdgcn_rcpf(1.f + __builtin_amdgcn_exp2f(-1.4426950408889634f * x)); }
__device__ __forceinline__ float gelu_tanh(float y) { const float z = 0.7978845608028654f * (y + 0.044715f * y * y * y); return y * fsigmoid(2.f * z); }

#define EPI_LOOP_ROWS for (int ai = 0; ai < 2; ++ai) _Pragma("unroll") for (int m = 0; m < 4; ++m)
__device__ __forceinline__ u32x4 pack8(const f32x4& v0, const f32x4& v1) { u32x4 w; w.x = cvt_pk_bf16(v0[0], v0[1]); w.y = cvt_pk_bf16(v0[2], v0[3]); w.z = cvt_pk_bf16(v1[0], v1[1]); w.w = cvt_pk_bf16(v1[2], v1[3]); return w; }

__device__ __forceinline__ float rs_row(const float* SS, int row) {
    const f32x4 a = *(const f32x4*)(SS + (size_t)row * 16), b = *(const f32x4*)(SS + (size_t)row * 16 + 4), c = *(const f32x4*)(SS + (size_t)row * 16 + 8), d = *(const f32x4*)(SS + (size_t)row * 16 + 12);
    const float s = ((a[0] + a[1]) + (a[2] + a[3])) + ((b[0] + b[1]) + (b[2] + b[3])) + ((c[0] + c[1]) + (c[2] + c[3])) + ((d[0] + d[1]) + (d[2] + d[3]));
    return 1.f / __builtin_sqrtf(s * (1.f / 1024.f) + 1e-6f);
}
template <int SCALE  > struct EpiPlainS {
    static constexpr bool PERM = true, AFTER_DRAIN = false;
    bf16_t* O; int ldc; int pm0, pn0; const float* SS; float inv;
    __device__ __forceinline__ void operator()(const f32x4 (&acc)[2][2][4][2], const Unit& u, int wr, int wc, int fr, int fq) const {
        const int row0 = (u.pm - pm0) * BM + wr * 64 + fr, col0 = (u.pn - pn0) * BM + wc * 32 + 8 * fq;
        float cs[2][8];
        if (SCALE == 2) {
#pragma unroll
            for (int bj = 0; bj < 2; ++bj)
#pragma unroll
                for (int e = 0; e < 8; ++e) cs[bj][e] = rs_row(SS, u.pn * BM + bj * HALF + wc * 32 + 8 * fq + e) * inv; }
#pragma unroll
        EPI_LOOP_ROWS { bf16_t* rowp = O + (size_t)(row0 + ai * HALF + m * 16) * ldc + col0; float rs = 1.f; if (SCALE == 1) rs = rs_row(SS, u.pm * BM + wr * 64 + fr + ai * HALF + m * 16) * inv;
#pragma unroll
            for (int bj = 0; bj < 2; ++bj) { f32x4 v0 = acc[ai][bj][m][0], v1 = acc[ai][bj][m][1];
                if (SCALE == 1) { v0 = v0 * rs; v1 = v1 * rs; }
                if (SCALE == 2) { v0 = v0 * (f32x4){cs[bj][0], cs[bj][1], cs[bj][2], cs[bj][3]}; v1 = v1 * (f32x4){cs[bj][4], cs[bj][5], cs[bj][6], cs[bj][7]}; }
                *(u32x4*)(rowp + bj * HALF) = pack8(v0, v1); } }
    }
};
struct EpiPlain {
    static constexpr bool PERM = true, AFTER_DRAIN = false;
    bf16_t* O; int ldc; int pm0, pn0;
    __device__ __forceinline__ void operator()(const f32x4 (&acc)[2][2][4][2], const Unit& u, int wr, int wc, int fr, int fq) const {
        const int row0 = (u.pm - pm0) * BM + wr * 64 + fr, col0 = (u.pn - pn0) * BM + wc * 32 + 8 * fq;
#pragma unroll
        EPI_LOOP_ROWS { bf16_t* rowp = O + (size_t)(row0 + ai * HALF + m * 16) * ldc + col0;
#pragma unroll
            for (int bj = 0; bj < 2; ++bj) *(u32x4*)(rowp + bj * HALF) = pack8(acc[ai][bj][m][0], acc[ai][bj][m][1]); }
    }
};
struct EpiProj0 {
    static constexpr bool PERM = true, AFTER_DRAIN = false;
    bf16_t* UG; bf16_t* QM;
    __device__ __forceinline__ void operator()(const f32x4 (&acc)[2][2][4][2], const Unit& u, int wr, int wc, int fr, int fq) const {
        const int row0 = u.pm * BM + wr * 64 + fr;
#pragma unroll
        EPI_LOOP_ROWS { const int t = row0 + ai * HALF + m * 16;
#pragma unroll
            for (int bj = 0; bj < 2; ++bj) { const int c = u.pn * BM + bj * HALF + wc * 32 + 8 * fq; bf16_t* p;
                if (u.pn < 3) p = UG + ((size_t)((c >> 4) * 512 + (t >> 5))) * 640 + (t & 31) * 16 + (c & 15); else p = QM + (size_t)t * 256 + (c - 768);
                *(u32x4*)p = pack8(acc[ai][bj][m][0], acc[ai][bj][m][1]); } }
    }
};
struct EpiS5a {
    static constexpr bool PERM = true, AFTER_DRAIN = false;
    float* XC;
    __device__ __forceinline__ void operator()(const f32x4 (&acc)[2][2][4][2], const Unit& u, int wr, int wc, int fr, int fq) const {
        const int row0 = u.pm * BM + wr * 64 + fr, col0 = wc * 32 + 8 * fq;
#pragma unroll
        EPI_LOOP_ROWS { float* rowp = XC + (size_t)(row0 + ai * HALF + m * 16) * 128 + col0; *(f32x4*)rowp = acc[ai][0][m][0]; *(f32x4*)(rowp + 4) = acc[ai][0][m][1]; }
    }
};
struct EpiS5c {
    static constexpr bool PERM = true, AFTER_DRAIN = false;
    const bf16_t* UG; const float* dskip; bf16_t* GACT;
    __device__ __forceinline__ void operator()(const f32x4 (&acc)[2][2][4][2], const Unit& u, int wr, int wc, int fr, int fq) const {
        const int row0 = u.pm * BM + wr * 64 + fr, g = u.pm >> 1;
#pragma unroll
        for (int bj = 0; bj < 2; ++bj) { const int col8 = (u.pn & 1) * BM + bj * HALF + wc * 32 + 8 * fq, j = col8 >> 4, nb = col8 & 15;
            const f32x4 d0 = *(const f32x4*)(dskip + g * 16 + nb), d1 = *(const f32x4*)(dskip + g * 16 + nb + 4);
#pragma unroll
            EPI_LOOP_ROWS { const int R = row0 + ai * HALF + m * 16, chunk = R & 511, t = chunk * 32 + j;
                const u32x4 uu = *(const u32x4*)(UG + (size_t)R * 640 + j * 16 + nb);
                f32x4 v0 = acc[ai][bj][m][0], v1 = acc[ai][bj][m][1];
                v0[0] = gelu_tanh(v0[0] + d0[0] * bf_lo(uu.x)); v0[1] = gelu_tanh(v0[1] + d0[1] * bf_hi(uu.x)); v0[2] = gelu_tanh(v0[2] + d0[2] * bf_lo(uu.y)); v0[3] = gelu_tanh(v0[3] + d0[3] * bf_hi(uu.y));
                v1[0] = gelu_tanh(v1[0] + d1[0] * bf_lo(uu.z)); v1[1] = gelu_tanh(v1[1] + d1[1] * bf_hi(uu.z)); v1[2] = gelu_tanh(v1[2] + d1[2] * bf_lo(uu.w)); v1[3] = gelu_tanh(v1[3] + d1[3] * bf_hi(uu.w));
                *(u32x4*)(GACT + ((size_t)g * 16384 + t) * 16 + nb) = pack8(v0, v1); } }
    }
};
struct EpiGlu {
    static constexpr bool PERM = true, AFTER_DRAIN = false;
    const bf16_t* GACT; const float* bias; bf16_t* CAT;
    __device__ __forceinline__ void operator()(const f32x4 (&acc)[2][2][4][2], const Unit& u, int wr, int wc, int fr, int fq) const {
        const int row0 = u.pm * BM + wr * 64 + fr;
#pragma unroll
        for (int bj = 0; bj < 2; ++bj) { const int c = u.pn * BM + bj * HALF + wc * 32 + 8 * fq;
            const f32x4 b0 = *(const f32x4*)(bias + c), b1 = *(const f32x4*)(bias + c + 4);
#pragma unroll
            EPI_LOOP_ROWS { const int t = row0 + ai * HALF + m * 16;
                const u32x4 gg = *(const u32x4*)(GACT + ((size_t)(c >> 4) * 16384 + t) * 16 + (c & 15));
                f32x4 v0 = acc[ai][bj][m][0] + b0, v1 = acc[ai][bj][m][1] + b1;
                v0[0] = bf_lo(gg.x) * fsigmoid(v0[0]); v0[1] = bf_hi(gg.x) * fsigmoid(v0[1]); v0[2] = bf_lo(gg.y) * fsigmoid(v0[2]); v0[3] = bf_hi(gg.y) * fsigmoid(v0[3]);
                v1[0] = bf_lo(gg.z) * fsigmoid(v1[0]); v1[1] = bf_hi(gg.z) * fsigmoid(v1[1]); v1[2] = bf_lo(gg.w) * fsigmoid(v1[2]); v1[3] = bf_hi(gg.w) * fsigmoid(v1[3]);
                *(u32x4*)(CAT + (size_t)t * 1024 + c) = pack8(v0, v1); } }
    }
};
typedef unsigned u32x2_ __attribute__((ext_vector_type(2)));
__device__ __forceinline__ unsigned pk4_fp8(float a, float b, float c, float d) { int w = 0; w = __builtin_amdgcn_cvt_pk_fp8_f32(a, b, w, false); w = __builtin_amdgcn_cvt_pk_fp8_f32(c, d, w, true); return (unsigned)w; }
__device__ __forceinline__ float swiglu_fast(float ag, float au, float c1, float K) { const float e = __builtin_amdgcn_exp2f(ag * c1); return (ag * au) * __builtin_amdgcn_rcpf(__builtin_fmaf(e, K, K)); }
template <int SCALE  , bool OUT8 = false  > struct EpiSwiglu {
    static constexpr bool PERM = true, AFTER_DRAIN = false;
    bf16_t* O; int ldc; int npe; int pm0; const float* RS; float osc;
    __device__ __forceinline__ void operator()(const f32x4 (&acc)[2][2][4][2], const Unit& u, int wr, int wc, int fr, int fq) const {
        const int row0 = (u.pm - pm0) * BM + wr * 64 + fr, col0 = (u.pn % npe) * HALF + wc * 32 + 8 * fq;
#pragma unroll
        EPI_LOOP_ROWS { f32x4 v0, v1; const int r = row0 + ai * HALF + m * 16; const float rs = (SCALE == 1) ? rs_row(RS, r) : RS[r]; const float c1 = -1.4426950408889634f * rs, K = __builtin_amdgcn_rcpf(rs * rs * (OUT8 ? osc : 1.f));
#pragma unroll
            for (int e = 0; e < 4; ++e) { v0[e] = swiglu_fast(acc[ai][0][m][0][e], acc[ai][1][m][0][e], c1, K); v1[e] = swiglu_fast(acc[ai][0][m][1][e], acc[ai][1][m][1][e], c1, K); }
            if constexpr (OUT8) {
#pragma unroll
                for (int e = 0; e < 4; ++e) { v0[e] = __builtin_amdgcn_fmed3f(v0[e], -440.f, 440.f); v1[e] = __builtin_amdgcn_fmed3f(v1[e], -440.f, 440.f); }
                *(u32x2_*)((unsigned char*)O + (size_t)r * ldc + col0) = (u32x2_){pk4_fp8(v0[0], v0[1], v0[2], v0[3]), pk4_fp8(v1[0], v1[1], v1[2], v1[3])}; }
            else *(u32x4*)(O + (size_t)r * ldc + col0) = pack8(v0, v1); }
    }
};
struct EpiSwigluF8 {
    static constexpr bool PERM = true, AFTER_DRAIN = false;
    unsigned char* O; int ldc; int npe; int pm0; float inv, sc;
    __device__ __forceinline__ void operator()(const f32x4 (&acc)[2][2][4][2], const Unit& u, int wr, int wc, int fr, int fq) const {
        const int row0 = (u.pm - pm0) * BM + wr * 64 + fr, col0 = (u.pn % npe) * HALF + wc * 32 + 8 * fq;
        const float c1 = -1.4426950408889634f * inv, K = 1.f / (inv * inv * sc);
#pragma unroll
        EPI_LOOP_ROWS { f32x4 v0, v1; const int r = row0 + ai * HALF + m * 16;
#pragma unroll
            for (int e = 0; e < 4; ++e) { v0[e] = __builtin_amdgcn_fmed3f(swiglu_fast(acc[ai][0][m][0][e], acc[ai][1][m][0][e], c1, K), -440.f, 440.f); v1[e] = __builtin_amdgcn_fmed3f(swiglu_fast(acc[ai][0][m][1][e], acc[ai][1][m][1][e], c1, K), -440.f, 440.f); }
            *(u32x2_*)(O + (size_t)r * ldc + col0) = (u32x2_){pk4_fp8(v0[0], v0[1], v0[2], v0[3]), pk4_fp8(v1[0], v1[1], v1[2], v1[3])}; }
    }
};
template <bool F32BASE  , bool W8 = false  > struct EpiResidB {
    static constexpr bool PERM = true, AFTER_DRAIN = false;
    const float* R; bf16_t* XR; float* SS; float inv; unsigned char* X8;
    __device__ __forceinline__ void operator()(const f32x4 (&acc)[2][2][4][2], const Unit& u, int wr, int wc, int fr, int fq) const {
        const int row0 = u.pm * BM + wr * 64 + fr, col0 = u.pn * BM + wc * 32 + 8 * fq;
#pragma unroll
        EPI_LOOP_ROWS { const int row = row0 + ai * HALF + m * 16; const size_t o = (size_t)row * 1024 + col0; float ss = 0.f; const float xs = F32BASE ? R[row] : 1.f;
#pragma unroll
            for (int bj = 0; bj < 2; ++bj) { f32x4 r0, r1;
                { const u32x4 w = *(const u32x4*)(XR + o + bj * HALF); r0 = (f32x4){bf_lo(w.x), bf_hi(w.x), bf_lo(w.y), bf_hi(w.y)}; r1 = (f32x4){bf_lo(w.z), bf_hi(w.z), bf_lo(w.w), bf_hi(w.w)}; }
                if (F32BASE) { r0 = r0 * xs; r1 = r1 * xs; }
                r0 = r0 + acc[ai][bj][m][0] * inv; r1 = r1 + acc[ai][bj][m][1] * inv;
                ss += (r0[0] * r0[0] + r0[1] * r0[1]) + (r0[2] * r0[2] + r0[3] * r0[3]) + (r1[0] * r1[0] + r1[1] * r1[1]) + (r1[2] * r1[2] + r1[3] * r1[3]);
                *(u32x4*)(XR + o + bj * HALF) = pack8(r0, r1);
                if constexpr (W8) { f32x4 q0, q1;
#pragma unroll
                    for (int e = 0; e < 4; ++e) { q0[e] = __builtin_amdgcn_fmed3f(r0[e] * 8.f, -440.f, 440.f); q1[e] = __builtin_amdgcn_fmed3f(r1[e] * 8.f, -440.f, 440.f); }
                    *(u32x2_*)(X8 + o + bj * HALF) = (u32x2_){pk4_fp8(q0[0], q0[1], q0[2], q0[3]), pk4_fp8(q1[0], q1[1], q1[2], q1[3])}; } }
            ss += __shfl_xor(ss, 16); ss += __shfl_xor(ss, 32);
            if (fq == 0) SS[(size_t)row * 16 + u.pn * 4 + wc] = ss; }
    }
};
template <bool FIRST  > struct EpiMoeDown {
    static constexpr bool PERM = true, AFTER_DRAIN = false;
    float* OUT; const int* rowtok; const float* rowgate; int pm0; bf16_t* XR; float sc;
    __device__ __forceinline__ void operator()(const f32x4 (&acc)[2][2][4][2], const Unit& u, int wr, int wc, int fr, int fq) const {
        const int row0 = (u.pm - pm0) * BM + wr * 64 + fr, col0 = (u.pn & 3) * BM + wc * 32 + 8 * fq;
#pragma unroll
        EPI_LOOP_ROWS { const int r = row0 + ai * HALF + m * 16; const int t = rowtok[r]; const float gt = rowgate[r] * sc;
            if (t >= 0) { float* o = OUT + (size_t)t * 1024 + col0;
#pragma unroll
                for (int bj = 0; bj < 2; ++bj) { bf16_t* xp = XR + (size_t)t * 1024 + col0 + bj * HALF;
                    const u32x4 w = *(const u32x4*)xp; f32x4 r0 = (f32x4){bf_lo(w.x), bf_hi(w.x), bf_lo(w.y), bf_hi(w.y)}, r1 = (f32x4){bf_lo(w.z), bf_hi(w.z), bf_lo(w.w), bf_hi(w.w)};
                    r0 = r0 + acc[ai][bj][m][0] * gt; r1 = r1 + acc[ai][bj][m][1] * gt;
                    if (FIRST) *(u32x4*)xp = pack8(r0, r1);
                    else { __builtin_nontemporal_store(r0, (f32x4*)(o + bj * HALF)); __builtin_nontemporal_store(r1, (f32x4*)(o + bj * HALF + 4)); } } } }
    }
};

__device__ __forceinline__ void sk_store_partial(const f32x4 (&acc)[2][2][4][2], unsigned long long* slot, int tid) {
#pragma unroll
    for (int ai = 0; ai < 2; ++ai)
#pragma unroll
        for (int bj = 0; bj < 2; ++bj)
#pragma unroll
            for (int m = 0; m < 4; ++m)
#pragma unroll
                for (int n = 0; n < 2; ++n) { const f32x4 v = acc[ai][bj][m][n]; const unsigned long long w = (unsigned long long)cvt_pk_bf16(v[0], v[1]) | ((unsigned long long)cvt_pk_bf16(v[2], v[3]) << 32);
                    __hip_atomic_store(slot + (((ai * 2 + bj) * 4 + m) * 2 + n) * 512 + tid, w, __ATOMIC_RELAXED, __HIP_MEMORY_SCOPE_AGENT); }
}
__device__ __forceinline__ void sk_add_partial(f32x4 (&acc)[2][2][4][2], unsigned long long* slot, int tid) {
#pragma unroll
    for (int ai = 0; ai < 2; ++ai)
#pragma unroll
        for (int bj = 0; bj < 2; ++bj)
#pragma unroll
            for (int m = 0; m < 4; ++m)
#pragma unroll
                for (int n = 0; n < 2; ++n) { const unsigned long long w = __hip_atomic_load(slot + (((ai * 2 + bj) * 4 + m) * 2 + n) * 512 + tid, __ATOMIC_RELAXED, __HIP_MEMORY_SCOPE_AGENT);
                    const unsigned lo = (unsigned)w, hi = (unsigned)(w >> 32); acc[ai][bj][m][n] = acc[ai][bj][m][n] + (f32x4){bf_lo(lo), bf_hi(lo), bf_lo(hi), bf_hi(hi)};
                    if (n == 1 && (m & 1)) asm volatile("" ::: "memory"); }
}
typedef int i32x4_ __attribute__((ext_vector_type(4)));
typedef int i32x8_ __attribute__((ext_vector_type(8)));
template <class Epi, class Sched, bool ALIGN_EPI = false, bool SP2 = false, bool FP8 = false>
__device__ __forceinline__ void gemm_phase(PG8_LAS unsigned char* lds, const Gemm g, const Sched& S, const Epi& E) {
    const int tid = threadIdx.x, wid = __builtin_amdgcn_readfirstlane(tid >> 6), lane = tid & 63, wr = wid >> 2, wc = wid & 3, fr = lane & 15, fq = lane >> 4;
    const int K = g.K; int nt = K / BK;
    unsigned voffA[2], voffB[2];
#pragma unroll
    for (int i = 0; i < 2; ++i) { int R, C; stage_rc(tid * 16 + i * 8192, R, C); const int Rb = Epi::PERM ? ((R & ~31) + perm32(R & 31)) : R;
        voffA[i] = g.amode ? (unsigned)(((C >> 4) * g.lda + R) * 16 + (C & 15)) * 2u : (unsigned)(R * g.lda + C) * 2u; voffB[i] = (unsigned)(Rb * g.ldb + C) * 2u; }
    const size_t kstep = (size_t)(BK * 2);
    const size_t hstepA = g.amode ? (size_t)HALF * 32 : (size_t)HALF * g.lda * 2, hstepB = (size_t)HALF * g.ldb * 2;
    const size_t kstepA = g.amode ? (size_t)4 * g.lda * 32 : kstep;
    const size_t tstepA = 2 * hstepA, tstepB = 2 * hstepB;
    const unsigned ldsw = (unsigned)wid * 1024u;
    const int aoff = lds_byte(wr * 64 + fr, fq * 8), boff = lds_byte(wc * 32 + fr, fq * 8);
#define PG8_SA(b, h) (((b) * 2 + (h)) * HTB)
#define PG8_SB(b, h) ((4 + (b) * 2 + (h)) * HTB)
#define PG8_STAGE(bufoff, gbase, voff) do { _Pragma("unroll") for (int _i = 0; _i < 2; ++_i) \
        __builtin_amdgcn_global_load_lds((const unsigned*)((const char*)(gbase) + (voff)[_i]), (PG8_LAS unsigned*)(lds + (bufoff) + ldsw + _i * 8192), 16, 0, 0); } while (0)
#define PG8_LDA(dst, b, h) do { if constexpr (FP8) { _Pragma("unroll") for (int m = 0; m < 4; ++m) { const i32x4_ l_ = *(const PG8_LAS i32x4_*)(lds + PG8_SA(b, h) + aoff + m * 2048), h_ = *(const PG8_LAS i32x4_*)(lds + PG8_SA(b, h) + aoff + m * 2048 + 1024); dst##8[m] = __builtin_shufflevector(l_, h_, 0, 1, 2, 3, 4, 5, 6, 7); } } \
        else { _Pragma("unroll") for (int m = 0; m < 4; ++m) _Pragma("unroll") for (int k = 0; k < 2; ++k) dst[m][k] = *(const PG8_LAS bf16x8*)(lds + PG8_SA(b, h) + aoff + m * 2048 + k * 1024); } } while (0)
#define PG8_LDB(dst, b, h) do { if constexpr (FP8) { _Pragma("unroll") for (int n = 0; n < 2; ++n) { const i32x4_ l_ = *(const PG8_LAS i32x4_*)(lds + PG8_SB(b, h) + boff + n * 2048), h_ = *(const PG8_LAS i32x4_*)(lds + PG8_SB(b, h) + boff + n * 2048 + 1024); dst##8[n] = __builtin_shufflevector(l_, h_, 0, 1, 2, 3, 4, 5, 6, 7); } } \
        else { _Pragma("unroll") for (int n = 0; n < 2; ++n) _Pragma("unroll") for (int k = 0; k < 2; ++k) dst[n][k] = *(const PG8_LAS bf16x8*)(lds + PG8_SB(b, h) + boff + n * 2048 + k * 1024); } } while (0)
#define PG8_MMA(ai, bj, At, Bt) do { __builtin_amdgcn_s_setprio(1); \
        if constexpr (FP8) { _Pragma("unroll") for (int m = 0; m < 4; ++m) _Pragma("unroll") for (int n = 0; n < 2; ++n) \
            acc[ai][bj][m][n] = __builtin_amdgcn_mfma_scale_f32_16x16x128_f8f6f4(Bt##8[n], At##8[m], acc[ai][bj][m][n], 0, 0, 0, 0x7f7f7f7f, 0, 0x7f7f7f7f); \
            _Pragma("unroll") for (int m = 0; m < 4; ++m) _Pragma("unroll") for (int n = 0; n < 2; ++n) asm volatile("" : "+v"(acc[ai][bj][m][n])); } \
        else { _Pragma("unroll") for (int m = 0; m < 4; ++m) _Pragma("unroll") for (int n = 0; n < 2; ++n) _Pragma("unroll") for (int k = 0; k < 2; ++k) \
            acc[ai][bj][m][n] = __builtin_amdgcn_mfma_f32_16x16x32_bf16(Bt[n][k], At[m][k], acc[ai][bj][m][n], 0, 0, 0); } \
        __builtin_amdgcn_s_setprio(0); } while (0)
#define PG8_WAIT_V(n) asm volatile("s_waitcnt vmcnt(" #n ")" ::: "memory")
#define PG8_WAIT_L(n) asm volatile("s_waitcnt lgkmcnt(" #n ")" ::: "memory")
#define PG8_BAR __builtin_amdgcn_s_barrier()
#define PG8_SCHED __builtin_amdgcn_sched_barrier(0)
    Unit cur, nxt; int ui = 0;
    if (!S.next(0, cur)) return;
    f32x4 acc[2][2][4][2];
#pragma unroll
    for (int a = 0; a < 2; ++a)
#pragma unroll
        for (int b = 0; b < 2; ++b)
#pragma unroll
            for (int m = 0; m < 4; ++m)
#pragma unroll
                for (int n = 0; n < 2; ++n) acc[a][b][m][n] = (f32x4){0.f, 0.f, 0.f, 0.f};
    bf16x8 At[4][2], B0[2][2], B1[2][2];
    i32x8_ At8[4], B08[2], B18[2];
    const char* cA = (const char*)g.A + (size_t)cur.pm * tstepA; const char* cB = (const char*)g.Bt + (size_t)cur.pn * tstepB;
    if constexpr (Sched::STREAMK) { nt = cur.nk; cA += (size_t)cur.k0 * kstep; cB += (size_t)cur.k0 * kstep; }

    if constexpr (SP2) {
        PG8_STAGE(PG8_SB(0, 0), cB, voffB); PG8_STAGE(PG8_SB(0, 1), cB + hstepB, voffB); PG8_STAGE(PG8_SA(0, 0), cA, voffA); PG8_STAGE(PG8_SA(0, 1), cA + hstepA, voffA);
        if (wr == 1) PG8_BAR;
        PG8_WAIT_V(2); PG8_BAR;
        PG8_STAGE(PG8_SB(1, 0), cB + kstep, voffB); PG8_STAGE(PG8_SA(1, 0), cA + kstepA, voffA); PG8_STAGE(PG8_SB(1, 1), cB + hstepB + kstep, voffB);
        PG8_WAIT_V(6); PG8_BAR;
    } else {
        PG8_STAGE(PG8_SB(0, 0), cB, voffB); PG8_STAGE(PG8_SA(0, 0), cA, voffA); PG8_STAGE(PG8_SB(0, 1), cB + hstepB, voffB); PG8_STAGE(PG8_SA(0, 1), cA + hstepA, voffA);
        if (wr == 1) PG8_BAR;
        PG8_WAIT_V(4); PG8_BAR;
        PG8_STAGE(PG8_SB(1, 0), cB + kstep, voffB); PG8_STAGE(PG8_SA(1, 0), cA + kstepA, voffA); PG8_STAGE(PG8_SB(1, 1), cB + hstepB + kstep, voffB);
        PG8_WAIT_V(6); PG8_BAR;
    }
    for (;;) {
        const bool has_next = S.next(ui + 1, nxt);
        const char* nA = has_next ? (const char*)g.A + (size_t)nxt.pm * tstepA : cA; const char* nB = has_next ? (const char*)g.Bt + (size_t)nxt.pn * tstepB : cB;
        if constexpr (Sched::STREAMK) { if (has_next) { nA += (size_t)nxt.k0 * kstep; nB += (size_t)nxt.k0 * kstep; } }
        for (int t = 0; t < nt; t += 2) {
            const bool last = (t == nt - 2);
            const char* a1 = cA + (size_t)(t + 1) * kstepA;
            const char* a2 = last ? nA : cA + (size_t)(t + 2) * kstepA; const char* b2 = last ? nB : cB + (size_t)(t + 2) * kstep;
            const char* a3 = a2 + kstepA; const char* b3 = b2 + kstep;

            if constexpr (SP2) {
            PG8_LDB(B0, 0, 0); PG8_LDB(B1, 0, 1); PG8_SCHED; PG8_LDA(At, 0, 0); PG8_STAGE(PG8_SA(1, 1), a1 + hstepA, voffA);
            PG8_WAIT_V(8); PG8_WAIT_L(0); PG8_BAR; PG8_MMA(0, 0, At, B0); PG8_MMA(0, 1, At, B1); PG8_BAR; PG8_SCHED;
            PG8_LDA(At, 0, 1); PG8_STAGE(PG8_SB(0, 0), b2, voffB); PG8_STAGE(PG8_SB(0, 1), b2 + hstepB, voffB); PG8_STAGE(PG8_SA(0, 0), a2, voffA);
            PG8_WAIT_V(8); PG8_WAIT_L(0); PG8_BAR; PG8_MMA(1, 0, At, B0); PG8_MMA(1, 1, At, B1); PG8_BAR; PG8_SCHED;
            PG8_LDB(B0, 1, 0); PG8_LDB(B1, 1, 1); PG8_SCHED; PG8_LDA(At, 1, 0); PG8_STAGE(PG8_SA(0, 1), a2 + hstepA, voffA);
            PG8_WAIT_V(8); PG8_WAIT_L(0); PG8_BAR; PG8_MMA(0, 0, At, B0); PG8_MMA(0, 1, At, B1); PG8_BAR; PG8_SCHED;
            PG8_LDA(At, 1, 1); PG8_STAGE(PG8_SB(1, 0), b3, voffB); PG8_STAGE(PG8_SB(1, 1), b3 + hstepB, voffB); PG8_STAGE(PG8_SA(1, 0), a3, voffA);
            PG8_WAIT_V(8); PG8_WAIT_L(0); PG8_BAR; PG8_MMA(1, 0, At, B0); PG8_MMA(1, 1, At, B1); PG8_BAR; PG8_SCHED;
            } else {
            PG8_LDB(B0, 0, 0); PG8_SCHED; PG8_LDA(At, 0, 0); PG8_STAGE(PG8_SA(1, 1), a1 + hstepA, voffA);
            PG8_WAIT_L(8); PG8_BAR; PG8_WAIT_L(0); PG8_MMA(0, 0, At, B0); PG8_BAR; PG8_SCHED;
            PG8_LDB(B1, 0, 1); PG8_STAGE(PG8_SB(0, 0), b2, voffB);
            PG8_BAR; PG8_WAIT_L(0); PG8_MMA(0, 1, At, B1); PG8_BAR;
            PG8_LDA(At, 0, 1); PG8_STAGE(PG8_SA(0, 0), a2, voffA);
            PG8_BAR; PG8_WAIT_L(0); PG8_MMA(1, 0, At, B0); PG8_BAR; PG8_SCHED;
            PG8_STAGE(PG8_SB(0, 1), b2 + hstepB, voffB);
            PG8_WAIT_V(6); PG8_BAR; PG8_MMA(1, 1, At, B1); PG8_BAR;
            PG8_LDB(B0, 1, 0); PG8_SCHED; PG8_LDA(At, 1, 0); PG8_STAGE(PG8_SA(0, 1), a2 + hstepA, voffA);
            PG8_WAIT_L(8); PG8_BAR; PG8_WAIT_L(0); PG8_MMA(0, 0, At, B0); PG8_BAR; PG8_SCHED;
            PG8_LDB(B1, 1, 1); PG8_STAGE(PG8_SB(1, 0), b3, voffB);
            PG8_BAR; PG8_WAIT_L(0); PG8_MMA(0, 1, At, B1); PG8_BAR;
            PG8_LDA(At, 1, 1); PG8_STAGE(PG8_SA(1, 0), a3, voffA);
            PG8_BAR; PG8_WAIT_L(0); PG8_MMA(1, 0, At, B0); PG8_BAR; PG8_SCHED;
            PG8_STAGE(PG8_SB(1, 1), b3 + hstepB, voffB);
            PG8_WAIT_V(6); PG8_BAR; PG8_MMA(1, 1, At, B1); PG8_BAR;
            }
        }
        if constexpr (ALIGN_EPI) { if (wr == 0) PG8_BAR; }
        if constexpr (Sched::STREAMK) {
            if (cur.part == 2) { sk_store_partial(acc, S.slots() + (size_t)S.c() * SK_SLOT_WORDS, tid); PG8_WAIT_V(0);
                if (lane == 0) __hip_atomic_fetch_add(S.flags() + S.c() * 64, 1u, __ATOMIC_RELAXED, __HIP_MEMORY_SCOPE_AGENT); }
            else if (cur.part == 0) E(acc, cur, wr, wc, fr, fq);
        } else
        if constexpr (!Epi::AFTER_DRAIN) { E(acc, cur, wr, wc, fr, fq); }
        if (!has_next) break;
#pragma unroll
        for (int a = 0; a < 2; ++a)
#pragma unroll
            for (int b = 0; b < 2; ++b)
#pragma unroll
                for (int m = 0; m < 4; ++m)
#pragma unroll
                    for (int n = 0; n < 2; ++n) acc[a][b][m][n] = (f32x4){0.f, 0.f, 0.f, 0.f};
        cur = nxt; cA = nA; cB = nB; ++ui;
        if constexpr (Sched::STREAMK) nt = cur.nk;
        if constexpr (ALIGN_EPI) { if (wr == 1) PG8_BAR; }
    }
    PG8_WAIT_V(0);
    if constexpr (!ALIGN_EPI) { if (wr == 0) PG8_BAR; }
    PG8_BAR;
    if constexpr (Epi::AFTER_DRAIN) { E.fused(acc, cur, wr, wc, fr, fq, lds, wid, lane); }
    if constexpr (Sched::STREAMK) { if (cur.part == 1) {
        const int np = S.split();
        if (tid == 0) { for (int q = 1; q < np; ++q) { unsigned sp = 0; while (__hip_atomic_load(S.flags() + (S.c() + q) * 64, __ATOMIC_RELAXED, __HIP_MEMORY_SCOPE_AGENT) < S.target()) { __builtin_amdgcn_s_sleep(2); if (++sp > (1u << 22)) break; } } }
        __syncthreads();
        for (int q = 1; q < np; ++q) sk_add_partial(acc, S.slots() + (size_t)(S.c() + q) * SK_SLOT_WORDS, tid);
        E(acc, cur, wr, wc, fr, fq); } }
#undef PG8_SA
#undef PG8_SB
#undef PG8_STAGE
#undef PG8_LDA
#undef PG8_LDB
#undef PG8_MMA
#undef PG8_WAIT_V
#undef PG8_WAIT_L
#undef PG8_BAR
#undef PG8_SCHED
}
}


constexpr int NWAVES = 8, NTHREADS = 512;
constexpr int T = 16384, D = 1024, SEQ = 2048, NB = 8;
constexpr int DFF = 2816, DFE = 3584, NEXP = 8;
constexpr int RROWS = 18432;
constexpr float RMS_EPS = 1e-6f;
constexpr float MOE_WSCALE = 64.f, MOE_ASCALE = 8.f;

constexpr size_t MiB = 1u << 20;
constexpr size_t WS_CTL = 0, CTL_ZERO_BYTES = 256 * 1024;
constexpr size_t WS_SMALL = 1 * MiB;
constexpr size_t SM_KMEANS = WS_SMALL, SM_LAM32 = WS_SMALL + 64 * 1024, SM_WGCNT = WS_SMALL + 128 * 1024, SM_PANEND = WS_SMALL + 160 * 1024,
                 SM_TOKE = WS_SMALL + 192 * 1024, SM_TOKLP = WS_SMALL + 320 * 1024, SM_TOKG = WS_SMALL + 448 * 1024, SM_ROWTOK = WS_SMALL + 576 * 1024, SM_ROWGATE = WS_SMALL + 720 * 1024;
static_assert(SM_ROWGATE + 2 * RROWS * 4 <= 2 * MiB, "small tables");
constexpr size_t WS_WMEMK = 2 * MiB, WS_WMEMV = 3 * MiB, WS_WKQ = 4 * MiB, WS_WV = WS_WKQ + 2560 * 1024, WS_WOUT1 = 7 * MiB, WS_WMGU = 9 * MiB, WS_WMD = 121 * MiB;
constexpr size_t WS_XB = 177 * MiB, WS_CAT = 209 * MiB, WS_MEMN = 241 * MiB, WS_MEMK = 245 * MiB, WS_MEMVT = 247 * MiB;
constexpr size_t WS_ARENA = 249 * MiB, WS_END = 447 * MiB;
constexpr size_t AR_XS = WS_ARENA, AR_ACTM = WS_ARENA + 72 * MiB;
constexpr size_t AR_WIN0 = WS_ARENA, AR_WGLU = WS_ARENA + 2 * MiB, AR_WOUT0 = WS_ARENA + 4 * MiB, AR_WFGU = WS_ARENA + 6 * MiB, AR_WFD = WS_ARENA + 17 * MiB;
constexpr size_t AR_TZ = WS_ARENA + 23 * MiB, AR_W1T = WS_ARENA + 53 * MiB, AR_UG = WS_ARENA + 65 * MiB, AR_QM0 = WS_ARENA + 95 * MiB, AR_XC = WS_ARENA + 103 * MiB, AR_GACT = WS_ARENA + 115 * MiB;
constexpr size_t AR_X8 = WS_ARENA + 140 * MiB;
constexpr size_t AR_S5SM = WS_ARENA + 156 * MiB;
constexpr size_t AR_ACT0 = WS_ARENA + 23 * MiB;
constexpr size_t AR_KQ = WS_ARENA, AR_VT = WS_ARENA + 40 * MiB;
static_assert(AR_ACTM + (size_t)RROWS * DFE * 2 <= WS_END && AR_ACT0 + (size_t)T * DFF * 2 <= AR_GACT, "arena");
constexpr int CW_BAR = 4096, CW_QUEUE = 8192, CW_SKFLAG = 16384;
static_assert((CW_SKFLAG + 2 * 256 * 64 + 64) * 4 <= (int)CTL_ZERO_BYTES, "control words inside the per-call memset");

constexpr int RING_BYTES = 131072, MISC_OFF = RING_BYTES + 320, LDS_BYTES = 147456;

#define GAS __attribute__((address_space(1)))
#define LAS __attribute__((address_space(3)))
typedef unsigned short bf16;
typedef unsigned v4u __attribute__((ext_vector_type(4)));
typedef unsigned v2u __attribute__((ext_vector_type(2)));
typedef float f32x4 __attribute__((ext_vector_type(4)));
typedef float f32x16 __attribute__((ext_vector_type(16)));
typedef short bf16x8 __attribute__((ext_vector_type(8)));
typedef short s16x4 __attribute__((ext_vector_type(4)));
typedef GAS unsigned gu32;
#define LDS_WAIT() asm volatile("s_waitcnt lgkmcnt(0)" ::: "memory")
using pg8::cvt_pk_bf16; using pg8::bf_lo; using pg8::bf_hi;
__device__ __forceinline__ unsigned f2bf(float f) { unsigned u = __builtin_bit_cast(unsigned, f); return (u + 0x7fffu + ((u >> 16) & 1u)) >> 16; }
__device__ __forceinline__ unsigned pk2(float lo, float hi) { return f2bf(lo) | (f2bf(hi) << 16); }
__device__ __forceinline__ float wave_sum(float v) {
#pragma unroll
    for (int o = 1; o < 64; o <<= 1) v += __shfl_xor(v, o);
    return v;
}

#define XB_TMO      128
#define XB_XCNT(j)  (256  + 64 * (j))
#define XB_XSUB(j)  (1280 + 64 * (j))
#define XB_XGEN(j)  (2304 + 64 * (j))
#define XB_TOP      3328
#define XB_TOPGEN   3392
#define XCD_BAR_WORDS 3456
#define XB_SPIN_CAP (1u << 18)

__device__ __forceinline__ unsigned xb_ld(unsigned* p)              { return __hip_atomic_load(p, __ATOMIC_RELAXED, __HIP_MEMORY_SCOPE_AGENT); }
__device__ __forceinline__ unsigned xb_add(unsigned* p, unsigned v) { return __hip_atomic_fetch_add(p, v, __ATOMIC_RELAXED, __HIP_MEMORY_SCOPE_AGENT); }
__device__ __forceinline__ unsigned xb_xcc_id() { return (unsigned)__builtin_amdgcn_s_getreg((3 << 11) | 20) & 0xFu; }
#define XB_SPIN(cond, bar) do { unsigned _sp = 0; while (cond) { __builtin_amdgcn_s_sleep(1); \
    if ((++_sp & 255u) == 0u) { if (xb_ld(&(bar)[XB_TMO])) break; if (_sp > XB_SPIN_CAP) { atomicAdd(&(bar)[XB_TMO], 1u); break; } } } } while (0)

struct XcdBarrier {
    unsigned* bar; unsigned x;
    volatile LAS unsigned* st;
};

__device__ __forceinline__ XcdBarrier xcd_barrier_post(unsigned* bar, volatile LAS unsigned* st) {
    XcdBarrier b; b.bar = bar; b.x = xb_xcc_id(); b.st = st;
    if (threadIdx.x == 0) (void)xb_add(&bar[XB_XCNT(b.x)], 1u);
    return b;
}
__device__ __forceinline__ void xcd_barrier_complete(unsigned* bar, unsigned x, unsigned& nloc, unsigned& nx) {
    const unsigned G = gridDim.x * gridDim.y * gridDim.z;
    unsigned sum, cnt, mine, sp = 0u;
    for (;;) {
        sum = 0u; cnt = 0u; mine = 0u;
#pragma unroll
        for (unsigned j = 0; j < 16; ++j) { const unsigned c = xb_ld(&bar[XB_XCNT(j)]); sum += c; cnt += (c > 0u) ? 1u : 0u; mine = (j == x) ? c : mine; }
        if (sum == G) break;
        __builtin_amdgcn_s_sleep(1);
        if ((++sp & 255u) == 0u) { if (xb_ld(&bar[XB_TMO])) break; if (sp > XB_SPIN_CAP) { atomicAdd(&bar[XB_TMO], 1u); break; } }
    }
    nloc = mine > 0u ? mine : 1u; nx = cnt > 0u ? cnt : 1u;
}

__device__ __forceinline__ void xcd_barrier(const XcdBarrier& b) {
    asm volatile("s_waitcnt vmcnt(0)" ::: "memory");
    __syncthreads();
    if (threadIdx.x == 0) {
        unsigned* bar = b.bar;
        __builtin_amdgcn_s_waitcnt(0);
        unsigned nloc = b.st[0], nx = b.st[1];
        if (nloc == 0u) { xcd_barrier_complete(bar, b.x, nloc, nx); b.st[0] = nloc; b.st[1] = nx; }
        const unsigned old = xb_add(&bar[XB_XSUB(b.x)], 1u);
        const unsigned gen = old / nloc;
        if (old + 1u == (gen + 1u) * nloc) {
            __builtin_amdgcn_fence(__ATOMIC_RELEASE, "agent");
            asm volatile("s_waitcnt vmcnt(0)" ::: "memory");
            const unsigned og = xb_add(&bar[XB_TOP], 1u);
            const unsigned tg = og / nx;
            if (og + 1u == (tg + 1u) * nx) xb_add(&bar[XB_TOPGEN], 1u);
            else XB_SPIN(xb_ld(&bar[XB_TOPGEN]) == tg, bar);
            __builtin_amdgcn_fence(__ATOMIC_ACQUIRE, "agent");
            xb_add(&bar[XB_XGEN(b.x)], 1u);
            asm volatile("s_waitcnt vmcnt(0)" ::: "memory");
        } else {
            XB_SPIN(xb_ld(&bar[XB_XGEN(b.x)]) == gen, bar);
            __builtin_amdgcn_fence(__ATOMIC_ACQUIRE, "agent");
            asm volatile("s_waitcnt vmcnt(0)" ::: "memory");
        }
    }
    __syncthreads();
}


__device__ __forceinline__ void cvt_item(const float* W, int ldw, int k0, int n0, const float* gain, bf16* WT, int ldo, int orow0, LAS unsigned* scr, int lane) {
    const int nq = lane & 15, kr = lane >> 4;
    f32x4 a[8], b[8];
    const float* src = W + (size_t)(k0 + 2 * kr) * ldw + n0 + 4 * nq;
#pragma unroll
    for (int i = 0; i < 8; ++i) { a[i] = *(const GAS f32x4*)(src + (size_t)(8 * i) * ldw); b[i] = *(const GAS f32x4*)(src + (size_t)(8 * i + 1) * ldw); }
    if (gain) {
#pragma unroll
        for (int i = 0; i < 8; ++i) { const float ga = gain[k0 + 8 * i + 2 * kr], gb = gain[k0 + 8 * i + 2 * kr + 1]; a[i] = a[i] * ga; b[i] = b[i] * gb; } }
#pragma unroll
    for (int i = 0; i < 8; ++i) {
#pragma unroll
        for (int e = 0; e < 4; ++e) scr[(4 * nq + e) * 33 + 4 * i + kr] = cvt_pk_bf16(a[i][e], b[i][e]); }
    LDS_WAIT(); asm volatile("" ::: "memory");
#pragma unroll
    for (int j = 0; j < 8; ++j) { const int q = lane + 64 * j, n = q >> 3, c = q & 7; const LAS unsigned* sp = scr + n * 33 + 4 * c;
        v4u o; o.x = sp[0]; o.y = sp[1]; o.z = sp[2]; o.w = sp[3];
        *(GAS v4u*)(WT + (size_t)(orow0 + n) * ldo + k0 + 8 * c) = o; }
    LDS_WAIT(); asm volatile("" ::: "memory");
}
struct CvtDesc { const float* src; const float* gain; bf16* dst; int ldw, ldo, k0; };
__device__ __forceinline__ void cvt_load(const CvtDesc& d, f32x4 (&a)[8], f32x4 (&b)[8], float (&ga)[8], float (&gb)[8], int lane) {
    const int nq = lane & 15, kr = lane >> 4; const float* src = d.src + (size_t)(2 * kr) * d.ldw + 4 * nq;
    if (d.gain) {
#pragma unroll
        for (int i = 0; i < 8; ++i) { ga[i] = d.gain[d.k0 + 8 * i + 2 * kr]; gb[i] = d.gain[d.k0 + 8 * i + 2 * kr + 1]; } }
    else {
#pragma unroll
        for (int i = 0; i < 8; ++i) { ga[i] = 1.f; gb[i] = 1.f; } }
#pragma unroll
    for (int i = 0; i < 8; ++i) { a[i] = *(const GAS f32x4*)(src + (size_t)(8 * i) * d.ldw); b[i] = *(const GAS f32x4*)(src + (size_t)(8 * i + 1) * d.ldw); }
}
__device__ __forceinline__ void cvt_emit(const CvtDesc& d, f32x4 (&a)[8], f32x4 (&b)[8], const float (&ga)[8], const float (&gb)[8], LAS unsigned* scr, int lane) {
    const int nq = lane & 15, kr = lane >> 4;
#pragma unroll
    for (int i = 0; i < 8; ++i) {
#pragma unroll
        for (int e = 0; e < 4; ++e) scr[(4 * nq + e) * 33 + 4 * i + kr] = cvt_pk_bf16(a[i][e] * ga[i], b[i][e] * gb[i]); }
    LDS_WAIT(); asm volatile("" ::: "memory");
#pragma unroll
    for (int j = 0; j < 8; ++j) { const int q = lane + 64 * j, n = q >> 3, c = q & 7; const LAS unsigned* sp = scr + n * 33 + 4 * c;
        v4u o; o.x = sp[0]; o.y = sp[1]; o.z = sp[2]; o.w = sp[3];
        *(GAS v4u*)(d.dst + (size_t)n * d.ldo + 8 * c) = o; }
    LDS_WAIT(); asm volatile("" ::: "memory");
}
struct CvtDesc8 { const float* src; const float* gain; unsigned char* dst; int ldw, ldo, k0; };
__device__ __forceinline__ void cvt_load8(const CvtDesc8& d, f32x4 (&a)[4][4], float (&g)[4][4], float scale, int lane) {
    const int nq = lane & 15, kr = lane >> 4; const float* src = d.src + (size_t)(4 * kr) * d.ldw + 4 * nq;
#pragma unroll
    for (int i = 0; i < 4; ++i)
#pragma unroll
        for (int r = 0; r < 4; ++r) g[i][r] = d.gain ? d.gain[d.k0 + 16 * i + 4 * kr + r] * scale : scale;
#pragma unroll
    for (int i = 0; i < 4; ++i)
#pragma unroll
        for (int r = 0; r < 4; ++r) a[i][r] = __builtin_nontemporal_load((const GAS f32x4*)(src + (size_t)(16 * i + r) * d.ldw));
}
__device__ __forceinline__ void cvt_load8_dma(const CvtDesc8& d, f32x4 (&a)[4][4], float (&g)[4][4], float scale, LAS unsigned char* buf, int lane) {
    const int nq = lane & 15, kr = lane >> 4;
#pragma unroll
    for (int i = 0; i < 4; ++i)
#pragma unroll
        for (int r = 0; r < 4; ++r) g[i][r] = d.gain ? d.gain[d.k0 + 16 * i + 4 * kr + r] * scale : scale;
    const float* src = d.src + (size_t)kr * d.ldw + 4 * nq;
#pragma unroll
    for (int j = 0; j < 16; ++j) __builtin_amdgcn_global_load_lds((const unsigned*)(src + (size_t)(4 * j) * d.ldw), (LAS unsigned*)(buf + j * 1024), 16, 0, 2);
    asm volatile("s_waitcnt vmcnt(0)" ::: "memory");
#pragma unroll
    for (int i = 0; i < 4; ++i)
#pragma unroll
        for (int r = 0; r < 4; ++r) a[i][r] = *(const LAS f32x4*)(buf + (16 * i + 4 * kr + r) * 256 + nq * 16);
    LDS_WAIT(); asm volatile("" ::: "memory");
}
__device__ __forceinline__ void cvt_emit8(const CvtDesc8& d, f32x4 (&a)[4][4], const float (&g)[4][4], LAS unsigned* scr, int lane) {
    const int nq = lane & 15, kr = lane >> 4;
#pragma unroll
    for (int i = 0; i < 4; ++i)
#pragma unroll
        for (int e = 0; e < 4; ++e) scr[(4 * nq + e) * 17 + 4 * i + kr] = pg8::pk4_fp8(a[i][0][e] * g[i][0], a[i][1][e] * g[i][1], a[i][2][e] * g[i][2], a[i][3][e] * g[i][3]);
    LDS_WAIT(); asm volatile("" ::: "memory");
#pragma unroll
    for (int j = 0; j < 4; ++j) { const int q = lane + 64 * j, n = q >> 2, c = q & 3; const LAS unsigned* sp = scr + n * 17 + 4 * c;
        v4u o; o.x = sp[0]; o.y = sp[1]; o.z = sp[2]; o.w = sp[3];
        __builtin_nontemporal_store(o, (GAS v4u*)(d.dst + (size_t)n * d.ldo + 16 * c)); }
    LDS_WAIT(); asm volatile("" ::: "memory");
}
__device__ __forceinline__ void rms_row_to_bf16(const float* xrow, bf16* orow, int lane, float* rms_out = nullptr) {
    const GAS f32x4* xr = (const GAS f32x4*)xrow + lane;
    f32x4 v[4]; float s = 0.f;
#pragma unroll
    for (int j = 0; j < 4; ++j) { v[j] = xr[64 * j]; s += (v[j].x * v[j].x + v[j].y * v[j].y) + (v[j].z * v[j].z + v[j].w * v[j].w); }
    const float rms = sqrtf(wave_sum(s) * (1.f / 1024.f) + RMS_EPS), r = 1.f / rms;
    if (rms_out != nullptr && lane == 0) *rms_out = rms;
    GAS unsigned long long* o8 = (GAS unsigned long long*)orow + lane;
#pragma unroll
    for (int j = 0; j < 4; ++j) o8[64 * j] = (unsigned long long)pk2(v[j].x * r, v[j].y * r) | ((unsigned long long)pk2(v[j].z * r, v[j].w * r) << 32);
}
__device__ __forceinline__ void dsincos(double a, double& s, double& c) {
    const double k = rint(a * 0.63661977236758134308);
    double r = fma(-k, 1.57079632679489655800e+00, a); r = fma(-k, 6.12323399573676603587e-17, r);
    const double z = r * r;
    double ps = 1.0 / 355687428096000.0;
    ps = fma(ps, z, -1.0 / 1307674368000.0); ps = fma(ps, z, 1.0 / 6227020800.0); ps = fma(ps, z, -1.0 / 39916800.0); ps = fma(ps, z, 1.0 / 362880.0);
    ps = fma(ps, z, -1.0 / 5040.0); ps = fma(ps, z, 1.0 / 120.0); ps = fma(ps, z, -1.0 / 6.0); ps = fma(ps * z, r, r);
    double pc = -1.0 / 6402373705728000.0;
    pc = fma(pc, z, 1.0 / 20922789888000.0); pc = fma(pc, z, -1.0 / 87178291200.0); pc = fma(pc, z, 1.0 / 479001600.0); pc = fma(pc, z, -1.0 / 3628800.0);
    pc = fma(pc, z, 1.0 / 40320.0); pc = fma(pc, z, -1.0 / 720.0); pc = fma(pc, z, 1.0 / 24.0); pc = fma(pc, z, -0.5); pc = fma(pc, z, 1.0);
    const long q = (long)k & 3;
    s = (q == 0) ? ps : (q == 1) ? pc : (q == 2) ? -ps : -pc;
    c = (q == 0) ? pc : (q == 1) ? -ps : (q == 2) ? -pc : ps;
}
__device__ __forceinline__ double dexp(double x) {
    const double k = rint(x * 1.44269504088896338700);
    double r = fma(-k, 6.93147180369123816490e-01, x); r = fma(-k, 1.90821492927058770002e-10, r);
    double p = 1.0 / 6227020800.0;
    p = fma(p, r, 1.0 / 479001600.0); p = fma(p, r, 1.0 / 39916800.0); p = fma(p, r, 1.0 / 3628800.0); p = fma(p, r, 1.0 / 362880.0); p = fma(p, r, 1.0 / 40320.0);
    p = fma(p, r, 1.0 / 5040.0); p = fma(p, r, 1.0 / 720.0); p = fma(p, r, 1.0 / 120.0); p = fma(p, r, 1.0 / 24.0); p = fma(p, r, 1.0 / 6.0); p = fma(p, r, 0.5); p = fma(p, r, 1.0); p = fma(p, r, 1.0);
    const long ki = (long)k;
    return p * __builtin_bit_cast(double, (unsigned long long)(1023 + ki) << 52);
}
constexpr int S5SM_PW = 64 * 33, S5SM_HEAD = 2 * S5SM_PW + 2048, S5SM_FLOATS = S5SM_HEAD + 8192;
struct S5Lds { LAS float* pwr; LAS float* pwi; LAS float* bbr; LAS float* bbi; LAS float* ccr; LAS float* cci; LAS float* km; };
__device__ __forceinline__ S5Lds s5_lds(LAS unsigned char* lds) { S5Lds L; L.pwr = (LAS float*)lds; L.pwi = L.pwr + S5SM_PW; L.bbr = L.pwi + S5SM_PW; L.bbi = L.bbr + 1024; L.ccr = L.bbi + 1024; L.cci = L.ccr + 1024; L.km = L.cci + 1024; return L; }
__device__ __forceinline__ void s5_tables_small(int g, LAS unsigned char* lds, const float* lam_re, const float* lam_im, const float* log_dt, const float* b_re, const float* b_im,
                                                const float* c_re, const float* c_im, float* S5SM, float* LAM32, int tid) {
    const S5Lds L = s5_lds(lds); LAS float* pwr = L.pwr; LAS float* pwi = L.pwi; LAS float* bbr = L.bbr; LAS float* bbi = L.bbi; LAS float* ccr = L.ccr; LAS float* cci = L.cci; LAS float* km = L.km;
    const double dt = dexp((double)log_dt[g]);
    for (int idx = tid; idx < 64 * 33; idx += NTHREADS) { const int p = idx / 33, tau = idx % 33;
        const double lr = lam_re[g * 64 + p], li = lam_im[g * 64 + p]; const double mag = dexp(lr * dt * tau); double s, c; dsincos(li * dt * tau, s, c);
        pwr[idx] = (float)(mag * c); pwi[idx] = (float)(mag * s); }
    for (int idx = tid; idx < 1024; idx += NTHREADS) { const int p = idx >> 4, m = idx & 15;
        const double lr = lam_re[g * 64 + p], li = lam_im[g * 64 + p]; const double mag = dexp(lr * dt); double s, c; dsincos(li * dt, s, c);
        const double ar = mag * c - 1.0, ai = mag * s, den = lr * lr + li * li, fr_ = (ar * lr + ai * li) / den, fi_ = (ai * lr - ar * li) / den;
        const double br = b_re[(g * 64 + p) * 16 + m], bi = b_im[(g * 64 + p) * 16 + m];
        bbr[idx] = (float)(fr_ * br - fi_ * bi); bbi[idx] = (float)(fr_ * bi + fi_ * br);
        ccr[idx] = c_re[g * 1024 + idx]; cci[idx] = c_im[g * 1024 + idx]; }
    __syncthreads();
    { const int half = tid >> 8, n = (tid >> 4) & 15, m = tid & 15; float acc[16];
#pragma unroll
      for (int t = 0; t < 16; ++t) acc[t] = 0.f;
      for (int p = 0; p < 64; ++p) { const float cr = ccr[n * 64 + p], ci = cci[n * 64 + p], br = bbr[p * 16 + m], bi = bbi[p * 16 + m]; const float zr = cr * br - ci * bi, zi = cr * bi + ci * br;
#pragma unroll
          for (int t = 0; t < 16; ++t) acc[t] += zr * pwr[p * 33 + 16 * half + t] - zi * pwi[p * 33 + 16 * half + t]; }
#pragma unroll
      for (int t = 0; t < 16; ++t) km[((16 * half + t) * 16 + n) * 16 + m] = acc[t]; }
    __syncthreads();
    float* S = S5SM + (size_t)g * S5SM_FLOATS;
    for (int i = tid; i < S5SM_HEAD; i += NTHREADS) S[i] = pwr[i];
    for (int i = tid; i < 8192; i += NTHREADS) S[S5SM_HEAD + i] = km[i];
    if (tid < 64) { LAM32[(g * 64 + tid) * 2] = pwr[tid * 33 + 32]; LAM32[(g * 64 + tid) * 2 + 1] = pwi[tid * 33 + 32]; }
    __syncthreads();
}
__device__ __forceinline__ void s5_load(int g, LAS unsigned char* lds, const float* S5SM, const float* c_re, const float* c_im, bool with_km, int tid) {
    const S5Lds L = s5_lds(lds); const float* S = S5SM + (size_t)g * S5SM_FLOATS;
    for (int i = tid; i < S5SM_HEAD / 4; i += NTHREADS) *(LAS f32x4*)(L.pwr + 4 * i) = *(const GAS f32x4*)(S + 4 * i);
    for (int i = tid; i < 256; i += NTHREADS) { *(LAS f32x4*)(L.ccr + 4 * i) = *(const GAS f32x4*)(c_re + g * 1024 + 4 * i); *(LAS f32x4*)(L.cci + 4 * i) = *(const GAS f32x4*)(c_im + g * 1024 + 4 * i); }
    if (with_km) for (int i = tid; i < 2048; i += NTHREADS) *(LAS f32x4*)(L.km + 4 * i) = *(const GAS f32x4*)(S + S5SM_HEAD + 4 * i);
    __syncthreads();
}
__device__ __forceinline__ void s5_expand_tz(int g, LAS unsigned char* lds, bf16* TZ, int row_lo, int row_hi, int tid) {
    const S5Lds L = s5_lds(lds); LAS float* pwr = L.pwr; LAS float* pwi = L.pwi; LAS float* ccr = L.ccr; LAS float* cci = L.cci; LAS float* km = L.km;
    bf16* tz = TZ + (size_t)g * 512 * 640;
    for (int pc = row_lo * 80 + tid; pc < row_hi * 80; pc += NTHREADS) { const int row = pc / 80, c8 = pc % 80, j = row >> 4, n = row & 15; float v[8];
        if (c8 < 64) { const int i = c8 >> 1, m0 = (c8 & 1) * 8;
#pragma unroll
            for (int e = 0; e < 8; ++e) v[e] = (i <= j) ? km[((j - i) * 16 + n) * 16 + m0 + e] : 0.f; }
        else { const int p0 = (c8 - 64) * 4;
#pragma unroll
            for (int q = 0; q < 4; ++q) { const int p = p0 + q; const float cr = ccr[n * 64 + p], ci = cci[n * 64 + p], pr = pwr[p * 33 + j + 1], pi = pwi[p * 33 + j + 1];
                v[2 * q] = cr * pr - ci * pi; v[2 * q + 1] = -(cr * pi + ci * pr); } }
        v4u o; o.x = pk2(v[0], v[1]); o.y = pk2(v[2], v[3]); o.z = pk2(v[4], v[5]); o.w = pk2(v[6], v[7]);
        *(GAS v4u*)(tz + (size_t)row * 640 + c8 * 8) = o; }
}
__device__ __forceinline__ void s5_expand_w1t(int g, LAS unsigned char* lds, bf16* W1T, int row_lo, int row_hi, int tid) {
    const S5Lds L = s5_lds(lds); LAS float* pwr = L.pwr; LAS float* pwi = L.pwi; LAS float* bbr = L.bbr; LAS float* bbi = L.bbi;
    bf16* w1 = W1T + (size_t)g * 256 * 512;
    for (int pc = row_lo * 64 + tid; pc < row_hi * 64; pc += NTHREADS) { const int row = pc >> 6, c8 = pc & 63, p = row >> 1, ri = row & 1, i = c8 >> 1, m0 = (c8 & 1) * 8; float v[8];
        const float ar = pwr[p * 33 + 31 - i], ai = pwi[p * 33 + 31 - i];
#pragma unroll
        for (int e = 0; e < 8; ++e) { const float br = bbr[p * 16 + m0 + e], bi = bbi[p * 16 + m0 + e]; v[e] = ri ? (ar * bi + ai * br) : (ar * br - ai * bi); }
        v4u o; o.x = pk2(v[0], v[1]); o.y = pk2(v[2], v[3]); o.z = pk2(v[4], v[5]); o.w = pk2(v[6], v[7]);
        *(GAS v4u*)(w1 + (size_t)row * 512 + c8 * 8) = o; }
}

constexpr int KS_PITCH = 144, VS_PITCH = 520, ATT_KS = 0, ATT_VS = 256 * KS_PITCH;
static_assert(ATT_VS + 64 * VS_PITCH <= RING_BYTES, "attention LDS");
#define MFMA32(a, b, c) __builtin_amdgcn_mfma_f32_32x32x16_bf16(a, b, c, 0, 0, 0)
struct KVRegs { v4u k[4]; v4u v[4]; };
__device__ __forceinline__ void att_load(KVRegs& R, const bf16* Kg, int kpitch, const bf16* Vg, int vpitch, int tid) {
#pragma unroll
    for (int i = 0; i < 4; ++i) { const int p = tid + NTHREADS * i, row = p >> 3, c = p & 7; R.k[i] = *(const GAS v4u*)(Kg + (size_t)row * kpitch + c * 8); }
#pragma unroll
    for (int i = 0; i < 4; ++i) { const int p = tid + NTHREADS * i, row = p >> 5, c = p & 31; R.v[i] = *(const GAS v4u*)(Vg + (size_t)row * vpitch + c * 8); }
}
__device__ __forceinline__ void att_store(LAS unsigned char* lds, const KVRegs& R, int tid) {
#pragma unroll
    for (int i = 0; i < 4; ++i) { const int p = tid + NTHREADS * i, row = p >> 3, c = p & 7; *(LAS v4u*)(lds + ATT_KS + row * KS_PITCH + c * 16) = R.k[i]; }
#pragma unroll
    for (int i = 0; i < 4; ++i) { const int p = tid + NTHREADS * i, row = p >> 5, c = p & 31;
        LAS v2u* d = (LAS v2u*)(lds + ATT_VS + row * VS_PITCH + c * 16); d[0] = (v2u){R.v[i].x, R.v[i].y}; d[1] = (v2u){R.v[i].z, R.v[i].w}; }
}
__device__ __forceinline__ void att_stage(LAS unsigned char* lds, const bf16* Kg, int kpitch, const bf16* Vg, int vpitch, int tid) { KVRegs R; att_load(R, Kg, kpitch, Vg, vpitch, tid); att_store(lds, R, tid); }
__device__ __forceinline__ void att_qk(const LAS unsigned char* lds, const bf16x8 (&qf)[4], int kt, f32x16& p0, f32x16& p1, int lane) {
    const int r32 = lane & 31, hi = lane >> 5;
#pragma unroll
    for (int r = 0; r < 16; ++r) { p0[r] = 0.f; p1[r] = 0.f; }
    const LAS unsigned char* kb = lds + ATT_KS + (kt * 64 + r32) * KS_PITCH + hi * 16;
#pragma unroll
    for (int d0 = 0; d0 < 4; ++d0) { const bf16x8 k0 = *(const LAS bf16x8*)(kb + d0 * 32), k1 = *(const LAS bf16x8*)(kb + 32 * KS_PITCH + d0 * 32);
        p0 = MFMA32(k0, qf[d0], p0); p1 = MFMA32(k1, qf[d0], p1); }
}
template <int MODE> __device__ __forceinline__ void att_finish(const LAS unsigned char* lds, int kt, f32x16& p0, f32x16& p1, f32x16& o0, f32x16& o1, float& l, int qloc, bool rowoff, int lane) {
    const int r32 = lane & 31, hi = lane >> 5; const float NEG = -__builtin_inff();
    if (MODE == 1) { const int kv0 = kt * 64 + 4 * hi;
#pragma unroll
        for (int r = 0; r < 16; ++r) { const int kv = kv0 + (r & 3) + 8 * (r >> 2); if (kv > qloc) p0[r] = NEG; if (kv + 32 > qloc) p1[r] = NEG; } }
    float rs = 0.f;
#pragma unroll
    for (int r = 0; r < 16; ++r) { p0[r] = __builtin_amdgcn_exp2f(p0[r]); p1[r] = __builtin_amdgcn_exp2f(p1[r]); rs += p0[r] + p1[r]; }
    if (MODE == 2) rs = rowoff ? 0.f : rs;
    l += rs;
    bf16x8 pb[4];
#pragma unroll
    for (int s = 0; s < 2; ++s) { v4u w0, w1;
        w0.x = cvt_pk_bf16(p0[8 * s + 0], p0[8 * s + 1]); w0.y = cvt_pk_bf16(p0[8 * s + 2], p0[8 * s + 3]); w0.z = cvt_pk_bf16(p0[8 * s + 4], p0[8 * s + 5]); w0.w = cvt_pk_bf16(p0[8 * s + 6], p0[8 * s + 7]);
        w1.x = cvt_pk_bf16(p1[8 * s + 0], p1[8 * s + 1]); w1.y = cvt_pk_bf16(p1[8 * s + 2], p1[8 * s + 3]); w1.z = cvt_pk_bf16(p1[8 * s + 4], p1[8 * s + 5]); w1.w = cvt_pk_bf16(p1[8 * s + 6], p1[8 * s + 7]);
        if (MODE == 2) { if (rowoff) { w0 = (v4u){0u, 0u, 0u, 0u}; w1 = (v4u){0u, 0u, 0u, 0u}; } }
        pb[s] = __builtin_bit_cast(bf16x8, w0); pb[2 + s] = __builtin_bit_cast(bf16x8, w1); }
    const LAS unsigned char* vb = lds + ATT_VS + r32 * VS_PITCH + (kt * 64 + 4 * hi) * 2;
#pragma unroll
    for (int s = 0; s < 4; ++s) { const int ko = (32 * (s >> 1) + 16 * (s & 1)) * 2;
        const s16x4 a0 = *(const LAS s16x4*)(vb + ko), a1 = *(const LAS s16x4*)(vb + ko + 16);
        const s16x4 b0 = *(const LAS s16x4*)(vb + 32 * VS_PITCH + ko), b1 = *(const LAS s16x4*)(vb + 32 * VS_PITCH + ko + 16);
        const bf16x8 va = (bf16x8){a0[0], a0[1], a0[2], a0[3], a1[0], a1[1], a1[2], a1[3]}, vc = (bf16x8){b0[0], b0[1], b0[2], b0[3], b1[0], b1[1], b1[2], b1[3]};
        o0 = MFMA32(va, pb[s], o0); o1 = MFMA32(vc, pb[s], o1); }
}
template <int MODE> __device__ __forceinline__ void att_block(const LAS unsigned char* lds, const bf16x8 (&qf)[4], f32x16& o0, f32x16& o1, float& l, int nkt, int qloc, bool rowoff, int lane) {
    f32x16 pa0, pa1, pb0, pb1;
    att_qk(lds, qf, 0, pa0, pa1, lane);
    int kt = 0;
    for (; kt + 1 < nkt; kt += 2) {
        att_qk(lds, qf, kt + 1, pb0, pb1, lane);
        att_finish<MODE>(lds, kt, pa0, pa1, o0, o1, l, qloc, rowoff, lane);
        if (kt + 2 < nkt) att_qk(lds, qf, kt + 2, pa0, pa1, lane);
        att_finish<MODE>(lds, kt + 1, pb0, pb1, o0, o1, l, qloc, rowoff, lane);
    }
    if (kt < nkt) att_finish<MODE>(lds, kt, pa0, pa1, o0, o1, l, qloc, rowoff, lane);
}
__device__ __forceinline__ void att_load_q(const bf16* qrow  , float (&qv)[4][8], bf16x8 (&qf)[4]) {
    float ss = 0.f;
#pragma unroll
    for (int d0 = 0; d0 < 4; ++d0) { const v4u w = *(const GAS v4u*)(qrow + d0 * 16);
        qv[d0][0] = bf_lo(w.x); qv[d0][1] = bf_hi(w.x); qv[d0][2] = bf_lo(w.y); qv[d0][3] = bf_hi(w.y); qv[d0][4] = bf_lo(w.z); qv[d0][5] = bf_hi(w.z); qv[d0][6] = bf_lo(w.w); qv[d0][7] = bf_hi(w.w);
#pragma unroll
        for (int e = 0; e < 8; ++e) ss += qv[d0][e] * qv[d0][e]; }
    ss += __shfl_xor(ss, 32);
    const float sc = (1.f / sqrtf(ss * (1.f / 64.f) + RMS_EPS)) * (0.125f * 1.4426950408889634f);
#pragma unroll
    for (int d0 = 0; d0 < 4; ++d0) { v4u w; w.x = cvt_pk_bf16(qv[d0][0] * sc, qv[d0][1] * sc); w.y = cvt_pk_bf16(qv[d0][2] * sc, qv[d0][3] * sc); w.z = cvt_pk_bf16(qv[d0][4] * sc, qv[d0][5] * sc); w.w = cvt_pk_bf16(qv[d0][6] * sc, qv[d0][7] * sc);
        qf[d0] = __builtin_bit_cast(bf16x8, w); }
}
constexpr int ATT_OST = 73728, OST_PITCH = 144;
static_assert(ATT_OST >= ATT_VS + 64 * VS_PITCH && ATT_OST + 8 * 32 * OST_PITCH <= RING_BYTES, "attention output stage");
template <bool OUT8 = false  >
__device__ __forceinline__ void att_store_o(LAS unsigned char* lds, bf16* obase  , int opitch, const f32x16& o0, const f32x16& o1, float l, int lane, int wid) {
    const int r32 = lane & 31, hi = lane >> 5;
    l += __shfl_xor(l, 32); const float inv = 1.f / l;
    LAS unsigned char* st = lds + ATT_OST + wid * (32 * OST_PITCH);
    if constexpr (OUT8) {
        const float i8 = inv * 8.f;
#pragma unroll
        for (int a = 0; a < 4; ++a) {
            *(LAS unsigned*)(st + r32 * OST_PITCH + (8 * a + 4 * hi)) = pg8::pk4_fp8(__builtin_amdgcn_fmed3f(o0[4 * a] * i8, -440.f, 440.f), __builtin_amdgcn_fmed3f(o0[4 * a + 1] * i8, -440.f, 440.f), __builtin_amdgcn_fmed3f(o0[4 * a + 2] * i8, -440.f, 440.f), __builtin_amdgcn_fmed3f(o0[4 * a + 3] * i8, -440.f, 440.f));
            *(LAS unsigned*)(st + r32 * OST_PITCH + (32 + 8 * a + 4 * hi)) = pg8::pk4_fp8(__builtin_amdgcn_fmed3f(o1[4 * a] * i8, -440.f, 440.f), __builtin_amdgcn_fmed3f(o1[4 * a + 1] * i8, -440.f, 440.f), __builtin_amdgcn_fmed3f(o1[4 * a + 2] * i8, -440.f, 440.f), __builtin_amdgcn_fmed3f(o1[4 * a + 3] * i8, -440.f, 440.f)); }
        LDS_WAIT(); asm volatile("" ::: "memory");
#pragma unroll
        for (int i = 0; i < 2; ++i) { const int idx = lane + 64 * i, row = idx >> 2, c = idx & 3;
            const v4u v = *(const LAS v4u*)(st + row * OST_PITCH + c * 16);
            *(GAS v4u*)((unsigned char*)obase + (size_t)row * opitch + c * 16) = v; }
        LDS_WAIT(); asm volatile("" ::: "memory");
        return; }
#pragma unroll
    for (int a = 0; a < 4; ++a) {
        *(LAS v2u*)(st + r32 * OST_PITCH + (8 * a + 4 * hi) * 2) = (v2u){cvt_pk_bf16(o0[4 * a] * inv, o0[4 * a + 1] * inv), cvt_pk_bf16(o0[4 * a + 2] * inv, o0[4 * a + 3] * inv)};
        *(LAS v2u*)(st + r32 * OST_PITCH + (32 + 8 * a + 4 * hi) * 2) = (v2u){cvt_pk_bf16(o1[4 * a] * inv, o1[4 * a + 1] * inv), cvt_pk_bf16(o1[4 * a + 2] * inv, o1[4 * a + 3] * inv)}; }
    LDS_WAIT(); asm volatile("" ::: "memory");
#pragma unroll
    for (int i = 0; i < 4; ++i) { const int idx = lane + 64 * i, row = idx >> 3, c = idx & 7;
        const v4u v = *(const LAS v4u*)(st + row * OST_PITCH + c * 16);
        *(GAS v4u*)(obase + (size_t)row * opitch + c * 8) = v; }
    LDS_WAIT(); asm volatile("" ::: "memory");
}
template <bool OUT8 = false  >
__device__ __forceinline__ void mem_unit(LAS unsigned char* lds, const bf16* Q, int qpitch, const bf16* Kg, const bf16* Vg, bf16* O, int tid) {
    const int lane = tid & 63, wid = __builtin_amdgcn_readfirstlane(tid >> 6), r32 = lane & 31, hi = lane >> 5;
    att_stage(lds, Kg, 512, Vg, 2048, tid);
    float qv[4][8]; bf16x8 qf[4];
    att_load_q(Q + (size_t)(wid * 32 + r32) * qpitch + hi * 8, qv, qf);
    __syncthreads();
    f32x16 o0, o1; float l = 0.f;
#pragma unroll
    for (int r = 0; r < 16; ++r) { o0[r] = 0.f; o1[r] = 0.f; }
    att_block<0>(lds, qf, o0, o1, l, 4, 0, false, lane);
    if constexpr (OUT8) att_store_o<true>(lds, (bf16*)((unsigned char*)O + (size_t)(wid * 32) * 1024), 1024, o0, o1, l, lane, wid);
    else att_store_o(lds, O + (size_t)(wid * 32) * 1024, 1024, o0, o1, l, lane, wid);
    __syncthreads();
}
__device__ __forceinline__ void moba_unit(LAS unsigned char* lds, int b, int qh, int qblk, const bf16* KQ, const bf16* VT, const float* KMEANS, bf16* CAT, int tid) {
    const int lane = tid & 63, wid = __builtin_amdgcn_readfirstlane(tid >> 6), r32 = lane & 31, hi = lane >> 5, kvh = qh / 3;
    const size_t tok0 = (size_t)b * SEQ + (size_t)qblk * 256;
    att_stage(lds, KQ + tok0 * 1280 + kvh * 64, 1280, VT + (size_t)(kvh * 64) * T + tok0, T, tid);
    float qv[4][8]; bf16x8 qf[4];
    att_load_q(KQ + (tok0 + wid * 32 + r32) * 1280 + 256 + qh * 64 + hi * 8, qv, qf);
    unsigned sel = 0u;
    if (qblk > 0) {
        float gt[7];
#pragma unroll
        for (int j = 0; j < 7; ++j) { gt[j] = -3e38f;
            if (j < qblk) { const float* km = KMEANS + (size_t)((b * 4 + kvh) * 8 + j) * 64 + hi * 8; float a = 0.f;
#pragma unroll
                for (int d0 = 0; d0 < 4; ++d0) { const f32x4 k0 = *(const GAS f32x4*)(km + d0 * 16), k1 = *(const GAS f32x4*)(km + d0 * 16 + 4);
                    a += qv[d0][0] * k0[0] + qv[d0][1] * k0[1] + qv[d0][2] * k0[2] + qv[d0][3] * k0[3] + qv[d0][4] * k1[0] + qv[d0][5] * k1[1] + qv[d0][6] * k1[2] + qv[d0][7] * k1[3]; }
                a += __shfl_xor(a, 32); gt[j] = a; } }
#pragma unroll
        for (int j = 0; j < 7; ++j) { int rank = 0;
#pragma unroll
            for (int j2 = 0; j2 < 7; ++j2) if (j2 != j) rank += (gt[j2] > gt[j] || (gt[j2] == gt[j] && j2 < j)) ? 1 : 0;
            if (j < qblk && rank < 3) sel |= 1u << j; }
    }
    __syncthreads();
    f32x16 o0, o1; float l = 0.f;
#pragma unroll
    for (int r = 0; r < 16; ++r) { o0[r] = 0.f; o1[r] = 0.f; }
    att_block<1>(lds, qf, o0, o1, l, (wid >> 1) + 1, wid * 32 + r32, false, lane);
    for (int j = 0; j < qblk; ++j) {
        __syncthreads();
        { const size_t tk = (size_t)b * SEQ + (size_t)j * 256; att_stage(lds, KQ + tk * 1280 + kvh * 64, 1280, VT + (size_t)(kvh * 64) * T + tk, T, tid); }
        __syncthreads();
        const bool off = !((sel >> j) & 1u);
        if (!__all(off)) att_block<2>(lds, qf, o0, o1, l, 4, 0, off, lane);
    }
    att_store_o<true>(lds, (bf16*)((unsigned char*)CAT + (size_t)(tok0 + wid * 32) * 1024 + qh * 64), 1024, o0, o1, l, lane, wid);
    __syncthreads();
}

struct Args { const float* in[42]; float* out; unsigned char* ws; int ph_lo, ph_hi; };
constexpr int NPHASE = 21;
__global__ void __launch_bounds__(NTHREADS, 2) fwd_kernel(Args args) {
    extern __shared__ __attribute__((aligned(16))) unsigned char lds_raw[];
    LAS unsigned char* lds = (LAS unsigned char*)lds_raw;
    volatile LAS unsigned* MISC = (volatile LAS unsigned*)(lds + MISC_OFF);
    const int tid = threadIdx.x, lane = tid & 63, wave = __builtin_amdgcn_readfirstlane(tid >> 6);
    const int G = gridDim.x, bx = blockIdx.x;
    const int gw = bx * NWAVES + wave, NGW = G * NWAVES;
    unsigned char* ws = args.ws;
    gu32* ctl = (gu32*)(ws + WS_CTL);
    for (int u = tid; u < (LDS_BYTES - RING_BYTES) / 4; u += NTHREADS) ((LAS unsigned*)(lds + RING_BYTES))[u] = 0u;
    __syncthreads();
    const int lo = args.ph_lo, hi_ph = args.ph_hi;
    XcdBarrier bar; bar.bar = (unsigned*)(ctl + CW_BAR); bar.x = 0; bar.st = nullptr;
    if (hi_ph - lo > 1) bar = xcd_barrier_post((unsigned*)(ctl + CW_BAR), MISC + 8);
#define IN(k) (lo <= (k) && (k) < hi_ph)
#define SEAM(k) do { if (IN(k) && IN((k) + 1)) xcd_barrier(bar); } while (0)
    const float* const* in = args.in;
    float* OUT = args.out;
    bf16* W_MEMK = (bf16*)(ws + WS_WMEMK); bf16* W_MEMV = (bf16*)(ws + WS_WMEMV); bf16* W_KQ = (bf16*)(ws + WS_WKQ); bf16* W_V = (bf16*)(ws + WS_WV); bf16* W_OUT1 = (bf16*)(ws + WS_WOUT1);
    bf16* W_MGU = (bf16*)(ws + WS_WMGU); bf16* W_MD = (bf16*)(ws + WS_WMD);
    bf16* XB = (bf16*)(ws + WS_XB); bf16* CAT = (bf16*)(ws + WS_CAT); bf16* MEMN = (bf16*)(ws + WS_MEMN); bf16* MEMK = (bf16*)(ws + WS_MEMK); bf16* MEMVT = (bf16*)(ws + WS_MEMVT);
    bf16* XS = (bf16*)(ws + AR_XS); bf16* ACTM = (bf16*)(ws + AR_ACTM);
    bf16* W_IN0 = (bf16*)(ws + AR_WIN0); bf16* W_GLU = (bf16*)(ws + AR_WGLU); bf16* W_OUT0 = (bf16*)(ws + AR_WOUT0); bf16* W_FGU = (bf16*)(ws + AR_WFGU); bf16* W_FD = (bf16*)(ws + AR_WFD);
    bf16* TZ = (bf16*)(ws + AR_TZ); bf16* W1T = (bf16*)(ws + AR_W1T); bf16* UG = (bf16*)(ws + AR_UG); bf16* QM0 = (bf16*)(ws + AR_QM0); float* XC = (float*)(ws + AR_XC); bf16* GACT = (bf16*)(ws + AR_GACT);
    unsigned char* X8 = ws + AR_X8;
    float* S5SM = (float*)(ws + AR_S5SM);
    bf16* ACT0 = (bf16*)(ws + AR_ACT0); bf16* KQ = (bf16*)(ws + AR_KQ); bf16* VT = (bf16*)(ws + AR_VT);
    float* KMEANS = (float*)(ws + SM_KMEANS); float* LAM32 = (float*)(ws + SM_LAM32); int* PANEND = (int*)(ws + SM_PANEND);
    int* WGCNT = (int*)(ws + WS_MEMN + 3 * MiB);
    float* XSC = (float*)(ws + WS_SMALL + 896 * 1024);
    float* SS = (float*)(ws + WS_MEMN); float* ROWRS = (float*)(ws + WS_MEMN + MiB); float* TOKRS = (float*)(ws + WS_MEMN + 2 * MiB);
    int* TOKE = (int*)(ws + SM_TOKE); int* TOKLP = (int*)(ws + SM_TOKLP); float* TOKG = (float*)(ws + SM_TOKG); int* ROWTOK = (int*)(ws + SM_ROWTOK); float* ROWGATE = (float*)(ws + SM_ROWGATE);

    constexpr int I_SQ = 16 * 16, I_GLU = 12 * 12, I_M = 16 * 4, I_F = 16 * 44, I_FD = 44 * 16;
    constexpr int CVT_P0_END = I_SQ + 4 * I_M, CVT_P2_END = CVT_P0_END + I_GLU + 3 * I_SQ + 2 * I_M, NITEMS = CVT_P2_END + 2 * I_F + I_FD;
    static_assert(NITEMS == 4 * I_SQ + I_GLU + 6 * I_M + 2 * I_F + I_FD, "items");
#define CV_F8(NI, SRC, LDW, NPB, GAIN, DST, LDO, ROW0) if (r < (NI)) { const int kb = r / (NPB), n0 = (r % (NPB)) * 64; CvtDesc8 d; d.src = (SRC) + (size_t)(kb * 64) * (LDW) + n0; d.gain = (GAIN); d.dst = (unsigned char*)(DST) + (size_t)((ROW0) + n0) * (LDO) + kb * 64; d.ldw = (LDW); d.ldo = (LDO); d.k0 = kb * 64; \
                f32x4 a[4][4]; float gq[4][4]; cvt_load8(d, a, gq, MOE_WSCALE, lane); cvt_emit8(d, a, gq, scr, lane); continue; } r -= (NI);
#define CV_PLAIN(NI, SRC, LDW, NPB, GAIN, DST, LDO, ROW0) if (r < (NI)) { const int kb = r / (NPB), n0 = (r % (NPB)) * 64; cvt_item(SRC, LDW, kb * 64, n0, GAIN, DST, LDO, (ROW0) + n0, scr, lane); continue; } r -= (NI);
#define CVT_RUN(FIRST, STRIDE, HI) do { LAS unsigned* scr = (LAS unsigned*)(lds + wave * 16384);        \
            for (int it = (FIRST); it < (HI); it += (STRIDE)) { int r = it; \
            CV_PLAIN(I_SQ, in[3], 1024, 16, in[2], W_IN0, 1024, 0) \
            CV_PLAIN(I_M, in[15], 256, 4, in[14], W_MEMK, 1024, 0) \
            CV_PLAIN(I_M, in[32], 256, 4, in[31], W_MEMK, 1024, 256) \
            CV_PLAIN(I_M, in[16], 256, 4, in[14], W_MEMV, 1024, 0) \
            CV_PLAIN(I_M, in[33], 256, 4, in[31], W_MEMV, 1024, 256) \
            CV_PLAIN(I_GLU, in[12], 768, 12, nullptr, W_GLU, 768, 0) \
            CV_PLAIN(I_SQ, in[19], 1024, 16, nullptr, W_OUT0, 1024, 0) \
            CV_F8(I_SQ, in[29], 1024, 16, in[28], W_KQ, 1024, 256) \
            CV_F8(I_M, in[25], 256, 4, in[24], W_KQ, 1024, 0) \
            CV_F8(I_M, in[26], 256, 4, in[24], W_V, 1024, 0) \
            CV_F8(I_SQ, in[36], 1024, 16, nullptr, W_OUT1, 1024, 0) \
            if (r < 2 * I_F) { const int up = r / I_F; r -= up * I_F; const int kb = r / 44, n0 = (r % 44) * 64; \
                cvt_item(in[21 + up], DFF, kb * 64, n0, in[20], W_FGU, 1024, (n0 >> 7) * 256 + (n0 & 127) + up * 128, scr, lane); continue; } \
            r -= 2 * I_F; \
            CV_F8(I_FD, in[23], 1024, 16, nullptr, W_FD, DFF, 0) \
            } } while (0)
    if (IN(0)) {
        if (bx < 48) s5_tables_small(bx, lds, in[4], in[5], in[6], in[7], in[8], in[9], in[10], S5SM, LAM32, tid);
#define RMS_ROW(R_) do { const int r_ = (R_); if (r_ < T) rms_row_to_bf16(in[0] + (size_t)r_ * D, XB + (size_t)r_ * D, lane, XSC + r_); else rms_row_to_bf16(in[1] + (size_t)(r_ - T) * D, MEMN + (size_t)(r_ - T) * D, lane); } while (0)
        static_assert(T + NB * 256 == 10 * 1664 + 4 * 384 + 256, "row split");
        if (bx >= 48) { const int nw = (bx - 48) * NWAVES + wave;
            CVT_RUN(nw, 1664, CVT_P0_END);
            for (int q = 0; q < 10; ++q) RMS_ROW(10 * nw + q);
            if (nw < 256) RMS_ROW(18176 + nw); }
        else { const int tw = bx * NWAVES + wave;
            for (int q = 0; q < 4; ++q) RMS_ROW(16640 + 4 * tw + q); }
#undef RMS_ROW
        for (int i = bx * NTHREADS + tid; i < 2 * RROWS; i += G * NTHREADS) ROWTOK[i] = -1;
    }
    SEAM(0);
    if (IN(1)) { pg8::Gemm g{XB, W_IN0, 1024, 1024, 1024}; pg8::StaticOrder S; S.init(T / 256, 4, G, bx); pg8::EpiProj0 E{UG, QM0};
        pg8::gemm_phase<pg8::EpiProj0, pg8::StaticOrder, true, true>(lds, g, S, E);
        if (bx < 192) { const int sg = bx >> 2, sq = bx & 3; s5_load(sg, lds, S5SM, in[9], in[10], false, tid); s5_expand_w1t(sg, lds, W1T, sq * 32, sq * 32 + 32, tid); __syncthreads(); } }
    SEAM(1);
    if (IN(2)) {
        if (bx < 96) { pg8::Gemm g{UG, W1T, 640, 512, 512}; pg8::BatchOrder S; S.init(48, 2, 1, 96, bx); pg8::EpiS5a E{XC};
          pg8::gemm_phase<pg8::EpiS5a, pg8::BatchOrder, true, true>(lds, g, S, E);
          if (tid < 256) { const int g = bx >> 1, mt = bx & 1, bl = tid >> 6, p = tid & 63;
            const float lr = LAM32[(g * 64 + p) * 2], li = LAM32[(g * 64 + p) * 2 + 1]; float hr = 0.f, hi_ = 0.f;
            const size_t row0 = (size_t)g * 512 + mt * 256 + bl * 64;
            for (int c = 0; c < 64; ++c) { const float xr = XC[(row0 + c) * 128 + 2 * p], xi = XC[(row0 + c) * 128 + 2 * p + 1];
                *(GAS unsigned*)(UG + (row0 + c) * 640 + 512 + 2 * p) = cvt_pk_bf16(hr, hi_);
                const float nr = lr * hr - li * hi_ + xr, ni = lr * hi_ + li * hr + xi; hr = nr; hi_ = ni; } } }
        else if (bx < 112) { pg8::Gemm g{MEMN, W_MEMK, 1024, 1024, 1024}; pg8::StaticOrder S; S.init(8, 2, 16, bx - 96); pg8::EpiPlain E{MEMK, 512, 0, 0};
          pg8::gemm_phase<pg8::EpiPlain, pg8::StaticOrder, true, true>(lds, g, S, E);
          pg8::Unit u; S.next(0, u); const int layer = u.pn; const float* kg = layer ? in[35] : in[18]; const float* qg = layer ? in[34] : in[17];
          const int c0 = lane * 4, d = c0 & 63; float gk[4];
#pragma unroll
          for (int e = 0; e < 4; ++e) gk[e] = kg[d + e] * qg[d + e];
          for (int rr = 0; rr < 32; ++rr) { bf16* p = MEMK + (size_t)(u.pm * 256 + wave * 32 + rr) * 512 + layer * 256 + c0; const v2u w = *(const GAS v2u*)p;
              float v[4] = {bf_lo(w.x), bf_hi(w.x), bf_lo(w.y), bf_hi(w.y)}; float ss = v[0] * v[0] + v[1] * v[1] + v[2] * v[2] + v[3] * v[3];
              ss += __shfl_xor(ss, 1); ss += __shfl_xor(ss, 2); ss += __shfl_xor(ss, 4); ss += __shfl_xor(ss, 8);
              const float r = 1.f / sqrtf(ss * (1.f / 64.f) + RMS_EPS);
              *(GAS v2u*)p = (v2u){cvt_pk_bf16(v[0] * r * gk[0], v[1] * r * gk[1]), cvt_pk_bf16(v[2] * r * gk[2], v[3] * r * gk[3])}; } }
        else if (bx < 128) { pg8::Gemm g{W_MEMV, MEMN, 1024, 1024, 1024}; pg8::StaticOrder S; S.init(2, 8, 16, bx - 112); pg8::EpiPlain E{MEMVT, 2048, 0, 0};
          pg8::gemm_phase<pg8::EpiPlain, pg8::StaticOrder, true, true>(lds, g, S, E); }
        else { int cur = -1;
          for (int it = (bx - 128) * 3; it < (bx - 128) * 3 + 3; ++it) { const int sg = it >> 3, part = it & 7;
              if (sg != cur) { __syncthreads(); s5_load(sg, lds, S5SM, in[9], in[10], true, tid); cur = sg; }
              s5_expand_tz(sg, lds, TZ, part * 64, part * 64 + 64, tid); }
          __syncthreads();
          CVT_RUN(CVT_P0_END + (bx - 128) * NWAVES + wave, 1024, CVT_P2_END); }
    }
    SEAM(2);
    if (IN(4)) {
        if (bx < 192) { pg8::Gemm g{UG, TZ, 640, 640, 640}; pg8::BatchOrder S; S.init(48, 2, 2, 192, bx); pg8::EpiS5c E{UG, in[11], GACT};
            pg8::gemm_phase<pg8::EpiS5c, pg8::BatchOrder, true, true>(lds, g, S, E); }
        for (;;) {
            if (tid == 0) MISC[0] = __hip_atomic_fetch_add((unsigned*)(ctl + CW_QUEUE + 128), 1u, __ATOMIC_RELAXED, __HIP_MEMORY_SCOPE_AGENT);
            __syncthreads();
            const int u = (int)MISC[0];
            __syncthreads();
            if (u >= 256) break;
            const int b = u >> 5, h = (u >> 3) & 3, qt = u & 7; const size_t t0 = (size_t)b * SEQ + qt * 256;
            mem_unit(lds, QM0 + t0 * 256 + h * 64, 256, MEMK + (size_t)(b * 256) * 512 + h * 64, MEMVT + (size_t)(h * 64) * 2048 + b * 256, CAT + t0 * 1024 + 768 + h * 64, tid); }
    }
    SEAM(4);
    if (IN(5)) { pg8::Gemm g{GACT, W_GLU, T, 768, 768, 1}; pg8::StaticOrder S; S.init(T / 256, 3, G, bx); pg8::EpiGlu E{GACT, in[13], CAT};
        pg8::gemm_phase<pg8::EpiGlu, pg8::StaticOrder, true, true>(lds, g, S, E);
        if (bx >= 192) CVT_RUN(CVT_P2_END + (bx - 192) * NWAVES + wave, 512, NITEMS); }
    SEAM(5);
    if (IN(6)) { pg8::Gemm g{CAT, W_OUT0, 1024, 1024, 1024}; pg8::StaticOrder S; S.init(T / 256, 4, G, bx); pg8::EpiResidB<true> E{XSC, XB, SS, 1.f, nullptr};
        pg8::gemm_phase<pg8::EpiResidB<true>, pg8::StaticOrder, true, true>(lds, g, S, E); }
    SEAM(6);
    if (IN(8)) {
        pg8::Gemm g{XB, W_FGU, 1024, 1024, 1024}; pg8::EpiSwiglu<1, true> E{ACT0, DFF, 22, 0, SS, MOE_ASCALE};
        const int slot = (bx >> 3) & 3, n1 = (slot == 0) ? 0 : (slot == 1) ? 1 : (slot == 2) ? 3 : 4;
        { pg8::RangeOrder S; S.S.init(T / 256, 22, G, bx); S.i0 = 0; S.i1 = n1; pg8::gemm_phase<pg8::EpiSwiglu<1, true>, pg8::RangeOrder, true, true>(lds, g, S, E); }
        { LAS unsigned* scr = (LAS unsigned*)(lds + wave * 16384);
          constexpr int I_E = (1024 / 64) * (DFE / 64), I_ED = (DFE / 64) * (1024 / 64), I_MOE = NEXP * (2 * I_E + I_ED), SHARE = (I_MOE + 255) / 256;
#define MOE_DESC(D_, IT_) do { int r = (IT_); const int e = r / (2 * I_E + I_ED); r -= e * (2 * I_E + I_ED); \
              if (r < 2 * I_E) { const int up = r / I_E; r -= up * I_E; const int kb = r / (DFE / 64), n0 = (r % (DFE / 64)) * 64; \
                  (D_).src = in[39 + up] + (size_t)e * 1024 * DFE + (size_t)(kb * 64) * DFE + n0; (D_).ldw = DFE; (D_).gain = in[37]; (D_).k0 = kb * 64; (D_).ldo = 1024; \
                  (D_).dst = (unsigned char*)W_MGU + (size_t)(e * 7168 + (n0 >> 7) * 256 + (n0 & 127) + up * 128) * 1024 + kb * 64; } \
              else { r -= 2 * I_E; const int kb = r / 16, n0 = (r % 16) * 64; \
                  (D_).src = in[41] + (size_t)e * DFE * 1024 + (size_t)(kb * 64) * 1024 + n0; (D_).ldw = 1024; (D_).gain = nullptr; (D_).k0 = kb * 64; (D_).ldo = DFE; \
                  (D_).dst = (unsigned char*)W_MD + (size_t)(e * 1024 + n0) * DFE + kb * 64; } } while (0)
          static_assert(SHARE == 84 && I_MOE == 256 * 84, "share sizes");
          const int it_beg = (bx < 128) ? bx * 72 : 128 * 72 + (bx - 128) * 96, it_end = it_beg + ((bx < 128) ? 72 : 96);
          for (int it = it_beg + wave; it < it_end; it += NWAVES) { CvtDesc8 d0; f32x4 a0[4][4]; float g0[4][4]; MOE_DESC(d0, it); cvt_load8_dma(d0, a0, g0, MOE_WSCALE, (LAS unsigned char*)scr, lane); cvt_emit8(d0, a0, g0, scr, lane); }
#undef MOE_DESC
          __syncthreads(); }
        { pg8::RangeOrder S; S.S.init(T / 256, 22, G, bx); S.i0 = n1; S.i1 = 1 << 20; pg8::gemm_phase<pg8::EpiSwiglu<1, true>, pg8::RangeOrder, true, true>(lds, g, S, E); }
    }
    SEAM(8);
    if (IN(9)) { pg8::Gemm g{ACT0, W_FD, DFF / 2, DFF / 2, DFF / 2}; pg8::StaticOrder S; S.init(T / 256, 4, G, bx); pg8::EpiResidB<false, true> E{nullptr, XB, SS, 1.f / (MOE_WSCALE * MOE_ASCALE), X8};
        pg8::gemm_phase<pg8::EpiResidB<false, true>, pg8::StaticOrder, true, true, true>(lds, g, S, E); }
    SEAM(9);
    if (IN(11)) {
        { pg8::Gemm g{(bf16*)X8, W_KQ, 512, 512, 512}; pg8::StaticOrder S; S.init(T / 256, 5, G, bx); pg8::EpiPlainS<1> E{KQ, 1280, 0, 0, SS, 1.f / (MOE_WSCALE * 8.f)};
          pg8::gemm_phase<pg8::EpiPlainS<1>, pg8::StaticOrder, true, true, true>(lds, g, S, E);
          pg8::Unit u;
          for (int i = 0; S.next(i, u); ++i) if (u.pn == 0) {
            const int b = u.pm >> 3, blk = u.pm & 7; const size_t t0 = (size_t)u.pm * 256;
            const int c0 = lane * 4, d = c0 & 63; float gk[4], cs[4] = {0.f, 0.f, 0.f, 0.f};
#pragma unroll
            for (int e = 0; e < 4; ++e) gk[e] = in[27][d + e] * in[30][d + e];
            for (int rr = 0; rr < 32; ++rr) { bf16* p = KQ + (t0 + wave * 32 + rr) * 1280 + c0; const v2u w = *(const GAS v2u*)p;
                float v[4] = {bf_lo(w.x), bf_hi(w.x), bf_lo(w.y), bf_hi(w.y)}; float ss = v[0] * v[0] + v[1] * v[1] + v[2] * v[2] + v[3] * v[3];
                ss += __shfl_xor(ss, 1); ss += __shfl_xor(ss, 2); ss += __shfl_xor(ss, 4); ss += __shfl_xor(ss, 8);
                const float r = 1.f / sqrtf(ss * (1.f / 64.f) + RMS_EPS);
#pragma unroll
                for (int e = 0; e < 4; ++e) { v[e] *= r * gk[e]; cs[e] += v[e]; }
                *(GAS v2u*)p = (v2u){cvt_pk_bf16(v[0], v[1]), cvt_pk_bf16(v[2], v[3])}; }
            LAS float* red = (LAS float*)lds;
#pragma unroll
            for (int e = 0; e < 4; ++e) red[wave * 256 + c0 + e] = cs[e];
            __syncthreads();
            if (tid < 256) { float sm = 0.f;
#pragma unroll
                for (int w = 0; w < 8; ++w) sm += red[w * 256 + tid];
                KMEANS[(size_t)((b * 4 + (tid >> 6)) * 8 + blk) * 64 + (tid & 63)] = sm * (1.f / 256.f); }
            __syncthreads(); } }
        { pg8::Gemm g{W_V, (bf16*)X8, 512, 512, 512}; pg8::StaticOrder S; S.init(1, T / 256, 64, bx - 64); pg8::EpiPlainS<2> E{VT, T, 0, 0, SS, 1.f / (MOE_WSCALE * 8.f)};
          if (bx >= 64) pg8::gemm_phase<pg8::EpiPlainS<2>, pg8::StaticOrder, true, true, true>(lds, g, S, E); }
    }
    SEAM(11);

    if (IN(13)) {
        for (;;) {
            if (tid == 0) MISC[0] = __hip_atomic_fetch_add((unsigned*)(ctl + CW_QUEUE), 1u, __ATOMIC_RELAXED, __HIP_MEMORY_SCOPE_AGENT);
            __syncthreads();
            const int it = (int)MISC[0];
            __syncthreads();
            if (it >= 1024) break;
            if (it < 768) { const int qblk = 7 - it / 96, r = it % 96; moba_unit(lds, r / 12, r % 12, qblk, KQ, VT, KMEANS, CAT, tid); }
            else { const int u = it - 768, b = u >> 5, h = (u >> 3) & 3, qt = u & 7; const size_t t0 = (size_t)b * SEQ + qt * 256;
                mem_unit<true>(lds, KQ + t0 * 1280 + 1024 + h * 64, 1280, MEMK + (size_t)(b * 256) * 512 + 256 + h * 64, MEMVT + (size_t)(256 + h * 64) * 2048 + b * 256, (bf16*)((unsigned char*)CAT + t0 * 1024 + 768 + h * 64), tid); }
        }
    }
    SEAM(13);
    if (IN(14)) { pg8::Gemm g{CAT, W_OUT1, 512, 512, 512}; pg8::StaticOrder S; S.init(T / 256, 4, G, bx); pg8::EpiResidB<false> E{nullptr, XB, SS, 1.f / (MOE_WSCALE * 8.f), nullptr};
        pg8::gemm_phase<pg8::EpiResidB<false>, pg8::StaticOrder, true, true, true>(lds, g, S, E); }
    SEAM(14);
    if (IN(15)) {
        LAS float* wrt = (LAS float*)lds;
        LAS int* el = (LAS int*)(lds + 32768);
        for (int i = tid; i < 8192; i += NTHREADS) { const int k = i >> 3, e = i & 7; wrt[e * 1024 + k] = in[37][k] * in[38][i]; }
        __syncthreads();
        const int tpw = T / G;
        for (int tl = wave; tl < tpw; tl += NWAVES) { const int t = bx * tpw + tl;
            const GAS v2u* xr = (const GAS v2u*)(XB + (size_t)t * D) + lane; f32x4 v[4]; float s = 0.f;
#pragma unroll
            for (int j = 0; j < 4; ++j) { const v2u w = xr[64 * j]; v[j] = (f32x4){bf_lo(w.x), bf_hi(w.x), bf_lo(w.y), bf_hi(w.y)}; s += (v[j].x * v[j].x + v[j].y * v[j].y) + (v[j].z * v[j].z + v[j].w * v[j].w); }
            const float r = 1.f / sqrtf(wave_sum(s) * (1.f / 1024.f) + RMS_EPS);
#pragma unroll
            for (int j = 0; j < 4; ++j) v[j] = v[j] * r;
            float lg[8];
#pragma unroll
            for (int e = 0; e < 8; ++e) { float a = 0.f;
#pragma unroll
                for (int j = 0; j < 4; ++j) { const f32x4 w = *(const LAS f32x4*)(wrt + e * 1024 + 256 * j + 4 * lane); a += v[j].x * w.x + v[j].y * w.y + v[j].z * w.z + v[j].w * w.w; }
                lg[e] = wave_sum(a); }
            int i0 = 0; float v0 = lg[0];
#pragma unroll
            for (int e = 1; e < 8; ++e) if (lg[e] > v0) { v0 = lg[e]; i0 = e; }
            int i1 = -1; float v1 = -3e38f;
#pragma unroll
            for (int e = 0; e < 8; ++e) if (e != i0 && lg[e] > v1) { v1 = lg[e]; i1 = e; }
            const float e1 = __expf(v1 - v0), g0 = 1.f / (1.f + e1), g1 = e1 * g0;
            if (lane == 0) { el[tl] = i0 * 8 + i1; TOKE[2 * t] = i0; TOKE[2 * t + 1] = i1; TOKG[2 * t] = g0; TOKG[2 * t + 1] = g1; TOKRS[t] = r; } }
        __syncthreads();
        if (tid < tpw) { const int pd = el[tid]; int lp = 0; for (int j = 0; j < tid; ++j) lp += (el[j] == pd) ? 1 : 0; TOKLP[(size_t)bx * tpw + tid] = lp; }
        if (tid >= 64 && tid < 128) { const int pd = tid - 64; int n = 0; for (int j = 0; j < tpw; ++j) n += (el[j] == pd) ? 1 : 0; WGCNT[bx * 64 + pd] = n; }
        __syncthreads();
    }
    SEAM(15);
    if (IN(16)) {
        LAS int* tab = (LAS int*)lds; LAS int* Cp = tab + 16384; LAS int* PRE = Cp + 64; LAS int* Fp = PRE + 64; LAS int* bAu = Fp + 64; LAS int* bAf = bAu + 64; LAS int* bBu = bAf + 64; LAS int* bBf = bBu + 64;
        LAS int* offA = bBf + 64; LAS int* offB = offA + 8; LAS int* UA = offB + 8; LAS int* VB = UA + 8;
        for (int i = tid; i < G * 64; i += NTHREADS) tab[i] = WGCNT[i];
        __syncthreads();
        if (tid < 64) { int tot = 0, pre = 0; for (int w = 0; w < G; ++w) { const int v = tab[w * 64 + tid]; if (w < bx) pre += v; tot += v; } Cp[tid] = tot; PRE[tid] = pre; Fp[tid] = 0; }
        __syncthreads();
        if (tid == 0) {
            int n0[8], rr[8], sup[8], dem[8]; int srem = 0;
            for (int e = 0; e < 8; ++e) { int n = 0; for (int b2 = 0; b2 < 8; ++b2) n += Cp[e * 8 + b2]; n0[e] = n; rr[e] = n & 255; srem += rr[e]; sup[e] = rr[e]; dem[e] = 0; }
            const int mup = srem >> 8;
            for (int it = 0; it < mup; ++it) { int be = -1, bv = -1; for (int e = 0; e < 8; ++e) if (dem[e] == 0 && sup[e] > bv) { bv = sup[e]; be = e; }
                if (be >= 0) { dem[be] = 256 - rr[be]; sup[be] = 0; } }
            for (int a = 0; a < 8; ++a) for (int b2 = 0; b2 < 8; ++b2) if (a != b2 && sup[a] > 0 && dem[b2] > 0) { int f = sup[a] < dem[b2] ? sup[a] : dem[b2]; if (Cp[a * 8 + b2] < f) f = Cp[a * 8 + b2];
                Fp[a * 8 + b2] = f; sup[a] -= f; dem[b2] -= f; }
            int oa = 0, ob = 0;
            for (int e = 0; e < 8; ++e) { int ua = 0, vb = 0, fin = 0, fout = 0;
                for (int x = 0; x < 8; ++x) { ua += Cp[e * 8 + x] - Fp[e * 8 + x]; vb += Cp[x * 8 + e] - Fp[x * 8 + e]; fin += Fp[x * 8 + e]; fout += Fp[e * 8 + x]; }
                UA[e] = ua; VB[e] = vb; offA[e] = oa * 256; offB[e] = ob * 256; oa += (ua + fin + 255) >> 8; ob += (vb + fout + 255) >> 8;
                if (bx == 0) { PANEND[e] = oa; PANEND[8 + e] = ob; } }
        }
        __syncthreads();
        if (tid < 64) { const int a = tid >> 3, b2 = tid & 7; int s1 = 0, s2 = 0, s3 = 0, s4 = 0;
            for (int x = 0; x < b2; ++x) { s1 += Cp[a * 8 + x] - Fp[a * 8 + x]; s4 += Fp[a * 8 + x]; }
            for (int x = 0; x < a; ++x) { s2 += Fp[x * 8 + b2]; s3 += Cp[x * 8 + b2] - Fp[x * 8 + b2]; }
            bAu[tid] = offA[a] + s1 - Fp[tid]; bAf[tid] = offA[b2] + UA[b2] + s2; bBu[tid] = offB[b2] + s3 - Fp[tid]; bBf[tid] = offB[a] + VB[a] + s4; }
        __syncthreads();
        const int tpw = T / G;
        for (int tl = wave; tl < tpw; tl += NWAVES) { const int t = bx * tpw + tl;
            const int pd = TOKE[2 * t] * 8 + TOKE[2 * t + 1], q = PRE[pd] + TOKLP[(size_t)bx * tpw + tl]; const bool fl = q < Fp[pd];
            const int rowA = q + (fl ? bAf[pd] : bAu[pd]), rowB = q + (fl ? bBf[pd] : bBu[pd]);
            const float rs_ = TOKRS[t];
            if (lane == 0) { ROWTOK[rowA] = t; ROWGATE[rowA] = TOKG[2 * t + (fl ? 1 : 0)]; ROWRS[rowA] = rs_;
                             ROWTOK[RROWS + rowB] = t; ROWGATE[RROWS + rowB] = TOKG[2 * t + (fl ? 0 : 1)]; ROWRS[RROWS + rowB] = rs_; }
            const GAS v4u* src = (const GAS v4u*)(XB + (size_t)t * D);
            GAS v2u* dA = (GAS v2u*)((unsigned char*)XS + (size_t)rowA * D); GAS v2u* dB = (GAS v2u*)((unsigned char*)XS + ((size_t)RROWS + rowB) * D);
#pragma unroll
            for (int h = 0; h < 2; ++h) { const v4u w = src[64 * h + lane];
                const v2u o = (v2u){pg8::pk4_fp8(bf_lo(w.x) * rs_, bf_hi(w.x) * rs_, bf_lo(w.y) * rs_, bf_hi(w.y) * rs_), pg8::pk4_fp8(bf_lo(w.z) * rs_, bf_hi(w.z) * rs_, bf_lo(w.w) * rs_, bf_hi(w.w) * rs_)};
                dA[64 * h + lane] = o; dB[64 * h + lane] = o; } }
        __syncthreads();
    }
    SEAM(16);
#define MOE_ROUND(PH, KK, FIRST_) \
    if (IN(PH)) { pg8::GroupOrder S; for (int e = 0; e < 8; ++e) S.pe[e] = PANEND[(KK) * 8 + e]; S.npe = 28; S.S.init(S.pe[7], 28, G, bx); \
        pg8::Gemm g{XS + (size_t)(KK) * RROWS * (D / 2), W_MGU, 512, 512, 512}; pg8::EpiSwigluF8 E{(unsigned char*)ACTM + (size_t)(KK) * RROWS * DFE, DFE, 28, 0, 1.f / MOE_WSCALE, MOE_ASCALE}; \
        pg8::gemm_phase<pg8::EpiSwigluF8, pg8::GroupOrder, true, true, true>(lds, g, S, E); } \
    SEAM(PH); \
    if (IN((PH) + 1)) { volatile LAS unsigned* tb = MISC + 16; \
        if (tid < 8) tb[tid] = (unsigned)PANEND[(KK) * 8 + tid]; \
        if (tid == 8) { const int npan = PANEND[(KK) * 8 + 7]; const int nun = npan * 4, tl = nun - G; \
            tb[8] = (unsigned)nun; tb[9] = (tl <= G / 4) ? 4u : (tl <= G / 2) ? 2u : 1u; tb[10] = (unsigned)npan; tb[11] = (unsigned)bx; tb[12] = 8u; tb[13] = 4u; tb[14] = (unsigned)(DFE / 128); tb[15] = (unsigned)G; \
            const unsigned long long sl = (unsigned long long)((KK) == 0 ? (unsigned char*)CAT : (unsigned char*)XS + 36 * MiB), fl = (unsigned long long)(unsigned*)(ctl + CW_SKFLAG + (KK) * 256 * 64); \
            tb[16] = (unsigned)sl; tb[17] = (unsigned)(sl >> 32); tb[18] = (unsigned)fl; tb[19] = (unsigned)(fl >> 32); } \
        __syncthreads(); \
        pg8::GroupStream S; S.tab = (const LAS unsigned*)(lds + MISC_OFF + 64); \
        pg8::Gemm g{ACTM + (size_t)(KK) * RROWS * (DFE / 2), W_MD, DFE / 2, DFE / 2, DFE / 2}; pg8::EpiMoeDown<FIRST_> E{OUT, ROWTOK + (KK) * RROWS, ROWGATE + (KK) * RROWS, 0, XB, 1.f / (MOE_WSCALE * MOE_ASCALE)}; \
        pg8::gemm_phase<pg8::EpiMoeDown<FIRST_>, pg8::GroupStream, true, true, true>(lds, g, S, E); }
    MOE_ROUND(17, 1, true)
    MOE_ROUND(19, 0, false)

#undef IN
#undef SEAM
}

extern "C" void kernel_launch(void* const* d_in, const int* in_sizes, int n_in, void* d_out, int out_size, void* d_ws, size_t ws_size, hipStream_t stream) {
    static int grid = 0;
    if (grid == 0) {
        if (n_in != 42 || in_sizes[0] != T * D || out_size != T * D || ws_size < WS_END) { fprintf(stderr, "kernel_launch: unexpected shapes (n_in %d, in0 %d, out %d, ws %zu < %zu); nothing launched\n", n_in, n_in > 0 ? in_sizes[0] : -1, out_size, ws_size, (size_t)WS_END); grid = -1; return; }
        int dev = 0, cus = 0, per_cu = 0;
        if (hipGetDevice(&dev) != hipSuccess || hipDeviceGetAttribute(&cus, hipDeviceAttributeMultiprocessorCount, dev) != hipSuccess) { grid = -1; return; }
        if (hipFuncSetAttribute((const void*)fwd_kernel, hipFuncAttributeMaxDynamicSharedMemorySize, LDS_BYTES) != hipSuccess) { fprintf(stderr, "kernel_launch: hipFuncSetAttribute failed\n"); grid = -1; return; }
        if (hipOccupancyMaxActiveBlocksPerMultiprocessor(&per_cu, (const void*)fwd_kernel, NTHREADS, LDS_BYTES) != hipSuccess || per_cu < 1) { fprintf(stderr, "kernel_launch: occupancy query reports %d\n", per_cu); }
        (void)hipGetLastError();
        grid = 256;
        if (cus < 256) { fprintf(stderr, "kernel_launch: device has %d CUs, need 256\n", cus); grid = -1; return; }
    }
    if (grid < 0) return;
    if (hipMemsetAsync((char*)d_ws + WS_CTL, 0, CTL_ZERO_BYTES, stream) != hipSuccess) return;
    Args a{};
    for (int i = 0; i < 42; ++i) a.in[i] = (const float*)d_in[i];
    a.out = (float*)d_out; a.ws = (unsigned char*)d_ws;
#ifdef MK_SPLIT
    for (int p = 0; p < NPHASE; ++p) { a.ph_lo = p; a.ph_hi = p + 1; hipLaunchKernelGGL(fwd_kernel, dim3(grid), dim3(NTHREADS), LDS_BYTES, stream, a); }
#else
#ifndef STOP_AFTER
#define STOP_AFTER (NPHASE - 1)
#endif
    a.ph_lo = 0; a.ph_hi = STOP_AFTER + 1;
    hipLaunchKernelGGL(fwd_kernel, dim3(grid), dim3(NTHREADS), LDS_BYTES, stream, a);
#endif
}
```

```cpp
#include <hip/hip_runtime.h>
#include <cstdio>
#include <cstdint>

namespace pg8 {
#define PG8_LAS __attribute__((address_space(3)))
typedef unsigned short bf16_t;
typedef short bf16x8 __attribute__((ext_vector_type(8)));
typedef float f32x4 __attribute__((ext_vector_type(4)));
typedef unsigned u32x4 __attribute__((ext_vector_type(4)));
constexpr int BM = 256, BK = 64, HALF = 128, HTB = HALF * BK * 2  , STAGE_BYTES = 8 * HTB, NXCD = 8, WGM = 4;

__host__ __device__ __forceinline__ int lds_byte(int r, int c) { const int st = (r >> 4) * 2 + (c >> 5), rr = r & 15, cc = c & 31, ob = rr * 64 + cc * 2; return st * 1024 + (ob ^ (((ob >> 9) & 1) << 5)); }
__host__ __device__ __forceinline__ void stage_rc(int b, int& R, int& C) { const int st = b / 1024, sb = b % 1024, swz = sb ^ (((sb >> 9) & 1) << 5); R = (st >> 1) * 16 + swz / 64; C = (st & 1) * 32 + (swz % 64) / 2; }
__host__ __device__ __forceinline__ int perm32(int rho) { const int n = rho >> 4, i = rho & 15; return 8 * (i >> 2) + 4 * n + (i & 3); }

struct Unit { int pm, pn; int k0, nk, part; };
struct Gemm { const bf16_t* A; const bf16_t* Bt; int lda, ldb, K; int amode = 0; };

struct StaticOrder {
    static constexpr bool STREAMK = false;
    int nM, nN, nwg, G, c;
    __host__ __device__ __forceinline__ void init(int nM_, int nN_, int G_, int c_) { nM = nM_; nN = nN_; nwg = nM * nN; G = G_; c = c_; }
    __host__ __device__ __forceinline__ bool next(int i, Unit& u) const {
        const long L = (long)i * G + c; if (L >= nwg || c >= G) return false;
        u.k0 = 0; u.nk = 0; u.part = 0; map((int)L, u); return true;
    }
    __host__ __device__ __forceinline__ void map(int L, Unit& u) const {
        int wgid = L; { const int q = nwg / NXCD, r = nwg % NXCD, xcd = wgid % NXCD, off = wgid / NXCD; wgid = (xcd < r ? xcd * (q + 1) : r * (q + 1) + (xcd - r) * q) + off; }
        const int nig = WGM * nN, gid = wgid / nig, fm = gid * WGM, gsz = (nM - fm) < WGM ? (nM - fm) : WGM;
        u.pm = fm + ((wgid % nig) % gsz); u.pn = (wgid % nig) / gsz;
    }
};
struct RangeOrder {
    static constexpr bool STREAMK = false;
    StaticOrder S; int i0, i1;
    __host__ __device__ __forceinline__ bool next(int i, Unit& u) const { return (i0 + i < i1) && S.next(i0 + i, u); }
};
struct BatchOrder {
    static constexpr bool STREAMK = false;
    int nunits, tm, tn, G, c;
    __host__ __device__ __forceinline__ void init(int nb, int tm_, int tn_, int G_, int c_) { tm = tm_; tn = tn_; nunits = nb * tm * tn; G = G_; c = c_; }
    __host__ __device__ __forceinline__ bool next(int i, Unit& u) const {
        const int L = i * G + c; if (L >= nunits || c >= G) return false;
        const int b = L / (tm * tn), r = L % (tm * tn); u.pm = b * tm + r / tn; u.pn = b * tn + r % tn; u.k0 = 0; u.nk = 0; u.part = 0; return true;
    }
};
struct GroupOrder {
    static constexpr bool STREAMK = false;
    StaticOrder S; int npe; int pe[8];
    __host__ __device__ __forceinline__ bool next(int i, Unit& u) const {
        if (!S.next(i, u)) return false;
        int e = 0;
#pragma unroll
        for (int k = 0; k < 7; ++k) e += (u.pm >= pe[k]) ? 1 : 0;
        u.pn += e * npe; return true;
    }
};

typedef float f32x2_t __attribute__((ext_vector_type(2))); typedef __bf16 bf16x2_t __attribute__((ext_vector_type(2)));
struct GroupStream {
    static constexpr bool STREAMK = true;
    const PG8_LAS unsigned* tab;
    __device__ __forceinline__ int c() const { return (int)tab[11]; }
    __device__ __forceinline__ int split() const { return (int)tab[9]; }
    __device__ __forceinline__ unsigned target() const { return tab[12]; }
    __device__ __forceinline__ unsigned long long* slots() const { return (unsigned long long*)(((unsigned long long)tab[17] << 32) | tab[16]); }
    __device__ __forceinline__ unsigned* flags() const { return (unsigned*)(((unsigned long long)tab[19] << 32) | tab[18]); }
    __device__ __forceinline__ bool next(int i, Unit& u) const {
        const int nunits = (int)tab[8], sp = (int)tab[9], npe = (int)tab[13], ntk = (int)tab[14], G = (int)tab[15], c_ = (int)tab[11];
        int L, k0 = 0, nk = ntk, part = 0;
        if (i == 0) { L = c_; if (L >= nunits) return false; }
        else if (i == 1) { const int j = c_ / sp, p = c_ % sp; L = G + j; if (L >= nunits) return false; const int base = (ntk / sp) & ~1, xh = (ntk - sp * base) >> 1; nk = base + (p < xh ? 2 : 0); k0 = p * base + 2 * (p < xh ? p : xh); part = (sp == 1) ? 0 : (p == 0 ? 1 : 2); }
        else return false;
        StaticOrder S; S.init((int)tab[10], npe, 1, 0); S.map(L, u); int e = 0;
#pragma unroll
        for (int k = 0; k < 7; ++k) e += (u.pm >= (int)tab[k]) ? 1 : 0;
        u.pn += e * npe; u.k0 = k0; u.nk = nk; u.part = part; return true;
    }
};
constexpr int SK_SLOT_WORDS = 32 * 512;

__device__ __forceinline__ unsigned cvt_pk_bf16(float lo, float hi) { f32x2_t v = {lo, hi}; bf16x2_t b = __builtin_convertvector(v, bf16x2_t); return __builtin_bit_cast(unsigned, b); }
__device__ __forceinline__ float bf_lo(unsigned w) { return __builtin_bit_cast(float, w << 16); }
__device__ __forceinline__ float bf_hi(unsigned w) { return __builtin_bit_cast(float, w & 0xffff0000u); }
__device__ __forceinline__ float fsigmoid(float x) { return __builtin_amdgcn_rcpf(1.f + __builtin_amdgcn_exp2f(-1.4426950408889634f * x)); }
__device__ __forceinline__ float gelu_tanh(float y) { const float z = 0.7978845608028654f * (y + 0.044715f * y * y * y); return y * fsigmoid(2.f * z); }

#define EPI_LOOP_ROWS for (int ai = 0; ai < 2; ++ai) _Pragma("unroll") for (int m = 0; m < 4; ++m)
__device__ __forceinline__ u32x4 pack8(const f32x4& v0, const f32x4& v1) { u32x4 w; w.x = cvt_pk_bf16(v0[0], v0[1]); w.y = cvt_pk_bf16(v0[2], v0[3]); w.z = cvt_pk_bf16(v1[0], v1[1]); w.w = cvt_pk_bf16(v1[2], v1[3]); return w; }

__device__ __forceinline__ float rs_row(const float* SS, int row) {
    const f32x4 a = *(const f32x4*)(SS + (size_t)row * 16), b = *(const f32x4*)(SS + (size_t)row * 16 + 4), c = *(const f32x4*)(SS + (size_t)row * 16 + 8), d = *(const f32x4*)(SS + (size_t)row * 16 + 12);
    const float s = ((a[0] + a[1]) + (a[2] + a[3])) + ((b[0] + b[1]) + (b[2] + b[3])) + ((c[0] + c[1]) + (c[2] + c[3])) + ((d[0] + d[1]) + (d[2] + d[3]));
    return 1.f / __builtin_sqrtf(s * (1.f / 1024.f) + 1e-6f);
}
template <int SCALE  > struct EpiPlainS {
    static constexpr bool PERM = true, AFTER_DRAIN = false;
    bf16_t* O; int ldc; int pm0, pn0; const float* SS; float inv;
    __device__ __forceinline__ void operator()(const f32x4 (&acc)[2][2][4][2], const Unit& u, int wr, int wc, int fr, int fq) const {
        const int row0 = (u.pm - pm0) * BM + wr * 64 + fr, col0 = (u.pn - pn0) * BM + wc * 32 + 8 * fq;
        float cs[2][8];
        if (SCALE == 2) {
#pragma unroll
            for (int bj = 0; bj < 2; ++bj)
#pragma unroll
                for (int e = 0; e < 8; ++e) cs[bj][e] = rs_row(SS, u.pn * BM + bj * HALF + wc * 32 + 8 * fq + e) * inv; }
#pragma unroll
        EPI_LOOP_ROWS { bf16_t* rowp = O + (size_t)(row0 + ai * HALF + m * 16) * ldc + col0; float rs = 1.f; if (SCALE == 1) rs = rs_row(SS, u.pm * BM + wr * 64 + fr + ai * HALF + m * 16) * inv;
#pragma unroll
            for (int bj = 0; bj < 2; ++bj) { f32x4 v0 = acc[ai][bj][m][0], v1 = acc[ai][bj][m][1];
                if (SCALE == 1) { v0 = v0 * rs; v1 = v1 * rs; }
                if (SCALE == 2) { v0 = v0 * (f32x4){cs[bj][0], cs[bj][1], cs[bj][2], cs[bj][3]}; v1 = v1 * (f32x4){cs[bj][4], cs[bj][5], cs[bj][6], cs[bj][7]}; }
                *(u32x4*)(rowp + bj * HALF) = pack8(v0, v1); } }
    }
};
struct EpiPlain {
    static constexpr bool PERM = true, AFTER_DRAIN = false;
    bf16_t* O; int ldc; int pm0, pn0;
    __device__ __forceinline__ void operator()(const f32x4 (&acc)[2][2][4][2], const Unit& u, int wr, int wc, int fr, int fq) const {
        const int row0 = (u.pm - pm0) * BM + wr * 64 + fr, col0 = (u.pn - pn0) * BM + wc * 32 + 8 * fq;
#pragma unroll
        EPI_LOOP_ROWS { bf16_t* rowp = O + (size_t)(row0 + ai * HALF + m * 16) * ldc + col0;
#pragma unroll
            for (int bj = 0; bj < 2; ++bj) *(u32x4*)(rowp + bj * HALF) = pack8(acc[ai][bj][m][0], acc[ai][bj][m][1]); }
    }
};
struct EpiProj0 {
    static constexpr bool PERM = true, AFTER_DRAIN = false;
    bf16_t* UG; bf16_t* QM;
    __device__ __forceinline__ void operator()(const f32x4 (&acc)[2][2][4][2], const Unit& u, int wr, int wc, int fr, int fq) const {
        const int row0 = u.pm * BM + wr * 64 + fr;
#pragma unroll
        EPI_LOOP_ROWS { const int t = row0 + ai * HALF + m * 16;
#pragma unroll
            for (int bj = 0; bj < 2; ++bj) { const int c = u.pn * BM + bj * HALF + wc * 32 + 8 * fq; bf16_t* p;
                if (u.pn < 3) p = UG + ((size_t)((c >> 4) * 512 + (t >> 5))) * 640 + (t & 31) * 16 + (c & 15); else p = QM + (size_t)t * 256 + (c - 768);
                *(u32x4*)p = pack8(acc[ai][bj][m][0], acc[ai][bj][m][1]); } }
    }
};
struct EpiS5a {
    static constexpr bool PERM = true, AFTER_DRAIN = false;
    float* XC;
    __device__ __forceinline__ void operator()(const f32x4 (&acc)[2][2][4][2], const Unit& u, int wr, int wc, int fr, int fq) const {
        const int row0 = u.pm * BM + wr * 64 + fr, col0 = wc * 32 + 8 * fq;
#pragma unroll
        EPI_LOOP_ROWS { float* rowp = XC + (size_t)(row0 + ai * HALF + m * 16) * 128 + col0; *(f32x4*)rowp = acc[ai][0][m][0]; *(f32x4*)(rowp + 4) = acc[ai][0][m][1]; }
    }
};
struct EpiS5c {
    static constexpr bool PERM = true, AFTER_DRAIN = false;
    const bf16_t* UG; const float* dskip; bf16_t* GACT;
    __device__ __forceinline__ void operator()(const f32x4 (&acc)[2][2][4][2], const Unit& u, int wr, int wc, int fr, int fq) const {
        const int row0 = u.pm * BM + wr * 64 + fr, g = u.pm >> 1;
#pragma unroll
        for (int bj = 0; bj < 2; ++bj) { const int col8 = (u.pn & 1) * BM + bj * HALF + wc * 32 + 8 * fq, j = col8 >> 4, nb = col8 & 15;
            const f32x4 d0 = *(const f32x4*)(dskip + g * 16 + nb), d1 = *(const f32x4*)(dskip + g * 16 + nb + 4);
#pragma unroll
            EPI_LOOP_ROWS { const int R = row0 + ai * HALF + m * 16, chunk = R & 511, t = chunk * 32 + j;
                const u32x4 uu = *(const u32x4*)(UG + (size_t)R * 640 + j * 16 + nb);
                f32x4 v0 = acc[ai][bj][m][0], v1 = acc[ai][bj][m][1];
                v0[0] = gelu_tanh(v0[0] + d0[0] * bf_lo(uu.x)); v0[1] = gelu_tanh(v0[1] + d0[1] * bf_hi(uu.x)); v0[2] = gelu_tanh(v0[2] + d0[2] * bf_lo(uu.y)); v0[3] = gelu_tanh(v0[3] + d0[3] * bf_hi(uu.y));
                v1[0] = gelu_tanh(v1[0] + d1[0] * bf_lo(uu.z)); v1[1] = gelu_tanh(v1[1] + d1[1] * bf_hi(uu.z)); v1[2] = gelu_tanh(v1[2] + d1[2] * bf_lo(uu.w)); v1[3] = gelu_tanh(v1[3] + d1[3] * bf_hi(uu.w));
                *(u32x4*)(GACT + ((size_t)g * 16384 + t) * 16 + nb) = pack8(v0, v1); } }
    }
};
struct EpiGlu {
    static constexpr bool PERM = true, AFTER_DRAIN = false;
    const bf16_t* GACT; const float* bias; bf16_t* CAT;
    __device__ __forceinline__ void operator()(const f32x4 (&acc)[2][2][4][2], const Unit& u, int wr, int wc, int fr, int fq) const {
        const int row0 = u.pm * BM + wr * 64 + fr;
#pragma unroll
        for (int bj = 0; bj < 2; ++bj) { const int c = u.pn * BM + bj * HALF + wc * 32 + 8 * fq;
            const f32x4 b0 = *(const f32x4*)(bias + c), b1 = *(const f32x4*)(bias + c + 4);
#pragma unroll
            EPI_LOOP_ROWS { const int t = row0 + ai * HALF + m * 16;
                const u32x4 gg = *(const u32x4*)(GACT + ((size_t)(c >> 4) * 16384 + t) * 16 + (c & 15));
                f32x4 v0 = acc[ai][bj][m][0] + b0, v1 = acc[ai][bj][m][1] + b1;
                v0[0] = bf_lo(gg.x) * fsigmoid(v0[0]); v0[1] = bf_hi(gg.x) * fsigmoid(v0[1]); v0[2] = bf_lo(gg.y) * fsigmoid(v0[2]); v0[3] = bf_hi(gg.y) * fsigmoid(v0[3]);
                v1[0] = bf_lo(gg.z) * fsigmoid(v1[0]); v1[1] = bf_hi(gg.z) * fsigmoid(v1[1]); v1[2] = bf_lo(gg.w) * fsigmoid(v1[2]); v1[3] = bf_hi(gg.w) * fsigmoid(v1[3]);
                *(u32x4*)(CAT + (size_t)t * 1024 + c) = pack8(v0, v1); } }
    }
};
typedef unsigned u32x2_ __attribute__((ext_vector_type(2)));
__device__ __forceinline__ unsigned pk4_fp8(float a, float b, float c, float d) { int w = 0; w = __builtin_amdgcn_cvt_pk_fp8_f32(a, b, w, false); w = __builtin_amdgcn_cvt_pk_fp8_f32(c, d, w, true); return (unsigned)w; }
__device__ __forceinline__ float swiglu_fast(float ag, float au, float c1, float K) { const float e = __builtin_amdgcn_exp2f(ag * c1); return (ag * au) * __builtin_amdgcn_rcpf(__builtin_fmaf(e, K, K)); }
template <int SCALE  , bool OUT8 = false  > struct EpiSwiglu {
    static constexpr bool PERM = true, AFTER_DRAIN = false;
    bf16_t* O; int ldc; int npe; int pm0; const float* RS; float osc;
    __device__ __forceinline__ void operator()(const f32x4 (&acc)[2][2][4][2], const Unit& u, int wr, int wc, int fr, int fq) const {
        const int row0 = (u.pm - pm0) * BM + wr * 64 + fr, col0 = (u.pn % npe) * HALF + wc * 32 + 8 * fq;
#pragma unroll
        EPI_LOOP_ROWS { f32x4 v0, v1; const int r = row0 + ai * HALF + m * 16; const float rs = (SCALE == 1) ? rs_row(RS, r) : RS[r]; const float c1 = -1.4426950408889634f * rs, K = __builtin_amdgcn_rcpf(rs * rs * (OUT8 ? osc : 1.f));
#pragma unroll
            for (int e = 0; e < 4; ++e) { v0[e] = swiglu_fast(acc[ai][0][m][0][e], acc[ai][1][m][0][e], c1, K); v1[e] = swiglu_fast(acc[ai][0][m][1][e], acc[ai][1][m][1][e], c1, K); }
            if constexpr (OUT8) {
#pragma unroll
                for (int e = 0; e < 4; ++e) { v0[e] = __builtin_amdgcn_fmed3f(v0[e], -440.f, 440.f); v1[e] = __builtin_amdgcn_fmed3f(v1[e], -440.f, 440.f); }
                *(u32x2_*)((unsigned char*)O + (size_t)r * ldc + col0) = (u32x2_){pk4_fp8(v0[0], v0[1], v0[2], v0[3]), pk4_fp8(v1[0], v1[1], v1[2], v1[3])}; }
            else *(u32x4*)(O + (size_t)r * ldc + col0) = pack8(v0, v1); }
    }
};
struct EpiSwigluF8 {
    static constexpr bool PERM = true, AFTER_DRAIN = false;
    unsigned char* O; int ldc; int npe; int pm0; float inv, sc;
    __device__ __forceinline__ void operator()(const f32x4 (&acc)[2][2][4][2], const Unit& u, int wr, int wc, int fr, int fq) const {
        const int row0 = (u.pm - pm0) * BM + wr * 64 + fr, col0 = (u.pn % npe) * HALF + wc * 32 + 8 * fq;
        const float c1 = -1.4426950408889634f * inv, K = 1.f / (inv * inv * sc);
#pragma unroll
        EPI_LOOP_ROWS { f32x4 v0, v1; const int r = row0 + ai * HALF + m * 16;
#pragma unroll
            for (int e = 0; e < 4; ++e) { v0[e] = __builtin_amdgcn_fmed3f(swiglu_fast(acc[ai][0][m][0][e], acc[ai][1][m][0][e], c1, K), -440.f, 440.f); v1[e] = __builtin_amdgcn_fmed3f(swiglu_fast(acc[ai][0][m][1][e], acc[ai][1][m][1][e], c1, K), -440.f, 440.f); }
            *(u32x2_*)(O + (size_t)r * ldc + col0) = (u32x2_){pk4_fp8(v0[0], v0[1], v0[2], v0[3]), pk4_fp8(v1[0], v1[1], v1[2], v1[3])}; }
    }
};
template <bool F32BASE  , bool W8 = false  > struct EpiResidB {
    static constexpr bool PERM = true, AFTER_DRAIN = false;
    const float* R; bf16_t* XR; float* SS; float inv; unsigned char* X8;
    __device__ __forceinline__ void operator()(const f32x4 (&acc)[2][2][4][2], const Unit& u, int wr, int wc, int fr, int fq) const {
        const int row0 = u.pm * BM + wr * 64 + fr, col0 = u.pn * BM + wc * 32 + 8 * fq;
#pragma unroll
        EPI_LOOP_ROWS { const int row = row0 + ai * HALF + m * 16; const size_t o = (size_t)row * 1024 + col0; float ss = 0.f; const float xs = F32BASE ? R[row] : 1.f;
#pragma unroll
            for (int bj = 0; bj < 2; ++bj) { f32x4 r0, r1;
                { const u32x4 w = *(const u32x4*)(XR + o + bj * HALF); r0 = (f32x4){bf_lo(w.x), bf_hi(w.x), bf_lo(w.y), bf_hi(w.y)}; r1 = (f32x4){bf_lo(w.z), bf_hi(w.z), bf_lo(w.w), bf_hi(w.w)}; }
                if (F32BASE) { r0 = r0 * xs; r1 = r1 * xs; }
                r0 = r0 + acc[ai][bj][m][0] * inv; r1 = r1 + acc[ai][bj][m][1] * inv;
                ss += (r0[0] * r0[0] + r0[1] * r0[1]) + (r0[2] * r0[2] + r0[3] * r0[3]) + (r1[0] * r1[0] + r1[1] * r1[1]) + (r1[2] * r1[2] + r1[3] * r1[3]);
                *(u32x4*)(XR + o + bj * HALF) = pack8(r0, r1);
                if constexpr (W8) { f32x4 q0, q1;
#pragma unroll
                    for (int e = 0; e < 4; ++e) { q0[e] = __builtin_amdgcn_fmed3f(r0[e] * 8.f, -440.f, 440.f); q1[e] = __builtin_amdgcn_fmed3f(r1[e] * 8.f, -440.f, 440.f); }
                    *(u32x2_*)(X8 + o + bj * HALF) = (u32x2_){pk4_fp8(q0[0], q0[1], q0[2], q0[3]), pk4_fp8(q1[0], q1[1], q1[2], q1[3])}; } }
            ss += __shfl_xor(ss, 16); ss += __shfl_xor(ss, 32);
            if (fq == 0) SS[(size_t)row * 16 + u.pn * 4 + wc] = ss; }
    }
};
template <bool FIRST  > struct EpiMoeDown {
    static constexpr bool PERM = true, AFTER_DRAIN = false;
    float* OUT; const int* rowtok; const float* rowgate; int pm0; bf16_t* XR; float sc;
    __device__ __forceinline__ void operator()(const f32x4 (&acc)[2][2][4][2], const Unit& u, int wr, int wc, int fr, int fq) const {
        const int row0 = (u.pm - pm0) * BM + wr * 64 + fr, col0 = (u.pn & 3) * BM + wc * 32 + 8 * fq;
#pragma unroll
        EPI_LOOP_ROWS { const int r = row0 + ai * HALF + m * 16; const int t = rowtok[r]; const float gt = rowgate[r] * sc;
            if (t >= 0) { float* o = OUT + (size_t)t * 1024 + col0;
#pragma unroll
                for (int bj = 0; bj < 2; ++bj) { bf16_t* xp = XR + (size_t)t * 1024 + col0 + bj * HALF;
                    const u32x4 w = *(const u32x4*)xp; f32x4 r0 = (f32x4){bf_lo(w.x), bf_hi(w.x), bf_lo(w.y), bf_hi(w.y)}, r1 = (f32x4){bf_lo(w.z), bf_hi(w.z), bf_lo(w.w), bf_hi(w.w)};
                    r0 = r0 + acc[ai][bj][m][0] * gt; r1 = r1 + acc[ai][bj][m][1] * gt;
                    if (FIRST) *(u32x4*)xp = pack8(r0, r1);
                    else { __builtin_nontemporal_store(r0, (f32x4*)(o + bj * HALF)); __builtin_nontemporal_store(r1, (f32x4*)(o + bj * HALF + 4)); } } } }
    }
};

__device__ __forceinline__ void sk_store_partial(const f32x4 (&acc)[2][2][4][2], unsigned long long* slot, int tid) {
#pragma unroll
    for (int ai = 0; ai < 2; ++ai)
#pragma unroll
        for (int bj = 0; bj < 2; ++bj)
#pragma unroll
            for (int m = 0; m < 4; ++m)
#pragma unroll
                for (int n = 0; n < 2; ++n) { const f32x4 v = acc[ai][bj][m][n]; const unsigned long long w = (unsigned long long)cvt_pk_bf16(v[0], v[1]) | ((unsigned long long)cvt_pk_bf16(v[2], v[3]) << 32);
                    __hip_atomic_store(slot + (((ai * 2 + bj) * 4 + m) * 2 + n) * 512 + tid, w, __ATOMIC_RELAXED, __HIP_MEMORY_SCOPE_AGENT); }
}
__device__ __forceinline__ void sk_add_partial(f32x4 (&acc)[2][2][4][2], unsigned long long* slot, int tid) {
#pragma unroll
    for (int ai = 0; ai < 2; ++ai)
#pragma unroll
        for (int bj = 0; bj < 2; ++bj)
#pragma unroll
            for (int m = 0; m < 4; ++m)
#pragma unroll
                for (int n = 0; n < 2; ++n) { const unsigned long long w = __hip_atomic_load(slot + (((ai * 2 + bj) * 4 + m) * 2 + n) * 512 + tid, __ATOMIC_RELAXED, __HIP_MEMORY_SCOPE_AGENT);
                    const unsigned lo = (unsigned)w, hi = (unsigned)(w >> 32); acc[ai][bj][m][n] = acc[ai][bj][m][n] + (f32x4){bf_lo(lo), bf_hi(lo), bf_lo(hi), bf_hi(hi)};
                    if (n == 1 && (m & 1)) asm volatile("" ::: "memory"); }
}
typedef int i32x4_ __attribute__((ext_vector_type(4)));
typedef int i32x8_ __attribute__((ext_vector_type(8)));
template <class Epi, class Sched, bool ALIGN_EPI = false, bool SP2 = false, bool FP8 = false>
__device__ __forceinline__ void gemm_phase(PG8_LAS unsigned char* lds, const Gemm g, const Sched& S, const Epi& E) {
    const int tid = threadIdx.x, wid = __builtin_amdgcn_readfirstlane(tid >> 6), lane = tid & 63, wr = wid >> 2, wc = wid & 3, fr = lane & 15, fq = lane >> 4;
    const int K = g.K; int nt = K / BK;
    unsigned voffA[2], voffB[2];
#pragma unroll
    for (int i = 0; i < 2; ++i) { int R, C; stage_rc(tid * 16 + i * 8192, R, C); const int Rb = Epi::PERM ? ((R & ~31) + perm32(R & 31)) : R;
        voffA[i] = g.amode ? (unsigned)(((C >> 4) * g.lda + R) * 16 + (C & 15)) * 2u : (unsigned)(R * g.lda + C) * 2u; voffB[i] = (unsigned)(Rb * g.ldb + C) * 2u; }
    const size_t kstep = (size_t)(BK * 2);
    const size_t hstepA = g.amode ? (size_t)HALF * 32 : (size_t)HALF * g.lda * 2, hstepB = (size_t)HALF * g.ldb * 2;
    const size_t kstepA = g.amode ? (size_t)4 * g.lda * 32 : kstep;
    const size_t tstepA = 2 * hstepA, tstepB = 2 * hstepB;
    const unsigned ldsw = (unsigned)wid * 1024u;
    const int aoff = lds_byte(wr * 64 + fr, fq * 8), boff = lds_byte(wc * 32 + fr, fq * 8);
#define PG8_SA(b, h) (((b) * 2 + (h)) * HTB)
#define PG8_SB(b, h) ((4 + (b) * 2 + (h)) * HTB)
#define PG8_STAGE(bufoff, gbase, voff) do { _Pragma("unroll") for (int _i = 0; _i < 2; ++_i) \
        __builtin_amdgcn_global_load_lds((const unsigned*)((const char*)(gbase) + (voff)[_i]), (PG8_LAS unsigned*)(lds + (bufoff) + ldsw + _i * 8192), 16, 0, 0); } while (0)
#define PG8_LDA(dst, b, h) do { if constexpr (FP8) { _Pragma("unroll") for (int m = 0; m < 4; ++m) { const i32x4_ l_ = *(const PG8_LAS i32x4_*)(lds + PG8_SA(b, h) + aoff + m * 2048), h_ = *(const PG8_LAS i32x4_*)(lds + PG8_SA(b, h) + aoff + m * 2048 + 1024); dst##8[m] = __builtin_shufflevector(l_, h_, 0, 1, 2, 3, 4, 5, 6, 7); } } \
        else { _Pragma("unroll") for (int m = 0; m < 4; ++m) _Pragma("unroll") for (int k = 0; k < 2; ++k) dst[m][k] = *(const PG8_LAS bf16x8*)(lds + PG8_SA(b, h) + aoff + m * 2048 + k * 1024); } } while (0)
#define PG8_LDB(dst, b, h) do { if constexpr (FP8) { _Pragma("unroll") for (int n = 0; n < 2; ++n) { const i32x4_ l_ = *(const PG8_LAS i32x4_*)(lds + PG8_SB(b, h) + boff + n * 2048), h_ = *(const PG8_LAS i32x4_*)(lds + PG8_SB(b, h) + boff + n * 2048 + 1024); dst##8[n] = __builtin_shufflevector(l_, h_, 0, 1, 2, 3, 4, 5, 6, 7); } } \
        else { _Pragma("unroll") for (int n = 0; n < 2; ++n) _Pragma("unroll") for (int k = 0; k < 2; ++k) dst[n][k] = *(const PG8_LAS bf16x8*)(lds + PG8_SB(b, h) + boff + n * 2048 + k * 1024); } } while (0)
#define PG8_MMA(ai, bj, At, Bt) do { __builtin_amdgcn_s_setprio(1); \
        if constexpr (FP8) { _Pragma("unroll") for (int m = 0; m < 4; ++m) _Pragma("unroll") for (int n = 0; n < 2; ++n) \
            acc[ai][bj][m][n] = __builtin_amdgcn_mfma_scale_f32_16x16x128_f8f6f4(Bt##8[n], At##8[m], acc[ai][bj][m][n], 0, 0, 0, 0x7f7f7f7f, 0, 0x7f7f7f7f); \
            _Pragma("unroll") for (int m = 0; m < 4; ++m) _Pragma("unroll") for (int n = 0; n < 2; ++n) asm volatile("" : "+v"(acc[ai][bj][m][n])); } \
        else { _Pragma("unroll") for (int m = 0; m < 4; ++m) _Pragma("unroll") for (int n = 0; n < 2; ++n) _Pragma("unroll") for (int k = 0; k < 2; ++k) \
            acc[ai][bj][m][n] = __builtin_amdgcn_mfma_f32_16x16x32_bf16(Bt[n][k], At[m][k], acc[ai][bj][m][n], 0, 0, 0); } \
        __builtin_amdgcn_s_setprio(0); } while (0)
#define PG8_WAIT_V(n) asm volatile("s_waitcnt vmcnt(" #n ")" ::: "memory")
#define PG8_WAIT_L(n) asm volatile("s_waitcnt lgkmcnt(" #n ")" ::: "memory")
#define PG8_BAR __builtin_amdgcn_s_barrier()
#define PG8_SCHED __builtin_amdgcn_sched_barrier(0)
    Unit cur, nxt; int ui = 0;
    if (!S.next(0, cur)) return;
    f32x4 acc[2][2][4][2];
#pragma unroll
    for (int a = 0; a < 2; ++a)
#pragma unroll
        for (int b = 0; b < 2; ++b)
#pragma unroll
            for (int m = 0; m < 4; ++m)
#pragma unroll
                for (int n = 0; n < 2; ++n) acc[a][b][m][n] = (f32x4){0.f, 0.f, 0.f, 0.f};
    bf16x8 At[4][2], B0[2][2], B1[2][2];
    i32x8_ At8[4], B08[2], B18[2];
    const char* cA = (const char*)g.A + (size_t)cur.pm * tstepA; const char* cB = (const char*)g.Bt + (size_t)cur.pn * tstepB;
    if constexpr (Sched::STREAMK) { nt = cur.nk; cA += (size_t)cur.k0 * kstep; cB += (size_t)cur.k0 * kstep; }

    if constexpr (SP2) {
        PG8_STAGE(PG8_SB(0, 0), cB, voffB); PG8_STAGE(PG8_SB(0, 1), cB + hstepB, voffB); PG8_STAGE(PG8_SA(0, 0), cA, voffA); PG8_STAGE(PG8_SA(0, 1), cA + hstepA, voffA);
        if (wr == 1) PG8_BAR;
        PG8_WAIT_V(2); PG8_BAR;
        PG8_STAGE(PG8_SB(1, 0), cB + kstep, voffB); PG8_STAGE(PG8_SA(1, 0), cA + kstepA, voffA); PG8_STAGE(PG8_SB(1, 1), cB + hstepB + kstep, voffB);
        PG8_WAIT_V(6); PG8_BAR;
    } else {
        PG8_STAGE(PG8_SB(0, 0), cB, voffB); PG8_STAGE(PG8_SA(0, 0), cA, voffA); PG8_STAGE(PG8_SB(0, 1), cB + hstepB, voffB); PG8_STAGE(PG8_SA(0, 1), cA + hstepA, voffA);
        if (wr == 1) PG8_BAR;
        PG8_WAIT_V(4); PG8_BAR;
        PG8_STAGE(PG8_SB(1, 0), cB + kstep, voffB); PG8_STAGE(PG8_SA(1, 0), cA + kstepA, voffA); PG8_STAGE(PG8_SB(1, 1), cB + hstepB + kstep, voffB);
        PG8_WAIT_V(6); PG8_BAR;
    }
    for (;;) {
        const bool has_next = S.next(ui + 1, nxt);
        const char* nA = has_next ? (const char*)g.A + (size_t)nxt.pm * tstepA : cA; const char* nB = has_next ? (const char*)g.Bt + (size_t)nxt.pn * tstepB : cB;
        if constexpr (Sched::STREAMK) { if (has_next) { nA += (size_t)nxt.k0 * kstep; nB += (size_t)nxt.k0 * kstep; } }
        for (int t = 0; t < nt; t += 2) {
            const bool last = (t == nt - 2);
            const char* a1 = cA + (size_t)(t + 1) * kstepA;
            const char* a2 = last ? nA : cA + (size_t)(t + 2) * kstepA; const char* b2 = last ? nB : cB + (size_t)(t + 2) * kstep;
            const char* a3 = a2 + kstepA; const char* b3 = b2 + kstep;

            if constexpr (SP2) {
            PG8_LDB(B0, 0, 0); PG8_LDB(B1, 0, 1); PG8_SCHED; PG8_LDA(At, 0, 0); PG8_STAGE(PG8_SA(1, 1), a1 + hstepA, voffA);
            PG8_WAIT_V(8); PG8_WAIT_L(0); PG8_BAR; PG8_MMA(0, 0, At, B0); PG8_MMA(0, 1, At, B1); PG8_BAR; PG8_SCHED;
            PG8_LDA(At, 0, 1); PG8_STAGE(PG8_SB(0, 0), b2, voffB); PG8_STAGE(PG8_SB(0, 1), b2 + hstepB, voffB); PG8_STAGE(PG8_SA(0, 0), a2, voffA);
            PG8_WAIT_V(8); PG8_WAIT_L(0); PG8_BAR; PG8_MMA(1, 0, At, B0); PG8_MMA(1, 1, At, B1); PG8_BAR; PG8_SCHED;
            PG8_LDB(B0, 1, 0); PG8_LDB(B1, 1, 1); PG8_SCHED; PG8_LDA(At, 1, 0); PG8_STAGE(PG8_SA(0, 1), a2 + hstepA, voffA);
            PG8_WAIT_V(8); PG8_WAIT_L(0); PG8_BAR; PG8_MMA(0, 0, At, B0); PG8_MMA(0, 1, At, B1); PG8_BAR; PG8_SCHED;
            PG8_LDA(At, 1, 1); PG8_STAGE(PG8_SB(1, 0), b3, voffB); PG8_STAGE(PG8_SB(1, 1), b3 + hstepB, voffB); PG8_STAGE(PG8_SA(1, 0), a3, voffA);
            PG8_WAIT_V(8); PG8_WAIT_L(0); PG8_BAR; PG8_MMA(1, 0, At, B0); PG8_MMA(1, 1, At, B1); PG8_BAR; PG8_SCHED;
            } else {
            PG8_LDB(B0, 0, 0); PG8_SCHED; PG8_LDA(At, 0, 0); PG8_STAGE(PG8_SA(1, 1), a1 + hstepA, voffA);
            PG8_WAIT_L(8); PG8_BAR; PG8_WAIT_L(0); PG8_MMA(0, 0, At, B0); PG8_BAR; PG8_SCHED;
            PG8_LDB(B1, 0, 1); PG8_STAGE(PG8_SB(0, 0), b2, voffB);
            PG8_BAR; PG8_WAIT_L(0); PG8_MMA(0, 1, At, B1); PG8_BAR;
            PG8_LDA(At, 0, 1); PG8_STAGE(PG8_SA(0, 0), a2, voffA);
            PG8_BAR; PG8_WAIT_L(0); PG8_MMA(1, 0, At, B0); PG8_BAR; PG8_SCHED;
            PG8_STAGE(PG8_SB(0, 1), b2 + hstepB, voffB);
            PG8_WAIT_V(6); PG8_BAR; PG8_MMA(1, 1, At, B1); PG8_BAR;
            PG8_LDB(B0, 1, 0); PG8_SCHED; PG8_LDA(At, 1, 0); PG8_STAGE(PG8_SA(0, 1), a2 + hstepA, voffA);
            PG8_WAIT_L(8); PG8_BAR; PG8_WAIT_L(0); PG8_MMA(0, 0, At, B0); PG8_BAR; PG8_SCHED;
            PG8_LDB(B1, 1, 1); PG8_STAGE(PG8_SB(1, 0), b3, voffB);
            PG8_BAR; PG8_WAIT_L(0); PG8_MMA(0, 1, At, B1); PG8_BAR;
            PG8_LDA(At, 1, 1); PG8_STAGE(PG8_SA(1, 0), a3, voffA);
            PG8_BAR; PG8_WAIT_L(0); PG8_MMA(1, 0, At, B0); PG8_BAR; PG8_SCHED;
            PG8_STAGE(PG8_SB(1, 1), b3 + hstepB, voffB);
            PG8_WAIT_V(6); PG8_BAR; PG8_MMA(1, 1, At, B1); PG8_BAR;
            }
        }
        if constexpr (ALIGN_EPI) { if (wr == 0) PG8_BAR; }
        if constexpr (Sched::STREAMK) {
            if (cur.part == 2) { sk_store_partial(acc, S.slots() + (size_t)S.c() * SK_SLOT_WORDS, tid); PG8_WAIT_V(0);
                if (lane == 0) __hip_atomic_fetch_add(S.flags() + S.c() * 64, 1u, __ATOMIC_RELAXED, __HIP_MEMORY_SCOPE_AGENT); }
            else if (cur.part == 0) E(acc, cur, wr, wc, fr, fq);
        } else
        if constexpr (!Epi::AFTER_DRAIN) { E(acc, cur, wr, wc, fr, fq); }
        if (!has_next) break;
#pragma unroll
        for (int a = 0; a < 2; ++a)
#pragma unroll
            for (int b = 0; b < 2; ++b)
#pragma unroll
                for (int m = 0; m < 4; ++m)
#pragma unroll
                    for (int n = 0; n < 2; ++n) acc[a][b][m][n] = (f32x4){0.f, 0.f, 0.f, 0.f};
        cur = nxt; cA = nA; cB = nB; ++ui;
        if constexpr (Sched::STREAMK) nt = cur.nk;
        if constexpr (ALIGN_EPI) { if (wr == 1) PG8_BAR; }
    }
    PG8_WAIT_V(0);
    if constexpr (!ALIGN_EPI) { if (wr == 0) PG8_BAR; }
    PG8_BAR;
    if constexpr (Epi::AFTER_DRAIN) { E.fused(acc, cur, wr, wc, fr, fq, lds, wid, lane); }
    if constexpr (Sched::STREAMK) { if (cur.part == 1) {
        const int np = S.split();
        if (tid == 0) { for (int q = 1; q < np; ++q) { unsigned sp = 0; while (__hip_atomic_load(S.flags() + (S.c() + q) * 64, __ATOMIC_RELAXED, __HIP_MEMORY_SCOPE_AGENT) < S.target()) { __builtin_amdgcn_s_sleep(2); if (++sp > (1u << 22)) break; } } }
        __syncthreads();
        for (int q = 1; q < np; ++q) sk_add_partial(acc, S.slots() + (size_t)(S.c() + q) * SK_SLOT_WORDS, tid);
        E(acc, cur, wr, wc, fr, fq); } }
#undef PG8_SA
#undef PG8_SB
#undef PG8_STAGE
#undef PG8_LDA
#undef PG8_LDB
#undef PG8_MMA
#undef PG8_WAIT_V
#undef PG8_WAIT_L
#undef PG8_BAR
#undef PG8_SCHED
}
}


constexpr int NWAVES = 8, NTHREADS = 512;
constexpr int T = 16384, D = 1024, SEQ = 2048, NB = 8;
constexpr int DFF = 2816, DFE = 3584, NEXP = 8;
constexpr int RROWS = 18432;
constexpr float RMS_EPS = 1e-6f;
constexpr float MOE_WSCALE = 64.f, MOE_ASCALE = 8.f;

constexpr size_t MiB = 1u << 20;
constexpr size_t WS_CTL = 0, CTL_ZERO_BYTES = 256 * 1024;
constexpr size_t WS_SMALL = 1 * MiB;
constexpr size_t SM_KMEANS = WS_SMALL, SM_LAM32 = WS_SMALL + 64 * 1024, SM_WGCNT = WS_SMALL + 128 * 1024, SM_PANEND = WS_SMALL + 160 * 1024,
                 SM_TOKE = WS_SMALL + 192 * 1024, SM_TOKLP = WS_SMALL + 320 * 1024, SM_TOKG = WS_SMALL + 448 * 1024, SM_ROWTOK = WS_SMALL + 576 * 1024, SM_ROWGATE = WS_SMALL + 720 * 1024;
static_assert(SM_ROWGATE + 2 * RROWS * 4 <= 2 * MiB, "small tables");
constexpr size_t WS_WMEMK = 2 * MiB, WS_WMEMV = 3 * MiB, WS_WKQ = 4 * MiB, WS_WV = WS_WKQ + 2560 * 1024, WS_WOUT1 = 7 * MiB, WS_WMGU = 9 * MiB, WS_WMD = 121 * MiB;
constexpr size_t WS_XB = 177 * MiB, WS_CAT = 209 * MiB, WS_MEMN = 241 * MiB, WS_MEMK = 245 * MiB, WS_MEMVT = 247 * MiB;
constexpr size_t WS_ARENA = 249 * MiB, WS_END = 447 * MiB;
constexpr size_t AR_XS = WS_ARENA, AR_ACTM = WS_ARENA + 72 * MiB;
constexpr size_t AR_WIN0 = WS_ARENA, AR_WGLU = WS_ARENA + 2 * MiB, AR_WOUT0 = WS_ARENA + 4 * MiB, AR_WFGU = WS_ARENA + 6 * MiB, AR_WFD = WS_ARENA + 17 * MiB;
constexpr size_t AR_TZ = WS_ARENA + 23 * MiB, AR_W1T = WS_ARENA + 53 * MiB, AR_UG = WS_ARENA + 65 * MiB, AR_QM0 = WS_ARENA + 95 * MiB, AR_XC = WS_ARENA + 103 * MiB, AR_GACT = WS_ARENA + 115 * MiB;
constexpr size_t AR_X8 = WS_ARENA + 140 * MiB;
constexpr size_t AR_S5SM = WS_ARENA + 156 * MiB;
constexpr size_t AR_ACT0 = WS_ARENA + 23 * MiB;
constexpr size_t AR_KQ = WS_ARENA, AR_VT = WS_ARENA + 40 * MiB;
static_assert(AR_ACTM + (size_t)RROWS * DFE * 2 <= WS_END && AR_ACT0 + (size_t)T * DFF * 2 <= AR_GACT, "arena");
constexpr int CW_BAR = 4096, CW_QUEUE = 8192, CW_SKFLAG = 16384;
static_assert((CW_SKFLAG + 2 * 256 * 64 + 64) * 4 <= (int)CTL_ZERO_BYTES, "control words inside the per-call memset");

constexpr int RING_BYTES = 131072, MISC_OFF = RING_BYTES + 320, LDS_BYTES = 147456;

#define GAS __attribute__((address_space(1)))
#define LAS __attribute__((address_space(3)))
typedef unsigned short bf16;
typedef unsigned v4u __attribute__((ext_vector_type(4)));
typedef unsigned v2u __attribute__((ext_vector_type(2)));
typedef float f32x4 __attribute__((ext_vector_type(4)));
typedef float f32x16 __attribute__((ext_vector_type(16)));
typedef short bf16x8 __attribute__((ext_vector_type(8)));
typedef short s16x4 __attribute__((ext_vector_type(4)));
typedef float v2f_ __attribute__((ext_vector_type(2)));
typedef GAS unsigned gu32;
#define LDS_WAIT() asm volatile("s_waitcnt lgkmcnt(0)" ::: "memory")
using pg8::cvt_pk_bf16; using pg8::bf_lo; using pg8::bf_hi;
__device__ __forceinline__ unsigned f2bf(float f) { unsigned u = __builtin_bit_cast(unsigned, f); return (u + 0x7fffu + ((u >> 16) & 1u)) >> 16; }
__device__ __forceinline__ unsigned pk2(float lo, float hi) { return f2bf(lo) | (f2bf(hi) << 16); }
__device__ __forceinline__ float wave_sum(float v) {
#pragma unroll
    for (int o = 1; o < 64; o <<= 1) v += __shfl_xor(v, o);
    return v;
}

#define XB_TMO      128
#define XB_XCNT(j)  (256  + 64 * (j))
#define XB_XSUB(j)  (1280 + 64 * (j))
#define XB_XGEN(j)  (2304 + 64 * (j))
#define XB_TOP      3328
#define XB_TOPGEN   3392
#define XCD_BAR_WORDS 3456
#define XB_SPIN_CAP (1u << 18)

__device__ __forceinline__ unsigned xb_ld(unsigned* p)              { return __hip_atomic_load(p, __ATOMIC_RELAXED, __HIP_MEMORY_SCOPE_AGENT); }
__device__ __forceinline__ unsigned xb_add(unsigned* p, unsigned v) { return __hip_atomic_fetch_add(p, v, __ATOMIC_RELAXED, __HIP_MEMORY_SCOPE_AGENT); }
__device__ __forceinline__ unsigned xb_xcc_id() { return (unsigned)__builtin_amdgcn_s_getreg((3 << 11) | 20) & 0xFu; }
#define XB_SPIN(cond, bar) do { unsigned _sp = 0; while (cond) { __builtin_amdgcn_s_sleep(1); \
    if ((++_sp & 255u) == 0u) { if (xb_ld(&(bar)[XB_TMO])) break; if (_sp > XB_SPIN_CAP) { atomicAdd(&(bar)[XB_TMO], 1u); break; } } } } while (0)

struct XcdBarrier {
    unsigned* bar; unsigned x;
    volatile LAS unsigned* st;
};

__device__ __forceinline__ XcdBarrier xcd_barrier_post(unsigned* bar, volatile LAS unsigned* st) {
    XcdBarrier b; b.bar = bar; b.x = xb_xcc_id(); b.st = st;
    if (threadIdx.x == 0) (void)xb_add(&bar[XB_XCNT(b.x)], 1u);
    return b;
}
__device__ __forceinline__ void xcd_barrier_complete(unsigned* bar, unsigned x, unsigned& nloc, unsigned& nx) {
    const unsigned G = gridDim.x * gridDim.y * gridDim.z;
    unsigned sum, cnt, mine, sp = 0u;
    for (;;) {
        sum = 0u; cnt = 0u; mine = 0u;
#pragma unroll
        for (unsigned j = 0; j < 16; ++j) { const unsigned c = xb_ld(&bar[XB_XCNT(j)]); sum += c; cnt += (c > 0u) ? 1u : 0u; mine = (j == x) ? c : mine; }
        if (sum == G) break;
        __builtin_amdgcn_s_sleep(1);
        if ((++sp & 255u) == 0u) { if (xb_ld(&bar[XB_TMO])) break; if (sp > XB_SPIN_CAP) { atomicAdd(&bar[XB_TMO], 1u); break; } }
    }
    nloc = mine > 0u ? mine : 1u; nx = cnt > 0u ? cnt : 1u;
}

__device__ __forceinline__ void xcd_barrier(const XcdBarrier& b) {
    asm volatile("s_waitcnt vmcnt(0)" ::: "memory");
    __syncthreads();
    if (threadIdx.x == 0) {
        unsigned* bar = b.bar;
        __builtin_amdgcn_s_waitcnt(0);
        unsigned nloc = b.st[0], nx = b.st[1];
        if (nloc == 0u) { xcd_barrier_complete(bar, b.x, nloc, nx); b.st[0] = nloc; b.st[1] = nx; }
        const unsigned old = xb_add(&bar[XB_XSUB(b.x)], 1u);
        const unsigned gen = old / nloc;
        if (old + 1u == (gen + 1u) * nloc) {
            __builtin_amdgcn_fence(__ATOMIC_RELEASE, "agent");
            asm volatile("s_waitcnt vmcnt(0)" ::: "memory");
            const unsigned og = xb_add(&bar[XB_TOP], 1u);
            const unsigned tg = og / nx;
            if (og + 1u == (tg + 1u) * nx) xb_add(&bar[XB_TOPGEN], 1u);
            else XB_SPIN(xb_ld(&bar[XB_TOPGEN]) == tg, bar);
            __builtin_amdgcn_fence(__ATOMIC_ACQUIRE, "agent");
            xb_add(&bar[XB_XGEN(b.x)], 1u);
            asm volatile("s_waitcnt vmcnt(0)" ::: "memory");
        } else {
            XB_SPIN(xb_ld(&bar[XB_XGEN(b.x)]) == gen, bar);
            __builtin_amdgcn_fence(__ATOMIC_ACQUIRE, "agent");
            asm volatile("s_waitcnt vmcnt(0)" ::: "memory");
        }
    }
    __syncthreads();
}


__device__ __forceinline__ void cvt_item(const float* W, int ldw, int k0, int n0, const float* gain, bf16* WT, int ldo, int orow0, LAS unsigned* scr, int lane) {
    const int nq = lane & 15, kr = lane >> 4;
    f32x4 a[8], b[8];
    const float* src = W + (size_t)(k0 + 2 * kr) * ldw + n0 + 4 * nq;
#pragma unroll
    for (int i = 0; i < 8; ++i) { a[i] = *(const GAS f32x4*)(src + (size_t)(8 * i) * ldw); b[i] = *(const GAS f32x4*)(src + (size_t)(8 * i + 1) * ldw); }
    if (gain) {
#pragma unroll
        for (int i = 0; i < 8; ++i) { const float ga = gain[k0 + 8 * i + 2 * kr], gb = gain[k0 + 8 * i + 2 * kr + 1]; a[i] = a[i] * ga; b[i] = b[i] * gb; } }
#pragma unroll
    for (int i = 0; i < 8; ++i) {
#pragma unroll
        for (int e = 0; e < 4; ++e) scr[(4 * nq + e) * 33 + 4 * i + kr] = cvt_pk_bf16(a[i][e], b[i][e]); }
    LDS_WAIT(); asm volatile("" ::: "memory");
#pragma unroll
    for (int j = 0; j < 8; ++j) { const int q = lane + 64 * j, n = q >> 3, c = q & 7; const LAS unsigned* sp = scr + n * 33 + 4 * c;
        v4u o; o.x = sp[0]; o.y = sp[1]; o.z = sp[2]; o.w = sp[3];
        *(GAS v4u*)(WT + (size_t)(orow0 + n) * ldo + k0 + 8 * c) = o; }
    LDS_WAIT(); asm volatile("" ::: "memory");
}
struct CvtDesc { const float* src; const float* gain; bf16* dst; int ldw, ldo, k0; };
__device__ __forceinline__ void cvt_load(const CvtDesc& d, f32x4 (&a)[8], f32x4 (&b)[8], float (&ga)[8], float (&gb)[8], int lane) {
    const int nq = lane & 15, kr = lane >> 4; const float* src = d.src + (size_t)(2 * kr) * d.ldw + 4 * nq;
    if (d.gain) {
#pragma unroll
        for (int i = 0; i < 8; ++i) { ga[i] = d.gain[d.k0 + 8 * i + 2 * kr]; gb[i] = d.gain[d.k0 + 8 * i + 2 * kr + 1]; } }
    else {
#pragma unroll
        for (int i = 0; i < 8; ++i) { ga[i] = 1.f; gb[i] = 1.f; } }
#pragma unroll
    for (int i = 0; i < 8; ++i) { a[i] = *(const GAS f32x4*)(src + (size_t)(8 * i) * d.ldw); b[i] = *(const GAS f32x4*)(src + (size_t)(8 * i + 1) * d.ldw); }
}
__device__ __forceinline__ void cvt_emit(const CvtDesc& d, f32x4 (&a)[8], f32x4 (&b)[8], const float (&ga)[8], const float (&gb)[8], LAS unsigned* scr, int lane) {
    const int nq = lane & 15, kr = lane >> 4;
#pragma unroll
    for (int i = 0; i < 8; ++i) {
#pragma unroll
        for (int e = 0; e < 4; ++e) scr[(4 * nq + e) * 33 + 4 * i + kr] = cvt_pk_bf16(a[i][e] * ga[i], b[i][e] * gb[i]); }
    LDS_WAIT(); asm volatile("" ::: "memory");
#pragma unroll
    for (int j = 0; j < 8; ++j) { const int q = lane + 64 * j, n = q >> 3, c = q & 7; const LAS unsigned* sp = scr + n * 33 + 4 * c;
        v4u o; o.x = sp[0]; o.y = sp[1]; o.z = sp[2]; o.w = sp[3];
        *(GAS v4u*)(d.dst + (size_t)n * d.ldo + 8 * c) = o; }
    LDS_WAIT(); asm volatile("" ::: "memory");
}
struct CvtDesc8 { const float* src; const float* gain; unsigned char* dst; int ldw, ldo, k0; };
__device__ __forceinline__ void cvt_load8(const CvtDesc8& d, f32x4 (&a)[4][4], float (&g)[4][4], float scale, int lane) {
    const int nq = lane & 15, kr = lane >> 4; const float* src = d.src + (size_t)(4 * kr) * d.ldw + 4 * nq;
#pragma unroll
    for (int i = 0; i < 4; ++i)
#pragma unroll
        for (int r = 0; r < 4; ++r) g[i][r] = d.gain ? d.gain[d.k0 + 16 * i + 4 * kr + r] * scale : scale;
#pragma unroll
    for (int i = 0; i < 4; ++i)
#pragma unroll
        for (int r = 0; r < 4; ++r) a[i][r] = __builtin_nontemporal_load((const GAS f32x4*)(src + (size_t)(16 * i + r) * d.ldw));
}
__device__ __forceinline__ void cvt_load8_dma(const CvtDesc8& d, f32x4 (&a)[4][4], float (&g)[4][4], float scale, LAS unsigned char* buf, int lane) {
    const int nq = lane & 15, kr = lane >> 4;
#pragma unroll
    for (int i = 0; i < 4; ++i)
#pragma unroll
        for (int r = 0; r < 4; ++r) g[i][r] = d.gain ? d.gain[d.k0 + 16 * i + 4 * kr + r] * scale : scale;
    const float* src = d.src + (size_t)kr * d.ldw + 4 * nq;
#pragma unroll
    for (int j = 0; j < 16; ++j) __builtin_amdgcn_global_load_lds((const unsigned*)(src + (size_t)(4 * j) * d.ldw), (LAS unsigned*)(buf + j * 1024), 16, 0, 2);
    asm volatile("s_waitcnt vmcnt(0)" ::: "memory");
#pragma unroll
    for (int i = 0; i < 4; ++i)
#pragma unroll
        for (int r = 0; r < 4; ++r) a[i][r] = *(const LAS f32x4*)(buf + (16 * i + 4 * kr + r) * 256 + nq * 16);
    LDS_WAIT(); asm volatile("" ::: "memory");
}
__device__ __forceinline__ void cvt_emit8(const CvtDesc8& d, f32x4 (&a)[4][4], const float (&g)[4][4], LAS unsigned* scr, int lane) {
    const int nq = lane & 15, kr = lane >> 4;
#pragma unroll
    for (int i = 0; i < 4; ++i)
#pragma unroll
        for (int e = 0; e < 4; ++e) scr[(4 * nq + e) * 17 + 4 * i + kr] = pg8::pk4_fp8(a[i][0][e] * g[i][0], a[i][1][e] * g[i][1], a[i][2][e] * g[i][2], a[i][3][e] * g[i][3]);
    LDS_WAIT(); asm volatile("" ::: "memory");
#pragma unroll
    for (int j = 0; j < 4; ++j) { const int q = lane + 64 * j, n = q >> 2, c = q & 3; const LAS unsigned* sp = scr + n * 17 + 4 * c;
        v4u o; o.x = sp[0]; o.y = sp[1]; o.z = sp[2]; o.w = sp[3];
        __builtin_nontemporal_store(o, (GAS v4u*)(d.dst + (size_t)n * d.ldo + 16 * c)); }
    LDS_WAIT(); asm volatile("" ::: "memory");
}
__device__ __forceinline__ void rms_row_to_bf16(const float* xrow, bf16* orow, int lane, float* rms_out = nullptr) {
    const GAS f32x4* xr = (const GAS f32x4*)xrow + lane;
    f32x4 v[4]; float s = 0.f;
#pragma unroll
    for (int j = 0; j < 4; ++j) { v[j] = xr[64 * j]; s += (v[j].x * v[j].x + v[j].y * v[j].y) + (v[j].z * v[j].z + v[j].w * v[j].w); }
    const float rms = sqrtf(wave_sum(s) * (1.f / 1024.f) + RMS_EPS), r = 1.f / rms;
    if (rms_out != nullptr && lane == 0) *rms_out = rms;
    GAS unsigned long long* o8 = (GAS unsigned long long*)orow + lane;
#pragma unroll
    for (int j = 0; j < 4; ++j) o8[64 * j] = (unsigned long long)pk2(v[j].x * r, v[j].y * r) | ((unsigned long long)pk2(v[j].z * r, v[j].w * r) << 32);
}
__device__ __forceinline__ void dsincos(double a, double& s, double& c) {
    const double k = rint(a * 0.63661977236758134308);
    double r = fma(-k, 1.57079632679489655800e+00, a); r = fma(-k, 6.12323399573676603587e-17, r);
    const double z = r * r;
    double ps = 1.0 / 355687428096000.0;
    ps = fma(ps, z, -1.0 / 1307674368000.0); ps = fma(ps, z, 1.0 / 6227020800.0); ps = fma(ps, z, -1.0 / 39916800.0); ps = fma(ps, z, 1.0 / 362880.0);
    ps = fma(ps, z, -1.0 / 5040.0); ps = fma(ps, z, 1.0 / 120.0); ps = fma(ps, z, -1.0 / 6.0); ps = fma(ps * z, r, r);
    double pc = -1.0 / 6402373705728000.0;
    pc = fma(pc, z, 1.0 / 20922789888000.0); pc = fma(pc, z, -1.0 / 87178291200.0); pc = fma(pc, z, 1.0 / 479001600.0); pc = fma(pc, z, -1.0 / 3628800.0);
    pc = fma(pc, z, 1.0 / 40320.0); pc = fma(pc, z, -1.0 / 720.0); pc = fma(pc, z, 1.0 / 24.0); pc = fma(pc, z, -0.5); pc = fma(pc, z, 1.0);
    const long q = (long)k & 3;
    s = (q == 0) ? ps : (q == 1) ? pc : (q == 2) ? -ps : -pc;
    c = (q == 0) ? pc : (q == 1) ? -ps : (q == 2) ? -pc : ps;
}
__device__ __forceinline__ double dexp(double x) {
    const double k = rint(x * 1.44269504088896338700);
    double r = fma(-k, 6.93147180369123816490e-01, x); r = fma(-k, 1.90821492927058770002e-10, r);
    double p = 1.0 / 6227020800.0;
    p = fma(p, r, 1.0 / 479001600.0); p = fma(p, r, 1.0 / 39916800.0); p = fma(p, r, 1.0 / 3628800.0); p = fma(p, r, 1.0 / 362880.0); p = fma(p, r, 1.0 / 40320.0);
    p = fma(p, r, 1.0 / 5040.0); p = fma(p, r, 1.0 / 720.0); p = fma(p, r, 1.0 / 120.0); p = fma(p, r, 1.0 / 24.0); p = fma(p, r, 1.0 / 6.0); p = fma(p, r, 0.5); p = fma(p, r, 1.0); p = fma(p, r, 1.0);
    const long ki = (long)k;
    return p * __builtin_bit_cast(double, (unsigned long long)(1023 + ki) << 52);
}
constexpr int S5SM_PW = 64 * 33, S5SM_HEAD = 2 * S5SM_PW + 2048, S5SM_FLOATS = S5SM_HEAD + 8192;
struct S5Lds { LAS float* pwr; LAS float* pwi; LAS float* bbr; LAS float* bbi; LAS float* ccr; LAS float* cci; LAS float* km; };
__device__ __forceinline__ S5Lds s5_lds(LAS unsigned char* lds) { S5Lds L; L.pwr = (LAS float*)lds; L.pwi = L.pwr + S5SM_PW; L.bbr = L.pwi + S5SM_PW; L.bbi = L.bbr + 1024; L.ccr = L.bbi + 1024; L.cci = L.ccr + 1024; L.km = L.cci + 1024; return L; }
__device__ __forceinline__ void s5_tables_small(int g, LAS unsigned char* lds, const float* lam_re, const float* lam_im, const float* log_dt, const float* b_re, const float* b_im,
                                                const float* c_re, const float* c_im, float* S5SM, float* LAM32, int tid) {
    const S5Lds L = s5_lds(lds); LAS float* pwr = L.pwr; LAS float* pwi = L.pwi; LAS float* bbr = L.bbr; LAS float* bbi = L.bbi; LAS float* ccr = L.ccr; LAS float* cci = L.cci; LAS float* km = L.km;
    const double dt = dexp((double)log_dt[g]);
    for (int idx = tid; idx < 64 * 33; idx += NTHREADS) { const int p = idx / 33, tau = idx % 33;
        const double lr = lam_re[g * 64 + p], li = lam_im[g * 64 + p]; const double mag = dexp(lr * dt * tau); double s, c; dsincos(li * dt * tau, s, c);
        pwr[idx] = (float)(mag * c); pwi[idx] = (float)(mag * s); }
    for (int idx = tid; idx < 1024; idx += NTHREADS) { const int p = idx >> 4, m = idx & 15;
        const double lr = lam_re[g * 64 + p], li = lam_im[g * 64 + p]; const double mag = dexp(lr * dt); double s, c; dsincos(li * dt, s, c);
        const double ar = mag * c - 1.0, ai = mag * s, den = lr * lr + li * li, fr_ = (ar * lr + ai * li) / den, fi_ = (ai * lr - ar * li) / den;
        const double br = b_re[(g * 64 + p) * 16 + m], bi = b_im[(g * 64 + p) * 16 + m];
        bbr[idx] = (float)(fr_ * br - fi_ * bi); bbi[idx] = (float)(fr_ * bi + fi_ * br);
        ccr[idx] = c_re[g * 1024 + idx]; cci[idx] = c_im[g * 1024 + idx]; }
    __syncthreads();
    { const int half = tid >> 8, n = (tid >> 4) & 15, m = tid & 15; float acc[16];
#pragma unroll
      for (int t = 0; t < 16; ++t) acc[t] = 0.f;
      for (int p = 0; p < 64; ++p) { const float cr = ccr[n * 64 + p], ci = cci[n * 64 + p], br = bbr[p * 16 + m], bi = bbi[p * 16 + m]; const float zr = cr * br - ci * bi, zi = cr * bi + ci * br;
#pragma unroll
          for (int t = 0; t < 16; ++t) acc[t] += zr * pwr[p * 33 + 16 * half + t] - zi * pwi[p * 33 + 16 * half + t]; }
#pragma unroll
      for (int t = 0; t < 16; ++t) km[((16 * half + t) * 16 + n) * 16 + m] = acc[t]; }
    __syncthreads();
    float* S = S5SM + (size_t)g * S5SM_FLOATS;
    for (int i = tid; i < S5SM_HEAD; i += NTHREADS) S[i] = pwr[i];
    for (int i = tid; i < 8192; i += NTHREADS) S[S5SM_HEAD + i] = km[i];
    if (tid < 64) { LAM32[(g * 64 + tid) * 2] = pwr[tid * 33 + 32]; LAM32[(g * 64 + tid) * 2 + 1] = pwi[tid * 33 + 32]; }
    __syncthreads();
}
__device__ __forceinline__ void s5_load(int g, LAS unsigned char* lds, const float* S5SM, const float* c_re, const float* c_im, bool with_km, int tid) {
    const S5Lds L = s5_lds(lds); const float* S = S5SM + (size_t)g * S5SM_FLOATS;
    for (int i = tid; i < S5SM_HEAD / 4; i += NTHREADS) *(LAS f32x4*)(L.pwr + 4 * i) = *(const GAS f32x4*)(S + 4 * i);
    for (int i = tid; i < 256; i += NTHREADS) { *(LAS f32x4*)(L.ccr + 4 * i) = *(const GAS f32x4*)(c_re + g * 1024 + 4 * i); *(LAS f32x4*)(L.cci + 4 * i) = *(const GAS f32x4*)(c_im + g * 1024 + 4 * i); }
    if (with_km) for (int i = tid; i < 2048; i += NTHREADS) *(LAS f32x4*)(L.km + 4 * i) = *(const GAS f32x4*)(S + S5SM_HEAD + 4 * i);
    __syncthreads();
}
__device__ __forceinline__ void s5_expand_tz(int g, LAS unsigned char* lds, bf16* TZ, int row_lo, int row_hi, int tid) {
    const S5Lds L = s5_lds(lds); LAS float* pwr = L.pwr; LAS float* pwi = L.pwi; LAS float* ccr = L.ccr; LAS float* cci = L.cci; LAS float* km = L.km;
    bf16* tz = TZ + (size_t)g * 512 * 640;
    for (int pc = row_lo * 80 + tid; pc < row_hi * 80; pc += NTHREADS) { const int row = pc / 80, c8 = pc % 80, j = row >> 4, n = row & 15; float v[8];
        if (c8 < 64) { const int i = c8 >> 1, m0 = (c8 & 1) * 8;
#pragma unroll
            for (int e = 0; e < 8; ++e) v[e] = (i <= j) ? km[((j - i) * 16 + n) * 16 + m0 + e] : 0.f; }
        else { const int p0 = (c8 - 64) * 4;
#pragma unroll
            for (int q = 0; q < 4; ++q) { const int p = p0 + q; const float cr = ccr[n * 64 + p], ci = cci[n * 64 + p], pr = pwr[p * 33 + j + 1], pi = pwi[p * 33 + j + 1];
                v[2 * q] = cr * pr - ci * pi; v[2 * q + 1] = -(cr * pi + ci * pr); } }
        v4u o; o.x = pk2(v[0], v[1]); o.y = pk2(v[2], v[3]); o.z = pk2(v[4], v[5]); o.w = pk2(v[6], v[7]);
        *(GAS v4u*)(tz + (size_t)row * 640 + c8 * 8) = o; }
}
__device__ __forceinline__ void s5_expand_w1t(int g, LAS unsigned char* lds, bf16* W1T, int row_lo, int row_hi, int tid) {
    const S5Lds L = s5_lds(lds); LAS float* pwr = L.pwr; LAS float* pwi = L.pwi; LAS float* bbr = L.bbr; LAS float* bbi = L.bbi;
    bf16* w1 = W1T + (size_t)g * 256 * 512;
    for (int pc = row_lo * 64 + tid; pc < row_hi * 64; pc += NTHREADS) { const int row = pc >> 6, c8 = pc & 63, p = row >> 1, ri = row & 1, i = c8 >> 1, m0 = (c8 & 1) * 8; float v[8];
        const float ar = pwr[p * 33 + 31 - i], ai = pwi[p * 33 + 31 - i];
#pragma unroll
        for (int e = 0; e < 8; ++e) { const float br = bbr[p * 16 + m0 + e], bi = bbi[p * 16 + m0 + e]; v[e] = ri ? (ar * bi + ai * br) : (ar * br - ai * bi); }
        v4u o; o.x = pk2(v[0], v[1]); o.y = pk2(v[2], v[3]); o.z = pk2(v[4], v[5]); o.w = pk2(v[6], v[7]);
        *(GAS v4u*)(w1 + (size_t)row * 512 + c8 * 8) = o; }
}

constexpr int KS_PITCH = 144, VS_PITCH = 520, ATT_KS = 0, ATT_VS = 256 * KS_PITCH;
static_assert(ATT_VS + 64 * VS_PITCH <= RING_BYTES, "attention LDS");
#define MFMA32(a, b, c) __builtin_amdgcn_mfma_f32_32x32x16_bf16(a, b, c, 0, 0, 0)
struct KVRegs { v4u k[4]; v4u v[4]; };
__device__ __forceinline__ void att_load(KVRegs& R, const bf16* Kg, int kpitch, const bf16* Vg, int vpitch, int tid) {
#pragma unroll
    for (int i = 0; i < 4; ++i) { const int p = tid + NTHREADS * i, row = p >> 3, c = p & 7; R.k[i] = *(const GAS v4u*)(Kg + (size_t)row * kpitch + c * 8); }
#pragma unroll
    for (int i = 0; i < 4; ++i) { const int p = tid + NTHREADS * i, row = p >> 5, c = p & 31; R.v[i] = *(const GAS v4u*)(Vg + (size_t)row * vpitch + c * 8); }
}
__device__ __forceinline__ void att_store(LAS unsigned char* lds, const KVRegs& R, int tid) {
#pragma unroll
    for (int i = 0; i < 4; ++i) { const int p = tid + NTHREADS * i, row = p >> 3, c = p & 7; *(LAS v4u*)(lds + ATT_KS + row * KS_PITCH + c * 16) = R.k[i]; }
#pragma unroll
    for (int i = 0; i < 4; ++i) { const int p = tid + NTHREADS * i, row = p >> 5, c = p & 31;
        LAS v2u* d = (LAS v2u*)(lds + ATT_VS + row * VS_PITCH + c * 16); d[0] = (v2u){R.v[i].x, R.v[i].y}; d[1] = (v2u){R.v[i].z, R.v[i].w}; }
}
__device__ __forceinline__ void att_stage(LAS unsigned char* lds, const bf16* Kg, int kpitch, const bf16* Vg, int vpitch, int tid) { KVRegs R; att_load(R, Kg, kpitch, Vg, vpitch, tid); att_store(lds, R, tid); }
__device__ __forceinline__ void att_qk(const LAS unsigned char* lds, const bf16x8 (&qf)[4], int kt, f32x16& p0, f32x16& p1, int lane) {
    const int r32 = lane & 31, hi = lane >> 5;
#pragma unroll
    for (int r = 0; r < 16; ++r) { p0[r] = 0.f; p1[r] = 0.f; }
    const LAS unsigned char* kb = lds + ATT_KS + (kt * 64 + r32) * KS_PITCH + hi * 16;
#pragma unroll
    for (int d0 = 0; d0 < 4; ++d0) { const bf16x8 k0 = *(const LAS bf16x8*)(kb + d0 * 32), k1 = *(const LAS bf16x8*)(kb + 32 * KS_PITCH + d0 * 32);
        p0 = MFMA32(k0, qf[d0], p0); p1 = MFMA32(k1, qf[d0], p1); }
}
template <int MODE> __device__ __forceinline__ void att_finish(const LAS unsigned char* lds, int kt, f32x16& p0, f32x16& p1, f32x16& o0, f32x16& o1, float& l, int qloc, bool rowoff, int lane) {
    const int r32 = lane & 31, hi = lane >> 5; const float NEG = -__builtin_inff();
    if (MODE == 1) { const int kv0 = kt * 64 + 4 * hi;
#pragma unroll
        for (int r = 0; r < 16; ++r) { const int kv = kv0 + (r & 3) + 8 * (r >> 2); if (kv > qloc) p0[r] = NEG; if (kv + 32 > qloc) p1[r] = NEG; } }
    float rs = 0.f;
#pragma unroll
    for (int r = 0; r < 16; ++r) { p0[r] = __builtin_amdgcn_exp2f(p0[r]); p1[r] = __builtin_amdgcn_exp2f(p1[r]); rs += p0[r] + p1[r]; }
    if (MODE == 2) rs = rowoff ? 0.f : rs;
    l += rs;
    bf16x8 pb[4];
#pragma unroll
    for (int s = 0; s < 2; ++s) { v4u w0, w1;
        w0.x = cvt_pk_bf16(p0[8 * s + 0], p0[8 * s + 1]); w0.y = cvt_pk_bf16(p0[8 * s + 2], p0[8 * s + 3]); w0.z = cvt_pk_bf16(p0[8 * s + 4], p0[8 * s + 5]); w0.w = cvt_pk_bf16(p0[8 * s + 6], p0[8 * s + 7]);
        w1.x = cvt_pk_bf16(p1[8 * s + 0], p1[8 * s + 1]); w1.y = cvt_pk_bf16(p1[8 * s + 2], p1[8 * s + 3]); w1.z = cvt_pk_bf16(p1[8 * s + 4], p1[8 * s + 5]); w1.w = cvt_pk_bf16(p1[8 * s + 6], p1[8 * s + 7]);
        if (MODE == 2) { if (rowoff) { w0 = (v4u){0u, 0u, 0u, 0u}; w1 = (v4u){0u, 0u, 0u, 0u}; } }
        pb[s] = __builtin_bit_cast(bf16x8, w0); pb[2 + s] = __builtin_bit_cast(bf16x8, w1); }
    const LAS unsigned char* vb = lds + ATT_VS + r32 * VS_PITCH + (kt * 64 + 4 * hi) * 2;
#pragma unroll
    for (int s = 0; s < 4; ++s) { const int ko = (32 * (s >> 1) + 16 * (s & 1)) * 2;
        const s16x4 a0 = *(const LAS s16x4*)(vb + ko), a1 = *(const LAS s16x4*)(vb + ko + 16);
        const s16x4 b0 = *(const LAS s16x4*)(vb + 32 * VS_PITCH + ko), b1 = *(const LAS s16x4*)(vb + 32 * VS_PITCH + ko + 16);
        const bf16x8 va = (bf16x8){a0[0], a0[1], a0[2], a0[3], a1[0], a1[1], a1[2], a1[3]}, vc = (bf16x8){b0[0], b0[1], b0[2], b0[3], b1[0], b1[1], b1[2], b1[3]};
        o0 = MFMA32(va, pb[s], o0); o1 = MFMA32(vc, pb[s], o1); }
}
template <int MODE> __device__ __forceinline__ void att_block(const LAS unsigned char* lds, const bf16x8 (&qf)[4], f32x16& o0, f32x16& o1, float& l, int nkt, int qloc, bool rowoff, int lane) {
    f32x16 pa0, pa1, pb0, pb1;
    att_qk(lds, qf, 0, pa0, pa1, lane);
    int kt = 0;
    for (; kt + 1 < nkt; kt += 2) {
        att_qk(lds, qf, kt + 1, pb0, pb1, lane);
        att_finish<MODE>(lds, kt, pa0, pa1, o0, o1, l, qloc, rowoff, lane);
        if (kt + 2 < nkt) att_qk(lds, qf, kt + 2, pa0, pa1, lane);
        att_finish<MODE>(lds, kt + 1, pb0, pb1, o0, o1, l, qloc, rowoff, lane);
    }
    if (kt < nkt) att_finish<MODE>(lds, kt, pa0, pa1, o0, o1, l, qloc, rowoff, lane);
}
__device__ __forceinline__ void att_load_q(const bf16* qrow  , float (&qv)[4][8], bf16x8 (&qf)[4]) {
    float ss = 0.f;
#pragma unroll
    for (int d0 = 0; d0 < 4; ++d0) { const v4u w = *(const GAS v4u*)(qrow + d0 * 16);
        qv[d0][0] = bf_lo(w.x); qv[d0][1] = bf_hi(w.x); qv[d0][2] = bf_lo(w.y); qv[d0][3] = bf_hi(w.y); qv[d0][4] = bf_lo(w.z); qv[d0][5] = bf_hi(w.z); qv[d0][6] = bf_lo(w.w); qv[d0][7] = bf_hi(w.w);
#pragma unroll
        for (int e = 0; e < 8; ++e) ss += qv[d0][e] * qv[d0][e]; }
    ss += __shfl_xor(ss, 32);
    const float sc = (1.f / sqrtf(ss * (1.f / 64.f) + RMS_EPS)) * (0.125f * 1.4426950408889634f);
#pragma unroll
    for (int d0 = 0; d0 < 4; ++d0) { v4u w; w.x = cvt_pk_bf16(qv[d0][0] * sc, qv[d0][1] * sc); w.y = cvt_pk_bf16(qv[d0][2] * sc, qv[d0][3] * sc); w.z = cvt_pk_bf16(qv[d0][4] * sc, qv[d0][5] * sc); w.w = cvt_pk_bf16(qv[d0][6] * sc, qv[d0][7] * sc);
        qf[d0] = __builtin_bit_cast(bf16x8, w); }
}
constexpr int ATT_OST = 73728, OST_PITCH = 144;
static_assert(ATT_OST >= ATT_VS + 64 * VS_PITCH && ATT_OST + 8 * 32 * OST_PITCH <= RING_BYTES, "attention output stage");
template <bool OUT8 = false  >
__device__ __forceinline__ void att_store_o(LAS unsigned char* lds, bf16* obase  , int opitch, const f32x16& o0, const f32x16& o1, float l, int lane, int wid) {
    const int r32 = lane & 31, hi = lane >> 5;
    l += __shfl_xor(l, 32); const float inv = 1.f / l;
    LAS unsigned char* st = lds + ATT_OST + wid * (32 * OST_PITCH);
    if constexpr (OUT8) {
        const float i8 = inv * 8.f;
#pragma unroll
        for (int a = 0; a < 4; ++a) {
            *(LAS unsigned*)(st + r32 * OST_PITCH + (8 * a + 4 * hi)) = pg8::pk4_fp8(__builtin_amdgcn_fmed3f(o0[4 * a] * i8, -440.f, 440.f), __builtin_amdgcn_fmed3f(o0[4 * a + 1] * i8, -440.f, 440.f), __builtin_amdgcn_fmed3f(o0[4 * a + 2] * i8, -440.f, 440.f), __builtin_amdgcn_fmed3f(o0[4 * a + 3] * i8, -440.f, 440.f));
            *(LAS unsigned*)(st + r32 * OST_PITCH + (32 + 8 * a + 4 * hi)) = pg8::pk4_fp8(__builtin_amdgcn_fmed3f(o1[4 * a] * i8, -440.f, 440.f), __builtin_amdgcn_fmed3f(o1[4 * a + 1] * i8, -440.f, 440.f), __builtin_amdgcn_fmed3f(o1[4 * a + 2] * i8, -440.f, 440.f), __builtin_amdgcn_fmed3f(o1[4 * a + 3] * i8, -440.f, 440.f)); }
        LDS_WAIT(); asm volatile("" ::: "memory");
#pragma unroll
        for (int i = 0; i < 2; ++i) { const int idx = lane + 64 * i, row = idx >> 2, c = idx & 3;
            const v4u v = *(const LAS v4u*)(st + row * OST_PITCH + c * 16);
            *(GAS v4u*)((unsigned char*)obase + (size_t)row * opitch + c * 16) = v; }
        LDS_WAIT(); asm volatile("" ::: "memory");
        return; }
#pragma unroll
    for (int a = 0; a < 4; ++a) {
        *(LAS v2u*)(st + r32 * OST_PITCH + (8 * a + 4 * hi) * 2) = (v2u){cvt_pk_bf16(o0[4 * a] * inv, o0[4 * a + 1] * inv), cvt_pk_bf16(o0[4 * a + 2] * inv, o0[4 * a + 3] * inv)};
        *(LAS v2u*)(st + r32 * OST_PITCH + (32 + 8 * a + 4 * hi) * 2) = (v2u){cvt_pk_bf16(o1[4 * a] * inv, o1[4 * a + 1] * inv), cvt_pk_bf16(o1[4 * a + 2] * inv, o1[4 * a + 3] * inv)}; }
    LDS_WAIT(); asm volatile("" ::: "memory");
#pragma unroll
    for (int i = 0; i < 4; ++i) { const int idx = lane + 64 * i, row = idx >> 3, c = idx & 7;
        const v4u v = *(const LAS v4u*)(st + row * OST_PITCH + c * 16);
        *(GAS v4u*)(obase + (size_t)row * opitch + c * 8) = v; }
    LDS_WAIT(); asm volatile("" ::: "memory");
}
template <bool OUT8 = false  >
__device__ __forceinline__ void mem_unit(LAS unsigned char* lds, const bf16* Q, int qpitch, const bf16* Kg, const bf16* Vg, bf16* O, int tid) {
    const int lane = tid & 63, wid = __builtin_amdgcn_readfirstlane(tid >> 6), r32 = lane & 31, hi = lane >> 5;
    att_stage(lds, Kg, 512, Vg, 2048, tid);
    float qv[4][8]; bf16x8 qf[4];
    att_load_q(Q + (size_t)(wid * 32 + r32) * qpitch + hi * 8, qv, qf);
    __syncthreads();
    f32x16 o0, o1; float l = 0.f;
#pragma unroll
    for (int r = 0; r < 16; ++r) { o0[r] = 0.f; o1[r] = 0.f; }
    att_block<0>(lds, qf, o0, o1, l, 4, 0, false, lane);
    if constexpr (OUT8) att_store_o<true>(lds, (bf16*)((unsigned char*)O + (size_t)(wid * 32) * 1024), 1024, o0, o1, l, lane, wid);
    else att_store_o(lds, O + (size_t)(wid * 32) * 1024, 1024, o0, o1, l, lane, wid);
    __syncthreads();
}
__device__ __forceinline__ void moba_unit(LAS unsigned char* lds, int b, int qh, int qblk, const bf16* KQ, const bf16* VT, const float* KMEANS, bf16* CAT, int tid) {
    const int lane = tid & 63, wid = __builtin_amdgcn_readfirstlane(tid >> 6), r32 = lane & 31, hi = lane >> 5, kvh = qh / 3;
    const size_t tok0 = (size_t)b * SEQ + (size_t)qblk * 256;
    att_stage(lds, KQ + tok0 * 1280 + kvh * 64, 1280, VT + (size_t)(kvh * 64) * T + tok0, T, tid);
    float qv[4][8]; bf16x8 qf[4];
    att_load_q(KQ + (tok0 + wid * 32 + r32) * 1280 + 256 + qh * 64 + hi * 8, qv, qf);
    unsigned sel = 0u;
    if (qblk > 0) {
        float gt[7];
#pragma unroll
        for (int j = 0; j < 7; ++j) { gt[j] = -3e38f;
            if (j < qblk) { const float* km = KMEANS + (size_t)((b * 4 + kvh) * 8 + j) * 64 + hi * 8; float a = 0.f;
#pragma unroll
                for (int d0 = 0; d0 < 4; ++d0) { const f32x4 k0 = *(const GAS f32x4*)(km + d0 * 16), k1 = *(const GAS f32x4*)(km + d0 * 16 + 4);
                    a += qv[d0][0] * k0[0] + qv[d0][1] * k0[1] + qv[d0][2] * k0[2] + qv[d0][3] * k0[3] + qv[d0][4] * k1[0] + qv[d0][5] * k1[1] + qv[d0][6] * k1[2] + qv[d0][7] * k1[3]; }
                a += __shfl_xor(a, 32); gt[j] = a; } }
#pragma unroll
        for (int j = 0; j < 7; ++j) { int rank = 0;
#pragma unroll
            for (int j2 = 0; j2 < 7; ++j2) if (j2 != j) rank += (gt[j2] > gt[j] || (gt[j2] == gt[j] && j2 < j)) ? 1 : 0;
            if (j < qblk && rank < 3) sel |= 1u << j; }
    }
    __syncthreads();
    f32x16 o0, o1; float l = 0.f;
#pragma unroll
    for (int r = 0; r < 16; ++r) { o0[r] = 0.f; o1[r] = 0.f; }
    att_block<1>(lds, qf, o0, o1, l, (wid >> 1) + 1, wid * 32 + r32, false, lane);
    for (int j = 0; j < qblk; ++j) {
        __syncthreads();
        { const size_t tk = (size_t)b * SEQ + (size_t)j * 256; att_stage(lds, KQ + tk * 1280 + kvh * 64, 1280, VT + (size_t)(kvh * 64) * T + tk, T, tid); }
        __syncthreads();
        const bool off = !((sel >> j) & 1u);
        if (!__all(off)) att_block<2>(lds, qf, o0, o1, l, 4, 0, off, lane);
    }
    att_store_o<true>(lds, (bf16*)((unsigned char*)CAT + (size_t)(tok0 + wid * 32) * 1024 + qh * 64), 1024, o0, o1, l, lane, wid);
    __syncthreads();
}

struct Args { const float* in[42]; float* out; unsigned char* ws; int ph_lo, ph_hi; };
constexpr int NPHASE = 21;
__global__ void __launch_bounds__(NTHREADS, 2) fwd_kernel(Args args) {
    extern __shared__ __attribute__((aligned(16))) unsigned char lds_raw[];
    LAS unsigned char* lds = (LAS unsigned char*)lds_raw;
    volatile LAS unsigned* MISC = (volatile LAS unsigned*)(lds + MISC_OFF);
    const int tid = threadIdx.x, lane = tid & 63, wave = __builtin_amdgcn_readfirstlane(tid >> 6);
    const int G = gridDim.x, bx = blockIdx.x;
    const int gw = bx * NWAVES + wave, NGW = G * NWAVES;
    unsigned char* ws = args.ws;
    gu32* ctl = (gu32*)(ws + WS_CTL);
    for (int u = tid; u < (LDS_BYTES - RING_BYTES) / 4; u += NTHREADS) ((LAS unsigned*)(lds + RING_BYTES))[u] = 0u;
    __syncthreads();
    const int lo = args.ph_lo, hi_ph = args.ph_hi;
    XcdBarrier bar; bar.bar = (unsigned*)(ctl + CW_BAR); bar.x = 0; bar.st = nullptr;
    if (hi_ph - lo > 1) bar = xcd_barrier_post((unsigned*)(ctl + CW_BAR), MISC + 8);
#define IN(k) (lo <= (k) && (k) < hi_ph)
#define SEAM(k) do { if (IN(k) && IN((k) + 1)) xcd_barrier(bar); } while (0)
    const float* const* in = args.in;
    float* OUT = args.out;
    bf16* W_MEMK = (bf16*)(ws + WS_WMEMK); bf16* W_MEMV = (bf16*)(ws + WS_WMEMV); bf16* W_KQ = (bf16*)(ws + WS_WKQ); bf16* W_V = (bf16*)(ws + WS_WV); bf16* W_OUT1 = (bf16*)(ws + WS_WOUT1);
    bf16* W_MGU = (bf16*)(ws + WS_WMGU); bf16* W_MD = (bf16*)(ws + WS_WMD);
    bf16* XB = (bf16*)(ws + WS_XB); bf16* CAT = (bf16*)(ws + WS_CAT); bf16* MEMN = (bf16*)(ws + WS_MEMN); bf16* MEMK = (bf16*)(ws + WS_MEMK); bf16* MEMVT = (bf16*)(ws + WS_MEMVT);
    bf16* XS = (bf16*)(ws + AR_XS); bf16* ACTM = (bf16*)(ws + AR_ACTM);
    bf16* W_IN0 = (bf16*)(ws + AR_WIN0); bf16* W_GLU = (bf16*)(ws + AR_WGLU); bf16* W_OUT0 = (bf16*)(ws + AR_WOUT0); bf16* W_FGU = (bf16*)(ws + AR_WFGU); bf16* W_FD = (bf16*)(ws + AR_WFD);
    bf16* TZ = (bf16*)(ws + AR_TZ); bf16* W1T = (bf16*)(ws + AR_W1T); bf16* UG = (bf16*)(ws + AR_UG); bf16* QM0 = (bf16*)(ws + AR_QM0); float* XC = (float*)(ws + AR_XC); bf16* GACT = (bf16*)(ws + AR_GACT);
    unsigned char* X8 = ws + AR_X8;
    float* S5SM = (float*)(ws + AR_S5SM);
    bf16* ACT0 = (bf16*)(ws + AR_ACT0); bf16* KQ = (bf16*)(ws + AR_KQ); bf16* VT = (bf16*)(ws + AR_VT);
    float* KMEANS = (float*)(ws + SM_KMEANS); float* LAM32 = (float*)(ws + SM_LAM32); int* PANEND = (int*)(ws + SM_PANEND);
    int* WGCNT = (int*)(ws + WS_MEMN + 3 * MiB);
    float* XSC = (float*)(ws + WS_SMALL + 896 * 1024);
    float* SS = (float*)(ws + WS_MEMN); float* ROWRS = (float*)(ws + WS_MEMN + MiB); float* TOKRS = (float*)(ws + WS_MEMN + 2 * MiB);
    int* TOKE = (int*)(ws + SM_TOKE); int* TOKLP = (int*)(ws + SM_TOKLP); float* TOKG = (float*)(ws + SM_TOKG); int* ROWTOK = (int*)(ws + SM_ROWTOK); float* ROWGATE = (float*)(ws + SM_ROWGATE);

    constexpr int I_SQ = 16 * 16, I_GLU = 12 * 12, I_M = 16 * 4, I_F = 16 * 44, I_FD = 44 * 16;
    constexpr int CVT_P0_END = I_SQ + 4 * I_M, CVT_P2_END = CVT_P0_END + I_GLU + 3 * I_SQ + 2 * I_M, NITEMS = CVT_P2_END + 2 * I_F + I_FD;
    static_assert(NITEMS == 4 * I_SQ + I_GLU + 6 * I_M + 2 * I_F + I_FD, "items");
#define CV_F8(NI, SRC, LDW, NPB, GAIN, DST, LDO, ROW0) if (r < (NI)) { const int kb = r / (NPB), n0 = (r % (NPB)) * 64; CvtDesc8 d; d.src = (SRC) + (size_t)(kb * 64) * (LDW) + n0; d.gain = (GAIN); d.dst = (unsigned char*)(DST) + (size_t)((ROW0) + n0) * (LDO) + kb * 64; d.ldw = (LDW); d.ldo = (LDO); d.k0 = kb * 64; \
                f32x4 a[4][4]; float gq[4][4]; cvt_load8(d, a, gq, MOE_WSCALE, lane); cvt_emit8(d, a, gq, scr, lane); continue; } r -= (NI);
#define CV_PLAIN(NI, SRC, LDW, NPB, GAIN, DST, LDO, ROW0) if (r < (NI)) { const int kb = r / (NPB), n0 = (r % (NPB)) * 64; cvt_item(SRC, LDW, kb * 64, n0, GAIN, DST, LDO, (ROW0) + n0, scr, lane); continue; } r -= (NI);
#define CVT_RUN(FIRST, STRIDE, HI) do { LAS unsigned* scr = (LAS unsigned*)(lds + wave * 16384);        \
            for (int it = (FIRST); it < (HI); it += (STRIDE)) { int r = it; \
            CV_PLAIN(I_SQ, in[3], 1024, 16, in[2], W_IN0, 1024, 0) \
            CV_PLAIN(I_M, in[15], 256, 4, in[14], W_MEMK, 1024, 0) \
            CV_PLAIN(I_M, in[32], 256, 4, in[31], W_MEMK, 1024, 256) \
            CV_PLAIN(I_M, in[16], 256, 4, in[14], W_MEMV, 1024, 0) \
            CV_PLAIN(I_M, in[33], 256, 4, in[31], W_MEMV, 1024, 256) \
            CV_PLAIN(I_GLU, in[12], 768, 12, nullptr, W_GLU, 768, 0) \
            CV_PLAIN(I_SQ, in[19], 1024, 16, nullptr, W_OUT0, 1024, 0) \
            CV_F8(I_SQ, in[29], 1024, 16, in[28], W_KQ, 1024, 256) \
            CV_F8(I_M, in[25], 256, 4, in[24], W_KQ, 1024, 0) \
            CV_F8(I_M, in[26], 256, 4, in[24], W_V, 1024, 0) \
            CV_F8(I_SQ, in[36], 1024, 16, nullptr, W_OUT1, 1024, 0) \
            if (r < 2 * I_F) { const int up = r / I_F; r -= up * I_F; const int kb = r / 44, n0 = (r % 44) * 64; \
                cvt_item(in[21 + up], DFF, kb * 64, n0, in[20], W_FGU, 1024, (n0 >> 7) * 256 + (n0 & 127) + up * 128, scr, lane); continue; } \
            r -= 2 * I_F; \
            CV_F8(I_FD, in[23], 1024, 16, nullptr, W_FD, DFF, 0) \
            } } while (0)
    if (IN(0)) {
        if (bx < 48) s5_tables_small(bx, lds, in[4], in[5], in[6], in[7], in[8], in[9], in[10], S5SM, LAM32, tid);
#define RMS_ROW(R_) do { const int r_ = (R_); if (r_ < T) rms_row_to_bf16(in[0] + (size_t)r_ * D, XB + (size_t)r_ * D, lane, XSC + r_); else rms_row_to_bf16(in[1] + (size_t)(r_ - T) * D, MEMN + (size_t)(r_ - T) * D, lane); } while (0)
        static_assert(T + NB * 256 == 10 * 1664 + 4 * 384 + 256, "row split");
        if (bx >= 48) { const int nw = (bx - 48) * NWAVES + wave;
            CVT_RUN(nw, 1664, CVT_P0_END);
            for (int q = 0; q < 10; ++q) RMS_ROW(10 * nw + q);
            if (nw < 256) RMS_ROW(18176 + nw); }
        else { const int tw = bx * NWAVES + wave;
            for (int q = 0; q < 4; ++q) RMS_ROW(16640 + 4 * tw + q); }
#undef RMS_ROW
        for (int i = bx * NTHREADS + tid; i < 2 * RROWS; i += G * NTHREADS) ROWTOK[i] = -1;
    }
    SEAM(0);
    if (IN(1)) { pg8::Gemm g{XB, W_IN0, 1024, 1024, 1024}; pg8::StaticOrder S; S.init(T / 256, 4, G, bx); pg8::EpiProj0 E{UG, QM0};
        pg8::gemm_phase<pg8::EpiProj0, pg8::StaticOrder, true, true>(lds, g, S, E);
        if (bx < 192) { const int sg = bx >> 2, sq = bx & 3; s5_load(sg, lds, S5SM, in[9], in[10], false, tid); s5_expand_w1t(sg, lds, W1T, sq * 32, sq * 32 + 32, tid); __syncthreads(); } }
    SEAM(1);
    if (IN(2)) {
        if (bx < 96) { pg8::Gemm g{UG, W1T, 640, 512, 512}; pg8::BatchOrder S; S.init(48, 2, 1, 96, bx); pg8::EpiS5a E{XC};
          pg8::gemm_phase<pg8::EpiS5a, pg8::BatchOrder, true, true>(lds, g, S, E);
          if (tid < 256) { const int g = bx >> 1, mt = bx & 1, bl = tid >> 6, p = tid & 63;
            const float lr = LAM32[(g * 64 + p) * 2], li = LAM32[(g * 64 + p) * 2 + 1]; float hr = 0.f, hi_ = 0.f;
            const size_t row0 = (size_t)g * 512 + mt * 256 + bl * 64;
            for (int cb = 0; cb < 64; cb += 16) { v2f_ xv[16];
#pragma unroll
                for (int k = 0; k < 16; ++k) xv[k] = *(const GAS v2f_*)(XC + (row0 + cb + k) * 128 + 2 * p);
#pragma unroll
                for (int k = 0; k < 16; ++k) { const int c = cb + k; const float xr = xv[k].x, xi = xv[k].y;
                    *(GAS unsigned*)(UG + (row0 + c) * 640 + 512 + 2 * p) = cvt_pk_bf16(hr, hi_);
                    const float nr = lr * hr - li * hi_ + xr, ni = lr * hi_ + li * hr + xi; hr = nr; hi_ = ni; } } } }
        else if (bx < 112) { pg8::Gemm g{MEMN, W_MEMK, 1024, 1024, 1024}; pg8::StaticOrder S; S.init(8, 2, 16, bx - 96); pg8::EpiPlain E{MEMK, 512, 0, 0};
          pg8::gemm_phase<pg8::EpiPlain, pg8::StaticOrder, true, true>(lds, g, S, E);
          pg8::Unit u; S.next(0, u); const int layer = u.pn; const float* kg = layer ? in[35] : in[18]; const float* qg = layer ? in[34] : in[17];
          const int c0 = lane * 4, d = c0 & 63; float gk[4];
#pragma unroll
          for (int e = 0; e < 4; ++e) gk[e] = kg[d + e] * qg[d + e];
          for (int rb = 0; rb < 32; rb += 8) { v2u wv[8];
#pragma unroll
              for (int k = 0; k < 8; ++k) wv[k] = *(const GAS v2u*)(MEMK + (size_t)(u.pm * 256 + wave * 32 + rb + k) * 512 + layer * 256 + c0);
#pragma unroll
              for (int k = 0; k < 8; ++k) { bf16* p = MEMK + (size_t)(u.pm * 256 + wave * 32 + rb + k) * 512 + layer * 256 + c0; const v2u w = wv[k];
                  float v[4] = {bf_lo(w.x), bf_hi(w.x), bf_lo(w.y), bf_hi(w.y)}; float ss = v[0] * v[0] + v[1] * v[1] + v[2] * v[2] + v[3] * v[3];
                  ss += __shfl_xor(ss, 1); ss += __shfl_xor(ss, 2); ss += __shfl_xor(ss, 4); ss += __shfl_xor(ss, 8);
                  const float r = 1.f / sqrtf(ss * (1.f / 64.f) + RMS_EPS);
                  *(GAS v2u*)p = (v2u){cvt_pk_bf16(v[0] * r * gk[0], v[1] * r * gk[1]), cvt_pk_bf16(v[2] * r * gk[2], v[3] * r * gk[3])}; } } }
        else if (bx < 128) { pg8::Gemm g{W_MEMV, MEMN, 1024, 1024, 1024}; pg8::StaticOrder S; S.init(2, 8, 16, bx - 112); pg8::EpiPlain E{MEMVT, 2048, 0, 0};
          pg8::gemm_phase<pg8::EpiPlain, pg8::StaticOrder, true, true>(lds, g, S, E); }
        else { int cur = -1;
          for (int it = (bx - 128) * 3; it < (bx - 128) * 3 + 3; ++it) { const int sg = it >> 3, part = it & 7;
              if (sg != cur) { __syncthreads(); s5_load(sg, lds, S5SM, in[9], in[10], true, tid); cur = sg; }
              s5_expand_tz(sg, lds, TZ, part * 64, part * 64 + 64, tid); }
          __syncthreads();
          CVT_RUN(CVT_P0_END + (bx - 128) * NWAVES + wave, 1024, CVT_P2_END); }
    }
    SEAM(2);
    if (IN(4)) {
        if (bx < 192) { pg8::Gemm g{UG, TZ, 640, 640, 640}; pg8::BatchOrder S; S.init(48, 2, 2, 192, bx); pg8::EpiS5c E{UG, in[11], GACT};
            pg8::gemm_phase<pg8::EpiS5c, pg8::BatchOrder, true, true>(lds, g, S, E); }
        for (;;) {
            if (tid == 0) MISC[0] = __hip_atomic_fetch_add((unsigned*)(ctl + CW_QUEUE + 128), 1u, __ATOMIC_RELAXED, __HIP_MEMORY_SCOPE_AGENT);
            __syncthreads();
            const int u = (int)MISC[0];
            __syncthreads();
            if (u >= 256) break;
            const int b = u >> 5, h = (u >> 3) & 3, qt = u & 7; const size_t t0 = (size_t)b * SEQ + qt * 256;
            mem_unit(lds, QM0 + t0 * 256 + h * 64, 256, MEMK + (size_t)(b * 256) * 512 + h * 64, MEMVT + (size_t)(h * 64) * 2048 + b * 256, CAT + t0 * 1024 + 768 + h * 64, tid); }
    }
    SEAM(4);
    if (IN(5)) { pg8::Gemm g{GACT, W_GLU, T, 768, 768, 1}; pg8::StaticOrder S; S.init(T / 256, 3, G, bx); pg8::EpiGlu E{GACT, in[13], CAT};
        pg8::gemm_phase<pg8::EpiGlu, pg8::StaticOrder, true, true>(lds, g, S, E);
        if (bx >= 192) CVT_RUN(CVT_P2_END + (bx - 192) * NWAVES + wave, 512, NITEMS); }
    SEAM(5);
    if (IN(6)) { pg8::Gemm g{CAT, W_OUT0, 1024, 1024, 1024}; pg8::StaticOrder S; S.init(T / 256, 4, G, bx); pg8::EpiResidB<true> E{XSC, XB, SS, 1.f, nullptr};
        pg8::gemm_phase<pg8::EpiResidB<true>, pg8::StaticOrder, true, true>(lds, g, S, E); }
    SEAM(6);
    if (IN(8)) {
        pg8::Gemm g{XB, W_FGU, 1024, 1024, 1024}; pg8::EpiSwiglu<1, true> E{ACT0, DFF, 22, 0, SS, MOE_ASCALE};
        const int slot = (bx >> 3) & 3, n1 = (slot == 0) ? 0 : (slot == 1) ? 1 : (slot == 2) ? 3 : 4;
        { pg8::RangeOrder S; S.S.init(T / 256, 22, G, bx); S.i0 = 0; S.i1 = n1; pg8::gemm_phase<pg8::EpiSwiglu<1, true>, pg8::RangeOrder, true, true>(lds, g, S, E); }
        { LAS unsigned* scr = (LAS unsigned*)(lds + wave * 16384);
          constexpr int I_E = (1024 / 64) * (DFE / 64), I_ED = (DFE / 64) * (1024 / 64), I_MOE = NEXP * (2 * I_E + I_ED), SHARE = (I_MOE + 255) / 256;
#define MOE_DESC(D_, IT_) do { int r = (IT_); const int e = r / (2 * I_E + I_ED); r -= e * (2 * I_E + I_ED); \
              if (r < 2 * I_E) { const int up = r / I_E; r -= up * I_E; const int kb = r / (DFE / 64), n0 = (r % (DFE / 64)) * 64; \
                  (D_).src = in[39 + up] + (size_t)e * 1024 * DFE + (size_t)(kb * 64) * DFE + n0; (D_).ldw = DFE; (D_).gain = in[37]; (D_).k0 = kb * 64; (D_).ldo = 1024; \
                  (D_).dst = (unsigned char*)W_MGU + (size_t)(e * 7168 + (n0 >> 7) * 256 + (n0 & 127) + up * 128) * 1024 + kb * 64; } \
              else { r -= 2 * I_E; const int kb = r / 16, n0 = (r % 16) * 64; \
                  (D_).src = in[41] + (size_t)e * DFE * 1024 + (size_t)(kb * 64) * 1024 + n0; (D_).ldw = 1024; (D_).gain = nullptr; (D_).k0 = kb * 64; (D_).ldo = DFE; \
                  (D_).dst = (unsigned char*)W_MD + (size_t)(e * 1024 + n0) * DFE + kb * 64; } } while (0)
          static_assert(SHARE == 84 && I_MOE == 256 * 84, "share sizes");
          const int it_beg = (bx < 128) ? bx * 72 : 128 * 72 + (bx - 128) * 96, it_end = it_beg + ((bx < 128) ? 72 : 96);
          for (int it = it_beg + wave; it < it_end; it += NWAVES) { CvtDesc8 d0; f32x4 a0[4][4]; float g0[4][4]; MOE_DESC(d0, it); cvt_load8_dma(d0, a0, g0, MOE_WSCALE, (LAS unsigned char*)scr, lane); cvt_emit8(d0, a0, g0, scr, lane); }
#undef MOE_DESC
          __syncthreads(); }
        { pg8::RangeOrder S; S.S.init(T / 256, 22, G, bx); S.i0 = n1; S.i1 = 1 << 20; pg8::gemm_phase<pg8::EpiSwiglu<1, true>, pg8::RangeOrder, true, true>(lds, g, S, E); }
    }
    SEAM(8);
    if (IN(9)) { pg8::Gemm g{ACT0, W_FD, DFF / 2, DFF / 2, DFF / 2}; pg8::StaticOrder S; S.init(T / 256, 4, G, bx); pg8::EpiResidB<false, true> E{nullptr, XB, SS, 1.f / (MOE_WSCALE * MOE_ASCALE), X8};
        pg8::gemm_phase<pg8::EpiResidB<false, true>, pg8::StaticOrder, true, true, true>(lds, g, S, E); }
    SEAM(9);
    if (IN(11)) {
        { pg8::Gemm g{(bf16*)X8, W_KQ, 512, 512, 512}; pg8::StaticOrder S; S.init(T / 256, 5, G, bx); pg8::EpiPlainS<1> E{KQ, 1280, 0, 0, SS, 1.f / (MOE_WSCALE * 8.f)};
          pg8::gemm_phase<pg8::EpiPlainS<1>, pg8::StaticOrder, true, true, true>(lds, g, S, E);
          pg8::Unit u;
          for (int i = 0; S.next(i, u); ++i) if (u.pn == 0) {
            const int b = u.pm >> 3, blk = u.pm & 7; const size_t t0 = (size_t)u.pm * 256;
            const int c0 = lane * 4, d = c0 & 63; float gk[4], cs[4] = {0.f, 0.f, 0.f, 0.f};
#pragma unroll
            for (int e = 0; e < 4; ++e) gk[e] = in[27][d + e] * in[30][d + e];
            for (int rb = 0; rb < 32; rb += 8) { v2u wv[8];
#pragma unroll
                for (int k = 0; k < 8; ++k) wv[k] = *(const GAS v2u*)(KQ + (t0 + wave * 32 + rb + k) * 1280 + c0);
#pragma unroll
                for (int k = 0; k < 8; ++k) { bf16* p = KQ + (t0 + wave * 32 + rb + k) * 1280 + c0; const v2u w = wv[k];
                    float v[4] = {bf_lo(w.x), bf_hi(w.x), bf_lo(w.y), bf_hi(w.y)}; float ss = v[0] * v[0] + v[1] * v[1] + v[2] * v[2] + v[3] * v[3];
                    ss += __shfl_xor(ss, 1); ss += __shfl_xor(ss, 2); ss += __shfl_xor(ss, 4); ss += __shfl_xor(ss, 8);
                    const float r = 1.f / sqrtf(ss * (1.f / 64.f) + RMS_EPS);
#pragma unroll
                    for (int e = 0; e < 4; ++e) { v[e] *= r * gk[e]; cs[e] += v[e]; }
                    *(GAS v2u*)p = (v2u){cvt_pk_bf16(v[0], v[1]), cvt_pk_bf16(v[2], v[3])}; } }
            LAS float* red = (LAS float*)lds;
#pragma unroll
            for (int e = 0; e < 4; ++e) red[wave * 256 + c0 + e] = cs[e];
            __syncthreads();
            if (tid < 256) { float sm = 0.f;
#pragma unroll
                for (int w = 0; w < 8; ++w) sm += red[w * 256 + tid];
                KMEANS[(size_t)((b * 4 + (tid >> 6)) * 8 + blk) * 64 + (tid & 63)] = sm * (1.f / 256.f); }
            __syncthreads(); } }
        { pg8::Gemm g{W_V, (bf16*)X8, 512, 512, 512}; pg8::StaticOrder S; S.init(1, T / 256, 64, bx - 64); pg8::EpiPlainS<2> E{VT, T, 0, 0, SS, 1.f / (MOE_WSCALE * 8.f)};
          if (bx >= 64) pg8::gemm_phase<pg8::EpiPlainS<2>, pg8::StaticOrder, true, true, true>(lds, g, S, E); }
    }
    SEAM(11);

    if (IN(13)) {
        for (;;) {
            if (tid == 0) MISC[0] = __hip_atomic_fetch_add((unsigned*)(ctl + CW_QUEUE), 1u, __ATOMIC_RELAXED, __HIP_MEMORY_SCOPE_AGENT);
            __syncthreads();
            const int it = (int)MISC[0];
            __syncthreads();
            if (it >= 1024) break;
            if (it < 768) { const int qblk = 7 - it / 96, r = it % 96; moba_unit(lds, r / 12, r % 12, qblk, KQ, VT, KMEANS, CAT, tid); }
            else { const int u = it - 768, b = u >> 5, h = (u >> 3) & 3, qt = u & 7; const size_t t0 = (size_t)b * SEQ + qt * 256;
                mem_unit<true>(lds, KQ + t0 * 1280 + 1024 + h * 64, 1280, MEMK + (size_t)(b * 256) * 512 + 256 + h * 64, MEMVT + (size_t)(256 + h * 64) * 2048 + b * 256, (bf16*)((unsigned char*)CAT + t0 * 1024 + 768 + h * 64), tid); }
        }
    }
    SEAM(13);
    if (IN(14)) { pg8::Gemm g{CAT, W_OUT1, 512, 512, 512}; pg8::StaticOrder S; S.init(T / 256, 4, G, bx); pg8::EpiResidB<false> E{nullptr, XB, SS, 1.f / (MOE_WSCALE * 8.f), nullptr};
        pg8::gemm_phase<pg8::EpiResidB<false>, pg8::StaticOrder, true, true, true>(lds, g, S, E); }
    SEAM(14);
    if (IN(15)) {
        LAS float* wrt = (LAS float*)lds;
        LAS int* el = (LAS int*)(lds + 32768);
        for (int i = tid; i < 8192; i += NTHREADS) { const int k = i >> 3, e = i & 7; wrt[e * 1024 + k] = in[37][k] * in[38][i]; }
        __syncthreads();
        const int tpw = T / G;
        for (int tl = wave; tl < tpw; tl += NWAVES) { const int t = bx * tpw + tl;
            const GAS v2u* xr = (const GAS v2u*)(XB + (size_t)t * D) + lane; f32x4 v[4]; float s = 0.f;
#pragma unroll
            for (int j = 0; j < 4; ++j) { const v2u w = xr[64 * j]; v[j] = (f32x4){bf_lo(w.x), bf_hi(w.x), bf_lo(w.y), bf_hi(w.y)}; s += (v[j].x * v[j].x + v[j].y * v[j].y) + (v[j].z * v[j].z + v[j].w * v[j].w); }
            const float r = 1.f / sqrtf(wave_sum(s) * (1.f / 1024.f) + RMS_EPS);
#pragma unroll
            for (int j = 0; j < 4; ++j) v[j] = v[j] * r;
            float lg[8];
#pragma unroll
            for (int e = 0; e < 8; ++e) { float a = 0.f;
#pragma unroll
                for (int j = 0; j < 4; ++j) { const f32x4 w = *(const LAS f32x4*)(wrt + e * 1024 + 256 * j + 4 * lane); a += v[j].x * w.x + v[j].y * w.y + v[j].z * w.z + v[j].w * w.w; }
                lg[e] = wave_sum(a); }
            int i0 = 0; float v0 = lg[0];
#pragma unroll
            for (int e = 1; e < 8; ++e) if (lg[e] > v0) { v0 = lg[e]; i0 = e; }
            int i1 = -1; float v1 = -3e38f;
#pragma unroll
            for (int e = 0; e < 8; ++e) if (e != i0 && lg[e] > v1) { v1 = lg[e]; i1 = e; }
            const float e1 = __expf(v1 - v0), g0 = 1.f / (1.f + e1), g1 = e1 * g0;
            if (lane == 0) { el[tl] = i0 * 8 + i1; TOKE[2 * t] = i0; TOKE[2 * t + 1] = i1; TOKG[2 * t] = g0; TOKG[2 * t + 1] = g1; TOKRS[t] = r; } }
        __syncthreads();
        if (tid < tpw) { const int pd = el[tid]; int lp = 0; for (int j = 0; j < tid; ++j) lp += (el[j] == pd) ? 1 : 0; TOKLP[(size_t)bx * tpw + tid] = lp; }
        if (tid >= 64 && tid < 128) { const int pd = tid - 64; int n = 0; for (int j = 0; j < tpw; ++j) n += (el[j] == pd) ? 1 : 0; WGCNT[bx * 64 + pd] = n; }
        __syncthreads();
    }
    SEAM(15);
    if (IN(16)) {
        LAS int* tab = (LAS int*)lds; LAS int* Cp = tab + 16384; LAS int* PRE = Cp + 64; LAS int* Fp = PRE + 64; LAS int* bAu = Fp + 64; LAS int* bAf = bAu + 64; LAS int* bBu = bAf + 64; LAS int* bBf = bBu + 64;
        LAS int* offA = bBf + 64; LAS int* offB = offA + 8; LAS int* UA = offB + 8; LAS int* VB = UA + 8;
        for (int i = tid; i < G * 64; i += NTHREADS) tab[i] = WGCNT[i];
        __syncthreads();
        if (tid < 64) { int tot = 0, pre = 0; for (int w = 0; w < G; ++w) { const int v = tab[w * 64 + tid]; if (w < bx) pre += v; tot += v; } Cp[tid] = tot; PRE[tid] = pre; Fp[tid] = 0; }
        __syncthreads();
        if (tid == 0) {
            int n0[8], rr[8], sup[8], dem[8]; int srem = 0;
            for (int e = 0; e < 8; ++e) { int n = 0; for (int b2 = 0; b2 < 8; ++b2) n += Cp[e * 8 + b2]; n0[e] = n; rr[e] = n & 255; srem += rr[e]; sup[e] = rr[e]; dem[e] = 0; }
            const int mup = srem >> 8;
            for (int it = 0; it < mup; ++it) { int be = -1, bv = -1; for (int e = 0; e < 8; ++e) if (dem[e] == 0 && sup[e] > bv) { bv = sup[e]; be = e; }
                if (be >= 0) { dem[be] = 256 - rr[be]; sup[be] = 0; } }
            for (int a = 0; a < 8; ++a) for (int b2 = 0; b2 < 8; ++b2) if (a != b2 && sup[a] > 0 && dem[b2] > 0) { int f = sup[a] < dem[b2] ? sup[a] : dem[b2]; if (Cp[a * 8 + b2] < f) f = Cp[a * 8 + b2];
                Fp[a * 8 + b2] = f; sup[a] -= f; dem[b2] -= f; }
            int oa = 0, ob = 0;
            for (int e = 0; e < 8; ++e) { int ua = 0, vb = 0, fin = 0, fout = 0;
                for (int x = 0; x < 8; ++x) { ua += Cp[e * 8 + x] - Fp[e * 8 + x]; vb += Cp[x * 8 + e] - Fp[x * 8 + e]; fin += Fp[x * 8 + e]; fout += Fp[e * 8 + x]; }
                UA[e] = ua; VB[e] = vb; offA[e] = oa * 256; offB[e] = ob * 256; oa += (ua + fin + 255) >> 8; ob += (vb + fout + 255) >> 8;
                if (bx == 0) { PANEND[e] = oa; PANEND[8 + e] = ob; } }
        }
        __syncthreads();
        if (tid < 64) { const int a = tid >> 3, b2 = tid & 7; int s1 = 0, s2 = 0, s3 = 0, s4 = 0;
            for (int x = 0; x < b2; ++x) { s1 += Cp[a * 8 + x] - Fp[a * 8 + x]; s4 += Fp[a * 8 + x]; }
            for (int x = 0; x < a; ++x) { s2 += Fp[x * 8 + b2]; s3 += Cp[x * 8 + b2] - Fp[x * 8 + b2]; }
            bAu[tid] = offA[a] + s1 - Fp[tid]; bAf[tid] = offA[b2] + UA[b2] + s2; bBu[tid] = offB[b2] + s3 - Fp[tid]; bBf[tid] = offB[a] + VB[a] + s4; }
        __syncthreads();
        const int tpw = T / G;
        for (int tl = wave; tl < tpw; tl += NWAVES) { const int t = bx * tpw + tl;
            const int pd = TOKE[2 * t] * 8 + TOKE[2 * t + 1], q = PRE[pd] + TOKLP[(size_t)bx * tpw + tl]; const bool fl = q < Fp[pd];
            const int rowA = q + (fl ? bAf[pd] : bAu[pd]), rowB = q + (fl ? bBf[pd] : bBu[pd]);
            const float rs_ = TOKRS[t];
            if (lane == 0) { ROWTOK[rowA] = t; ROWGATE[rowA] = TOKG[2 * t + (fl ? 1 : 0)]; ROWRS[rowA] = rs_;
                             ROWTOK[RROWS + rowB] = t; ROWGATE[RROWS + rowB] = TOKG[2 * t + (fl ? 0 : 1)]; ROWRS[RROWS + rowB] = rs_; }
            const GAS v4u* src = (const GAS v4u*)(XB + (size_t)t * D);
            GAS v2u* dA = (GAS v2u*)((unsigned char*)XS + (size_t)rowA * D); GAS v2u* dB = (GAS v2u*)((unsigned char*)XS + ((size_t)RROWS + rowB) * D);
#pragma unroll
            for (int h = 0; h < 2; ++h) { const v4u w = src[64 * h + lane];
                const v2u o = (v2u){pg8::pk4_fp8(bf_lo(w.x) * rs_, bf_hi(w.x) * rs_, bf_lo(w.y) * rs_, bf_hi(w.y) * rs_), pg8::pk4_fp8(bf_lo(w.z) * rs_, bf_hi(w.z) * rs_, bf_lo(w.w) * rs_, bf_hi(w.w) * rs_)};
                dA[64 * h + lane] = o; dB[64 * h + lane] = o; } }
        __syncthreads();
    }
    SEAM(16);
#define MOE_ROUND(PH, KK, FIRST_) \
    if (IN(PH)) { pg8::GroupOrder S; for (int e = 0; e < 8; ++e) S.pe[e] = PANEND[(KK) * 8 + e]; S.npe = 28; S.S.init(S.pe[7], 28, G, bx); \
        pg8::Gemm g{XS + (size_t)(KK) * RROWS * (D / 2), W_MGU, 512, 512, 512}; pg8::EpiSwigluF8 E{(unsigned char*)ACTM + (size_t)(KK) * RROWS * DFE, DFE, 28, 0, 1.f / MOE_WSCALE, MOE_ASCALE}; \
        pg8::gemm_phase<pg8::EpiSwigluF8, pg8::GroupOrder, true, true, true>(lds, g, S, E); } \
    SEAM(PH); \
    if (IN((PH) + 1)) { volatile LAS unsigned* tb = MISC + 16; \
        if (tid < 8) tb[tid] = (unsigned)PANEND[(KK) * 8 + tid]; \
        if (tid == 8) { const int npan = PANEND[(KK) * 8 + 7]; const int nun = npan * 4, tl = nun - G; \
            tb[8] = (unsigned)nun; tb[9] = (tl <= G / 4) ? 4u : (tl <= G / 2) ? 2u : 1u; tb[10] = (unsigned)npan; tb[11] = (unsigned)bx; tb[12] = 8u; tb[13] = 4u; tb[14] = (unsigned)(DFE / 128); tb[15] = (unsigned)G; \
            const unsigned long long sl = (unsigned long long)((KK) == 0 ? (unsigned char*)CAT : (unsigned char*)XS + 36 * MiB), fl = (unsigned long long)(unsigned*)(ctl + CW_SKFLAG + (KK) * 256 * 64); \
            tb[16] = (unsigned)sl; tb[17] = (unsigned)(sl >> 32); tb[18] = (unsigned)fl; tb[19] = (unsigned)(fl >> 32); } \
        __syncthreads(); \
        pg8::GroupStream S; S.tab = (const LAS unsigned*)(lds + MISC_OFF + 64); \
        pg8::Gemm g{ACTM + (size_t)(KK) * RROWS * (DFE / 2), W_MD, DFE / 2, DFE / 2, DFE / 2}; pg8::EpiMoeDown<FIRST_> E{OUT, ROWTOK + (KK) * RROWS, ROWGATE + (KK) * RROWS, 0, XB, 1.f / (MOE_WSCALE * MOE_ASCALE)}; \
        pg8::gemm_phase<pg8::EpiMoeDown<FIRST_>, pg8::GroupStream, true, true, true>(lds, g, S, E); }
    MOE_ROUND(17, 1, true)
    MOE_ROUND(19, 0, false)

#undef IN
#undef SEAM
}

extern "C" void kernel_launch(void* const* d_in, const int* in_sizes, int n_in, void* d_out, int out_size, void* d_ws, size_t ws_size, hipStream_t stream) {
    static int grid = 0;
    if (grid == 0) {
        if (n_in != 42 || in_sizes[0] != T * D || out_size != T * D || ws_size < WS_END) { fprintf(stderr, "kernel_launch: unexpected shapes (n_in %d, in0 %d, out %d, ws %zu < %zu); nothing launched\n", n_in, n_in > 0 ? in_sizes[0] : -1, out_size, ws_size, (size_t)WS_END); grid = -1; return; }
        int dev = 0, cus = 0, per_cu = 0;
        if (hipGetDevice(&dev) != hipSuccess || hipDeviceGetAttribute(&cus, hipDeviceAttributeMultiprocessorCount, dev) != hipSuccess) { grid = -1; return; }
        if (hipFuncSetAttribute((const void*)fwd_kernel, hipFuncAttributeMaxDynamicSharedMemorySize, LDS_BYTES) != hipSuccess) { fprintf(stderr, "kernel_launch: hipFuncSetAttribute failed\n"); grid = -1; return; }
        if (hipOccupancyMaxActiveBlocksPerMultiprocessor(&per_cu, (const void*)fwd_kernel, NTHREADS, LDS_BYTES) != hipSuccess || per_cu < 1) { fprintf(stderr, "kernel_launch: occupancy query reports %d\n", per_cu); }
        (void)hipGetLastError();
        grid = 256;
        if (cus < 256) { fprintf(stderr, "kernel_launch: device has %d CUs, need 256\n", cus); grid = -1; return; }
    }
    if (grid < 0) return;
    if (hipMemsetAsync((char*)d_ws + WS_CTL, 0, CTL_ZERO_BYTES, stream) != hipSuccess) return;
    Args a{};
    for (int i = 0; i < 42; ++i) a.in[i] = (const float*)d_in[i];
    a.out = (float*)d_out; a.ws = (unsigned char*)d_ws;
#ifdef MK_SPLIT
    for (int p = 0; p < NPHASE; ++p) { a.ph_lo = p; a.ph_hi = p + 1; hipLaunchKernelGGL(fwd_kernel, dim3(grid), dim3(NTHREADS), LDS_BYTES, stream, a); }
#else
#ifndef STOP_AFTER
#define STOP_AFTER (NPHASE - 1)
#endif
    a.ph_lo = 0; a.ph_hi = STOP_AFTER + 1;
    hipLaunchKernelGGL(fwd_kernel, dim3(grid), dim3(NTHREADS), LDS_BYTES, stream, a);
#endif
}
```
